# Optimizing an MI355X kernel written in HIP

```python
import math
import jax, jax.numpy as jnp
from jax import lax
import numpy as np

D_MODEL = 2048
BATCH = 8
SEQ = 2048
DEPTH = 2

CTX_LEN = 256
GRID_W = 64
F32 = jnp.float32
EPS = 1e-6
N_MOD = 9
FFN_RESIDUAL = 0.5
D_FF = 5632
N_BRANCH = 4
BRANCH_W = 512
HEAD_DIM = 128
SG_GROUPS = 4
SG_CHUNK = 128
ML_HEADS = 4
ML_CHUNK = 128
GD_HEADS = 4
GD_CHUNK = 64
GD_CONV = 3
AT_Q_HEADS = 4
AT_KV_HEADS = 2
AT_BLOCK = 128
ROPE_THETA = 10000.0

COLS = (
    ("ml_kv", 2 * BRANCH_W),
    ("ml_if", 4 * ML_HEADS),
    ("gd_kv", 2 * BRANCH_W),
    ("gd_ba", 4 * GD_HEADS),
    ("at_kv", 2 * AT_KV_HEADS * HEAD_DIM),
    ("sg_uv", 2 * BRANCH_W),
    ("ml_q", BRANCH_W),
    ("ml_o", BRANCH_W),
    ("gd_q", BRANCH_W),
    ("gd_z", BRANCH_W),
    ("at_q", AT_Q_HEADS * HEAD_DIM),
    ("gate", N_BRANCH * D_MODEL),
)
KV_COLS = 2 * BRANCH_W + 4 * ML_HEADS + 2 * BRANCH_W + 4 * GD_HEADS + 2 * AT_KV_HEADS * HEAD_DIM
IN_COLS = KV_COLS + 2 * BRANCH_W + 5 * BRANCH_W + N_BRANCH * D_MODEL

kernel_name = "hybrid_gated_branch_dit_block"


def _col(z, name):
    off = 0
    for n, w in COLS:
        if n == name:
            return z[..., off:off + w]
        off += w
    raise KeyError(name)


def rms_norm(x, g):
    xf = x.astype(F32)
    y = xf * lax.rsqrt(jnp.mean(xf * xf, axis=-1, keepdims=True) + EPS)
    return (y * g.astype(F32)).astype(x.dtype)


def _l2norm(x):
    return x * lax.rsqrt(jnp.sum(x * x, axis=-1, keepdims=True) + EPS)


def modulate(h, shift, scale):
    return h * (1.0 + scale) + shift


def swiglu(h, w_in, w_out):
    a, b = jnp.split(h @ w_in, 2, axis=-1)
    return (jax.nn.silu(a) * b) @ w_out


def _heads(t, n_heads):
    Bn, T, W = t.shape
    return t.reshape(Bn, T, n_heads, W // n_heads).transpose(0, 2, 1, 3)


def _dwconv(x, w):
    K, C = w.shape
    return lax.conv_general_dilated(
        x, w[:, None, :].astype(x.dtype), window_strides=(1,), padding=[(K // 2, K // 2)],
        dimension_numbers=("NWC", "WIO", "NWC"), feature_group_count=C)


def axial_rope_tables(rows):
    n = HEAD_DIM // 4
    inv = ROPE_THETA ** (-jnp.arange(n, dtype=F32) / n)
    r = jnp.repeat(jnp.arange(rows, dtype=F32), GRID_W)
    cl = jnp.tile(jnp.arange(GRID_W, dtype=F32), rows)
    ar = r[:, None] * inv
    ac = cl[:, None] * inv
    return (jnp.cos(ar), jnp.sin(ar), jnp.cos(ac), jnp.sin(ac))


def _rope_1d(x, cos, sin):
    x1, x2 = jnp.split(x, 2, axis=-1)
    return jnp.concatenate([x1 * cos - x2 * sin, x2 * cos + x1 * sin], axis=-1)


def axial_rope(x, tabs):
    cos_r, sin_r, cos_c, sin_c = tabs
    e = lambda t: t[None, :, None, :]
    xr, xc = jnp.split(x.astype(F32), 2, axis=-1)
    y = jnp.concatenate([_rope_1d(xr, e(cos_r), e(sin_r)), _rope_1d(xc, e(cos_c), e(sin_c))], axis=-1)
    return y.astype(x.dtype)


def spatial_gating(z_uv, norm_g, w_s, b_s):
    Bn, T, _ = z_uv.shape
    u, v = jnp.split(jax.nn.gelu(z_uv), 2, axis=-1)
    v = rms_norm(v, norm_g)
    v = v.reshape(Bn, T // SG_CHUNK, SG_CHUNK, SG_GROUPS, BRANCH_W // SG_GROUPS)
    s = jnp.einsum("gts,bnsgc->bntgc", w_s.astype(v.dtype), v) + b_s.T[None, None, :, :, None]
    return u * s.reshape(Bn, T, BRANCH_W)


def _bidir(scan_fn, q, k, v, a_fw, b_fw, a_bw, b_bw, st_fw, st_bw, with_out):
    out_f, fin_f = scan_fn(q, k, v, a_fw, b_fw, st_fw, with_out)
    fl = lambda t: None if t is None else jnp.flip(t, axis=2)
    out_b, fin_b = scan_fn(fl(q), fl(k), fl(v), jnp.flip(a_bw, -1), jnp.flip(b_bw, -1), st_bw, with_out)
    out = (out_f + jnp.flip(out_b, axis=2)) if with_out else None
    return out, fin_f, fin_b


def mlstm_scan(q, k, v, logi, logf, state, with_out=True):
    Bn, H, T, d = k.shape
    L = ML_CHUNK
    N = T // L
    ch = lambda t: t.reshape(Bn, H, N, L, *t.shape[3:])
    k = ch(k) * (d ** -0.5)
    v = ch(v)
    li = ch(logi)
    lf = ch(logf)
    b = jnp.cumsum(lf, axis=-1)
    b_end = b[..., -1]
    a = b_end[..., None] - b + li
    m_loc = jnp.max(a, axis=-1)
    wgt = jnp.exp(a - m_loc[..., None])
    C_loc = jnp.einsum("bhnl,bhnle,bhnld->bhned", wgt, v, k)
    n_loc = jnp.einsum("bhnl,bhnld->bhnd", wgt, k)

    def step(carry, xs):
        C, n, m = carry
        Cl, nl, ml, be = xs
        m_new = jnp.maximum(be + m, ml)
        sp = jnp.exp(be + m - m_new)
        sl = jnp.exp(ml - m_new)
        new = (sp[..., None, None] * C + sl[..., None, None] * Cl, sp[..., None] * n + sl[..., None] * nl, m_new)
        return new, (carry if with_out else None)

    mv = lambda t: jnp.moveaxis(t, 2, 0)
    final, prev = lax.scan(step, state, (mv(C_loc), mv(n_loc), mv(m_loc), mv(b_end)))
    if not with_out:
        return None, final
    C_prev, n_prev, m_prev = (jnp.moveaxis(t, 0, 2) for t in prev)
    q = ch(q)
    incl = jnp.tril(jnp.ones((L, L), dtype=bool))
    Dm = jnp.where(incl, b[..., :, None] - b[..., None, :] + li[..., None, :], -jnp.inf)
    g = b + m_prev[..., None]
    m_t = jnp.maximum(jnp.max(Dm, axis=-1), g)
    P = jnp.exp(Dm - m_t[..., None]) * jnp.einsum("bhntd,bhnsd->bhnts", q, k)
    inter = jnp.exp(g - m_t)
    num = jnp.einsum("bhnts,bhnse->bhnte", P, v) + inter[..., None] * jnp.einsum("bhned,bhntd->bhnte", C_prev, q)
    den = jnp.sum(P, axis=-1) + inter * jnp.einsum("bhnd,bhntd->bhnt", n_prev, q)
    h = num / jnp.maximum(jnp.abs(den), jnp.exp(-m_t))[..., None]
    return h.reshape(Bn, H, T, d), final


def mlstm_branch(zc, zl, p, ctx_out):
    def prep(z, with_q):
        k, v = jnp.split(_col(z, "ml_kv"), 2, axis=-1)
        k = _heads(k, ML_HEADS).astype(F32)
        v = _heads(v, ML_HEADS).astype(F32)
        pre = (_col(z, "ml_if") + p["ml_if_bias"]).astype(F32)
        Bn, T, _ = pre.shape
        pre = pre.reshape(Bn, T, 4, ML_HEADS).transpose(2, 0, 3, 1)
        gates = (pre[0], jax.nn.log_sigmoid(pre[2]), pre[1], jax.nn.log_sigmoid(pre[3]))
        q = _heads(_col(z, "ml_q"), ML_HEADS).astype(F32) if with_q else None
        return q, k, v, gates

    def out(h, z):
        Bn, H, T, d = h.shape
        h = rms_norm(h.transpose(0, 2, 1, 3), p["ml_norm"].reshape(ML_HEADS, HEAD_DIM))
        return (jax.nn.sigmoid(_col(z, "ml_o").astype(F32)) * h.reshape(Bn, T, H * d)).astype(z.dtype)

    qc, kc, vc, gc = prep(zc, ctx_out)
    Bn = kc.shape[0]
    zero = (jnp.zeros((Bn, ML_HEADS, HEAD_DIM, HEAD_DIM), F32), jnp.zeros((Bn, ML_HEADS, HEAD_DIM), F32),
            jnp.zeros((Bn, ML_HEADS), F32))
    hc, st_fw, st_bw = _bidir(mlstm_scan, qc, kc, vc, *gc, zero, zero, ctx_out)
    ql, kl, vl, gl = prep(zl, True)
    hl, _, _ = _bidir(mlstm_scan, ql, kl, vl, *gl, st_fw, st_bw, True)
    return (out(hc, zc) if ctx_out else None), out(hl, zl)


def gdn_scan(q, k, v, g, beta, S0, with_out=True):
    Bn, H, T, d = k.shape
    L = GD_CHUNK
    N = T // L
    ch = lambda t: t.reshape(Bn, H, N, L, *t.shape[3:])
    k, v, g, beta = ch(k), ch(v), ch(g), ch(beta)
    gc = jnp.cumsum(g, axis=-1)
    incl = jnp.tril(jnp.ones((L, L), dtype=bool))
    decay = jnp.exp(jnp.where(incl, gc[..., :, None] - gc[..., None, :], -jnp.inf))
    kb = k * beta[..., None]
    M = jnp.tril(jnp.einsum("bhnid,bhnjd->bhnij", kb, k) * decay, -1)
    eye = jnp.eye(L, dtype=M.dtype)
    Tinv = lax.linalg.triangular_solve(M + eye, jnp.broadcast_to(eye, M.shape), left_side=True,
                                       lower=True, unit_diagonal=True)
    u = jnp.einsum("bhnij,bhnjd->bhnid", Tinv, v * beta[..., None])
    w = jnp.einsum("bhnij,bhnjd->bhnid", Tinv, kb * jnp.exp(gc)[..., None])
    k_end = k * jnp.exp(gc[..., -1:] - gc)[..., None]
    g_end = jnp.exp(gc[..., -1])
    mv = lambda t: jnp.moveaxis(t, 2, 0)
    if with_out:
        q = ch(q) * (d ** -0.5)
        qk = jnp.einsum("bhnid,bhnjd->bhnij", q, k) * decay
        q_dec = q * jnp.exp(gc)[..., None]

        def step(S, xs):
            u_n, w_n, ke_n, ge_n, qk_n, qd_n = xs
            v_new = u_n - jnp.einsum("bhld,bhde->bhle", w_n, S)
            o = jnp.einsum("bhld,bhde->bhle", qd_n, S) + jnp.einsum("bhij,bhje->bhie", qk_n, v_new)
            S = S * ge_n[..., None, None] + jnp.einsum("bhld,bhle->bhde", ke_n, v_new)
            return S, o

        S_fin, o = lax.scan(step, S0, (mv(u), mv(w), mv(k_end), mv(g_end), mv(qk), mv(q_dec)))
        return jnp.moveaxis(o, 0, 2).reshape(Bn, H, T, d), S_fin

    def step_state(S, xs):
        u_n, w_n, ke_n, ge_n = xs
        v_new = u_n - jnp.einsum("bhld,bhde->bhle", w_n, S)
        return S * ge_n[..., None, None] + jnp.einsum("bhld,bhle->bhde", ke_n, v_new), None

    S_fin, _ = lax.scan(step_state, S0, (mv(u), mv(w), mv(k_end), mv(g_end)))
    return None, S_fin


def gdn_branch(zc, zl, p, ctx_out):
    def prep(z, with_q):
        kv = jax.nn.silu(_dwconv(_col(z, "gd_kv"), p["gd_conv"][:, BRANCH_W:]))
        k, v = jnp.split(kv, 2, axis=-1)
        k = _l2norm(_heads(k, GD_HEADS).astype(F32))
        v = _heads(v, GD_HEADS).astype(F32)
        ba = _col(z, "gd_ba").astype(F32)
        Bn, T, _ = ba.shape
        ba = ba.reshape(Bn, T, 4, GD_HEADS).transpose(2, 0, 3, 1)
        A = jnp.exp(p["gd_a_log"].astype(F32))[:, None, :, None]
        dtb = p["gd_dt_bias"].astype(F32)[:, None, :, None]
        g = -A * jax.nn.softplus(ba[2:] + dtb)
        beta = jax.nn.sigmoid(ba[:2])
        q = None
        if with_q:
            q = jax.nn.silu(_dwconv(_col(z, "gd_q"), p["gd_conv"][:, :BRANCH_W]))
            q = _l2norm(_heads(q, GD_HEADS).astype(F32))
        return q, k, v, (g[0], beta[0], g[1], beta[1])

    def out(o, z):
        Bn, H, T, d = o.shape
        o = rms_norm(o.transpose(0, 2, 1, 3), p["gd_norm"])
        return (o.reshape(Bn, T, H * d) * jax.nn.silu(_col(z, "gd_z").astype(F32))).astype(z.dtype)

    qc, kc, vc, gc = prep(zc, ctx_out)
    Bn = kc.shape[0]
    zero = jnp.zeros((Bn, GD_HEADS, HEAD_DIM, HEAD_DIM), F32)
    oc, st_fw, st_bw = _bidir(gdn_scan, qc, kc, vc, *gc, zero, zero, ctx_out)
    ql, kl, vl, gl = prep(zl, True)
    ol, _, _ = _bidir(gdn_scan, ql, kl, vl, *gl, st_fw, st_bw, True)
    return (out(oc, zc) if ctx_out else None), out(ol, zl)


def block_attention(q, k, v):
    Bn, Tq, Hq, d = q.shape
    Hkv = k.shape[2]
    G = Hq // Hkv
    nb = Tq // AT_BLOCK
    qb = q.reshape(Bn, nb, AT_BLOCK, Hkv, G, d).transpose(1, 0, 3, 4, 2, 5)
    kt = k.transpose(0, 2, 1, 3)
    vt = v.transpose(0, 2, 1, 3)
    scale = d ** -0.5

    def one(qblk):
        s = jnp.einsum("bhgqd,bhkd->bhgqk", qblk, kt).astype(F32) * scale
        pr = jax.nn.softmax(s, axis=-1).astype(vt.dtype)
        return jnp.einsum("bhgqk,bhkd->bhgqd", pr, vt)

    o = lax.map(one, qb)
    return o.transpose(1, 0, 4, 2, 3, 5).reshape(Bn, Tq, Hq * d)


def attn_branch(zc, zl, p, rope, ctx_out):
    def kv(z):
        k, v = jnp.split(_col(z, "at_kv"), 2, axis=-1)
        Bn, T, _ = k.shape
        k = rms_norm(k.reshape(Bn, T, AT_KV_HEADS, HEAD_DIM), p["at_k_norm"])
        return k, v.reshape(Bn, T, AT_KV_HEADS, HEAD_DIM)

    def qry(z):
        q = _col(z, "at_q")
        Bn, T, _ = q.shape
        return rms_norm(q.reshape(Bn, T, AT_Q_HEADS, HEAD_DIM), p["at_q_norm"])

    kc, vc = kv(zc)
    kl, vl = kv(zl)
    kl = axial_rope(kl, rope)
    ql = axial_rope(qry(zl), rope)
    yl = block_attention(ql, jnp.concatenate([kc, kl], axis=1), jnp.concatenate([vc, vl], axis=1))
    yc = block_attention(qry(zc), kc, vc) if ctx_out else None
    return yc, yl


def merge_branches(ys, z, w_branch, w_out):
    gates = _col(z, "gate")
    Bn, T, _ = gates.shape
    gates = gates.reshape(Bn, T, N_BRANCH, D_MODEL)
    merged = sum(jax.nn.sigmoid(gates[:, :, n]) * (ys[n].astype(z.dtype) @ w_branch[n]) for n in range(N_BRANCH))
    return merged @ w_out


def trunk_layer(x, xc, c, c_ctx, p, rope, last):
    mod_l = (jax.nn.silu(c) @ p["mod_w"] + p["mod_b"])[:, None, :]
    mod_c = (jax.nn.silu(c_ctx) @ p["mod_w"] + p["mod_b"])[None, None, :]
    ml = jnp.split(mod_l, N_MOD, axis=-1)
    mc = jnp.split(mod_c, N_MOD, axis=-1)
    ctx_out = not last

    x = x + FFN_RESIDUAL * ml[2] * swiglu(modulate(rms_norm(x, p["ffn1_norm"]), ml[0], ml[1]),
                                          p["ffn1_w_in"], p["ffn1_w_out"])
    xc = xc + FFN_RESIDUAL * mc[2] * swiglu(modulate(rms_norm(xc, p["ffn1_norm"]), mc[0], mc[1]),
                                            p["ffn1_w_in"], p["ffn1_w_out"])

    hl = modulate(rms_norm(x, p["mix_norm"]), ml[3], ml[4])
    hc = modulate(rms_norm(xc, p["mix_norm"]), mc[3], mc[4])
    zl = hl @ p["w_in"]
    zc = hc @ (p["w_in"] if ctx_out else p["w_in"][:, :KV_COLS])
    y_sg_l = spatial_gating(_col(zl, "sg_uv"), p["sg_norm"], p["sg_w"], p["sg_b"])
    y_ml_c, y_ml_l = mlstm_branch(zc, zl, p, ctx_out)
    y_gd_c, y_gd_l = gdn_branch(zc, zl, p, ctx_out)
    y_at_c, y_at_l = attn_branch(zc, zl, p, rope, ctx_out)
    x = x + ml[5] * merge_branches([y_sg_l, y_ml_l, y_gd_l, y_at_l], zl, p["w_branch"], p["w_out"])
    if ctx_out:
        y_sg_c = spatial_gating(_col(zc, "sg_uv"), p["sg_norm"], p["sg_w"], p["sg_b"])
        xc = xc + mc[5] * merge_branches([y_sg_c, y_ml_c, y_gd_c, y_at_c], zc, p["w_branch"], p["w_out"])

    x = x + FFN_RESIDUAL * ml[8] * swiglu(modulate(rms_norm(x, p["ffn2_norm"]), ml[6], ml[7]),
                                          p["ffn2_w_in"], p["ffn2_w_out"])
    if ctx_out:
        xc = xc + FFN_RESIDUAL * mc[8] * swiglu(modulate(rms_norm(xc, p["ffn2_norm"]), mc[6], mc[7]),
                                                p["ffn2_w_in"], p["ffn2_w_out"])
    return x, xc


def setup_inputs(seed: int = 0) -> dict:
    key = jax.random.key(seed)
    ks = iter(jax.random.split(key, 40))
    L = DEPTH

    def normal(shape, scale):
        return scale * jax.random.normal(next(ks), shape, F32)

    def gain(shape):
        return 1.0 + 0.02 * jax.random.normal(next(ks), shape, F32)

    x = normal((BATCH, SEQ, D_MODEL), 1.0)
    c = normal((BATCH, D_MODEL), 1.0)
    ctx = normal((BATCH, CTX_LEN, D_MODEL), 1.0)
    c_ctx = normal((D_MODEL,), 1.0)
    mod_w = normal((L, D_MODEL, N_MOD * D_MODEL), 0.5 * D_MODEL ** -0.5)
    mod_b = normal((L, N_MOD * D_MODEL), 0.01)
    ffn1_norm = gain((L, D_MODEL))
    ffn1_w_in = normal((L, D_MODEL, 2 * D_FF), D_MODEL ** -0.5)
    ffn1_w_out = normal((L, D_FF, D_MODEL), D_FF ** -0.5)
    mix_norm = gain((L, D_MODEL))
    w_in = normal((L, D_MODEL, IN_COLS), D_MODEL ** -0.5)
    sg_norm = gain((L, BRANCH_W))
    sg_w = normal((L, SG_GROUPS, SG_CHUNK, SG_CHUNK), SG_CHUNK ** -0.5)
    sg_b = normal((L, SG_GROUPS, SG_CHUNK), 0.02)
    ml_if_bias = jnp.concatenate([normal((L, 2 * ML_HEADS), 0.1),
                                  3.0 + normal((L, 2 * ML_HEADS), 0.1)], axis=-1)
    ml_norm = gain((L, BRANCH_W))
    gd_conv = normal((L, GD_CONV, 3 * BRANCH_W), GD_CONV ** -0.5)
    gd_a_log = jnp.log(jax.random.uniform(next(ks), (L, 2, GD_HEADS), F32, 1.0, 16.0))
    dt = jnp.exp(jax.random.uniform(next(ks), (L, 2, GD_HEADS), F32, math.log(1e-3), math.log(1e-1)))
    gd_dt_bias = dt + jnp.log(-jnp.expm1(-dt))
    gd_norm = gain((L, HEAD_DIM))
    at_q_norm = gain((L, HEAD_DIM))
    at_k_norm = gain((L, HEAD_DIM))
    w_branch = normal((L, N_BRANCH, BRANCH_W, D_MODEL), BRANCH_W ** -0.5)
    w_out = normal((L, D_MODEL, D_MODEL), D_MODEL ** -0.5)
    ffn2_norm = gain((L, D_MODEL))
    ffn2_w_in = normal((L, D_MODEL, 2 * D_FF), D_MODEL ** -0.5)
    ffn2_w_out = normal((L, D_FF, D_MODEL), D_FF ** -0.5)
    return {"x": x, "c": c, "ctx": ctx, "c_ctx": c_ctx, "mod_w": mod_w, "mod_b": mod_b,
            "ffn1_norm": ffn1_norm, "ffn1_w_in": ffn1_w_in, "ffn1_w_out": ffn1_w_out,
            "mix_norm": mix_norm, "w_in": w_in, "sg_norm": sg_norm, "sg_w": sg_w, "sg_b": sg_b,
            "ml_if_bias": ml_if_bias, "ml_norm": ml_norm, "gd_conv": gd_conv, "gd_a_log": gd_a_log,
            "gd_dt_bias": gd_dt_bias, "gd_norm": gd_norm, "at_q_norm": at_q_norm, "at_k_norm": at_k_norm,
            "w_branch": w_branch, "w_out": w_out, "ffn2_norm": ffn2_norm, "ffn2_w_in": ffn2_w_in,
            "ffn2_w_out": ffn2_w_out}


def reference(x, c, ctx, c_ctx, mod_w, mod_b, ffn1_norm, ffn1_w_in, ffn1_w_out, mix_norm, w_in,
              sg_norm, sg_w, sg_b, ml_if_bias, ml_norm, gd_conv, gd_a_log, gd_dt_bias, gd_norm,
              at_q_norm, at_k_norm, w_branch, w_out, ffn2_norm, ffn2_w_in, ffn2_w_out):
    ROWS = x.shape[1] // GRID_W
    rope = axial_rope_tables(ROWS)
    xc = ctx
    for l in range(DEPTH):
        p = dict(mod_w=mod_w[l], mod_b=mod_b[l], ffn1_norm=ffn1_norm[l], ffn1_w_in=ffn1_w_in[l],
                 ffn1_w_out=ffn1_w_out[l], mix_norm=mix_norm[l], w_in=w_in[l], sg_norm=sg_norm[l],
                 sg_w=sg_w[l], sg_b=sg_b[l], ml_if_bias=ml_if_bias[l], ml_norm=ml_norm[l],
                 gd_conv=gd_conv[l], gd_a_log=gd_a_log[l], gd_dt_bias=gd_dt_bias[l], gd_norm=gd_norm[l],
                 at_q_norm=at_q_norm[l], at_k_norm=at_k_norm[l], w_branch=w_branch[l], w_out=w_out[l],
                 ffn2_norm=ffn2_norm[l], ffn2_w_in=ffn2_w_in[l], ffn2_w_out=ffn2_w_out[l])
        x, xc = trunk_layer(x, xc, c, c_ctx, p, rope, l == DEPTH - 1)
    return x
```

```cpp
#include <hip/hip_runtime.h>
#include <cstdio>
#include <cstdint>
namespace pg8 {
#define PG8_LAS __attribute__((address_space(3)))
typedef unsigned short bf16_t;
typedef short bf16x8 __attribute__((ext_vector_type(8)));
typedef float f32x4 __attribute__((ext_vector_type(4)));
typedef unsigned u32x4 __attribute__((ext_vector_type(4)));
constexpr int BM = 256, BK = 64, HALF = 128, HTB = HALF * BK * 2  , STAGE_BYTES = 8 * HTB, NXCD = 8, WGM = 8;

__host__ __device__ __forceinline__ int lds_byte(int r, int c) { const int st = (r >> 4) * 2 + (c >> 5), rr = r & 15, cc = c & 31, ob = rr * 64 + cc * 2; return st * 1024 + (ob ^ (((ob >> 9) & 1) << 5)); }
__host__ __device__ __forceinline__ void stage_rc(int b, int& R, int& C) { const int st = b / 1024, sb = b % 1024, swz = sb ^ (((sb >> 9) & 1) << 5); R = (st >> 1) * 16 + swz / 64; C = (st & 1) * 32 + (swz % 64) / 2; }
__host__ __device__ __forceinline__ int perm32(int rho) { const int n = rho >> 4, i = rho & 15; return 8 * (i >> 2) + 4 * n + (i & 3); }

struct Unit { int pm, pn; };
struct Gemm { const bf16_t* A; const bf16_t* Bt; int M, N, K; };

struct StaticOrder {
    int nM, nN, nwg, G, c;
    __host__ __device__ void init(int M, int N, int G_, int c_) { nM = M / BM; nN = N / BM; nwg = nM * nN; G = G_; c = c_; }
    __host__ __device__ bool next(int i, Unit& u) const {
        const long L = (long)i * G + c; if (L >= nwg) return false;
        int wgid = (int)L; { const int q = nwg / NXCD, r = nwg % NXCD, xcd = wgid % NXCD, off = wgid / NXCD; wgid = (xcd < r ? xcd * (q + 1) : r * (q + 1) + (xcd - r) * q) + off; }
        const int nig = WGM * nN, gid = wgid / nig, fm = gid * WGM, gsz = (nM - fm) < WGM ? (nM - fm) : WGM;
        u.pm = fm + ((wgid % nig) % gsz); u.pn = (wgid % nig) / gsz; return true;
    }
    __device__ __forceinline__ void a_ready(const Unit&) const {}
    __device__ __forceinline__ void done(const Unit&) const {}
};

typedef float f32x2c_t __attribute__((ext_vector_type(2)));
typedef __bf16 bf16x2c_t __attribute__((ext_vector_type(2)));
__device__ __forceinline__ unsigned cvt_pk_bf16(float lo, float hi) { const f32x2c_t v = {lo, hi}; const bf16x2c_t b = __builtin_convertvector(v, bf16x2c_t); return __builtin_bit_cast(unsigned, b); }
typedef float f32x2 __attribute__((ext_vector_type(2)));
__device__ __forceinline__ void tile_map(int nM, int nN, int wgid, int& pm, int& pn) {
    const int nwg = nM * nN;
    { const int q = nwg / NXCD, r = nwg % NXCD, xcd = wgid % NXCD, off = wgid / NXCD; wgid = (xcd < r ? xcd * (q + 1) : r * (q + 1) + (xcd - r) * q) + off; }
    const int nig = WGM * nN, gid = wgid / nig, fm = gid * WGM, gsz = (nM - fm) < WGM ? (nM - fm) : WGM;
    pm = fm + ((wgid % nig) % gsz); pn = (wgid % nig) / gsz;
}
struct TileOrder {
    int nM0, nN0, n0, nM1, nN1, n1, pm1, G, c;
    __device__ __forceinline__ void init(int nM0_, int nN0_, int nM1_, int nN1_, int pm1_, int G_, int c_) { nM0 = nM0_; nN0 = nN0_; n0 = nM0_ * nN0_; nM1 = nM1_; nN1 = nN1_; n1 = nM1_ * nN1_; pm1 = pm1_; G = G_; c = c_; }
    __device__ __forceinline__ bool next(int i, Unit& u) const {
        long L = (long)i * G + c;
        if (L < n0) { tile_map(nM0, nN0, (int)L, u.pm, u.pn); return true; }
        L -= n0;
        if (L < n1) { tile_map(nM1, nN1, (int)L, u.pm, u.pn); u.pm += pm1; return true; }
        return false;
    }
    __device__ __forceinline__ void a_ready(const Unit&) const {}
    __device__ __forceinline__ void done(const Unit&) const {}
};
struct BranchOrder {
    int nM, NPM, G, c;
    __device__ __forceinline__ void init(int nM_, int NPM_, int G_, int c_) { nM = nM_; NPM = NPM_; G = G_; c = c_; }
    __device__ __forceinline__ bool next(int i, Unit& u) const {
        const long L = (long)(i >> 2) * G + c; if (L >= nM * 8) return false;
        int pm, pn; tile_map(nM, 8, (int)L, pm, pn); const int n = i & 3;
        u.pm = n * NPM + pm; u.pn = n * 8 + pn; return true;
    }
    __device__ __forceinline__ void a_ready(const Unit&) const {}
    __device__ __forceinline__ void done(const Unit&) const {}
};

__device__ __forceinline__ float silu_f(float a) { return a * __builtin_amdgcn_rcpf(1.0f + __expf(-a)); }
__device__ __forceinline__ float sigmoid_f(float a) { return __builtin_amdgcn_rcpf(1.0f + __expf(-a)); }
struct EpiSwiglu {
    static constexpr bool PERM = true, AFTER_DRAIN = false;
    bf16_t* O; int ldc;
    __device__ __forceinline__ void operator()(const f32x4 (&acc)[2][2][4][2], const Unit& u, int wr, int wc, int fr, int fq) const {
        const int row0 = u.pm * BM + wr * 64 + fr, col0 = u.pn * HALF + wc * 32 + 8 * fq;
#pragma unroll
        for (int ai = 0; ai < 2; ++ai)
#pragma unroll
            for (int m = 0; m < 4; ++m) { bf16_t* rowp = O + (size_t)(row0 + ai * HALF + m * 16) * ldc + col0;
                const f32x4 a0 = acc[ai][0][m][0], a1 = acc[ai][0][m][1], b0 = acc[ai][1][m][0], b1 = acc[ai][1][m][1];
                f32x4 v0, v1;
#pragma unroll
                for (int j = 0; j < 4; ++j) { v0[j] = silu_f(a0[j]) * b0[j]; v1[j] = silu_f(a1[j]) * b1[j]; }
                u32x4 w; w.x = cvt_pk_bf16(v0[0], v0[1]); w.y = cvt_pk_bf16(v0[2], v0[3]); w.z = cvt_pk_bf16(v1[0], v1[1]); w.w = cvt_pk_bf16(v1[2], v1[3]);
                *(u32x4*)rowp = w; }
    }
};
struct EpiRes {
    static constexpr bool PERM = false, AFTER_DRAIN = false;
    const float* base_l; const float* base_c; float* out_l; float* out_c; const float* gate; float coef;
    __device__ __forceinline__ void operator()(const f32x4 (&acc)[2][2][4][2], const Unit& u, int wr, int wc, int fr, int fq) const {
        const bool isc = u.pm >= 64; const int b9 = isc ? 8 : (u.pm >> 3);
        const int prow = (isc ? (u.pm - 64) : u.pm) * BM + wr * 64 + fr, col0 = u.pn * BM + wc * 32 + 4 * fq;
        const float* bp = isc ? base_c : base_l; float* op = isc ? out_c : out_l;
        const float* gp = gate + (size_t)b9 * 18432 + col0;
        f32x4 gv[2][2];
#pragma unroll
        for (int bj = 0; bj < 2; ++bj)
#pragma unroll
            for (int n = 0; n < 2; ++n) gv[bj][n] = *(const f32x4*)(gp + bj * HALF + n * 16) * coef;
#pragma unroll
        for (int ai = 0; ai < 2; ++ai)
#pragma unroll
            for (int m = 0; m < 4; ++m) { const size_t off = (size_t)(prow + ai * HALF + m * 16) * 2048 + col0;
#pragma unroll
                for (int bj = 0; bj < 2; ++bj)
#pragma unroll
                    for (int n = 0; n < 2; ++n) { const f32x4 bs = *(const f32x4*)(bp + off + bj * HALF + n * 16); *(f32x4*)(op + off + bj * HALF + n * 16) = bs + gv[bj][n] * acc[ai][bj][m][n]; }
                asm volatile("" ::: "memory"); }
    }
};
struct EpiZ {
    static constexpr bool PERM = true, AFTER_DRAIN = false;
    bf16_t* Z; float* ZS; int ldz;
    __device__ __forceinline__ void operator()(const f32x4 (&acc)[2][2][4][2], const Unit& u, int wr, int wc, int fr, int fq) const {
        const int row0 = u.pm * BM + wr * 64 + fr, col0 = u.pn * BM + wc * 32 + 8 * fq;
        if (u.pn == 10) {
            if (wc == 0) {
#pragma unroll
                for (int ai = 0; ai < 2; ++ai)
#pragma unroll
                    for (int m = 0; m < 4; ++m) { float* zp = ZS + (size_t)(row0 + ai * HALF + m * 16) * 32 + 8 * fq;
                        *(f32x4*)zp = acc[ai][0][m][0]; *(f32x4*)(zp + 4) = acc[ai][0][m][1]; }
            }
            return;
        }
#pragma unroll
        for (int ai = 0; ai < 2; ++ai)
#pragma unroll
            for (int m = 0; m < 4; ++m) { bf16_t* rowp = Z + (size_t)(row0 + ai * HALF + m * 16) * ldz + col0;
#pragma unroll
                for (int bj = 0; bj < 2; ++bj) { const f32x4 v0 = acc[ai][bj][m][0], v1 = acc[ai][bj][m][1];
                    u32x4 w; w.x = cvt_pk_bf16(v0[0], v0[1]); w.y = cvt_pk_bf16(v0[2], v0[3]); w.z = cvt_pk_bf16(v1[0], v1[1]); w.w = cvt_pk_bf16(v1[2], v1[3]);
                    *(u32x4*)(rowp + bj * HALF) = w; } }
    }
};
struct EpiBranch {
    static constexpr bool PERM = true, AFTER_DRAIN = false;
    bf16_t* Z; int ldz; int gate_col; bf16_t* Hout; int NPM;
    __device__ __forceinline__ void operator()(const f32x4 (&acc)[2][2][4][2], const Unit& u, int wr, int wc, int fr, int fq) const {
        const int n = u.pn >> 3, pn = u.pn & 7, pm = u.pm - n * NPM;
        const int row0 = pm * BM + wr * 64 + fr, col0 = pn * BM + wc * 32 + 8 * fq;
#pragma unroll
        for (int ai = 0; ai < 2; ++ai)
#pragma unroll
            for (int m = 0; m < 4; ++m) { const size_t r = (size_t)(row0 + ai * HALF + m * 16);
#pragma unroll
                for (int bj = 0; bj < 2; ++bj) { const int c = col0 + bj * HALF;
                    const u32x4 g8 = *(const u32x4*)(Z + r * ldz + gate_col + n * 2048 + c);
                    const f32x4 a0 = acc[ai][bj][m][0], a1 = acc[ai][bj][m][1];
                    f32x4 s0, s1;
                    s0[0] = sigmoid_f(__uint_as_float(g8.x << 16)) * a0[0]; s0[1] = sigmoid_f(__uint_as_float(g8.x & 0xffff0000u)) * a0[1];
                    s0[2] = sigmoid_f(__uint_as_float(g8.y << 16)) * a0[2]; s0[3] = sigmoid_f(__uint_as_float(g8.y & 0xffff0000u)) * a0[3];
                    s1[0] = sigmoid_f(__uint_as_float(g8.z << 16)) * a1[0]; s1[1] = sigmoid_f(__uint_as_float(g8.z & 0xffff0000u)) * a1[1];
                    s1[2] = sigmoid_f(__uint_as_float(g8.w << 16)) * a1[2]; s1[3] = sigmoid_f(__uint_as_float(g8.w & 0xffff0000u)) * a1[3];
                    float* mp = (float*)(Z + r * ldz) + c;
                    if (n > 0) { s0 = s0 + *(const f32x4*)mp; s1 = s1 + *(const f32x4*)(mp + 4); }
                    if (n < 3) { *(f32x4*)mp = s0; *(f32x4*)(mp + 4) = s1; }
                    else { u32x4 w; w.x = cvt_pk_bf16(s0[0], s0[1]); w.y = cvt_pk_bf16(s0[2], s0[3]); w.z = cvt_pk_bf16(s1[0], s1[1]); w.w = cvt_pk_bf16(s1[2], s1[3]);
                        *(u32x4*)(Hout + r * 2048 + c) = w; } } }
    }
};
template <class Epi, class Sched, bool ALIGN_EPI = false, bool SP2 = false>
__device__ __forceinline__ void gemm_phase(PG8_LAS unsigned char* lds, const Gemm g, const Sched& S, const Epi& E) {
    const int tid = threadIdx.x, wid = __builtin_amdgcn_readfirstlane(tid >> 6), lane = tid & 63, wr = wid >> 2, wc = wid & 3, fr = lane & 15, fq = lane >> 4;
    const int K = g.K, nt = K / BK;
    unsigned voffA[2], voffB[2];
#pragma unroll
    for (int i = 0; i < 2; ++i) { int R, C; stage_rc(tid * 16 + i * 8192, R, C); const int Rb = Epi::PERM ? ((R & ~31) + perm32(R & 31)) : R;
        voffA[i] = (unsigned)(R * K + C) * 2u; voffB[i] = (unsigned)(Rb * K + C) * 2u; }
    const size_t kstep = (size_t)(BK * 2);
    const size_t hstep = (size_t)HALF * K * 2;
    const size_t tstep = 2 * hstep;
    const unsigned ldsw = (unsigned)wid * 1024u;
    const int aoff = lds_byte(wr * 64 + fr, fq * 8), boff = lds_byte(wc * 32 + fr, fq * 8);
#define PG8_SA(b, h) (((b) * 2 + (h)) * HTB)
#define PG8_SB(b, h) ((4 + (b) * 2 + (h)) * HTB)
#define PG8_STAGE(bufoff, gbase, voff) do { _Pragma("unroll") for (int _i = 0; _i < 2; ++_i) \
        __builtin_amdgcn_global_load_lds((const unsigned*)((const char*)(gbase) + (voff)[_i]), (PG8_LAS unsigned*)(lds + (bufoff) + ldsw + _i * 8192), 16, 0, 0); } while (0)
#define PG8_LDA(dst, b, h) do { _Pragma("unroll") for (int m = 0; m < 4; ++m) _Pragma("unroll") for (int k = 0; k < 2; ++k) dst[m][k] = *(const PG8_LAS bf16x8*)(lds + PG8_SA(b, h) + aoff + m * 2048 + k * 1024); } while (0)
#define PG8_LDB(dst, b, h) do { _Pragma("unroll") for (int n = 0; n < 2; ++n) _Pragma("unroll") for (int k = 0; k < 2; ++k) dst[n][k] = *(const PG8_LAS bf16x8*)(lds + PG8_SB(b, h) + boff + n * 2048 + k * 1024); } while (0)
#define PG8_MMA(ai, bj, At, Bt) do { __builtin_amdgcn_s_setprio(1); _Pragma("unroll") for (int m = 0; m < 4; ++m) _Pragma("unroll") for (int n = 0; n < 2; ++n) _Pragma("unroll") for (int k = 0; k < 2; ++k) \
        acc[ai][bj][m][n] = __builtin_amdgcn_mfma_f32_16x16x32_bf16(Bt[n][k], At[m][k], acc[ai][bj][m][n], 0, 0, 0); __builtin_amdgcn_s_setprio(0); } while (0)
#define PG8_WAIT_V(n) asm volatile("s_waitcnt vmcnt(" #n ")" ::: "memory")
#define PG8_WAIT_L(n) asm volatile("s_waitcnt lgkmcnt(" #n ")" ::: "memory")
#define PG8_BAR __builtin_amdgcn_s_barrier()
#define PG8_SCHED __builtin_amdgcn_sched_barrier(0)
    Unit cur, nxt; int ui = 0;
    if (!S.next(0, cur)) return;
    f32x4 acc[2][2][4][2];
#pragma unroll
    for (int a = 0; a < 2; ++a)
#pragma unroll
        for (int b = 0; b < 2; ++b)
#pragma unroll
            for (int m = 0; m < 4; ++m)
#pragma unroll
                for (int n = 0; n < 2; ++n) acc[a][b][m][n] = (f32x4){0.f, 0.f, 0.f, 0.f};
    bf16x8 At[4][2], B0[2][2], B1[2][2];
    const char* cA = (const char*)g.A + (size_t)cur.pm * tstep; const char* cB = (const char*)g.Bt + (size_t)cur.pn * tstep;
    S.a_ready(cur);
    if constexpr (SP2) {
        PG8_STAGE(PG8_SB(0, 0), cB, voffB); PG8_STAGE(PG8_SB(0, 1), cB + hstep, voffB); PG8_STAGE(PG8_SA(0, 0), cA, voffA); PG8_STAGE(PG8_SA(0, 1), cA + hstep, voffA);
        if (wr == 1) PG8_BAR;
        PG8_WAIT_V(2); PG8_BAR;
        PG8_STAGE(PG8_SB(1, 0), cB + kstep, voffB); PG8_STAGE(PG8_SA(1, 0), cA + kstep, voffA); PG8_STAGE(PG8_SB(1, 1), cB + hstep + kstep, voffB);
        PG8_WAIT_V(6); PG8_BAR;
    } else {
        PG8_STAGE(PG8_SB(0, 0), cB, voffB); PG8_STAGE(PG8_SA(0, 0), cA, voffA); PG8_STAGE(PG8_SB(0, 1), cB + hstep, voffB); PG8_STAGE(PG8_SA(0, 1), cA + hstep, voffA);
        if (wr == 1) PG8_BAR;
        PG8_WAIT_V(4); PG8_BAR;
        PG8_STAGE(PG8_SB(1, 0), cB + kstep, voffB); PG8_STAGE(PG8_SA(1, 0), cA + kstep, voffA); PG8_STAGE(PG8_SB(1, 1), cB + hstep + kstep, voffB);
        PG8_WAIT_V(6); PG8_BAR;
    }
    for (;;) {
        const bool has_next = S.next(ui + 1, nxt);
        const char* nA = has_next ? (const char*)g.A + (size_t)nxt.pm * tstep : cA; const char* nB = has_next ? (const char*)g.Bt + (size_t)nxt.pn * tstep : cB;
        for (int t = 0; t < nt; t += 2) {
            const bool last = (t == nt - 2);
            const char* a1 = cA + (size_t)(t + 1) * kstep;
            const char* a2 = last ? nA : cA + (size_t)(t + 2) * kstep; const char* b2 = last ? nB : cB + (size_t)(t + 2) * kstep;
            const char* a3 = a2 + kstep; const char* b3 = b2 + kstep;
            if (last && has_next) S.a_ready(nxt);
            if constexpr (SP2) {
            PG8_LDB(B0, 0, 0); PG8_LDB(B1, 0, 1); PG8_SCHED; PG8_LDA(At, 0, 0); PG8_STAGE(PG8_SA(1, 1), a1 + hstep, voffA);
            PG8_WAIT_V(8); PG8_WAIT_L(0); PG8_BAR; PG8_MMA(0, 0, At, B0); PG8_MMA(0, 1, At, B1); PG8_BAR; PG8_SCHED;
            PG8_LDA(At, 0, 1); PG8_STAGE(PG8_SB(0, 0), b2, voffB); PG8_STAGE(PG8_SB(0, 1), b2 + hstep, voffB); PG8_STAGE(PG8_SA(0, 0), a2, voffA);
            PG8_WAIT_V(8); PG8_WAIT_L(0); PG8_BAR; PG8_MMA(1, 0, At, B0); PG8_MMA(1, 1, At, B1); PG8_BAR; PG8_SCHED;
            PG8_LDB(B0, 1, 0); PG8_LDB(B1, 1, 1); PG8_SCHED; PG8_LDA(At, 1, 0); PG8_STAGE(PG8_SA(0, 1), a2 + hstep, voffA);
            PG8_WAIT_V(8); PG8_WAIT_L(0); PG8_BAR; PG8_MMA(0, 0, At, B0); PG8_MMA(0, 1, At, B1); PG8_BAR; PG8_SCHED;
            PG8_LDA(At, 1, 1); PG8_STAGE(PG8_SB(1, 0), b3, voffB); PG8_STAGE(PG8_SB(1, 1), b3 + hstep, voffB); PG8_STAGE(PG8_SA(1, 0), a3, voffA);
            PG8_WAIT_V(8); PG8_WAIT_L(0); PG8_BAR; PG8_MMA(1, 0, At, B0); PG8_MMA(1, 1, At, B1); PG8_BAR; PG8_SCHED;
            } else {
            PG8_LDB(B0, 0, 0); PG8_SCHED; PG8_LDA(At, 0, 0); PG8_STAGE(PG8_SA(1, 1), a1 + hstep, voffA);
            PG8_WAIT_L(8); PG8_BAR; PG8_WAIT_L(0); PG8_MMA(0, 0, At, B0); PG8_BAR; PG8_SCHED;
            PG8_LDB(B1, 0, 1); PG8_STAGE(PG8_SB(0, 0), b2, voffB);
            PG8_BAR; PG8_WAIT_L(0); PG8_MMA(0, 1, At, B1); PG8_BAR;
            PG8_LDA(At, 0, 1); PG8_STAGE(PG8_SA(0, 0), a2, voffA);
            PG8_BAR; PG8_WAIT_L(0); PG8_MMA(1, 0, At, B0); PG8_BAR; PG8_SCHED;
            PG8_STAGE(PG8_SB(0, 1), b2 + hstep, voffB);
            PG8_WAIT_V(6); PG8_BAR; PG8_MMA(1, 1, At, B1); PG8_BAR;
            PG8_LDB(B0, 1, 0); PG8_SCHED; PG8_LDA(At, 1, 0); PG8_STAGE(PG8_SA(0, 1), a2 + hstep, voffA);
            PG8_WAIT_L(8); PG8_BAR; PG8_WAIT_L(0); PG8_MMA(0, 0, At, B0); PG8_BAR; PG8_SCHED;
            PG8_LDB(B1, 1, 1); PG8_STAGE(PG8_SB(1, 0), b3, voffB);
            PG8_BAR; PG8_WAIT_L(0); PG8_MMA(0, 1, At, B1); PG8_BAR;
            PG8_LDA(At, 1, 1); PG8_STAGE(PG8_SA(1, 0), a3, voffA);
            PG8_BAR; PG8_WAIT_L(0); PG8_MMA(1, 0, At, B0); PG8_BAR; PG8_SCHED;
            PG8_STAGE(PG8_SB(1, 1), b3 + hstep, voffB);
            PG8_WAIT_V(6); PG8_BAR; PG8_MMA(1, 1, At, B1); PG8_BAR;
            }
        }
        if constexpr (ALIGN_EPI) { if (wr == 0) PG8_BAR; }
        if constexpr (!Epi::AFTER_DRAIN) { E(acc, cur, wr, wc, fr, fq); S.done(cur); }
        if (!has_next) break;
#pragma unroll
        for (int a = 0; a < 2; ++a)
#pragma unroll
            for (int b = 0; b < 2; ++b)
#pragma unroll
                for (int m = 0; m < 4; ++m)
#pragma unroll
                    for (int n = 0; n < 2; ++n) acc[a][b][m][n] = (f32x4){0.f, 0.f, 0.f, 0.f};
        cur = nxt; cA = nA; cB = nB; ++ui;
        if constexpr (ALIGN_EPI) { if (wr == 1) PG8_BAR; }
    }
    PG8_WAIT_V(0);
    if constexpr (!ALIGN_EPI) { if (wr == 0) PG8_BAR; }
    PG8_BAR;
    if constexpr (Epi::AFTER_DRAIN) { E.fused(acc, cur, wr, wc, fr, fq, lds, wid, lane); S.done(cur); }
#undef PG8_SA
#undef PG8_SB
#undef PG8_STAGE
#undef PG8_LDA
#undef PG8_LDB
#undef PG8_MMA
#undef PG8_WAIT_V
#undef PG8_WAIT_L
#undef PG8_BAR
#undef PG8_SCHED
}
}
#ifndef PG8_SP2
#define PG8_SP2 true
#endif
#ifndef PG8_ALIGN
#define PG8_ALIGN true
#endif
constexpr int NWAVES = 8;
constexpr int D = 2048, BATCH = 8, SEQ = 2048, CTXL = 256, DFF = 5632, NLAYER = 2;
constexpr int ML = BATCH * SEQ, MC = BATCH * CTXL, MT = ML + MC;
constexpr int NZ = 14592;
constexpr int MODW = 9 * D;
constexpr int INC = 14368;
constexpr float EPS = 1e-6f;
constexpr int ZC_MLK = 0, ZC_MLV = 512, ZC_GDK = 1024, ZC_GDV = 1536, ZC_ATK = 2048, ZC_ATV = 2304, ZC_SMALL = 2560, ZC_SGU = 2816, ZC_SGV = 3328,
              ZC_MLQ = 3840, ZC_MLO = 4352, ZC_GDQ = 4864, ZC_GDZ = 5376, ZC_ATQ = 5888, ZC_GATE = 6400;
constexpr int NKV_TILES = 11;

constexpr size_t MiB = 1u << 20;
constexpr size_t WS_CTL = 0, CTL_ZERO_BYTES = 1 * MiB;
constexpr size_t WS_MOD = 1 * MiB;
constexpr size_t WS_ROPE = 3 * MiB;
constexpr size_t WS_XC = 4 * MiB;
constexpr size_t WS_WFI = 20 * MiB;
constexpr size_t WS_WFO = 64 * MiB;
constexpr size_t WS_WZ = 86 * MiB;
constexpr size_t WS_WB = 143 * MiB;
constexpr size_t WS_WO = 151 * MiB;
constexpr size_t WS_H = 159 * MiB;
constexpr size_t WS_Z = 231 * MiB;
constexpr size_t WS_ZS = 744 * MiB;
constexpr size_t WS_Y = 747 * MiB;
constexpr size_t WS_QA = 819 * MiB;
constexpr size_t WS_KC = 837 * MiB;
constexpr size_t WS_VC = 846 * MiB;
constexpr size_t WS_MIX = 855 * MiB;
constexpr size_t WS_END = 1150 * MiB;
static_assert(WS_Z + (size_t)MT * NZ * 2 <= WS_ZS && WS_H + (size_t)MT * D * 2 <= WS_Z && WS_Y + (size_t)4 * MT * 512 * 2 <= WS_QA, "d_ws map");
static_assert(WS_WFI + (size_t)2 * DFF * D * 2 <= WS_WFO && WS_WFO + (size_t)D * DFF * 2 <= WS_WZ && WS_WZ + (size_t)NZ * D * 2 <= WS_WB, "d_ws map (weights)");
constexpr int CW_TMO = 0, CW_CODE = 1, CW_BAR = 4096;

constexpr int RING_OFF = 0, RING_BYTES = 131072;
constexpr int LDSCTL_OFF = RING_BYTES, MISC_OFF = LDSCTL_OFF + 320;
constexpr int LDS_BYTES = 147456;

#define GAS __attribute__((address_space(1)))
#define LAS __attribute__((address_space(3)))
typedef unsigned short bf16;
typedef unsigned v4u __attribute__((ext_vector_type(4)));
typedef unsigned v2u __attribute__((ext_vector_type(2)));
typedef float f32x4 __attribute__((ext_vector_type(4)));
typedef short bf16x8 __attribute__((ext_vector_type(8)));
typedef GAS unsigned gu32;
#define RLX_AGENT __ATOMIC_RELAXED, __HIP_MEMORY_SCOPE_AGENT
#define LDS_WAIT() asm volatile("s_waitcnt lgkmcnt(0)" ::: "memory")
#define VM_WAIT() asm volatile("s_waitcnt vmcnt(0)" ::: "memory")
typedef float f32x2_t __attribute__((ext_vector_type(2)));
typedef __bf16 bf16x2_t __attribute__((ext_vector_type(2)));
__device__ __forceinline__ unsigned pk2(float lo, float hi) { const f32x2_t v = {lo, hi}; const bf16x2_t b = __builtin_convertvector(v, bf16x2_t); return __builtin_bit_cast(unsigned, b); }
__device__ __forceinline__ float bflo(unsigned w) { return __uint_as_float(w << 16); }
__device__ __forceinline__ float bfhi(unsigned w) { return __uint_as_float(w & 0xffff0000u); }
__device__ __forceinline__ float bf1(bf16 b) { return __uint_as_float(((unsigned)b) << 16); }
__device__ __forceinline__ bf16 f2bf1(float f) { return (bf16)(pk2(f, 0.f) & 0xffffu); }
__device__ __forceinline__ float silu1(float a) { return a / (1.0f + __expf(-a)); }
__device__ __forceinline__ float sigm1(float a) { return 1.0f / (1.0f + __expf(-a)); }
__device__ __forceinline__ float wave_sum(float v) {
#pragma unroll
    for (int o = 1; o < 64; o <<= 1) v += __shfl_xor(v, o);
    return v;
}
#define XB_TMO      128
#define XB_XCNT(j)  (256  + 64 * (j))
#define XB_XSUB(j)  (1280 + 64 * (j))
#define XB_XGEN(j)  (2304 + 64 * (j))
#define XB_TOP      3328
#define XB_TOPGEN   3392
#define XCD_BAR_WORDS 3456
#define XB_SPIN_CAP (1u << 18)

__device__ __forceinline__ unsigned xb_ld(unsigned* p)              { return __hip_atomic_load(p, __ATOMIC_RELAXED, __HIP_MEMORY_SCOPE_AGENT); }
__device__ __forceinline__ unsigned xb_add(unsigned* p, unsigned v) { return __hip_atomic_fetch_add(p, v, __ATOMIC_RELAXED, __HIP_MEMORY_SCOPE_AGENT); }
__device__ __forceinline__ unsigned xb_xcc_id() { return (unsigned)__builtin_amdgcn_s_getreg((3 << 11) | 20) & 0xFu; }
#define XB_SPIN(cond, bar) do { unsigned _sp = 0; while (cond) { __builtin_amdgcn_s_sleep(1); \
    if ((++_sp & 255u) == 0u) { if (xb_ld(&(bar)[XB_TMO])) break; if (_sp > XB_SPIN_CAP) { atomicAdd(&(bar)[XB_TMO], 1u); break; } } } } while (0)

struct XcdBarrier {
    unsigned* bar; unsigned x;
    volatile LAS unsigned* st;
};

__device__ __forceinline__ XcdBarrier xcd_barrier_post(unsigned* bar, volatile LAS unsigned* st) {
    XcdBarrier b; b.bar = bar; b.x = xb_xcc_id(); b.st = st;
    if (threadIdx.x == 0) (void)xb_add(&bar[XB_XCNT(b.x)], 1u);
    return b;
}
__device__ __forceinline__ void xcd_barrier_complete(unsigned* bar, unsigned x, unsigned& nloc, unsigned& nx) {
    const unsigned G = gridDim.x * gridDim.y * gridDim.z;
    unsigned sum, cnt, mine, sp = 0u;
    for (;;) {
        sum = 0u; cnt = 0u; mine = 0u;
#pragma unroll
        for (unsigned j = 0; j < 16; ++j) { const unsigned c = xb_ld(&bar[XB_XCNT(j)]); sum += c; cnt += (c > 0u) ? 1u : 0u; mine = (j == x) ? c : mine; }
        if (sum == G) break;
        __builtin_amdgcn_s_sleep(1);
        if ((++sp & 255u) == 0u) { if (xb_ld(&bar[XB_TMO])) break; if (sp > XB_SPIN_CAP) { atomicAdd(&bar[XB_TMO], 1u); break; } }
    }
    nloc = mine > 0u ? mine : 1u; nx = cnt > 0u ? cnt : 1u;
}

__device__ __forceinline__ void xcd_barrier(const XcdBarrier& b) {
    asm volatile("s_waitcnt vmcnt(0)" ::: "memory");
    __syncthreads();
    if (threadIdx.x == 0) {
        unsigned* bar = b.bar;
        __builtin_amdgcn_s_waitcnt(0);
        unsigned nloc = b.st[0], nx = b.st[1];
        if (nloc == 0u) { xcd_barrier_complete(bar, b.x, nloc, nx); b.st[0] = nloc; b.st[1] = nx; }
        const unsigned old = xb_add(&bar[XB_XSUB(b.x)], 1u);
        const unsigned gen = old / nloc;
        if (old + 1u == (gen + 1u) * nloc) {
            __builtin_amdgcn_fence(__ATOMIC_RELEASE, "agent");
            asm volatile("s_waitcnt vmcnt(0)" ::: "memory");
            const unsigned og = xb_add(&bar[XB_TOP], 1u);
            const unsigned tg = og / nx;
            if (og + 1u == (tg + 1u) * nx) xb_add(&bar[XB_TOPGEN], 1u);
            else XB_SPIN(xb_ld(&bar[XB_TOPGEN]) == tg, bar);
            __builtin_amdgcn_fence(__ATOMIC_ACQUIRE, "agent");
            xb_add(&bar[XB_XGEN(b.x)], 1u);
            asm volatile("s_waitcnt vmcnt(0)" ::: "memory");
        } else {
            XB_SPIN(xb_ld(&bar[XB_XGEN(b.x)]) == gen, bar);
            __builtin_amdgcn_fence(__ATOMIC_ACQUIRE, "agent");
            asm volatile("s_waitcnt vmcnt(0)" ::: "memory");
        }
    }
    __syncthreads();
}
struct Frame {
    LAS unsigned char* lds;
    volatile LAS unsigned* MISC;
    gu32* ctl;
    int tid, lane, wave, G;
    unsigned char* ws;
    const float* const* in;
    float* out;
};
enum { I_X = 0, I_C, I_CTX, I_CCTX, I_MODW, I_MODB, I_F1N, I_F1WI, I_F1WO, I_MIXN, I_WIN, I_SGN, I_SGW, I_SGB, I_MLIFB, I_MLN, I_GDCONV, I_GDALOG, I_GDDTB, I_GDN,
       I_ATQN, I_ATKN, I_WBR, I_WOUT, I_F2N, I_F2WI, I_F2WO };

__device__ __forceinline__ void phase_mod(Frame& F) {
    LAS float* tab = (LAS float*)(F.lds + RING_OFF);
    LAS float* red = (LAS float*)(F.lds + RING_OFF + 98304);
    const float* c = F.in[I_C]; const float* cc = F.in[I_CCTX];
    for (int i = F.tid; i < 9 * D; i += NWAVES * 64) { const int b = i / D, k = i % D; const float x = b < 8 ? c[b * D + k] : cc[k]; tab[k * 12 + b] = silu1(x); }
    __syncthreads();
    float* MOD = (float*)(F.ws + WS_MOD);
    for (int item = blockIdx.x; item < 2 * 288; item += F.G) {
        const int l = item / 288, n0 = (item % 288) * 64;
        const float* W = F.in[I_MODW] + (size_t)l * D * MODW + n0 + F.lane;
        float acc[9];
#pragma unroll
        for (int b = 0; b < 9; ++b) acc[b] = 0.f;
        const int k0 = F.wave * 256;
        for (int k = k0; k < k0 + 256; k += 8) {
            float w[8];
#pragma unroll
            for (int j = 0; j < 8; ++j) w[j] = W[(size_t)(k + j) * MODW];
#pragma unroll
            for (int j = 0; j < 8; ++j) { const LAS f32x4* tp = (const LAS f32x4*)(tab + (k + j) * 12); const f32x4 s0 = tp[0], s1 = tp[1], s2 = tp[2];
                acc[0] += s0[0] * w[j]; acc[1] += s0[1] * w[j]; acc[2] += s0[2] * w[j]; acc[3] += s0[3] * w[j];
                acc[4] += s1[0] * w[j]; acc[5] += s1[1] * w[j]; acc[6] += s1[2] * w[j]; acc[7] += s1[3] * w[j]; acc[8] += s2[0] * w[j]; }
        }
#pragma unroll
        for (int b = 0; b < 9; ++b) red[(F.wave * 9 + b) * 64 + F.lane] = acc[b];
        __syncthreads();
        for (int i = F.tid; i < 576; i += NWAVES * 64) { const int b = i / 64, cc2 = i % 64; float s = 0.f;
#pragma unroll
            for (int w = 0; w < 8; ++w) s += red[(w * 9 + b) * 64 + cc2];
            MOD[(size_t)(l * 9 + b) * MODW + n0 + cc2] = s + F.in[I_MODB][(size_t)l * MODW + n0 + cc2]; }
        __syncthreads();
    }
}
__device__ __forceinline__ void phase_rope(Frame& F) {
    float* RC = (float*)(F.ws + WS_ROPE); float* RS = RC + 96 * 32;
    const int idx = blockIdx.x * (NWAVES * 64) + F.tid;
    if (idx < 96 * 32) {
        const int pos = idx >> 5, i = idx & 31; const float p = (float)(pos < 32 ? pos : pos - 32);
        const float inv = exp2f(-(float)i * (13.287712379549449f / 32.0f));
        const float x = p * inv;
        const float kf = rintf(x * 0.6366197723675814f);
        float r = fmaf(-kf, 1.5707963705062866f, x); r = fmaf(-kf, -4.371138828673793e-8f, r);
        const float r2 = r * r;
        const float sn = r + r * r2 * (-1.6666667163e-1f + r2 * (8.3333337680e-3f + r2 * (-1.9841270114e-4f + r2 * 2.7557314297e-6f)));
        const float cs = 1.0f + r2 * (-0.5f + r2 * (4.1666667908e-2f + r2 * (-1.3888889225e-3f + r2 * (2.4801587642e-5f + r2 * -2.7557314297e-7f))));
        const int q = ((int)kf) & 3;
        const float sv = (q == 0) ? sn : (q == 1) ? cs : (q == 2) ? -sn : -cs;
        const float cv = (q == 0) ? cs : (q == 1) ? -sn : (q == 2) ? -cs : sn;
        RC[idx] = cv; RS[idx] = sv;
    }
}
template <int MAP> __device__ __forceinline__ int dst_row(int n) {
    if (MAP == 0) return n;
    if (MAP == 1) { const int half = n >= DFF ? 1 : 0, j = n - half * DFF; return (j >> 7) * 256 + half * 128 + (j & 127); }
    if (n < 1024) return n;
    if (n < 1040) return ZC_SMALL + (n - 1024);
    if (n < 2064) return 1024 + (n - 1040);
    if (n < 2080) return ZC_SMALL + 16 + (n - 2064);
    if (n < 2592) return 2048 + (n - 2080);
    return n + 224;
}
template <int MAP> __device__ __forceinline__ void conv_item(const float* W, int K, int N, bf16* WT, LAS float* scr, int item, int lane) {
    const int nblk = N / 32, kb = item / nblk, nb = item % nblk, k0 = 64 * kb, n0 = 32 * nb;
#pragma unroll 8
    for (int i = 0; i < 32; ++i) { const int kk = 2 * i + (lane >> 5); scr[kk * 33 + (lane & 31)] = W[(size_t)(k0 + kk) * N + n0 + (lane & 31)]; }
    LDS_WAIT(); asm volatile("" ::: "memory");
    const int c = lane & 7;
#pragma unroll
    for (int j = 0; j < 4; ++j) { const int n = (lane >> 3) + 8 * j; const LAS float* s = scr + (8 * c) * 33 + n;
        v4u o; o.x = pk2(s[0 * 33], s[1 * 33]); o.y = pk2(s[2 * 33], s[3 * 33]); o.z = pk2(s[4 * 33], s[5 * 33]); o.w = pk2(s[6 * 33], s[7 * 33]);
        *(GAS v4u*)(WT + (size_t)dst_row<MAP>(n0 + n) * K + k0 + 8 * c) = o; }
    LDS_WAIT(); asm volatile("" ::: "memory");
}
__device__ __forceinline__ void phase_conv(Frame& F, int l, int part) {
    LAS float* scr = (LAS float*)(F.lds + RING_OFF + F.wave * 16384);
    const int gw = blockIdx.x * NWAVES + F.wave, NGW = F.G * NWAVES;
    constexpr int I_FI = (D / 64) * (2 * DFF / 32), I_FO = (DFF / 64) * (D / 32), I_Z = (D / 64) * (INC / 32), I_B = (512 / 64) * (D / 32), I_O = (D / 64) * (D / 32);
    bf16* WFI = (bf16*)(F.ws + WS_WFI); bf16* WFO = (bf16*)(F.ws + WS_WFO); bf16* WZ = (bf16*)(F.ws + WS_WZ); bf16* WB = (bf16*)(F.ws + WS_WB); bf16* WO = (bf16*)(F.ws + WS_WO);
    const float* fwi = F.in[part ? I_F2WI : I_F1WI] + (size_t)l * D * 2 * DFF; const float* fwo = F.in[part ? I_F2WO : I_F1WO] + (size_t)l * DFF * D;
    const int NIT = part ? (I_FI + I_FO) : (I_FI + I_FO + I_Z + 4 * I_B + I_O);
    for (int it = gw; it < NIT; it += NGW) {
        int r = it;
        if (r < I_FI) { conv_item<1>(fwi, D, 2 * DFF, WFI, scr, r, F.lane); continue; } r -= I_FI;
        if (r < I_FO) { conv_item<0>(fwo, DFF, D, WFO, scr, r, F.lane); continue; } r -= I_FO;
        if (r < I_Z) { conv_item<2>(F.in[I_WIN] + (size_t)l * D * INC, D, INC, WZ, scr, r, F.lane); continue; } r -= I_Z;
        if (r < 4 * I_B) { const int n = r / I_B; conv_item<0>(F.in[I_WBR] + ((size_t)l * 4 + n) * 512 * D, 512, D, WB + (size_t)n * D * 512, scr, r % I_B, F.lane); continue; } r -= 4 * I_B;
        conv_item<0>(F.in[I_WOUT] + (size_t)l * D * D, D, D, WO, scr, r, F.lane);
    }
    if (part == 0) {
        GAS v4u* z = (GAS v4u*)(WZ + (size_t)(ZC_SMALL + 32) * D); const int n16 = 224 * D * 2 / 16;
        for (int i = blockIdx.x * (NWAVES * 64) + F.tid; i < n16; i += F.G * NWAVES * 64) z[i] = (v4u){0u, 0u, 0u, 0u};
    }
}
__device__ __forceinline__ void phase_norm(Frame& F, const float* xl, const float* xc, const float* gain, const float* mod  , int nrows) {
    bf16* H = (bf16*)(F.ws + WS_H);
    const int gw = blockIdx.x * NWAVES + F.wave, NGW = F.G * NWAVES;
    for (int row = gw; row < nrows; row += NGW) {
        const bool isc = row >= ML; const int b9 = isc ? 8 : row / SEQ;
        const GAS f32x4* xr = (const GAS f32x4*)(isc ? xc + (size_t)(row - ML) * D : xl + (size_t)row * D) + F.lane;
        f32x4 v[8]; float s = 0.f;
#pragma unroll
        for (int j = 0; j < 8; ++j) { v[j] = xr[64 * j]; s += (v[j].x * v[j].x + v[j].y * v[j].y) + (v[j].z * v[j].z + v[j].w * v[j].w); }
        const float rstd = 1.0f / sqrtf(wave_sum(s) * (1.0f / D) + EPS);
        const float* sh = mod + (size_t)b9 * MODW; const float* sc = sh + D;
        GAS v2u* o8 = (GAS v2u*)(H + (size_t)row * D) + F.lane;
#pragma unroll
        for (int j = 0; j < 8; ++j) { const int c = 4 * F.lane + 256 * j;
            const f32x4 g = *(const f32x4*)(gain + c), a = *(const f32x4*)(sc + c), b = *(const f32x4*)(sh + c);
            const f32x4 y = (v[j] * rstd * g) * (a + 1.0f) + b;
            v2u w; w.x = pk2(y.x, y.y); w.y = pk2(y.z, y.w); o8[64 * j] = w; }
    }
}
#include <hip/hip_bf16.h>
namespace attn {
using bf16 = __hip_bfloat16;
constexpr int   D = 128, NW = 8, QBLK = 32, KVBLK = 64;
constexpr float SCALE = 0.088388347648318440f;
constexpr float THR = 8.f;
constexpr int SDEPTH = 2;
constexpr int LDQ = 512, LDK = 256, LDO = 512;
constexpr size_t SHM_V = KVBLK * D * 2, SHM_K = KVBLK * D * 2, SHM_ATTN = 2 * SHM_V + 2 * SHM_K + NW * 64 * 4;
using bf16x8 = __attribute__((ext_vector_type(8))) short;
using s16x4  = __attribute__((ext_vector_type(4))) short;
using f32x16 = __attribute__((ext_vector_type(16))) float;
using f32x8  = __attribute__((ext_vector_type(8))) float;
using u32x4  = __attribute__((ext_vector_type(4))) unsigned;
#define KSWZ(row, colB) ((row) * 256 + ((colB) ^ (((row) & 7) << 4)))
#define SBAR() __builtin_amdgcn_sched_barrier(0)
__device__ __forceinline__ int crow(int r, int hi) { return (r & 3) + 8 * (r >> 2) + 4 * hi; }
__device__ __forceinline__ unsigned cvtpk(float lo, float hi) {
  unsigned r; asm volatile("v_cvt_pk_bf16_f32 %0, %1, %2" : "=v"(r) : "v"(lo), "v"(hi)); return r;
}
template <typename TIn> struct Stage;
template <> struct Stage<bf16>  { using T = bf16x8;
  __device__ static __forceinline__ T ld8(const bf16* p) { return *reinterpret_cast<const bf16x8*>(p); }
  __device__ static __forceinline__ bf16x8 tobf(T x) { return x; } };
template <> struct Stage<float> { using T = f32x8;
  __device__ static __forceinline__ T ld8(const float* p) { return *reinterpret_cast<const f32x8*>(p); }
  __device__ static __forceinline__ bf16x8 tobf(T x) {
    u32x4 w = {cvtpk(x[0], x[1]), cvtpk(x[2], x[3]), cvtpk(x[4], x[5]), cvtpk(x[6], x[7])}; return *reinterpret_cast<bf16x8*>(&w); } };

__device__ __forceinline__ void partialSM(f32x16& p0, f32x16& p1, float& m_reg, float& mn, float& alpha) {
  constexpr float C = SCALE * 1.4426950408889634f;
  float pmax = p0[0]; for (int r = 1; r < 16; ++r) pmax = fmaxf(pmax, p0[r]); for (int r = 0; r < 16; ++r) pmax = fmaxf(pmax, p1[r]);
  { auto rr = __builtin_amdgcn_permlane32_swap(__float_as_uint(pmax), __float_as_uint(pmax), false, false);
    pmax = fmaxf(__uint_as_float(rr[0]), __uint_as_float(rr[1])); }
  if (__builtin_expect(__all(pmax - m_reg <= THR / SCALE), 1)) { mn = m_reg; alpha = 1.f; }
  else { mn = fmaxf(m_reg, pmax); alpha = __builtin_amdgcn_exp2f((m_reg - mn) * C); m_reg = mn; }
  float mnC = -mn * C;
  for (int r = 0; r < 16; ++r) p0[r] = fmaf(p0[r], C, mnC); for (int r = 0; r < 16; ++r) p1[r] = fmaf(p1[r], C, mnC);
  for (int r = 0; r < 16; ++r) p0[r] = __builtin_amdgcn_exp2f(p0[r]);
}
__device__ __forceinline__ void finishSM(f32x16& p0, f32x16& p1, float alpha, float& l_reg, bf16x8& pa0, bf16x8& pa1, bf16x8& pa2, bf16x8& pa3) {
  for (int r = 0; r < 16; ++r) p1[r] = __builtin_amdgcn_exp2f(p1[r]);
  float ps = 0; for (int r = 0; r < 16; ++r) ps += p0[r]; for (int r = 0; r < 16; ++r) ps += p1[r];
  { auto rr = __builtin_amdgcn_permlane32_swap(__float_as_uint(ps), __float_as_uint(ps), false, false);
    ps = __uint_as_float(rr[0]) + __uint_as_float(rr[1]); }
  l_reg = l_reg * alpha + ps;
#define PK4(P, BASE, OUT) do { unsigned a0 = cvtpk(P[BASE + 0], P[BASE + 1]), a1 = cvtpk(P[BASE + 2], P[BASE + 3]);   \
    unsigned b0 = cvtpk(P[BASE + 4], P[BASE + 5]), b1 = cvtpk(P[BASE + 6], P[BASE + 7]);                              \
    auto r0 = __builtin_amdgcn_permlane32_swap(a0, b0, false, false); auto r1 = __builtin_amdgcn_permlane32_swap(a1, b1, false, false); \
    u32x4 w = {r0[0], r1[0], r0[1], r1[1]}; OUT = *reinterpret_cast<bf16x8*>(&w); } while (0)
  PK4(p0, 0, pa0); PK4(p0, 8, pa1); PK4(p1, 0, pa2); PK4(p1, 8, pa3);
#undef PK4
}
__device__ __forceinline__ void qkt(f32x16& p0, f32x16& p1, const bf16* Ks, const bf16x8* qr, int r32, int hi) {
  p0 = f32x16{}; p1 = f32x16{};
  for (int d0 = 0; d0 < 8; ++d0) { int cb = (d0 * 16 + hi * 8) * 2;
    bf16x8 b0 = *reinterpret_cast<const bf16x8*>((const char*)Ks + KSWZ(r32, cb));
    bf16x8 b1 = *reinterpret_cast<const bf16x8*>((const char*)Ks + KSWZ(32 + r32, cb));
    p0 = __builtin_amdgcn_mfma_f32_32x32x16_bf16(b0, qr[d0], p0, 0, 0, 0);
    p1 = __builtin_amdgcn_mfma_f32_32x32x16_bf16(b1, qr[d0], p1, 0, 0, 0); }
}
__device__ __forceinline__ int v_st(int k, int c) { const int kk = (k & ~0xC) | ((k & 4) << 1) | ((k & 8) >> 1); return ((kk >> 3) * 4 + (c >> 5)) * 512 + ((kk & 7) * 32 + (c & 31)) * 2; }
__device__ __forceinline__ int v_rd_base(int lane) { return ((lane & 3) << 3) | (((lane >> 2) & 3) << 6) | (((lane >> 4) & 1) << 5) | (((lane >> 5) & 1) << 8); }
constexpr int v_rd_off(int d0, int ks, int half) { return d0 * 512 + ks * 4096 + half * 2048; }
template <int OFF> __device__ __forceinline__ s16x4 tr_read(int vb) {
  s16x4 r; asm volatile("ds_read_b64_tr_b16 %0, %1 offset:%2" : "=&v"(r) : "v"(vb), "i"(OFF) : "memory"); return r;
}
template <int D0> __device__ __forceinline__ void pv_one(f32x16& od, int vb, bf16x8 pa0, bf16x8 pa1, bf16x8 pa2, bf16x8 pa3) {
  const s16x4 l0 = tr_read<v_rd_off(D0, 0, 0)>(vb), h0 = tr_read<v_rd_off(D0, 0, 1)>(vb), l1 = tr_read<v_rd_off(D0, 1, 0)>(vb), h1 = tr_read<v_rd_off(D0, 1, 1)>(vb);
  const s16x4 l2 = tr_read<v_rd_off(D0, 2, 0)>(vb), h2 = tr_read<v_rd_off(D0, 2, 1)>(vb), l3 = tr_read<v_rd_off(D0, 3, 0)>(vb), h3 = tr_read<v_rd_off(D0, 3, 1)>(vb);
  asm volatile("s_waitcnt lgkmcnt(0)" ::: "memory"); SBAR();
#define PK(L, H) (bf16x8){L[0], L[1], L[2], L[3], H[0], H[1], H[2], H[3]}
  od = __builtin_amdgcn_mfma_f32_32x32x16_bf16(pa0, PK(l0, h0), od, 0, 0, 0);
  od = __builtin_amdgcn_mfma_f32_32x32x16_bf16(pa1, PK(l1, h1), od, 0, 0, 0);
  od = __builtin_amdgcn_mfma_f32_32x32x16_bf16(pa2, PK(l2, h2), od, 0, 0, 0);
  od = __builtin_amdgcn_mfma_f32_32x32x16_bf16(pa3, PK(l3, h3), od, 0, 0, 0);
#undef PK
}
__device__ __forceinline__ void pv_d0(f32x16* o, int vb, bf16x8 pa0, bf16x8 pa1, bf16x8 pa2, bf16x8 pa3) {
  pv_one<0>(o[0], vb, pa0, pa1, pa2, pa3); pv_one<1>(o[1], vb, pa0, pa1, pa2, pa3); pv_one<2>(o[2], vb, pa0, pa1, pa2, pa3); pv_one<3>(o[3], vb, pa0, pa1, pa2, pa3);
}

template <typename TQ>
__device__ __forceinline__ void attn_dense_body(const TQ* __restrict__ Qb, const bf16* __restrict__ Kh, const bf16* __restrict__ Vh,
                                                bf16* __restrict__ Ob, int seq, char* lds) {
  using St = Stage<bf16>; using SQ = Stage<TQ>;
  const int tid = threadIdx.x, wid = tid >> 6, lane = tid & 63, r32 = lane & 31, hi = lane >> 5;
  bf16* V_lds = (bf16*)lds; bf16* K_lds = (bf16*)(lds + 2 * SHM_V);
  float* ws = (float*)(lds + 2 * SHM_V + 2 * SHM_K) + wid * 64; float* li_l = ws; float* al_l = ws + 32;
  float m_reg = -1e30f, l_reg = 0; f32x16 o[4] = {}; bf16x8 qr[8];
  const TQ* Qw = Qb + (long)(wid * QBLK + r32) * LDQ + hi * 8;
#pragma unroll
  for (int d0 = 0; d0 < 8; ++d0) qr[d0] = SQ::tobf(SQ::ld8(Qw + d0 * 16));
  const int sr = tid >> 4, sc = (tid & 15) * 8, vst0 = v_st(sr, sc), vst1 = v_st(32 + sr, sc);
  const int vb0 = (int)(uintptr_t)V_lds + v_rd_base(lane);
  struct { typename St::T vs0, vs1, ks0, ks1; } sr_[SDEPTH];
#define SLOAD(i, k0) do { sr_[i].vs0 = St::ld8(&Vh[(long)((k0) + sr) * LDK + sc]); sr_[i].vs1 = St::ld8(&Vh[(long)((k0) + 32 + sr) * LDK + sc]); \
    sr_[i].ks0 = St::ld8(&Kh[(long)((k0) + sr) * LDK + sc]); sr_[i].ks1 = St::ld8(&Kh[(long)((k0) + 32 + sr) * LDK + sc]); } while (0)
#define SWRITE(b, i) do { *(bf16x8*)((char*)V_lds + (b) * SHM_V + vst0) = St::tobf(sr_[i].vs0);          \
    *(bf16x8*)((char*)V_lds + (b) * SHM_V + vst1) = St::tobf(sr_[i].vs1); int kc = sc * 2;               \
    *(bf16x8*)((char*)K_lds + (b) * SHM_K + KSWZ(sr, kc)) = St::tobf(sr_[i].ks0);                       \
    *(bf16x8*)((char*)K_lds + (b) * SHM_K + KSWZ(32 + sr, kc)) = St::tobf(sr_[i].ks1); } while (0)
#define SWAIT() do { if constexpr (SDEPTH == 2) asm volatile("s_waitcnt vmcnt(4)" ::: "memory"); else asm volatile("s_waitcnt vmcnt(0)" ::: "memory"); } while (0)
#define RESC(a) do { if (__any((a) < 1.f)) { if (hi == 0) al_l[r32] = (a); asm volatile("s_waitcnt lgkmcnt(0)" ::: "memory"); \
    for (int d = 0; d < 4; ++d) for (int r = 0; r < 16; ++r) o[d][r] *= al_l[crow(r, hi)]; } } while (0)
  f32x16 pA0, pA1, pB0, pB1; float mnA, mnB, alA, alB; bf16x8 pa0, pa1, pa2, pa3; const int NT = seq / KVBLK;
  constexpr int SE = 0, SO = SDEPTH - 1;
  SLOAD(SE, 0); asm volatile("s_waitcnt vmcnt(0)" ::: "memory"); SWRITE(0, SE); __syncthreads();
  qkt(pA0, pA1, K_lds, qr, r32, hi); partialSM(pA0, pA1, m_reg, mnA, alA);
  SLOAD(SO, KVBLK); if constexpr (SDEPTH == 2) { if (2 < NT) SLOAD(SE, 2 * KVBLK); }
  SWAIT(); SWRITE(1, SO); __syncthreads();
  for (int j = 1; j + 1 < NT; j += 2) {
    SBAR(); qkt(pB0, pB1, (bf16*)((char*)K_lds + SHM_K), qr, r32, hi);
    finishSM(pA0, pA1, alA, l_reg, pa0, pa1, pa2, pa3); SBAR();
    SLOAD(SO, (j + SDEPTH) * KVBLK); SBAR();
    pv_d0(o, vb0, pa0, pa1, pa2, pa3); partialSM(pB0, pB1, m_reg, mnB, alB);
    __syncthreads(); SWAIT(); SWRITE(0, SE);
    RESC(alB); __syncthreads();
    SBAR(); qkt(pA0, pA1, K_lds, qr, r32, hi);
    finishSM(pB0, pB1, alB, l_reg, pa0, pa1, pa2, pa3); SBAR();
    if (SDEPTH == 1 || j + 3 < NT) SLOAD(SE, (j + 1 + SDEPTH) * KVBLK); SBAR();
    pv_d0(o, vb0 + (int)SHM_V, pa0, pa1, pa2, pa3); partialSM(pA0, pA1, m_reg, mnA, alA);
    __syncthreads(); SWAIT(); SWRITE(1, SO);
    RESC(alA); __syncthreads();
  }
  SBAR(); qkt(pB0, pB1, (bf16*)((char*)K_lds + SHM_K), qr, r32, hi);
  finishSM(pA0, pA1, alA, l_reg, pa0, pa1, pa2, pa3); SBAR();
  pv_d0(o, vb0, pa0, pa1, pa2, pa3); partialSM(pB0, pB1, m_reg, mnB, alB);
  __syncthreads(); RESC(alB);
  finishSM(pB0, pB1, alB, l_reg, pa0, pa1, pa2, pa3); SBAR();
  pv_d0(o, vb0 + (int)SHM_V, pa0, pa1, pa2, pa3);
  if (hi == 0) li_l[r32] = l_reg; asm volatile("s_waitcnt lgkmcnt(0)" ::: "memory");
  float rli[16];
#pragma unroll
  for (int r = 0; r < 16; ++r) rli[r] = __builtin_amdgcn_rcpf(li_l[crow(r, hi)]);
  bf16* Ow = Ob + (long)(wid * QBLK) * LDO;
#pragma unroll
  for (int r = 0; r < 16; ++r) { int orow = crow(r, hi);
    for (int d0 = 0; d0 < 4; ++d0) Ow[(long)orow * LDO + d0 * 32 + r32] = __float2bfloat16(o[d0][r] * rli[r]); }
#undef SLOAD
#undef SWRITE
#undef SWAIT
#undef RESC
}

#undef KSWZ
#undef SBAR
}
constexpr size_t MX_CL = 0;
constexpr size_t MX_CP = 36 * MiB;
constexpr size_t MX_NL = 72 * MiB;
constexpr size_t MX_NP = 73 * MiB;
constexpr size_t MX_ST = 74 * MiB;
constexpr size_t MX_SP = 75 * MiB;
constexpr size_t MX_GQ = 76 * MiB, MX_GK = 94 * MiB, MX_GV = 112 * MiB;
constexpr size_t MX_GG = 130 * MiB, MX_GB = 131 * MiB;
constexpr size_t MX_GD1 = 132 * MiB;
constexpr size_t GD1_ITEM = 73728;
constexpr size_t MX_GE = 294 * MiB;
static_assert(MX_GD1 + (size_t)2304 * GD1_ITEM <= MX_GE && WS_MIX + MX_GE + 2304 * 128 <= WS_END, "mixer scratch map");

typedef float f32x4m __attribute__((ext_vector_type(4)));
#define MFMA16(a, b, c) __builtin_amdgcn_mfma_f32_16x16x32_bf16((a), (b), (c), 0, 0, 0)
__device__ __forceinline__ bf16x8 lds_frag(const LAS unsigned char* base, int stride, int row0, int kb, int lane) {
    return *(const LAS bf16x8*)(base + (row0 + (lane & 15)) * stride + kb + (lane >> 4) * 16);
}
__device__ __forceinline__ float gelu_tanh(float x) { const float y = 0.7978845608028654f * (x + 0.044715f * x * x * x); const float t = 1.0f - 2.0f / (1.0f + __expf(2.0f * y)); return 0.5f * x * (1.0f + t); }
__device__ __forceinline__ float logsigmoid1(float x) { return fminf(x, 0.f) - log1pf(__expf(-fabsf(x))); }
__device__ __forceinline__ float softplus1(float x) { return fmaxf(x, 0.f) + log1pf(__expf(-fabsf(x))); }
__device__ __forceinline__ int perm32p(int jl) { return 8 * ((jl & 15) >> 2) + 4 * (jl >> 4) + (jl & 3); }

__device__ __forceinline__ void phase_attn_prep(Frame& F, int l, bool last) {
    const bf16* Z = (const bf16*)(F.ws + WS_Z); bf16* QA = (bf16*)(F.ws + WS_QA); bf16* KC = (bf16*)(F.ws + WS_KC); bf16* VC = (bf16*)(F.ws + WS_VC);
    const float* RC = (const float*)(F.ws + WS_ROPE); const float* RS = RC + 96 * 32;
    const float* gq = F.in[I_ATQN] + l * 128; const float* gk = F.in[I_ATKN] + l * 128;
    const int gw = blockIdx.x * NWAVES + F.wave, NGW = F.G * NWAVES;
    const int half = F.lane >> 5, i = F.lane & 31, da = 64 * half + i, db = da + 32;
    const float gqa = gq[da], gqb = gq[db], gka = gk[da], gkb = gk[db];
    for (int row = gw; row < MT; row += NGW) {
        const bool isc = row >= ML; const int b = isc ? (row - ML) / CTXL : row / SEQ, t = isc ? (row - ML) % CTXL : row % SEQ;
        const bf16* zr = Z + (size_t)row * NZ;
        float cs = 1.f, sn = 0.f;
        if (!isc) { const int pos = half ? 32 + (t & 63) : (t >> 6); cs = RC[pos * 32 + i]; sn = RS[pos * 32 + i]; }
        if (!(isc && last)) {
#pragma unroll
            for (int h = 0; h < 4; ++h) {
                const float a = bf1(zr[ZC_ATQ + h * 128 + da]), bb = bf1(zr[ZC_ATQ + h * 128 + db]);
                const float rs = 1.0f / sqrtf(wave_sum(a * a + bb * bb) * (1.0f / 128.0f) + EPS);
                const float ya = a * rs * gqa, yb = bb * rs * gqb;
                QA[(size_t)row * 512 + h * 128 + da] = f2bf1(ya * cs - yb * sn); QA[(size_t)row * 512 + h * 128 + db] = f2bf1(yb * cs + ya * sn);
            }
        }
        const size_t krow = (size_t)b * 2304 + (isc ? t : 256 + t);
#pragma unroll
        for (int h = 0; h < 2; ++h) {
            const float a = bf1(zr[ZC_ATK + h * 128 + da]), bb = bf1(zr[ZC_ATK + h * 128 + db]);
            const float rs = 1.0f / sqrtf(wave_sum(a * a + bb * bb) * (1.0f / 128.0f) + EPS);
            const float ya = a * rs * gka, yb = bb * rs * gkb;
            KC[krow * 256 + h * 128 + da] = f2bf1(ya * cs - yb * sn); KC[krow * 256 + h * 128 + db] = f2bf1(yb * cs + ya * sn);
        }
        *(GAS v2u*)(VC + krow * 256 + 4 * F.lane) = *(const GAS v2u*)(zr + ZC_ATV + 4 * F.lane);
    }
}
__device__ __forceinline__ void phase_attention(Frame& F, bool last) {
    const attn::bf16* QA = (const attn::bf16*)(F.ws + WS_QA); const attn::bf16* KC = (const attn::bf16*)(F.ws + WS_KC); const attn::bf16* VC = (const attn::bf16*)(F.ws + WS_VC);
    attn::bf16* Y3 = (attn::bf16*)(F.ws + WS_Y) + (size_t)3 * MT * 512;
    const int nitems = last ? 256 : 288;
    for (int it = blockIdx.x; it < nitems; it += F.G) {
        if (it < 256) { const int qb = it & 7, h = (it >> 3) & 3, b = it >> 5; const size_t r0 = (size_t)b * SEQ + qb * 256;
            attn::attn_dense_body<attn::bf16>(QA + r0 * 512 + h * 128, KC + (size_t)b * 2304 * 256 + (h >> 1) * 128, VC + (size_t)b * 2304 * 256 + (h >> 1) * 128, Y3 + r0 * 512 + h * 128, 2304, (char*)F.lds + RING_OFF);
        } else { const int j = it - 256, h = j & 3, b = j >> 2; const size_t r0 = (size_t)ML + b * CTXL;
            attn::attn_dense_body<attn::bf16>(QA + r0 * 512 + h * 128, KC + (size_t)b * 2304 * 256 + (h >> 1) * 128, VC + (size_t)b * 2304 * 256 + (h >> 1) * 128, Y3 + r0 * 512 + h * 128, 256, (char*)F.lds + RING_OFF);
        }
        __syncthreads();
    }
}
__device__ __forceinline__ void phase_spatial(Frame& F, int l, bool last) {
    const bf16* Z = (const bf16*)(F.ws + WS_Z); bf16* Y0 = (bf16*)(F.ws + WS_Y);
    LAS unsigned char* Wl = F.lds + RING_OFF; LAS unsigned char* Vt = Wl + 34816;
    const int nchunk = last ? ML / 128 : MT / 128;
    const int tid = F.tid, r = tid >> 2, q = tid & 3;
    for (int it = blockIdx.x; it < nchunk * 4; it += F.G) {
        const int ch = it >> 2, g = it & 3; const size_t row0 = (size_t)ch * 128;
        const bf16* zv = Z + (row0 + r) * NZ + ZC_SGV;
        float ss = 0.f;
#pragma unroll 4
        for (int j = 0; j < 16; ++j) { const v4u w = *(const GAS v4u*)(zv + q * 128 + j * 8);
            const float e0 = gelu_tanh(bflo(w.x)), e1 = gelu_tanh(bfhi(w.x)), e2 = gelu_tanh(bflo(w.y)), e3 = gelu_tanh(bfhi(w.y)), e4 = gelu_tanh(bflo(w.z)), e5 = gelu_tanh(bfhi(w.z)), e6 = gelu_tanh(bflo(w.w)), e7 = gelu_tanh(bfhi(w.w));
            ss += (e0 * e0 + e1 * e1) + (e2 * e2 + e3 * e3) + (e4 * e4 + e5 * e5) + (e6 * e6 + e7 * e7); }
        ss += __shfl_xor(ss, 1); ss += __shfl_xor(ss, 2);
        const float rstd = 1.0f / sqrtf(ss * (1.0f / 512.0f) + EPS);
        const float* gn = F.in[I_SGN] + l * 512 + g * 128 + q * 32;
#pragma unroll
        for (int j = 0; j < 4; ++j) { const v4u w = *(const GAS v4u*)(zv + g * 128 + q * 32 + j * 8);
            const float e[8] = {gelu_tanh(bflo(w.x)), gelu_tanh(bfhi(w.x)), gelu_tanh(bflo(w.y)), gelu_tanh(bfhi(w.y)), gelu_tanh(bflo(w.z)), gelu_tanh(bfhi(w.z)), gelu_tanh(bflo(w.w)), gelu_tanh(bfhi(w.w))};
#pragma unroll
            for (int k = 0; k < 8; ++k) { const int c = q * 32 + j * 8 + k; *(LAS bf16*)(Vt + c * 272 + r * 2) = f2bf1(e[k] * rstd * gn[j * 8 + k]); } }
        const float* wg = F.in[I_SGW] + ((size_t)(l * 4 + g) * 128 + r) * 128 + q * 32;
#pragma unroll
        for (int j = 0; j < 4; ++j) { const f32x4 a = *(const f32x4*)(wg + j * 8), b = *(const f32x4*)(wg + j * 8 + 4);
            v4u o; o.x = pk2(a.x, a.y); o.y = pk2(a.z, a.w); o.z = pk2(b.x, b.y); o.w = pk2(b.z, b.w);
            *(LAS v4u*)(Wl + r * 272 + (q * 32 + j * 8) * 2) = o; }
        __syncthreads();
        const int wr = F.wave >> 1, wc = F.wave & 1;
        f32x4 acc[2][4];
#pragma unroll
        for (int mi = 0; mi < 2; ++mi)
#pragma unroll
            for (int ni = 0; ni < 4; ++ni) acc[mi][ni] = (f32x4){0.f, 0.f, 0.f, 0.f};
#pragma unroll
        for (int ks = 0; ks < 4; ++ks) {
            bf16x8 a[2], b[4];
#pragma unroll
            for (int mi = 0; mi < 2; ++mi) a[mi] = lds_frag(Wl, 272, 32 * wr + 16 * mi, ks * 64, F.lane);
#pragma unroll
            for (int ni = 0; ni < 4; ++ni) b[ni] = lds_frag(Vt, 272, 64 * wc + 16 * ni, ks * 64, F.lane);
#pragma unroll
            for (int mi = 0; mi < 2; ++mi)
#pragma unroll
                for (int ni = 0; ni < 4; ++ni) acc[mi][ni] = MFMA16(a[mi], b[ni], acc[mi][ni]);
        }
        const float* bs = F.in[I_SGB] + (l * 4 + g) * 128;
#pragma unroll
        for (int mi = 0; mi < 2; ++mi)
#pragma unroll
            for (int rr = 0; rr < 4; ++rr) { const int t = 32 * wr + 16 * mi + 4 * (F.lane >> 4) + rr; const float bias = bs[t];
#pragma unroll
                for (int ni = 0; ni < 4; ++ni) { const int c = g * 128 + 64 * wc + 16 * ni + (F.lane & 15);
                    const float u = gelu_tanh(bf1(Z[(row0 + t) * NZ + ZC_SGU + c]));
                    Y0[(row0 + t) * 512 + c] = f2bf1(u * (acc[mi][ni][rr] + bias)); } }
        __syncthreads();
    }
}
__device__ __forceinline__ void ml_slot(int chain, int k, int& rowbase, int& h, int& dir) {
    const int b = chain >> 3; h = (chain >> 1) & 3; dir = chain & 1;
    if (k < 2) { const int j = dir ? 1 - k : k; rowbase = ML + b * CTXL + 128 * j; }
    else { const int n = k - 2, j = dir ? 15 - n : n; rowbase = b * SEQ + 128 * j; }
}
__device__ __forceinline__ void ml_gates(Frame& F, int l, int rowbase, int h, int dir, LAS float* li, LAS float* lf, LAS float* bc) {
    const float* ZS = (const float*)(F.ws + WS_ZS); const float* bias = F.in[I_MLIFB] + l * 16;
    if (F.tid < 128) { const float* zr = ZS + (size_t)(rowbase + F.tid) * 32;
        li[F.tid] = zr[dir * 4 + h] + bias[dir * 4 + h];
        lf[F.tid] = logsigmoid1(zr[(2 + dir) * 4 + h] + bias[(2 + dir) * 4 + h]); }
    __syncthreads();
    if (F.tid < 128) { float s = 0.f;
        if (dir == 0) { for (int t = 0; t <= F.tid; ++t) s += lf[t]; } else { for (int t = 127; t >= F.tid; --t) s += lf[t]; }
        bc[F.tid] = s; }
    __syncthreads();
}
__device__ __forceinline__ void phase_ml1(Frame& F, int l) {
    const bf16* Z = (const bf16*)(F.ws + WS_Z);
    bf16* CL = (bf16*)(F.ws + WS_MIX + MX_CL); float* NL = (float*)(F.ws + WS_MIX + MX_NL); float* ST = (float*)(F.ws + WS_MIX + MX_ST);
    LAS unsigned char* kT = F.lds + RING_OFF; LAS unsigned char* vT = kT + 34816;
    LAS float* li = (LAS float*)(F.lds + RING_OFF + 69632); LAS float* lf = li + 128; LAS float* bc = lf + 128; LAS float* wg = bc + 128; LAS float* red = wg + 128;
    const int tid = F.tid, tau = tid >> 2, q = tid & 3;
    for (int it = blockIdx.x; it < 64 * 18; it += F.G) {
        const int chain = it / 18, k = it % 18; int rowbase, h, dir; ml_slot(chain, k, rowbase, h, dir);
        ml_gates(F, l, rowbase, h, dir, li, lf, bc);
        const float bend = dir ? bc[0] : bc[127];
        if (tid < 128) wg[tid] = bend - bc[tid] + li[tid];
        __syncthreads();
        if (tid < 64) { float m = fmaxf(wg[tid], wg[tid + 64]);
#pragma unroll
            for (int o = 1; o < 64; o <<= 1) m = fmaxf(m, __shfl_xor(m, o));
            if (tid == 0) red[0] = m; }
        __syncthreads();
        const float mloc = red[0];
        __syncthreads();
        if (tid < 128) wg[tid] = __expf(wg[tid] - mloc);
        __syncthreads();
        { const bf16* zk = Z + (size_t)(rowbase + tau) * NZ + ZC_MLK + h * 128 + q * 32; const bf16* zv = Z + (size_t)(rowbase + tau) * NZ + ZC_MLV + h * 128 + q * 32; const float w = wg[tau];
#pragma unroll
          for (int j = 0; j < 4; ++j) { const v4u a = *(const GAS v4u*)(zk + j * 8), b = *(const GAS v4u*)(zv + j * 8);
              const float ka[8] = {bflo(a.x), bfhi(a.x), bflo(a.y), bfhi(a.y), bflo(a.z), bfhi(a.z), bflo(a.w), bfhi(a.w)};
              const float va[8] = {bflo(b.x), bfhi(b.x), bflo(b.y), bfhi(b.y), bflo(b.z), bfhi(b.z), bflo(b.w), bfhi(b.w)};
#pragma unroll
              for (int c = 0; c < 8; ++c) { const int col = q * 32 + j * 8 + c;
                  *(LAS bf16*)(kT + col * 272 + tau * 2) = f2bf1(ka[c] * 0.08838834764831845f);
                  *(LAS bf16*)(vT + col * 272 + tau * 2) = f2bf1(va[c] * w); } } }
        __syncthreads();
        const int wr = F.wave >> 1, wc = F.wave & 1;
        f32x4 acc[2][4];
#pragma unroll
        for (int mi = 0; mi < 2; ++mi)
#pragma unroll
            for (int ni = 0; ni < 4; ++ni) acc[mi][ni] = (f32x4){0.f, 0.f, 0.f, 0.f};
#pragma unroll
        for (int ks = 0; ks < 4; ++ks) {
            bf16x8 a[2], b[4];
#pragma unroll
            for (int mi = 0; mi < 2; ++mi) a[mi] = lds_frag(vT, 272, 32 * wr + 16 * mi, ks * 64, F.lane);
#pragma unroll
            for (int ni = 0; ni < 4; ++ni) b[ni] = lds_frag(kT, 272, 64 * wc + 16 * ni, ks * 64, F.lane);
#pragma unroll
            for (int mi = 0; mi < 2; ++mi)
#pragma unroll
                for (int ni = 0; ni < 4; ++ni) acc[mi][ni] = MFMA16(a[mi], b[ni], acc[mi][ni]);
        }
        bf16* cl = CL + (size_t)it * 16384;
#pragma unroll
        for (int mi = 0; mi < 2; ++mi)
#pragma unroll
            for (int rr = 0; rr < 4; ++rr) { const int e = 32 * wr + 16 * mi + 4 * (F.lane >> 4) + rr;
#pragma unroll
                for (int ni = 0; ni < 4; ++ni) cl[e * 128 + 64 * wc + 16 * ni + (F.lane & 15)] = f2bf1(acc[mi][ni][rr]); }
        if (tid < 128) { float s = 0.f; const LAS bf16* kr = (const LAS bf16*)(kT + tid * 272);
            for (int t = 0; t < 128; ++t) s += wg[t] * bf1(kr[t]);
            NL[(size_t)it * 128 + tid] = s; }
        if (tid == 0) { ST[it * 32 + 0] = mloc; ST[it * 32 + 1] = bend; }
        __syncthreads();
    }
}
__device__ __forceinline__ void phase_ml2(Frame& F) {
    const bf16* CL = (const bf16*)(F.ws + WS_MIX + MX_CL); const float* NL = (const float*)(F.ws + WS_MIX + MX_NL); const float* ST = (const float*)(F.ws + WS_MIX + MX_ST);
    bf16* CP = (bf16*)(F.ws + WS_MIX + MX_CP); float* NP = (float*)(F.ws + WS_MIX + MX_NP); float* SP = (float*)(F.ws + WS_MIX + MX_SP);
    const int gt = blockIdx.x * (NWAVES * 64) + F.tid, NT = F.G * NWAVES * 64;
    for (int task = gt; task < 64 * 4096; task += NT) {
        const int chain = task >> 12, e4 = (task & 4095) * 4;
        float c0 = 0.f, c1 = 0.f, c2 = 0.f, c3 = 0.f, m = 0.f;
        for (int k = 0; k < 18; ++k) { const int it = chain * 18 + k;
            const float mloc = ST[it * 32 + 0], bend = ST[it * 32 + 1];
            const v2u w = *(const GAS v2u*)(CL + (size_t)it * 16384 + e4);
            v2u o; o.x = pk2(c0, c1); o.y = pk2(c2, c3); *(GAS v2u*)(CP + (size_t)it * 16384 + e4) = o;
            const float mn = fmaxf(bend + m, mloc), sp = __expf(bend + m - mn), sl = __expf(mloc - mn);
            c0 = sp * c0 + sl * bflo(w.x); c1 = sp * c1 + sl * bfhi(w.x); c2 = sp * c2 + sl * bflo(w.y); c3 = sp * c3 + sl * bfhi(w.y); m = mn; }
    }
    for (int task = gt; task < 64 * 128; task += NT) {
        const int chain = task >> 7, d = task & 127; float n = 0.f, m = 0.f;
        for (int k = 0; k < 18; ++k) { const int it = chain * 18 + k;
            const float mloc = ST[it * 32 + 0], bend = ST[it * 32 + 1];
            const float nl = NL[(size_t)it * 128 + d]; NP[(size_t)it * 128 + d] = n;
            if (d == 0) SP[it * 32] = m;
            const float mn = fmaxf(bend + m, mloc), sp = __expf(bend + m - mn), sl = __expf(mloc - mn);
            n = sp * n + sl * nl; m = mn; }
    }
}
__device__ __forceinline__ void phase_ml3(Frame& F, int l, bool last) {
    const bf16* Z = (const bf16*)(F.ws + WS_Z); bf16* Y1 = (bf16*)(F.ws + WS_Y) + (size_t)MT * 512;
    const bf16* CL = (const bf16*)(F.ws + WS_MIX + MX_CP); const float* NL = (const float*)(F.ws + WS_MIX + MX_NP); const float* ST = (const float*)(F.ws + WS_MIX + MX_SP);
    LAS unsigned char* qs = F.lds + RING_OFF; LAS unsigned char* ks = qs + 34816; LAS unsigned char* vT = ks + 34816;
    LAS float* li = (LAS float*)(F.lds + RING_OFF + 104448); LAS float* lf = li + 128; LAS float* bc = lf + 128; LAS float* cv = bc + 128; LAS float* Mt = cv + 128;
    LAS float* inter = Mt + 128; LAS float* rden = inter + 128; LAS float* emt = rden + 128; LAS float* rowss = emt + 128; LAS float* npv = rowss + 256;
    const int tid = F.tid, tau = tid >> 2, q = tid & 3, lane = F.lane, g4 = lane >> 4, l15 = lane & 15;
    const int nitems = last ? 512 : 576;
    for (int it = blockIdx.x; it < nitems; it += F.G) {
        int b, h, j, rowbase, nch;
        if (it < 512) { b = it >> 6; h = (it >> 4) & 3; j = it & 15; rowbase = b * SEQ + 128 * j; nch = 16; }
        else { const int r = it - 512; b = r >> 3; h = (r >> 1) & 3; j = r & 1; rowbase = ML + b * CTXL + 128 * j; nch = 2; }
        { const bf16* zq = Z + (size_t)(rowbase + tau) * NZ + ZC_MLQ + h * 128 + q * 32; const bf16* zk = Z + (size_t)(rowbase + tau) * NZ + ZC_MLK + h * 128 + q * 32;
          const bf16* zv = Z + (size_t)(rowbase + tau) * NZ + ZC_MLV + h * 128 + q * 32;
#pragma unroll
          for (int jj = 0; jj < 4; ++jj) { const v4u a = *(const GAS v4u*)(zq + jj * 8), kk = *(const GAS v4u*)(zk + jj * 8), vv = *(const GAS v4u*)(zv + jj * 8);
              *(LAS v4u*)(qs + tau * 272 + (q * 32 + jj * 8) * 2) = a;
              v4u ko; const float s = 0.08838834764831845f;
              ko.x = pk2(bflo(kk.x) * s, bfhi(kk.x) * s); ko.y = pk2(bflo(kk.y) * s, bfhi(kk.y) * s); ko.z = pk2(bflo(kk.z) * s, bfhi(kk.z) * s); ko.w = pk2(bflo(kk.w) * s, bfhi(kk.w) * s);
              *(LAS v4u*)(ks + tau * 272 + (q * 32 + jj * 8) * 2) = ko;
              const unsigned vw[4] = {vv.x, vv.y, vv.z, vv.w};
#pragma unroll
              for (int c = 0; c < 4; ++c) { const int col = q * 32 + jj * 8 + 2 * c;
                  *(LAS bf16*)(vT + col * 272 + tau * 2) = (bf16)(vw[c] & 0xffffu); *(LAS bf16*)(vT + (col + 1) * 272 + tau * 2) = (bf16)(vw[c] >> 16); } } }
        __syncthreads();
        const int wr = F.wave >> 1, wc = F.wave & 1;
        f32x4 accS[2][4];
#pragma unroll
        for (int mi = 0; mi < 2; ++mi)
#pragma unroll
            for (int ni = 0; ni < 4; ++ni) accS[mi][ni] = (f32x4){0.f, 0.f, 0.f, 0.f};
#pragma unroll
        for (int kk = 0; kk < 4; ++kk) {
            bf16x8 a[2], bq[4];
#pragma unroll
            for (int mi = 0; mi < 2; ++mi) a[mi] = lds_frag(ks, 272, 32 * wr + 16 * mi, kk * 64, lane);
#pragma unroll
            for (int ni = 0; ni < 4; ++ni) bq[ni] = lds_frag(qs, 272, 64 * wc + 16 * ni, kk * 64, lane);
#pragma unroll
            for (int mi = 0; mi < 2; ++mi)
#pragma unroll
                for (int ni = 0; ni < 4; ++ni) accS[mi][ni] = MFMA16(a[mi], bq[ni], accS[mi][ni]);
        }
        f32x4 hsum[2][4];
#pragma unroll
        for (int mi = 0; mi < 2; ++mi)
#pragma unroll
            for (int ni = 0; ni < 4; ++ni) hsum[mi][ni] = (f32x4){0.f, 0.f, 0.f, 0.f};
        for (int dir = 0; dir < 2; ++dir) {
            const int n = dir ? nch - 1 - j : j, slot = (it < 512) ? 2 + n : n, chain = (b * 4 + h) * 2 + dir, sit = chain * 18 + slot;
            __syncthreads();
            ml_gates(F, l, rowbase, h, dir, li, lf, bc);
            const float mprev = ST[sit * 32];
            if (tid < 128) { cv[tid] = li[tid] - bc[tid]; npv[tid] = NL[(size_t)sit * 128 + tid]; }
            __syncthreads();
            if (tid < 128) { float mx = -3.0e38f;
                if (dir == 0) { for (int s = 0; s <= tid; ++s) mx = fmaxf(mx, cv[s]); } else { for (int s = 127; s >= tid; --s) mx = fmaxf(mx, cv[s]); }
                const float M = fmaxf(mx, mprev); Mt[tid] = M; inter[tid] = __expf(mprev - M); emt[tid] = __expf(-(bc[tid] + M)); }
            __syncthreads();
#pragma unroll
            for (int mi = 0; mi < 2; ++mi)
#pragma unroll
                for (int ni = 0; ni < 4; ++ni) { const int t = 64 * wc + 16 * ni + l15, s0 = 32 * wr + 16 * mi + 4 * g4; const float M = Mt[t];
                    float p[4];
#pragma unroll
                    for (int rr = 0; rr < 4; ++rr) { const int s = s0 + rr; const bool ok = dir ? (s >= t) : (s <= t); p[rr] = ok ? __expf(cv[s] - M) * accS[mi][ni][rr] : 0.f; }
                    v2u o; o.x = pk2(p[0], p[1]); o.y = pk2(p[2], p[3]); *(LAS v2u*)(ks + t * 272 + s0 * 2) = o; }
            __syncthreads();
            { float sp = 0.f, sn = 0.f; const LAS bf16* pr = (const LAS bf16*)(ks + tau * 272) + q * 32; const LAS bf16* qr = (const LAS bf16*)(qs + tau * 272) + q * 32;
#pragma unroll 8
              for (int c = 0; c < 32; ++c) { sp += bf1(pr[c]); sn += npv[q * 32 + c] * bf1(qr[c]); }
              sp += __shfl_xor(sp, 1); sp += __shfl_xor(sp, 2); sn += __shfl_xor(sn, 1); sn += __shfl_xor(sn, 2);
              if (q == 0) { const float den = sp + inter[tau] * sn; rden[tau] = 1.0f / fmaxf(fabsf(den), emt[tau]); } }
            f32x4 acc[2][4];
#pragma unroll
            for (int mi = 0; mi < 2; ++mi)
#pragma unroll
                for (int ni = 0; ni < 4; ++ni) acc[mi][ni] = (f32x4){0.f, 0.f, 0.f, 0.f};
            const bf16* cp = CL + (size_t)sit * 16384;
#pragma unroll
            for (int kk = 0; kk < 4; ++kk) {
                bf16x8 a[2], bb[4];
#pragma unroll
                for (int mi = 0; mi < 2; ++mi) a[mi] = lds_frag(qs, 272, 32 * wr + 16 * mi, kk * 64, lane);
#pragma unroll
                for (int ni = 0; ni < 4; ++ni) bb[ni] = *(const GAS bf16x8*)(cp + (64 * wc + 16 * ni + l15) * 128 + kk * 32 + g4 * 8);
#pragma unroll
                for (int mi = 0; mi < 2; ++mi)
#pragma unroll
                    for (int ni = 0; ni < 4; ++ni) acc[mi][ni] = MFMA16(a[mi], bb[ni], acc[mi][ni]);
            }
#pragma unroll
            for (int mi = 0; mi < 2; ++mi)
#pragma unroll
                for (int rr = 0; rr < 4; ++rr) { const float sc = inter[32 * wr + 16 * mi + 4 * g4 + rr];
#pragma unroll
                    for (int ni = 0; ni < 4; ++ni) acc[mi][ni][rr] *= sc; }
#pragma unroll
            for (int kk = 0; kk < 4; ++kk) {
                bf16x8 a[2], bb[4];
#pragma unroll
                for (int mi = 0; mi < 2; ++mi) a[mi] = lds_frag(ks, 272, 32 * wr + 16 * mi, kk * 64, lane);
#pragma unroll
                for (int ni = 0; ni < 4; ++ni) bb[ni] = lds_frag(vT, 272, 64 * wc + 16 * ni, kk * 64, lane);
#pragma unroll
                for (int mi = 0; mi < 2; ++mi)
#pragma unroll
                    for (int ni = 0; ni < 4; ++ni) acc[mi][ni] = MFMA16(a[mi], bb[ni], acc[mi][ni]);
            }
            __syncthreads();
#pragma unroll
            for (int mi = 0; mi < 2; ++mi)
#pragma unroll
                for (int rr = 0; rr < 4; ++rr) { const float sc = rden[32 * wr + 16 * mi + 4 * g4 + rr];
#pragma unroll
                    for (int ni = 0; ni < 4; ++ni) hsum[mi][ni][rr] += acc[mi][ni][rr] * sc; }
        }
        __syncthreads();
#pragma unroll
        for (int mi = 0; mi < 2; ++mi)
#pragma unroll
            for (int rr = 0; rr < 4; ++rr) { float s = 0.f;
#pragma unroll
                for (int ni = 0; ni < 4; ++ni) s += hsum[mi][ni][rr] * hsum[mi][ni][rr];
                s += __shfl_xor(s, 1); s += __shfl_xor(s, 2); s += __shfl_xor(s, 4); s += __shfl_xor(s, 8);
                if (l15 == 0) rowss[wc * 128 + 32 * wr + 16 * mi + 4 * g4 + rr] = s; }
        __syncthreads();
        const float* gn = F.in[I_MLN] + l * 512 + h * 128;
#pragma unroll
        for (int mi = 0; mi < 2; ++mi)
#pragma unroll
            for (int rr = 0; rr < 4; ++rr) { const int t = 32 * wr + 16 * mi + 4 * g4 + rr; const float rs = 1.0f / sqrtf((rowss[t] + rowss[128 + t]) * (1.0f / 128.0f) + EPS);
#pragma unroll
                for (int ni = 0; ni < 4; ++ni) { const int e = 64 * wc + 16 * ni + l15;
                    const float og = sigm1(bf1(Z[(size_t)(rowbase + t) * NZ + ZC_MLO + h * 128 + e]));
                    Y1[(size_t)(rowbase + t) * 512 + h * 128 + e] = f2bf1(og * hsum[mi][ni][rr] * rs * gn[e]); } }
        __syncthreads();
    }
}
__device__ __forceinline__ void gd_slot(int chain, int k, int& seqbase, int& T, int& n, int& h, int& dir) {
    const int b = chain >> 3; h = (chain >> 1) & 3; dir = chain & 1;
    if (k < 4) { seqbase = ML + b * CTXL; T = CTXL; n = k; } else { seqbase = b * SEQ; T = SEQ; n = k - 4; }
}
__device__ __forceinline__ void phase_gd0(Frame& F, int l, bool last) {
    const bf16* Z = (const bf16*)(F.ws + WS_Z); const float* ZS = (const float*)(F.ws + WS_ZS);
    bf16* GQ = (bf16*)(F.ws + WS_MIX + MX_GQ); bf16* GK = (bf16*)(F.ws + WS_MIX + MX_GK); bf16* GV = (bf16*)(F.ws + WS_MIX + MX_GV);
    float* GG = (float*)(F.ws + WS_MIX + MX_GG); float* GB = (float*)(F.ws + WS_MIX + MX_GB);
    const float* cw = F.in[I_GDCONV] + (size_t)l * 3 * 1536;
    const int gw = blockIdx.x * NWAVES + F.wave, NGW = F.G * NWAVES, c8 = F.lane * 8;
    for (int row = gw; row < MT; row += NGW) {
        const bool isc = row >= ML; const int t = isc ? (row - ML) % CTXL : row % SEQ, T = isc ? CTXL : SEQ;
        const bool hp = t > 0, hn = t < T - 1;
#pragma unroll
        for (int seg = 0; seg < 3; ++seg) {
            if (seg == 0 && isc && last) continue;
            const int zc = (seg == 0 ? ZC_GDQ : seg == 1 ? ZC_GDK : ZC_GDV) + c8;
            const bf16* zr = Z + (size_t)row * NZ + zc;
            const v4u x1 = *(const GAS v4u*)zr;
            v4u x0 = (v4u){0u, 0u, 0u, 0u}, x2 = (v4u){0u, 0u, 0u, 0u};
            if (hp) x0 = *(const GAS v4u*)(zr - NZ);
            if (hn) x2 = *(const GAS v4u*)(zr + NZ);
            const float* w0 = cw + seg * 512 + c8; const float* w1 = w0 + 1536; const float* w2 = w1 + 1536;
            const unsigned a0[4] = {x0.x, x0.y, x0.z, x0.w}, a1[4] = {x1.x, x1.y, x1.z, x1.w}, a2[4] = {x2.x, x2.y, x2.z, x2.w};
            float y[8]; float ss = 0.f;
#pragma unroll
            for (int j = 0; j < 4; ++j) {
                const float lo = bflo(a0[j]) * w0[2 * j] + bflo(a1[j]) * w1[2 * j] + bflo(a2[j]) * w2[2 * j];
                const float hi = bfhi(a0[j]) * w0[2 * j + 1] + bfhi(a1[j]) * w1[2 * j + 1] + bfhi(a2[j]) * w2[2 * j + 1];
                y[2 * j] = silu1(lo); y[2 * j + 1] = silu1(hi); ss += y[2 * j] * y[2 * j] + y[2 * j + 1] * y[2 * j + 1]; }
            float sc = 1.f;
            if (seg < 2) { ss += __shfl_xor(ss, 1); ss += __shfl_xor(ss, 2); ss += __shfl_xor(ss, 4); ss += __shfl_xor(ss, 8);
                sc = 1.0f / sqrtf(ss + EPS); if (seg == 0) sc *= 0.08838834764831845f; }
            v4u o; o.x = pk2(y[0] * sc, y[1] * sc); o.y = pk2(y[2] * sc, y[3] * sc); o.z = pk2(y[4] * sc, y[5] * sc); o.w = pk2(y[6] * sc, y[7] * sc);
            bf16* dst = (seg == 0 ? GQ : seg == 1 ? GK : GV) + (size_t)row * 512 + c8;
            *(GAS v4u*)dst = o;
        }
        if (F.lane < 8) {
            const int dir = F.lane >> 2, h = F.lane & 3; const float* zs = ZS + (size_t)row * 32 + 16;
            const float beta = sigm1(zs[dir * 4 + h]);
            const float g = -__expf(F.in[I_GDALOG][l * 8 + dir * 4 + h]) * softplus1(zs[(2 + dir) * 4 + h] + F.in[I_GDDTB][l * 8 + dir * 4 + h]);
            GG[((size_t)dir * MT + row) * 4 + h] = g; GB[((size_t)dir * MT + row) * 4 + h] = beta;
        }
    }
}
__device__ __forceinline__ void phase_gd1(Frame& F) {
    const bf16* GQ = (const bf16*)(F.ws + WS_MIX + MX_GQ); const bf16* GK = (const bf16*)(F.ws + WS_MIX + MX_GK); const bf16* GV = (const bf16*)(F.ws + WS_MIX + MX_GV);
    const float* GG = (const float*)(F.ws + WS_MIX + MX_GG); const float* GB = (const float*)(F.ws + WS_MIX + MX_GB);
    unsigned char* G1 = F.ws + WS_MIX + MX_GD1; float* GE = (float*)(F.ws + WS_MIX + MX_GE);
    LAS unsigned char* kl = F.lds + RING_OFF; LAS unsigned char* ql = kl + 17408; LAS unsigned char* vl = ql + 17408;
    LAS float* Mf = (LAS float*)(F.lds + RING_OFF + 52224);
    LAS unsigned char* wst = F.lds + RING_OFF + 69632;
    LAS float* gc = (LAS float*)(F.lds + RING_OFF + 86016); LAS float* bt = gc + 64; LAS float* gr = bt + 64;
    const int tid = F.tid, lane = F.lane, g4 = lane >> 4, l15 = lane & 15;
    for (int it = blockIdx.x; it < 64 * 36; it += F.G) {
        const int chain = it / 36, k = it % 36; int seqbase, T, n, h, dir; gd_slot(chain, k, seqbase, T, n, h, dir);
        unsigned char* out = G1 + (size_t)it * GD1_ITEM;
        bf16* WN = (bf16*)out; bf16* QD = (bf16*)(out + 16384); bf16* KT = (bf16*)(out + 32768); bf16* UT = (bf16*)(out + 49152); bf16* QKM = (bf16*)(out + 65536);
        { const int p = tid >> 3, c0 = (tid & 7) * 16; const int tok = dir ? T - 1 - (64 * n + p) : 64 * n + p; const size_t off = (size_t)(seqbase + tok) * 512 + h * 128 + c0;
          *(LAS v4u*)(kl + p * 272 + c0 * 2) = *(const GAS v4u*)(GK + off); *(LAS v4u*)(kl + p * 272 + c0 * 2 + 16) = *(const GAS v4u*)(GK + off + 8);
          *(LAS v4u*)(ql + p * 272 + c0 * 2) = *(const GAS v4u*)(GQ + off); *(LAS v4u*)(ql + p * 272 + c0 * 2 + 16) = *(const GAS v4u*)(GQ + off + 8);
          *(LAS v4u*)(vl + p * 272 + c0 * 2) = *(const GAS v4u*)(GV + off); *(LAS v4u*)(vl + p * 272 + c0 * 2 + 16) = *(const GAS v4u*)(GV + off + 8); }
        if (tid < 64) { const int tok = dir ? T - 1 - (64 * n + tid) : 64 * n + tid; const size_t gi = ((size_t)dir * MT + seqbase + tok) * 4 + h; gr[tid] = GG[gi]; bt[tid] = GB[gi]; }
        __syncthreads();
        if (tid < 64) { float s = 0.f; for (int p = 0; p <= tid; ++p) s += gr[p]; gc[tid] = s; }
        __syncthreads();
        const float gcend = gc[63];
        if (F.wave < 4) {
            const int i0 = 16 * F.wave; f32x4 acc[4];
#pragma unroll
            for (int ni = 0; ni < 4; ++ni) acc[ni] = (f32x4){0.f, 0.f, 0.f, 0.f};
#pragma unroll
            for (int ks = 0; ks < 4; ++ks) { const bf16x8 a = lds_frag(kl, 272, i0, ks * 64, lane);
#pragma unroll
                for (int ni = 0; ni < 4; ++ni) acc[ni] = MFMA16(a, lds_frag(kl, 272, 16 * ni, ks * 64, lane), acc[ni]); }
#pragma unroll
            for (int ni = 0; ni < 4; ++ni)
#pragma unroll
                for (int rr = 0; rr < 4; ++rr) { const int i = i0 + 4 * g4 + rr, j = 16 * ni + l15;
                    Mf[i * 65 + j] = (j < i) ? bt[i] * acc[ni][rr] * __expf(gc[i] - gc[j]) : 0.f; }
        } else {
            const int j0 = 16 * (F.wave - 4); f32x4 acc[4];
#pragma unroll
            for (int ni = 0; ni < 4; ++ni) acc[ni] = (f32x4){0.f, 0.f, 0.f, 0.f};
#pragma unroll
            for (int ks = 0; ks < 4; ++ks) { const bf16x8 a = lds_frag(kl, 272, j0, ks * 64, lane);
#pragma unroll
                for (int ni = 0; ni < 4; ++ni) acc[ni] = MFMA16(a, lds_frag(ql, 272, 16 * ni, ks * 64, lane), acc[ni]); }
            const int jt = F.wave - 4;
#pragma unroll
            for (int ni = 0; ni < 4; ++ni) { const int i = 16 * ni + l15; float v[4];
#pragma unroll
                for (int rr = 0; rr < 4; ++rr) { const int j = j0 + 4 * g4 + rr; v[rr] = (j <= i) ? acc[ni][rr] * __expf(gc[i] - gc[j]) : 0.f; }
                v2u o; o.x = pk2(v[0], v[1]); o.y = pk2(v[2], v[3]);
                *(GAS v2u*)(QKM + i * 64 + 32 * (jt >> 1) + 8 * g4 + 4 * (jt & 1)) = o; }
        }
        __syncthreads();
        if (F.wave >= 4) {
            const int t2 = tid - 256;
            { const int d = t2 & 127, hf = t2 >> 7; float v[32];
#pragma unroll
              for (int ll = 0; ll < 32; ++ll) { const int lq = 32 * hf + ll; v[perm32p(ll)] = bf1(((const LAS bf16*)(kl + lq * 272))[d]) * __expf(gcend - gc[lq]); }
#pragma unroll
              for (int j = 0; j < 4; ++j) { v4u o; o.x = pk2(v[8 * j], v[8 * j + 1]); o.y = pk2(v[8 * j + 2], v[8 * j + 3]); o.z = pk2(v[8 * j + 4], v[8 * j + 5]); o.w = pk2(v[8 * j + 6], v[8 * j + 7]);
                  *(GAS v4u*)(KT + d * 64 + 32 * hf + 8 * j) = o; } }
            { const int lq = t2 & 63, db = t2 >> 6; const float e = __expf(gc[lq]); float v[32]; const LAS bf16* qr = (const LAS bf16*)(ql + lq * 272) + 32 * db;
#pragma unroll
              for (int dd = 0; dd < 32; ++dd) v[perm32p(dd)] = bf1(qr[dd]) * e;
#pragma unroll
              for (int j = 0; j < 4; ++j) { v4u o; o.x = pk2(v[8 * j], v[8 * j + 1]); o.y = pk2(v[8 * j + 2], v[8 * j + 3]); o.z = pk2(v[8 * j + 4], v[8 * j + 5]); o.w = pk2(v[8 * j + 6], v[8 * j + 7]);
                  *(GAS v4u*)(QD + lq * 128 + 32 * db + 8 * j) = o; } }
            if (t2 == 0) GE[it * 32] = __expf(gcend);
        }
        { const bool isw = F.wave >= 4; const int cb = 32 * (F.wave & 3);
          const LAS bf16* src = (const LAS bf16*)((isw ? kl : vl) + lane * 272) + cb;
          float res[32]; const float sc = isw ? bt[lane] * __expf(gc[lane]) : bt[lane];
#pragma unroll
          for (int j = 0; j < 4; ++j) { const v4u w = *(const LAS v4u*)(src + 8 * j);
              res[8 * j] = bflo(w.x) * sc; res[8 * j + 1] = bfhi(w.x) * sc; res[8 * j + 2] = bflo(w.y) * sc; res[8 * j + 3] = bfhi(w.y) * sc;
              res[8 * j + 4] = bflo(w.z) * sc; res[8 * j + 5] = bfhi(w.z) * sc; res[8 * j + 6] = bflo(w.w) * sc; res[8 * j + 7] = bfhi(w.w) * sc; }
          for (int j = 0; j < 63; ++j) { const float mj = Mf[lane * 65 + j];
#pragma unroll
              for (int cc = 0; cc < 32; ++cc) { const float xj = __builtin_bit_cast(float, __builtin_amdgcn_readlane(__builtin_bit_cast(int, res[cc]), j)); res[cc] -= mj * xj; } }
          if (!isw) {
#pragma unroll
              for (int cc = 0; cc < 32; ++cc) UT[(cb + cc) * 64 + lane] = f2bf1(res[cc]);
          } else {
              float v[32];
#pragma unroll
              for (int cc = 0; cc < 32; ++cc) v[perm32p(cc)] = -res[cc];
#pragma unroll
              for (int j = 0; j < 4; ++j) { v4u o; o.x = pk2(v[8 * j], v[8 * j + 1]); o.y = pk2(v[8 * j + 2], v[8 * j + 3]); o.z = pk2(v[8 * j + 4], v[8 * j + 5]); o.w = pk2(v[8 * j + 6], v[8 * j + 7]);
                  *(GAS v4u*)(WN + lane * 128 + cb + 8 * j) = o; }
          } }
        __syncthreads();
    }
}
constexpr int GD2_BUF = 62464;
__device__ __forceinline__ void gd2_load(const unsigned char* src, v4u (&r)[7], int tid) {
#pragma unroll
    for (int j = 0; j < 7; ++j) r[j] = *(const GAS v4u*)(src + (size_t)(tid + 512 * j) * 16);
}
__device__ __forceinline__ void gd2_store(LAS unsigned char* buf, const v4u (&r)[7], int tid) {
#pragma unroll
    for (int j = 0; j < 7; ++j) { const int pc = tid + 512 * j;
        int off;
        if (pc < 1024) off = (pc >> 4) * 272 + (pc & 15) * 16;
        else if (pc < 2048) off = 17408 + ((pc - 1024) >> 4) * 272 + (pc & 15) * 16;
        else if (pc < 3072) off = 44032 + ((pc - 2048) >> 3) * 144 + (pc & 7) * 16;
        else off = 34816 + ((pc - 3072) >> 3) * 144 + (pc & 7) * 16;
        *(LAS v4u*)(buf + off) = r[j]; }
}
__device__ __forceinline__ void phase_gd2(Frame& F, bool last) {
    const unsigned char* G1 = F.ws + WS_MIX + MX_GD1; const float* GE = (const float*)(F.ws + WS_MIX + MX_GE);
    float* GO = (float*)(F.ws + WS_H);
    const int tid = F.tid, lane = F.lane, g4 = lane >> 4, l15 = lane & 15, e0 = 16 * F.wave;
    for (int chain = blockIdx.x; chain < 64; chain += F.G) {
        const int h = (chain >> 1) & 3, dir = chain & 1, b = chain >> 3;
        f32x4 S[8];
#pragma unroll
        for (int db = 0; db < 8; ++db) S[db] = (f32x4){0.f, 0.f, 0.f, 0.f};
        v4u r[7];
        { const unsigned char* it0 = G1 + (size_t)(chain * 36) * GD1_ITEM;
#pragma unroll
          for (int j = 0; j < 7; ++j) { const int pc = tid + 512 * j; const int gp = pc < 3072 ? pc : pc + 1024; r[j] = *(const GAS v4u*)(it0 + (size_t)gp * 16); } }
        gd2_store(F.lds + RING_OFF, r, tid);
        __syncthreads();
        for (int k = 0; k < 36; ++k) {
            LAS unsigned char* buf = F.lds + RING_OFF + (k & 1) * GD2_BUF;
            const unsigned char* item = G1 + (size_t)(chain * 36 + k) * GD1_ITEM;
            if (k + 1 < 36) { const unsigned char* nx = item + GD1_ITEM;
#pragma unroll
                for (int j = 0; j < 7; ++j) { const int pc = tid + 512 * j; const int gp = pc < 3072 ? pc : pc + 1024; r[j] = *(const GAS v4u*)(nx + (size_t)gp * 16); } }
            const bf16* UT = (const bf16*)(item + 49152);
            const float gend = GE[(chain * 36 + k) * 32];
            int seqbase, T, n; if (k < 4) { seqbase = ML + b * CTXL; T = CTXL; n = k; } else { seqbase = b * SEQ; T = SEQ; n = k - 4; }
            bf16x8 Sb[4];
#pragma unroll
            for (int ks = 0; ks < 4; ++ks) { v4u w; w.x = pk2(S[2 * ks][0], S[2 * ks][1]); w.y = pk2(S[2 * ks][2], S[2 * ks][3]); w.z = pk2(S[2 * ks + 1][0], S[2 * ks + 1][1]); w.w = pk2(S[2 * ks + 1][2], S[2 * ks + 1][3]);
                Sb[ks] = __builtin_bit_cast(bf16x8, w); }
            f32x4 vn[4];
#pragma unroll
            for (int lb = 0; lb < 4; ++lb) { const v2u uu = *(const GAS v2u*)(UT + (e0 + l15) * 64 + 16 * lb + 4 * g4);
                f32x4 acc = (f32x4){bflo(uu.x), bfhi(uu.x), bflo(uu.y), bfhi(uu.y)};
#pragma unroll
                for (int ks = 0; ks < 4; ++ks) acc = MFMA16(lds_frag(buf, 272, 16 * lb, ks * 64, lane), Sb[ks], acc);
                vn[lb] = acc; }
            bf16x8 Vb[2];
#pragma unroll
            for (int ks = 0; ks < 2; ++ks) { v4u w; w.x = pk2(vn[2 * ks][0], vn[2 * ks][1]); w.y = pk2(vn[2 * ks][2], vn[2 * ks][3]); w.z = pk2(vn[2 * ks + 1][0], vn[2 * ks + 1][1]); w.w = pk2(vn[2 * ks + 1][2], vn[2 * ks + 1][3]);
                Vb[ks] = __builtin_bit_cast(bf16x8, w); }
            const bool wr_o = !(last && k < 4);
#pragma unroll
            for (int lb = 0; lb < 4; ++lb) { f32x4 acc = (f32x4){0.f, 0.f, 0.f, 0.f};
#pragma unroll
                for (int ks = 0; ks < 4; ++ks) acc = MFMA16(lds_frag(buf + 17408, 272, 16 * lb, ks * 64, lane), Sb[ks], acc);
#pragma unroll
                for (int ks = 0; ks < 2; ++ks) acc = MFMA16(lds_frag(buf + 34816, 144, 16 * lb, ks * 64, lane), Vb[ks], acc);
                if (wr_o) {
#pragma unroll
                    for (int rr = 0; rr < 4; ++rr) { const int p = 16 * lb + 4 * g4 + rr; const int tok = dir ? T - 1 - (64 * n + p) : 64 * n + p;
                        GO[((size_t)dir * MT + seqbase + tok) * 512 + h * 128 + e0 + l15] = acc[rr]; } } }
#pragma unroll
            for (int db = 0; db < 8; ++db) { f32x4 acc = S[db] * gend;
#pragma unroll
                for (int ks = 0; ks < 2; ++ks) acc = MFMA16(lds_frag(buf + 44032, 144, 16 * db, ks * 64, lane), Vb[ks], acc);
                S[db] = acc; }
            if (k + 1 < 36) gd2_store(F.lds + RING_OFF + ((k + 1) & 1) * GD2_BUF, r, tid);
            __syncthreads();
        }
    }
}
__device__ __forceinline__ void phase_gd3(Frame& F, int l, bool last) {
    const float* GO = (const float*)(F.ws + WS_H); const bf16* Z = (const bf16*)(F.ws + WS_Z); bf16* Y2 = (bf16*)(F.ws + WS_Y) + (size_t)2 * MT * 512;
    const int gw = blockIdx.x * NWAVES + F.wave, NGW = F.G * NWAVES, c8 = F.lane * 8; const int nrows = last ? ML : MT;
    const float* gn = F.in[I_GDN] + l * 128 + (c8 & 127);
    for (int row = gw; row < nrows; row += NGW) {
        const f32x4 a0 = *(const f32x4*)(GO + (size_t)row * 512 + c8), a1 = *(const f32x4*)(GO + (size_t)row * 512 + c8 + 4);
        const f32x4 b0 = *(const f32x4*)(GO + ((size_t)MT + row) * 512 + c8), b1 = *(const f32x4*)(GO + ((size_t)MT + row) * 512 + c8 + 4);
        const f32x4 s0 = a0 + b0, s1 = a1 + b1;
        float ss = (s0.x * s0.x + s0.y * s0.y) + (s0.z * s0.z + s0.w * s0.w) + (s1.x * s1.x + s1.y * s1.y) + (s1.z * s1.z + s1.w * s1.w);
        ss += __shfl_xor(ss, 1); ss += __shfl_xor(ss, 2); ss += __shfl_xor(ss, 4); ss += __shfl_xor(ss, 8);
        const float rs = 1.0f / sqrtf(ss * (1.0f / 128.0f) + EPS);
        const v4u zz = *(const GAS v4u*)(Z + (size_t)row * NZ + ZC_GDZ + c8);
        const float o[8] = {s0.x, s0.y, s0.z, s0.w, s1.x, s1.y, s1.z, s1.w}; const float zf[8] = {bflo(zz.x), bfhi(zz.x), bflo(zz.y), bfhi(zz.y), bflo(zz.z), bfhi(zz.z), bflo(zz.w), bfhi(zz.w)};
        float y[8];
#pragma unroll
        for (int j = 0; j < 8; ++j) y[j] = o[j] * rs * gn[j] * silu1(zf[j]);
        v4u w; w.x = pk2(y[0], y[1]); w.y = pk2(y[2], y[3]); w.z = pk2(y[4], y[5]); w.w = pk2(y[6], y[7]);
        *(GAS v4u*)(Y2 + (size_t)row * 512 + c8) = w;
    }
}
#define MIX_PHASE_1 phase_attn_prep(F, l, last); phase_spatial(F, l, last); phase_gd0(F, l, last);
#define MIX_PHASE_2 phase_ml1(F, l); phase_gd1(F);
#define MIX_PHASE_3 phase_ml2(F); phase_gd2(F, last);
#define MIX_PHASE_4 phase_ml3(F, l, last); phase_attention(F, last); phase_gd3(F, l, last);
#ifndef PROBE
#define PROBE 0
#endif
constexpr int PH_PER_LAYER = 15, N_PHASES = PROBE ? (1 + PH_PER_LAYER + 1) : (1 + NLAYER * PH_PER_LAYER);
#ifndef PHMASK
#define PHMASK 0xffff
#endif
#define PHEN(k) ((PHMASK >> (k)) & 1)
#define IN(p) (lo <= (p) && (p) < hi)
#define SEAM(p) do { if (lo <= (p) && (p) + 1 < hi) xcd_barrier(bar); } while (0)
struct Args { const float* in[27]; float* out; unsigned char* ws; int ph_lo, ph_hi, li, pad; };
template <int l> __device__ __forceinline__ void layer_body(Frame& F, const XcdBarrier& bar, const int lo, const int hi) {
    float* MOD = (float*)(F.ws + WS_MOD);
    float* XC = (float*)(F.ws + WS_XC);
    bf16* Hb = (bf16*)(F.ws + WS_H); bf16* Zb = (bf16*)(F.ws + WS_Z); bf16* ACT = (bf16*)(F.ws + WS_Z); float* ZS = (float*)(F.ws + WS_ZS);
    bf16* WFI = (bf16*)(F.ws + WS_WFI); bf16* WFO = (bf16*)(F.ws + WS_WFO); bf16* WZ = (bf16*)(F.ws + WS_WZ); bf16* WB = (bf16*)(F.ws + WS_WB); bf16* WO = (bf16*)(F.ws + WS_WO);
    bf16* Yb = (bf16*)(F.ws + WS_Y);
        constexpr int P = 1 + l * PH_PER_LAYER;
        constexpr bool last = (l == NLAYER - 1);
        const float* modl = MOD + (size_t)l * 9 * MODW;
        const float* xin_l = (l == 0) ? F.in[I_X] : F.out;
        const float* xin_c = (l == 0) ? F.in[I_CTX] : XC;
        constexpr int nPM = last ? 64 : 72;

        if (PHEN(0) && IN(P + 0)) phase_conv(F, l, 0);
        SEAM(P + 0);
        if (PHEN(1) && IN(P + 1)) phase_norm(F, xin_l, xin_c, F.in[I_F1N] + (size_t)l * D, modl + 0 * D, MT);
        SEAM(P + 1);
        if (PHEN(2) && IN(P + 2)) {
            pg8::Gemm g{Hb, WFI, MT, 2 * DFF, D}; pg8::TileOrder S; S.init(72, 44, 0, 0, 0, F.G, (int)blockIdx.x);
            pg8::EpiSwiglu E{ACT, DFF};
            pg8::gemm_phase<pg8::EpiSwiglu, pg8::TileOrder, PG8_ALIGN, PG8_SP2>(F.lds + RING_OFF, g, S, E);
        }
        SEAM(P + 2);
        if (PHEN(3) && IN(P + 3)) {
            pg8::Gemm g{ACT, WFO, MT, D, DFF}; pg8::TileOrder S; S.init(72, 8, 0, 0, 0, F.G, (int)blockIdx.x);
            pg8::EpiRes E{xin_l, xin_c, F.out, XC, modl + 2 * D, 0.5f};
            pg8::gemm_phase<pg8::EpiRes, pg8::TileOrder, PG8_ALIGN, PG8_SP2>(F.lds + RING_OFF, g, S, E);
        }
        SEAM(P + 3);
        if (PHEN(4) && IN(P + 4)) phase_norm(F, F.out, XC, F.in[I_MIXN] + (size_t)l * D, modl + 3 * D, MT);
        SEAM(P + 4);
        if (PHEN(5) && IN(P + 5)) {
            pg8::Gemm g{Hb, WZ, MT, NZ, D}; pg8::TileOrder S;
            if (last) S.init(64, 57, 8, NKV_TILES, 64, F.G, (int)blockIdx.x); else S.init(72, 57, 0, 0, 0, F.G, (int)blockIdx.x);
            pg8::EpiZ E{Zb, ZS, NZ};
            pg8::gemm_phase<pg8::EpiZ, pg8::TileOrder, PG8_ALIGN, PG8_SP2>(F.lds + RING_OFF, g, S, E);
        }
        SEAM(P + 5);
        if (PHEN(6) && IN(P + 6)) { phase_conv(F, l, 1); MIX_PHASE_1 }
        SEAM(P + 6);
        if (PHEN(7) && IN(P + 7)) { MIX_PHASE_2 }
        SEAM(P + 7);
        if (PHEN(8) && IN(P + 8)) { MIX_PHASE_3 }
        SEAM(P + 8);
        if (PHEN(9) && IN(P + 9)) { MIX_PHASE_4 }
        SEAM(P + 9);
        if (PHEN(10) && IN(P + 10)) {
            pg8::Gemm g{Yb, WB, 4 * MT, 4 * D, 512}; pg8::BranchOrder S; S.init(nPM, 72, F.G, (int)blockIdx.x);
            pg8::EpiBranch E{Zb, NZ, ZC_GATE, Hb, 72};
            pg8::gemm_phase<pg8::EpiBranch, pg8::BranchOrder, PG8_ALIGN, PG8_SP2>(F.lds + RING_OFF, g, S, E);
        }
        SEAM(P + 10);
        if (PHEN(11) && IN(P + 11)) {
            pg8::Gemm g{Hb, WO, MT, D, D}; pg8::TileOrder S; S.init(nPM, 8, 0, 0, 0, F.G, (int)blockIdx.x);
            pg8::EpiRes E{F.out, XC, F.out, XC, modl + 5 * D, 1.0f};
            pg8::gemm_phase<pg8::EpiRes, pg8::TileOrder, PG8_ALIGN, PG8_SP2>(F.lds + RING_OFF, g, S, E);
        }
        SEAM(P + 11);
        if (PHEN(12) && IN(P + 12)) phase_norm(F, F.out, XC, F.in[I_F2N] + (size_t)l * D, modl + 6 * D, nPM * 256);
        SEAM(P + 12);
        if (PHEN(13) && IN(P + 13)) {
            pg8::Gemm g{Hb, WFI, MT, 2 * DFF, D}; pg8::TileOrder S; S.init(nPM, 44, 0, 0, 0, F.G, (int)blockIdx.x);
            pg8::EpiSwiglu E{ACT, DFF};
            pg8::gemm_phase<pg8::EpiSwiglu, pg8::TileOrder, PG8_ALIGN, PG8_SP2>(F.lds + RING_OFF, g, S, E);
        }
        SEAM(P + 13);
        if (PHEN(14) && IN(P + 14)) {
            pg8::Gemm g{ACT, WFO, MT, D, DFF}; pg8::TileOrder S; S.init(nPM, 8, 0, 0, 0, F.G, (int)blockIdx.x);
            pg8::EpiRes E{F.out, XC, F.out, XC, modl + 8 * D, 0.5f};
            pg8::gemm_phase<pg8::EpiRes, pg8::TileOrder, PG8_ALIGN, PG8_SP2>(F.lds + RING_OFF, g, S, E);
        }
        SEAM(P + 14);
    }
__global__ void __launch_bounds__(NWAVES * 64, 2) mk_fwd(Args args) {
    extern __shared__ __attribute__((aligned(16))) unsigned char lds[];
    Frame F;
    F.lds = (LAS unsigned char*)lds;
    F.MISC = (volatile LAS unsigned*)(F.lds + MISC_OFF);
    F.tid = threadIdx.x; F.lane = F.tid & 63; F.wave = __builtin_amdgcn_readfirstlane(F.tid >> 6);
    F.G = gridDim.x;
    F.ws = args.ws; F.ctl = (gu32*)(args.ws + WS_CTL); F.out = args.out;
    F.in = args.in;
    for (int u = F.tid; u < (LDS_BYTES - LDSCTL_OFF) / 4; u += NWAVES * 64) ((LAS unsigned*)(F.lds + LDSCTL_OFF))[u] = 0u;
    __syncthreads();
    const int lo = args.ph_lo, hi = args.ph_hi;
    XcdBarrier bar; bar.bar = (unsigned*)(F.ctl + CW_BAR) + args.li * XCD_BAR_WORDS; bar.x = 0; bar.st = nullptr;
    if (hi - lo > 1) bar = xcd_barrier_post((unsigned*)(F.ctl + CW_BAR) + args.li * XCD_BAR_WORDS, F.MISC + 8);


    if (IN(0)) { phase_mod(F); phase_rope(F); }
    SEAM(0);

    layer_body<0>(F, bar, lo, hi);
#if !PROBE
    layer_body<1>(F, bar, lo, hi);
#endif
#if PROBE
    if (IN(16)) {
        const size_t n = (size_t)ML * D; float* o = F.out;
        for (size_t i = (size_t)blockIdx.x * 512 + F.tid; i < n; i += (size_t)F.G * 512) { const size_t r = i / D, c = i % D;
#if PROBE == 1
            o[i] = bf1(((const bf16*)(F.ws + WS_Y))[(size_t)MT * 512 + r * 512 + (c & 511)]);
#elif PROBE == 2
            o[i] = bf1(((const bf16*)(F.ws + WS_MIX + MX_CP))[(i % ((size_t)1152 * 16384))]);
#elif PROBE == 3
            o[i] = bf1(((const bf16*)(F.ws + WS_MIX + MX_CL))[(i % ((size_t)1152 * 16384))]);
#elif PROBE == 4
            o[i] = ((const float*)(F.ws + WS_ZS))[(i % ((size_t)ML * 32))];
#endif
        }
    }
#endif
#undef IN
#undef SEAM
}

#ifndef MK_N_LAUNCHES
#define MK_N_LAUNCHES 1
#endif
extern "C" void kernel_launch(void* const* d_in, const int* in_sizes, int n_in, void* d_out, int out_size, void* d_ws, size_t ws_size, hipStream_t stream) {
    static int grid = 0;
    if (grid == 0) {
        if (n_in != 27 || in_sizes[0] != ML * D || out_size != ML * D || ws_size < WS_END) { fprintf(stderr, "kernel_launch: shape mismatch n_in %d in0 %d out %d ws %zu (need %zu)\n", n_in, n_in > 0 ? in_sizes[0] : -1, out_size, ws_size, (size_t)WS_END); grid = -1; return; }
        int dev = 0, cus = 0, per_cu = 0;
        if (hipGetDevice(&dev) != hipSuccess || hipDeviceGetAttribute(&cus, hipDeviceAttributeMultiprocessorCount, dev) != hipSuccess) { grid = -1; return; }
        if (hipFuncSetAttribute((const void*)mk_fwd, hipFuncAttributeMaxDynamicSharedMemorySize, LDS_BYTES) != hipSuccess) { fprintf(stderr, "kernel_launch: hipFuncSetAttribute failed\n"); grid = -1; return; }
        if (hipOccupancyMaxActiveBlocksPerMultiprocessor(&per_cu, (const void*)mk_fwd, NWAVES * 64, LDS_BYTES) != hipSuccess || per_cu < 1)
            fprintf(stderr, "kernel_launch: note: occupancy query reports %d workgroups per CU\n", per_cu);
        (void)hipGetLastError();
        grid = cus;
    }
    if (grid < 0) return;
    if (hipMemsetAsync((char*)d_ws + WS_CTL, 0, CTL_ZERO_BYTES, stream) != hipSuccess) return;
    Args a{};
    for (int i = 0; i < 27; ++i) a.in[i] = (const float*)d_in[i];
    a.out = (float*)d_out; a.ws = (unsigned char*)d_ws; a.pad = 0;
#if MK_N_LAUNCHES == 1
    a.ph_lo = 0; a.ph_hi = N_PHASES; a.li = 0;
    hipLaunchKernelGGL(mk_fwd, dim3(grid), dim3(NWAVES * 64), LDS_BYTES, stream, a);
#else
    for (int p = 0; p < N_PHASES; ++p) { a.ph_lo = p; a.ph_hi = p + 1; a.li = 0;
        hipLaunchKernelGGL(mk_fwd, dim3(grid), dim3(NWAVES * 64), LDS_BYTES, stream, a); }
#endif
    const hipError_t le = hipPeekAtLastError();
    if (le != hipSuccess) fprintf(stderr, "kernel_launch: launch failed: %s\n", hipGetErrorName(le));
}
```

```cpp
#include <hip/hip_runtime.h>
#include <cstdio>
#include <cstdint>
namespace pg8 {
#define PG8_LAS __attribute__((address_space(3)))
typedef unsigned short bf16_t;
typedef short bf16x8 __attribute__((ext_vector_type(8)));
typedef float f32x4 __attribute__((ext_vector_type(4)));
typedef unsigned u32x4 __attribute__((ext_vector_type(4)));
constexpr int BM = 256, BK = 64, HALF = 128, HTB = HALF * BK * 2  , STAGE_BYTES = 8 * HTB, NXCD = 8, WGM = 8;

__host__ __device__ __forceinline__ int lds_byte(int r, int c) { const int st = (r >> 4) * 2 + (c >> 5), rr = r & 15, cc = c & 31, ob = rr * 64 + cc * 2; return st * 1024 + (ob ^ (((ob >> 9) & 1) << 5)); }
__host__ __device__ __forceinline__ void stage_rc(int b, int& R, int& C) { const int st = b / 1024, sb = b % 1024, swz = sb ^ (((sb >> 9) & 1) << 5); R = (st >> 1) * 16 + swz / 64; C = (st & 1) * 32 + (swz % 64) / 2; }
__host__ __device__ __forceinline__ int perm32(int rho) { const int n = rho >> 4, i = rho & 15; return 8 * (i >> 2) + 4 * n + (i & 3); }

struct Unit { int pm, pn, k0, nt; };
struct Gemm { const bf16_t* A; const bf16_t* Bt; int M, N, K; };

struct StaticOrder {
    int nM, nN, nwg, G, c;
    __host__ __device__ void init(int M, int N, int G_, int c_) { nM = M / BM; nN = N / BM; nwg = nM * nN; G = G_; c = c_; }
    __host__ __device__ bool next(int i, Unit& u) const {
        const long L = (long)i * G + c; if (L >= nwg) return false;
        int wgid = (int)L; { const int q = nwg / NXCD, r = nwg % NXCD, xcd = wgid % NXCD, off = wgid / NXCD; wgid = (xcd < r ? xcd * (q + 1) : r * (q + 1) + (xcd - r) * q) + off; }
        const int nig = WGM * nN, gid = wgid / nig, fm = gid * WGM, gsz = (nM - fm) < WGM ? (nM - fm) : WGM;
        u.pm = fm + ((wgid % nig) % gsz); u.pn = (wgid % nig) / gsz; u.k0 = 0; u.nt = 0; return true;
    }
    __device__ __forceinline__ void a_ready(const Unit&) const {}
    __device__ __forceinline__ void done(const Unit&) const {}
};

typedef float f32x2c_t __attribute__((ext_vector_type(2)));
typedef __bf16 bf16x2c_t __attribute__((ext_vector_type(2)));
__device__ __forceinline__ unsigned cvt_pk_bf16(float lo, float hi) { const f32x2c_t v = {lo, hi}; const bf16x2c_t b = __builtin_convertvector(v, bf16x2c_t); return __builtin_bit_cast(unsigned, b); }
typedef float f32x2 __attribute__((ext_vector_type(2)));
__device__ __forceinline__ void tile_map(int nM, int nN, int wgid, int& pm, int& pn) {
    const int nwg = nM * nN;
    { const int q = nwg / NXCD, r = nwg % NXCD, xcd = wgid % NXCD, off = wgid / NXCD; wgid = (xcd < r ? xcd * (q + 1) : r * (q + 1) + (xcd - r) * q) + off; }
    const int nig = WGM * nN, gid = wgid / nig, fm = gid * WGM, gsz = (nM - fm) < WGM ? (nM - fm) : WGM;
    pm = fm + ((wgid % nig) % gsz); pn = (wgid % nig) / gsz;
}
struct TileOrder {
    int nM0, nN0, n0, nM1, nN1, n1, pm1, G, c, ntK, skip1;
    __device__ __forceinline__ void init(int nM0_, int nN0_, int nM1_, int nN1_, int pm1_, int G_, int c_, int ntK_, int skip1_ = -1) { skip1 = skip1_; ntK = ntK_; nM0 = nM0_; nN0 = nN0_; n0 = nM0_ * nN0_; nM1 = nM1_; nN1 = nN1_; n1 = nM1_ * nN1_; pm1 = pm1_; G = G_; c = c_; }
    __device__ __forceinline__ bool next(int i, Unit& u) const {
        long L = (long)i * G + c; u.k0 = 0; u.nt = ntK;
        if (L < n0) { tile_map(nM0, nN0, (int)L, u.pm, u.pn); return true; }
        L -= n0;
        if (L < n1) { tile_map(nM1, nN1, (int)L, u.pm, u.pn); u.pm += pm1; if (skip1 >= 0 && u.pn >= skip1) ++u.pn; return true; }
        return false;
    }
    __device__ __forceinline__ void a_ready(const Unit&) const {}
    __device__ __forceinline__ void done(const Unit&) const {}
};
struct QuarterOrder {
    int n, pm0, G, c, ntK;
    __device__ __forceinline__ void init(int nM, int pm0_, int ntq, int G_, int c_) { n = nM * 8 * 4; pm0 = pm0_; ntK = ntq; G = G_; c = c_; }
    __device__ __forceinline__ bool next(int i, Unit& u) const {
        const long L = (long)i * G + c; if (L >= n) return false;
        const int t = (int)L >> 2, qq = (int)L & 3; u.pm = pm0 + (t >> 3); u.pn = t & 7; u.k0 = qq * ntK; u.nt = ntK; return true;
    }
    __device__ __forceinline__ void a_ready(const Unit&) const {}
    __device__ __forceinline__ void done(const Unit&) const {}
};
struct BranchOrder {
    int nM, NPM, G, c; static constexpr int ntK = 8;
    __device__ __forceinline__ void init(int nM_, int NPM_, int G_, int c_) { nM = nM_; NPM = NPM_; G = G_; c = c_; }
    __device__ __forceinline__ bool next(int i, Unit& u) const {
        const long L = (long)(i >> 2) * G + c; if (L >= nM * 8) return false;
        int pm, pn; tile_map(nM, 8, (int)L, pm, pn); const int n = i & 3;
        u.pm = n * NPM + pm; u.pn = n * 8 + pn; u.k0 = 0; u.nt = 8; return true;
    }
    __device__ __forceinline__ void a_ready(const Unit&) const {}
    __device__ __forceinline__ void done(const Unit&) const {}
};

__device__ __forceinline__ float silu_f(float a) { return a * __builtin_amdgcn_rcpf(1.0f + __expf(-a)); }
__device__ __forceinline__ float sigmoid_f(float a) { return __builtin_amdgcn_rcpf(1.0f + __expf(-a)); }
struct EpiSwiglu {
    static constexpr bool PERM = true, AFTER_DRAIN = false, CHAIN = false;
    bf16_t* O; int ldc;
    __device__ __forceinline__ void operator()(const f32x4 (&acc)[2][2][4][2], const Unit& u, int wr, int wc, int fr, int fq) const {
        const int row0 = u.pm * BM + wr * 64 + fr, col0 = u.pn * HALF + wc * 32 + 8 * fq;
#pragma unroll
        for (int ai = 0; ai < 2; ++ai)
#pragma unroll
            for (int m = 0; m < 4; ++m) { bf16_t* rowp = O + (size_t)(row0 + ai * HALF + m * 16) * ldc + col0;
                const f32x4 a0 = acc[ai][0][m][0], a1 = acc[ai][0][m][1], b0 = acc[ai][1][m][0], b1 = acc[ai][1][m][1];
                f32x4 v0, v1;
#pragma unroll
                for (int j = 0; j < 4; ++j) { v0[j] = silu_f(a0[j]) * b0[j]; v1[j] = silu_f(a1[j]) * b1[j]; }
                u32x4 w; w.x = cvt_pk_bf16(v0[0], v0[1]); w.y = cvt_pk_bf16(v0[2], v0[3]); w.z = cvt_pk_bf16(v1[0], v1[1]); w.w = cvt_pk_bf16(v1[2], v1[3]);
                *(u32x4*)rowp = w; }
    }
};
template <bool ATOMIC  > struct EpiRes {
    static constexpr bool PERM = false, AFTER_DRAIN = false, CHAIN = false;
    float* out_l; float* out_c; const float* gate; float coef;
    __device__ __forceinline__ void operator()(const f32x4 (&acc)[2][2][4][2], const Unit& u, int wr, int wc, int fr, int fq) const {
        const bool isc = u.pm >= 64; const int b9 = isc ? 8 : (u.pm >> 3);
        const int prow = (isc ? (u.pm - 64) : u.pm) * BM + wr * 64 + fr, col0 = u.pn * BM + wc * 32 + 4 * fq;
        float* op = isc ? out_c : out_l;
        const float* gp = gate + (size_t)b9 * 18432 + col0;
        f32x4 gv[2][2];
#pragma unroll
        for (int bj = 0; bj < 2; ++bj)
#pragma unroll
            for (int n = 0; n < 2; ++n) gv[bj][n] = *(const f32x4*)(gp + bj * HALF + n * 16) * coef;
        if constexpr (!ATOMIC) {
#pragma unroll
            for (int ai = 0; ai < 2; ++ai)
#pragma unroll
                for (int m = 0; m < 4; ++m) { const size_t off = (size_t)(prow + ai * HALF + m * 16) * 2048 + col0;
#pragma unroll
                    for (int bj = 0; bj < 2; ++bj)
#pragma unroll
                        for (int n = 0; n < 2; ++n) { const f32x4 bs = *(const f32x4*)(op + off + bj * HALF + n * 16); *(f32x4*)(op + off + bj * HALF + n * 16) = bs + gv[bj][n] * acc[ai][bj][m][n]; }
                    asm volatile("" ::: "memory"); }
        } else {
            float* pp = op + (size_t)(u.k0 / u.nt) * ((size_t)2048 * 2048);
#pragma unroll
            for (int ai = 0; ai < 2; ++ai)
#pragma unroll
                for (int m = 0; m < 4; ++m) { const size_t off = (size_t)(prow + ai * HALF + m * 16) * 2048 + col0;
#pragma unroll
                    for (int bj = 0; bj < 2; ++bj)
#pragma unroll
                        for (int n = 0; n < 2; ++n) *(f32x4*)(pp + off + bj * HALF + n * 16) = gv[bj][n] * acc[ai][bj][m][n]; }
        }
    }
};
struct EpiZ {
    static constexpr bool PERM = true, AFTER_DRAIN = false, CHAIN = false;
    bf16_t* Z; float* ZS; int ldz;
    __device__ __forceinline__ void operator()(const f32x4 (&acc)[2][2][4][2], const Unit& u, int wr, int wc, int fr, int fq) const {
        const int row0 = u.pm * BM + wr * 64 + fr, col0 = u.pn * BM + wc * 32 + 8 * fq;
        if (u.pn == 10) {
            if (wc == 0) {
#pragma unroll
                for (int ai = 0; ai < 2; ++ai)
#pragma unroll
                    for (int m = 0; m < 4; ++m) { float* zp = ZS + (size_t)(row0 + ai * HALF + m * 16) * 32 + 8 * fq;
                        *(f32x4*)zp = acc[ai][0][m][0]; *(f32x4*)(zp + 4) = acc[ai][0][m][1]; }
            }
            return;
        }
#pragma unroll
        for (int ai = 0; ai < 2; ++ai)
#pragma unroll
            for (int m = 0; m < 4; ++m) { bf16_t* rowp = Z + (size_t)(row0 + ai * HALF + m * 16) * ldz + col0;
#pragma unroll
                for (int bj = 0; bj < 2; ++bj) { const f32x4 v0 = acc[ai][bj][m][0], v1 = acc[ai][bj][m][1];
                    u32x4 w; w.x = cvt_pk_bf16(v0[0], v0[1]); w.y = cvt_pk_bf16(v0[2], v0[3]); w.z = cvt_pk_bf16(v1[0], v1[1]); w.w = cvt_pk_bf16(v1[2], v1[3]);
                    *(u32x4*)(rowp + bj * HALF) = w; } }
    }
};
struct EpiBranch {
    static constexpr bool PERM = true, AFTER_DRAIN = false, CHAIN = true;
    const bf16_t* Z; int ldz; int gate_col; bf16_t* Hout; int NPM;
    static __device__ __forceinline__ float epos(float g) { return __expf(-fminf(fmaxf(g, -40.f), 40.f)); }
    __device__ __forceinline__ void chain(f32x4 (&acc)[2][2][4][2], const Unit& u, int wr, int wc, int fr, int fq) const {
        const int n = u.pn >> 3, pn = u.pn & 7, pm = u.pm - n * NPM;
        const int row0 = pm * BM + wr * 64 + fr, col0 = pn * BM + wc * 32 + 8 * fq;
#pragma unroll
        for (int ai = 0; ai < 2; ++ai) {
            u32x4 gaa[4][2], gbb[4][2];
#pragma unroll
            for (int m = 0; m < 4; ++m)
#pragma unroll
                for (int bj = 0; bj < 2; ++bj) { const bf16_t* gp = Z + (size_t)(row0 + ai * HALF + m * 16) * ldz + gate_col + n * 2048 + col0 + bj * HALF; gaa[m][bj] = *(const u32x4*)gp; gbb[m][bj] = (n < 3) ? *(const u32x4*)(gp + 2048) : gaa[m][bj]; }
#pragma unroll
            for (int m = 0; m < 4; ++m) { const size_t r = (size_t)(row0 + ai * HALF + m * 16);
#pragma unroll
                for (int bj = 0; bj < 2; ++bj) {
                    const unsigned wa[4] = {gaa[m][bj].x, gaa[m][bj].y, gaa[m][bj].z, gaa[m][bj].w}, wb[4] = {gbb[m][bj].x, gbb[m][bj].y, gbb[m][bj].z, gbb[m][bj].w};
                    f32x4 f0, f1;
#pragma unroll
                    for (int j = 0; j < 4; ++j) { const float ea = epos((j & 1) ? __uint_as_float(wa[j >> 1] & 0xffff0000u) : __uint_as_float(wa[j >> 1] << 16));
                        const float eb = epos((j & 1) ? __uint_as_float(wb[j >> 1] & 0xffff0000u) : __uint_as_float(wb[j >> 1] << 16));
                        f0[j] = ((n < 3) ? (1.0f + eb) : 1.0f) * __builtin_amdgcn_rcpf(1.0f + ea); }
#pragma unroll
                    for (int j = 0; j < 4; ++j) { const float ea = epos((j & 1) ? __uint_as_float(wa[2 + (j >> 1)] & 0xffff0000u) : __uint_as_float(wa[2 + (j >> 1)] << 16));
                        const float eb = epos((j & 1) ? __uint_as_float(wb[2 + (j >> 1)] & 0xffff0000u) : __uint_as_float(wb[2 + (j >> 1)] << 16));
                        f1[j] = ((n < 3) ? (1.0f + eb) : 1.0f) * __builtin_amdgcn_rcpf(1.0f + ea); }
                    const f32x4 s0 = acc[ai][bj][m][0] * f0, s1 = acc[ai][bj][m][1] * f1;
                    if (n < 3) { acc[ai][bj][m][0] = s0; acc[ai][bj][m][1] = s1; }
                    else { u32x4 w; w.x = cvt_pk_bf16(s0[0], s0[1]); w.y = cvt_pk_bf16(s0[2], s0[3]); w.z = cvt_pk_bf16(s1[0], s1[1]); w.w = cvt_pk_bf16(s1[2], s1[3]);
                        *(u32x4*)(Hout + r * 2048 + col0 + bj * HALF) = w;
                        acc[ai][bj][m][0] = (f32x4){0.f, 0.f, 0.f, 0.f}; acc[ai][bj][m][1] = (f32x4){0.f, 0.f, 0.f, 0.f}; } } }
        }
    }
};
template <class Epi, class Sched, bool ALIGN_EPI = false, bool SP2 = false>
__device__ __forceinline__ void gemm_phase(PG8_LAS unsigned char* lds, const Gemm g, const Sched& S, const Epi& E) {
    const int tid = threadIdx.x, wid = __builtin_amdgcn_readfirstlane(tid >> 6), lane = tid & 63, wr = wid >> 2, wc = wid & 3, fr = lane & 15, fq = lane >> 4;
    const int K = g.K, nt = S.ntK;
    unsigned voffA[2], voffB[2];
#pragma unroll
    for (int i = 0; i < 2; ++i) { int R, C; stage_rc(tid * 16 + i * 8192, R, C); const int Rb = Epi::PERM ? ((R & ~31) + perm32(R & 31)) : R;
        voffA[i] = (unsigned)(R * K + C) * 2u; voffB[i] = (unsigned)(Rb * K + C) * 2u; }
    const size_t kstep = (size_t)(BK * 2);
    const size_t hstep = (size_t)HALF * K * 2;
    const size_t tstep = 2 * hstep;
    const unsigned ldsw = (unsigned)wid * 1024u;
    const int aoff = lds_byte(wr * 64 + fr, fq * 8), boff = lds_byte(wc * 32 + fr, fq * 8);
#define PG8_SA(b, h) (((b) * 2 + (h)) * HTB)
#define PG8_SB(b, h) ((4 + (b) * 2 + (h)) * HTB)
#define PG8_STAGE(bufoff, gbase, voff) do { _Pragma("unroll") for (int _i = 0; _i < 2; ++_i) \
        __builtin_amdgcn_global_load_lds((const unsigned*)((const char*)(gbase) + (voff)[_i]), (PG8_LAS unsigned*)(lds + (bufoff) + ldsw + _i * 8192), 16, 0, 0); } while (0)
#define PG8_LDA(dst, b, h) do { _Pragma("unroll") for (int m = 0; m < 4; ++m) _Pragma("unroll") for (int k = 0; k < 2; ++k) dst[m][k] = *(const PG8_LAS bf16x8*)(lds + PG8_SA(b, h) + aoff + m * 2048 + k * 1024); } while (0)
#define PG8_LDB(dst, b, h) do { _Pragma("unroll") for (int n = 0; n < 2; ++n) _Pragma("unroll") for (int k = 0; k < 2; ++k) dst[n][k] = *(const PG8_LAS bf16x8*)(lds + PG8_SB(b, h) + boff + n * 2048 + k * 1024); } while (0)
#define PG8_MMA(ai, bj, At, Bt) do { __builtin_amdgcn_s_setprio(1); _Pragma("unroll") for (int m = 0; m < 4; ++m) _Pragma("unroll") for (int n = 0; n < 2; ++n) _Pragma("unroll") for (int k = 0; k < 2; ++k) \
        acc[ai][bj][m][n] = __builtin_amdgcn_mfma_f32_16x16x32_bf16(Bt[n][k], At[m][k], acc[ai][bj][m][n], 0, 0, 0); __builtin_amdgcn_s_setprio(0); } while (0)
#define PG8_WAIT_V(n) asm volatile("s_waitcnt vmcnt(" #n ")" ::: "memory")
#define PG8_WAIT_L(n) asm volatile("s_waitcnt lgkmcnt(" #n ")" ::: "memory")
#define PG8_BAR __builtin_amdgcn_s_barrier()
#define PG8_SCHED __builtin_amdgcn_sched_barrier(0)
    Unit cur, nxt; int ui = 0;
    if (!S.next(0, cur)) return;
    f32x4 acc[2][2][4][2];
#pragma unroll
    for (int a = 0; a < 2; ++a)
#pragma unroll
        for (int b = 0; b < 2; ++b)
#pragma unroll
            for (int m = 0; m < 4; ++m)
#pragma unroll
                for (int n = 0; n < 2; ++n) acc[a][b][m][n] = (f32x4){0.f, 0.f, 0.f, 0.f};
    bf16x8 At[4][2], B0[2][2], B1[2][2];
    const char* cA = (const char*)g.A + (size_t)cur.pm * tstep + (size_t)cur.k0 * kstep; const char* cB = (const char*)g.Bt + (size_t)cur.pn * tstep + (size_t)cur.k0 * kstep;
    S.a_ready(cur);
    if constexpr (SP2) {
        PG8_STAGE(PG8_SB(0, 0), cB, voffB); PG8_STAGE(PG8_SB(0, 1), cB + hstep, voffB); PG8_STAGE(PG8_SA(0, 0), cA, voffA); PG8_STAGE(PG8_SA(0, 1), cA + hstep, voffA);
        if (wr == 1) PG8_BAR;
        PG8_WAIT_V(2); PG8_BAR;
        PG8_STAGE(PG8_SB(1, 0), cB + kstep, voffB); PG8_STAGE(PG8_SA(1, 0), cA + kstep, voffA); PG8_STAGE(PG8_SB(1, 1), cB + hstep + kstep, voffB);
        PG8_WAIT_V(6); PG8_BAR;
    } else {
        PG8_STAGE(PG8_SB(0, 0), cB, voffB); PG8_STAGE(PG8_SA(0, 0), cA, voffA); PG8_STAGE(PG8_SB(0, 1), cB + hstep, voffB); PG8_STAGE(PG8_SA(0, 1), cA + hstep, voffA);
        if (wr == 1) PG8_BAR;
        PG8_WAIT_V(4); PG8_BAR;
        PG8_STAGE(PG8_SB(1, 0), cB + kstep, voffB); PG8_STAGE(PG8_SA(1, 0), cA + kstep, voffA); PG8_STAGE(PG8_SB(1, 1), cB + hstep + kstep, voffB);
        PG8_WAIT_V(6); PG8_BAR;
    }
    for (;;) {
        const bool has_next = S.next(ui + 1, nxt);
        const char* nA = has_next ? (const char*)g.A + (size_t)nxt.pm * tstep + (size_t)nxt.k0 * kstep : cA; const char* nB = has_next ? (const char*)g.Bt + (size_t)nxt.pn * tstep + (size_t)nxt.k0 * kstep : cB;
        for (int t = 0; t < nt; t += 2) {
            const bool last = (t == nt - 2);
            const char* a1 = cA + (size_t)(t + 1) * kstep;
            const char* a2 = last ? nA : cA + (size_t)(t + 2) * kstep; const char* b2 = last ? nB : cB + (size_t)(t + 2) * kstep;
            const char* a3 = a2 + kstep; const char* b3 = b2 + kstep;
            if (last && has_next) S.a_ready(nxt);
            if constexpr (SP2) {
            PG8_LDB(B0, 0, 0); PG8_LDB(B1, 0, 1); PG8_SCHED; PG8_LDA(At, 0, 0); PG8_STAGE(PG8_SA(1, 1), a1 + hstep, voffA);
            PG8_WAIT_V(8); PG8_WAIT_L(0); PG8_BAR; PG8_MMA(0, 0, At, B0); PG8_MMA(0, 1, At, B1); PG8_BAR; PG8_SCHED;
            PG8_LDA(At, 0, 1); PG8_STAGE(PG8_SB(0, 0), b2, voffB); PG8_STAGE(PG8_SB(0, 1), b2 + hstep, voffB); PG8_STAGE(PG8_SA(0, 0), a2, voffA);
            PG8_WAIT_V(8); PG8_WAIT_L(0); PG8_BAR; PG8_MMA(1, 0, At, B0); PG8_MMA(1, 1, At, B1); PG8_BAR; PG8_SCHED;
            PG8_LDB(B0, 1, 0); PG8_LDB(B1, 1, 1); PG8_SCHED; PG8_LDA(At, 1, 0); PG8_STAGE(PG8_SA(0, 1), a2 + hstep, voffA);
            PG8_WAIT_V(8); PG8_WAIT_L(0); PG8_BAR; PG8_MMA(0, 0, At, B0); PG8_MMA(0, 1, At, B1); PG8_BAR; PG8_SCHED;
            PG8_LDA(At, 1, 1); PG8_STAGE(PG8_SB(1, 0), b3, voffB); PG8_STAGE(PG8_SB(1, 1), b3 + hstep, voffB); PG8_STAGE(PG8_SA(1, 0), a3, voffA);
            PG8_WAIT_V(8); PG8_WAIT_L(0); PG8_BAR; PG8_MMA(1, 0, At, B0); PG8_MMA(1, 1, At, B1); PG8_BAR; PG8_SCHED;
            } else {
            PG8_LDB(B0, 0, 0); PG8_SCHED; PG8_LDA(At, 0, 0); PG8_STAGE(PG8_SA(1, 1), a1 + hstep, voffA);
            PG8_WAIT_L(8); PG8_BAR; PG8_WAIT_L(0); PG8_MMA(0, 0, At, B0); PG8_BAR; PG8_SCHED;
            PG8_LDB(B1, 0, 1); PG8_STAGE(PG8_SB(0, 0), b2, voffB);
            PG8_BAR; PG8_WAIT_L(0); PG8_MMA(0, 1, At, B1); PG8_BAR;
            PG8_LDA(At, 0, 1); PG8_STAGE(PG8_SA(0, 0), a2, voffA);
            PG8_BAR; PG8_WAIT_L(0); PG8_MMA(1, 0, At, B0); PG8_BAR; PG8_SCHED;
            PG8_STAGE(PG8_SB(0, 1), b2 + hstep, voffB);
            PG8_WAIT_V(6); PG8_BAR; PG8_MMA(1, 1, At, B1); PG8_BAR;
            PG8_LDB(B0, 1, 0); PG8_SCHED; PG8_LDA(At, 1, 0); PG8_STAGE(PG8_SA(0, 1), a2 + hstep, voffA);
            PG8_WAIT_L(8); PG8_BAR; PG8_WAIT_L(0); PG8_MMA(0, 0, At, B0); PG8_BAR; PG8_SCHED;
            PG8_LDB(B1, 1, 1); PG8_STAGE(PG8_SB(1, 0), b3, voffB);
            PG8_BAR; PG8_WAIT_L(0); PG8_MMA(0, 1, At, B1); PG8_BAR;
            PG8_LDA(At, 1, 1); PG8_STAGE(PG8_SA(1, 0), a3, voffA);
            PG8_BAR; PG8_WAIT_L(0); PG8_MMA(1, 0, At, B0); PG8_BAR; PG8_SCHED;
            PG8_STAGE(PG8_SB(1, 1), b3 + hstep, voffB);
            PG8_WAIT_V(6); PG8_BAR; PG8_MMA(1, 1, At, B1); PG8_BAR;
            }
        }
        if constexpr (ALIGN_EPI) { if (wr == 0) PG8_BAR; }
        if constexpr (Epi::CHAIN) { E.chain(acc, cur, wr, wc, fr, fq); S.done(cur); }
        else if constexpr (!Epi::AFTER_DRAIN) { E(acc, cur, wr, wc, fr, fq); S.done(cur); }
        if (!has_next) break;
        if constexpr (!Epi::CHAIN) {
#pragma unroll
        for (int a = 0; a < 2; ++a)
#pragma unroll
            for (int b = 0; b < 2; ++b)
#pragma unroll
                for (int m = 0; m < 4; ++m)
#pragma unroll
                    for (int n = 0; n < 2; ++n) acc[a][b][m][n] = (f32x4){0.f, 0.f, 0.f, 0.f};
        }
        cur = nxt; cA = nA; cB = nB; ++ui;
        if constexpr (ALIGN_EPI) { if (wr == 1) PG8_BAR; }
    }
    PG8_WAIT_V(0);
    if constexpr (!ALIGN_EPI) { if (wr == 0) PG8_BAR; }
    PG8_BAR;
    if constexpr (Epi::AFTER_DRAIN) { E.fused(acc, cur, wr, wc, fr, fq, lds, wid, lane); S.done(cur); }
#undef PG8_SA
#undef PG8_SB
#undef PG8_STAGE
#undef PG8_LDA
#undef PG8_LDB
#undef PG8_MMA
#undef PG8_WAIT_V
#undef PG8_WAIT_L
#undef PG8_BAR
#undef PG8_SCHED
}
}
#ifndef PG8_SP2
#define PG8_SP2 true
#endif
#ifndef PG8_ALIGN
#define PG8_ALIGN true
#endif
constexpr int NWAVES = 8;
constexpr int D = 2048, BATCH = 8, SEQ = 2048, CTXL = 256, DFF = 5632, NLAYER = 2;
constexpr int ML = BATCH * SEQ, MC = BATCH * CTXL, MT = ML + MC;
constexpr int NZ = 14592;
constexpr int MODW = 9 * D;
constexpr int INC = 14368;
constexpr float EPS = 1e-6f;
constexpr int ZC_MLK = 0, ZC_MLV = 512, ZC_GDK = 1024, ZC_GDV = 1536, ZC_ATK = 2048, ZC_ATV = 2304, ZC_SMALL = 2560, ZC_SGU = 2816, ZC_SGV = 3328,
              ZC_MLQ = 3840, ZC_MLO = 4352, ZC_GDQ = 4864, ZC_GDZ = 5376, ZC_ATQ = 5888, ZC_GATE = 6400;
constexpr int NKV_TILES = 11;

constexpr size_t MiB = 1u << 20;
constexpr size_t WS_CTL = 0, CTL_ZERO_BYTES = 1 * MiB;
constexpr size_t WS_MOD = 1 * MiB;
constexpr size_t WS_ROPE = 3 * MiB;
constexpr size_t WS_XC = 4 * MiB;
constexpr size_t WS_WFI = 20 * MiB;
constexpr size_t WS_WFO = 64 * MiB;
constexpr size_t WS_WZ = 86 * MiB;
constexpr size_t WS_WB = 143 * MiB;
constexpr size_t WS_WO = 151 * MiB;
constexpr size_t WS_H = 159 * MiB;
constexpr size_t WS_Z = 231 * MiB;
constexpr size_t WS_ZS = 744 * MiB;
constexpr size_t WS_Y = 747 * MiB;
constexpr size_t WS_QA = 819 * MiB;
constexpr size_t WS_KC = 837 * MiB;
constexpr size_t WS_VC = 846 * MiB;
constexpr size_t WS_MIX = 855 * MiB;
constexpr size_t WS_END = 1150 * MiB;
static_assert(WS_Z + (size_t)MT * NZ * 2 <= WS_ZS && WS_H + (size_t)MT * D * 2 <= WS_Z && WS_Y + (size_t)4 * MT * 512 * 2 <= WS_QA, "d_ws map");
static_assert(WS_WFI + (size_t)2 * DFF * D * 2 <= WS_WFO && WS_WFO + (size_t)D * DFF * 2 <= WS_WZ && WS_WZ + (size_t)NZ * D * 2 <= WS_WB, "d_ws map (weights)");
constexpr int CW_TMO = 0, CW_CODE = 1, CW_BAR = 4096;

constexpr int RING_OFF = 0, RING_BYTES = 131072;
constexpr int LDSCTL_OFF = RING_BYTES, MISC_OFF = LDSCTL_OFF + 320;
constexpr int LDS_BYTES = 147456;

#define GAS __attribute__((address_space(1)))
#define LAS __attribute__((address_space(3)))
typedef unsigned short bf16;
typedef unsigned v4u __attribute__((ext_vector_type(4)));
typedef unsigned v2u __attribute__((ext_vector_type(2)));
typedef float f32x4 __attribute__((ext_vector_type(4)));
typedef short bf16x8 __attribute__((ext_vector_type(8)));
typedef GAS unsigned gu32;
#define RLX_AGENT __ATOMIC_RELAXED, __HIP_MEMORY_SCOPE_AGENT
#define LDS_WAIT() asm volatile("s_waitcnt lgkmcnt(0)" ::: "memory")
#define VM_WAIT() asm volatile("s_waitcnt vmcnt(0)" ::: "memory")
typedef float f32x2_t __attribute__((ext_vector_type(2)));
typedef __bf16 bf16x2_t __attribute__((ext_vector_type(2)));
__device__ __forceinline__ unsigned pk2(float lo, float hi) { const f32x2_t v = {lo, hi}; const bf16x2_t b = __builtin_convertvector(v, bf16x2_t); return __builtin_bit_cast(unsigned, b); }
__device__ __forceinline__ float bflo(unsigned w) { return __uint_as_float(w << 16); }
__device__ __forceinline__ float bfhi(unsigned w) { return __uint_as_float(w & 0xffff0000u); }
__device__ __forceinline__ float bf1(bf16 b) { return __uint_as_float(((unsigned)b) << 16); }
__device__ __forceinline__ bf16 f2bf1(float f) { return (bf16)(pk2(f, 0.f) & 0xffffu); }
__device__ __forceinline__ float silu1(float a) { return a / (1.0f + __expf(-a)); }
__device__ __forceinline__ float sigm1(float a) { return 1.0f / (1.0f + __expf(-a)); }
__device__ __forceinline__ float wave_sum(float v) {
#pragma unroll
    for (int o = 1; o < 64; o <<= 1) v += __shfl_xor(v, o);
    return v;
}
#define XB_TMO      128
#define XB_XCNT(j)  (256  + 64 * (j))
#define XB_XSUB(j)  (1280 + 64 * (j))
#define XB_XGEN(j)  (2304 + 64 * (j))
#define XB_TOP      3328
#define XB_TOPGEN   3392
#define XCD_BAR_WORDS 3456
#define XB_SPIN_CAP (1u << 18)

__device__ __forceinline__ unsigned xb_ld(unsigned* p)              { return __hip_atomic_load(p, __ATOMIC_RELAXED, __HIP_MEMORY_SCOPE_AGENT); }
__device__ __forceinline__ unsigned xb_add(unsigned* p, unsigned v) { return __hip_atomic_fetch_add(p, v, __ATOMIC_RELAXED, __HIP_MEMORY_SCOPE_AGENT); }
__device__ __forceinline__ unsigned xb_xcc_id() { return (unsigned)__builtin_amdgcn_s_getreg((3 << 11) | 20) & 0xFu; }
#define XB_SPIN(cond, bar) do { unsigned _sp = 0; while (cond) { __builtin_amdgcn_s_sleep(1); \
    if ((++_sp & 255u) == 0u) { if (xb_ld(&(bar)[XB_TMO])) break; if (_sp > XB_SPIN_CAP) { atomicAdd(&(bar)[XB_TMO], 1u); break; } } } } while (0)

struct XcdBarrier {
    unsigned* bar; unsigned x;
    volatile LAS unsigned* st;
};

__device__ __forceinline__ XcdBarrier xcd_barrier_post(unsigned* bar, volatile LAS unsigned* st) {
    XcdBarrier b; b.bar = bar; b.x = xb_xcc_id(); b.st = st;
    if (threadIdx.x == 0) (void)xb_add(&bar[XB_XCNT(b.x)], 1u);
    return b;
}
__device__ __forceinline__ void xcd_barrier_complete(unsigned* bar, unsigned x, unsigned& nloc, unsigned& nx) {
    const unsigned G = gridDim.x * gridDim.y * gridDim.z;
    unsigned sum, cnt, mine, sp = 0u;
    for (;;) {
        sum = 0u; cnt = 0u; mine = 0u;
#pragma unroll
        for (unsigned j = 0; j < 16; ++j) { const unsigned c = xb_ld(&bar[XB_XCNT(j)]); sum += c; cnt += (c > 0u) ? 1u : 0u; mine = (j == x) ? c : mine; }
        if (sum == G) break;
        __builtin_amdgcn_s_sleep(1);
        if ((++sp & 255u) == 0u) { if (xb_ld(&bar[XB_TMO])) break; if (sp > XB_SPIN_CAP) { atomicAdd(&bar[XB_TMO], 1u); break; } }
    }
    nloc = mine > 0u ? mine : 1u; nx = cnt > 0u ? cnt : 1u;
}

__device__ __forceinline__ void xcd_barrier(const XcdBarrier& b) {
    asm volatile("s_waitcnt vmcnt(0)" ::: "memory");
    __syncthreads();
    if (threadIdx.x == 0) {
        unsigned* bar = b.bar;
        __builtin_amdgcn_s_waitcnt(0);
        unsigned nloc = b.st[0], nx = b.st[1];
        if (nloc == 0u) { xcd_barrier_complete(bar, b.x, nloc, nx); b.st[0] = nloc; b.st[1] = nx; }
        const unsigned old = xb_add(&bar[XB_XSUB(b.x)], 1u);
        const unsigned gen = old / nloc;
        if (old + 1u == (gen + 1u) * nloc) {
            __builtin_amdgcn_fence(__ATOMIC_RELEASE, "agent");
            asm volatile("s_waitcnt vmcnt(0)" ::: "memory");
            const unsigned og = xb_add(&bar[XB_TOP], 1u);
            const unsigned tg = og / nx;
            if (og + 1u == (tg + 1u) * nx) xb_add(&bar[XB_TOPGEN], 1u);
            else XB_SPIN(xb_ld(&bar[XB_TOPGEN]) == tg, bar);
            __builtin_amdgcn_fence(__ATOMIC_ACQUIRE, "agent");
            xb_add(&bar[XB_XGEN(b.x)], 1u);
            asm volatile("s_waitcnt vmcnt(0)" ::: "memory");
        } else {
            XB_SPIN(xb_ld(&bar[XB_XGEN(b.x)]) == gen, bar);
            __builtin_amdgcn_fence(__ATOMIC_ACQUIRE, "agent");
            asm volatile("s_waitcnt vmcnt(0)" ::: "memory");
        }
    }
    __syncthreads();
}
struct Frame {
    LAS unsigned char* lds;
    volatile LAS unsigned* MISC;
    gu32* ctl;
    int tid, lane, wave, G;
    unsigned char* ws;
    const float* const* in;
    float* out;
};
enum { I_X = 0, I_C, I_CTX, I_CCTX, I_MODW, I_MODB, I_F1N, I_F1WI, I_F1WO, I_MIXN, I_WIN, I_SGN, I_SGW, I_SGB, I_MLIFB, I_MLN, I_GDCONV, I_GDALOG, I_GDDTB, I_GDN,
       I_ATQN, I_ATKN, I_WBR, I_WOUT, I_F2N, I_F2WI, I_F2WO };

__device__ __forceinline__ void phase_mod(Frame& F) {
    LAS float* tab = (LAS float*)(F.lds + RING_OFF);
    LAS float* red = (LAS float*)(F.lds + RING_OFF + 98304);
    const float* c = F.in[I_C]; const float* cc = F.in[I_CCTX];
    for (int i = F.tid; i < 9 * D; i += NWAVES * 64) { const int b = i / D, k = i % D; const float x = b < 8 ? c[b * D + k] : cc[k]; tab[k * 12 + b] = silu1(x); }
    __syncthreads();
    float* MOD = (float*)(F.ws + WS_MOD);
    for (int item = blockIdx.x; item < 2 * 288; item += F.G) {
        const int l = item / 288, n0 = (item % 288) * 64;
        const float* W = F.in[I_MODW] + (size_t)l * D * MODW + n0 + F.lane;
        float acc[9];
#pragma unroll
        for (int b = 0; b < 9; ++b) acc[b] = 0.f;
        const int k0 = F.wave * 256;
        for (int k = k0; k < k0 + 256; k += 8) {
            float w[8];
#pragma unroll
            for (int j = 0; j < 8; ++j) w[j] = W[(size_t)(k + j) * MODW];
#pragma unroll
            for (int j = 0; j < 8; ++j) { const LAS f32x4* tp = (const LAS f32x4*)(tab + (k + j) * 12); const f32x4 s0 = tp[0], s1 = tp[1], s2 = tp[2];
                acc[0] += s0[0] * w[j]; acc[1] += s0[1] * w[j]; acc[2] += s0[2] * w[j]; acc[3] += s0[3] * w[j];
                acc[4] += s1[0] * w[j]; acc[5] += s1[1] * w[j]; acc[6] += s1[2] * w[j]; acc[7] += s1[3] * w[j]; acc[8] += s2[0] * w[j]; }
        }
#pragma unroll
        for (int b = 0; b < 9; ++b) red[(F.wave * 9 + b) * 64 + F.lane] = acc[b];
        __syncthreads();
        for (int i = F.tid; i < 576; i += NWAVES * 64) { const int b = i / 64, cc2 = i % 64; float s = 0.f;
#pragma unroll
            for (int w = 0; w < 8; ++w) s += red[(w * 9 + b) * 64 + cc2];
            MOD[(size_t)(l * 9 + b) * MODW + n0 + cc2] = s + F.in[I_MODB][(size_t)l * MODW + n0 + cc2]; }
        __syncthreads();
    }
}
__device__ __forceinline__ void phase_rope(Frame& F) {
    float* RC = (float*)(F.ws + WS_ROPE); float* RS = RC + 96 * 32;
    const int idx = blockIdx.x * (NWAVES * 64) + F.tid;
    if (idx < 96 * 32) {
        const int pos = idx >> 5, i = idx & 31; const float p = (float)(pos < 32 ? pos : pos - 32);
        const float inv = exp2f(-(float)i * (13.287712379549449f / 32.0f));
        const float x = p * inv;
        const float kf = rintf(x * 0.6366197723675814f);
        float r = fmaf(-kf, 1.5707963705062866f, x); r = fmaf(-kf, -4.371138828673793e-8f, r);
        const float r2 = r * r;
        const float sn = r + r * r2 * (-1.6666667163e-1f + r2 * (8.3333337680e-3f + r2 * (-1.9841270114e-4f + r2 * 2.7557314297e-6f)));
        const float cs = 1.0f + r2 * (-0.5f + r2 * (4.1666667908e-2f + r2 * (-1.3888889225e-3f + r2 * (2.4801587642e-5f + r2 * -2.7557314297e-7f))));
        const int q = ((int)kf) & 3;
        const float sv = (q == 0) ? sn : (q == 1) ? cs : (q == 2) ? -sn : -cs;
        const float cv = (q == 0) ? cs : (q == 1) ? -sn : (q == 2) ? -cs : sn;
        RC[idx] = cv; RS[idx] = sv;
    }
}
template <int MAP> __device__ __forceinline__ int dst_row(int n) {
    if (MAP == 0) return n;
    if (MAP == 1) { const int half = n >= DFF ? 1 : 0, j = n - half * DFF; return (j >> 7) * 256 + half * 128 + (j & 127); }
    if (n < 1024) return n;
    if (n < 1040) return ZC_SMALL + (n - 1024);
    if (n < 2064) return 1024 + (n - 1040);
    if (n < 2080) return ZC_SMALL + 16 + (n - 2064);
    if (n < 2592) return 2048 + (n - 2080);
    return n + 224;
}
template <int MAP> __device__ __forceinline__ void conv_item(const float* W, int K, int N, bf16* WT, LAS float* scr, int item, int lane) {
    const int nblk = N / 32, kb = item / nblk, nb = item % nblk, k0 = 64 * kb, n0 = 32 * nb;
#pragma unroll 8
    for (int i = 0; i < 32; ++i) { const int kk = 2 * i + (lane >> 5); scr[kk * 33 + (lane & 31)] = W[(size_t)(k0 + kk) * N + n0 + (lane & 31)]; }
    LDS_WAIT(); asm volatile("" ::: "memory");
    const int c = lane & 7;
#pragma unroll
    for (int j = 0; j < 4; ++j) { const int n = (lane >> 3) + 8 * j; const LAS float* s = scr + (8 * c) * 33 + n;
        v4u o; o.x = pk2(s[0 * 33], s[1 * 33]); o.y = pk2(s[2 * 33], s[3 * 33]); o.z = pk2(s[4 * 33], s[5 * 33]); o.w = pk2(s[6 * 33], s[7 * 33]);
        *(GAS v4u*)(WT + (size_t)dst_row<MAP>(n0 + n) * K + k0 + 8 * c) = o; }
    LDS_WAIT(); asm volatile("" ::: "memory");
}
__device__ __forceinline__ void conv_set(Frame& F, int l, int set, unsigned* queue) {
    LAS float* scr = (LAS float*)(F.lds + RING_OFF + F.wave * 16384);
    const int gw = blockIdx.x * NWAVES + F.wave, NGW = F.G * NWAVES;
    constexpr int I_FI = (D / 64) * (2 * DFF / 32), I_FO = (DFF / 64) * (D / 32), I_Z = (D / 64) * (INC / 32), I_B = (512 / 64) * (D / 32), I_O = (D / 64) * (D / 32);
    bf16* WFI = (bf16*)(F.ws + WS_WFI); bf16* WFO = (bf16*)(F.ws + WS_WFO); bf16* WZ = (bf16*)(F.ws + WS_WZ); bf16* WB = (bf16*)(F.ws + WS_WB); bf16* WO = (bf16*)(F.ws + WS_WO);
    const float* fwi = F.in[set == 1 ? I_F2WI : I_F1WI] + (size_t)l * D * 2 * DFF; const float* fwo = F.in[set == 1 ? I_F2WO : I_F1WO] + (size_t)l * DFF * D;
    const int NIT = set < 2 ? (I_FI + I_FO) : (I_Z + 4 * I_B + I_O);
    int it = gw, lim = NIT, step = NGW;
    for (;;) {
        if (queue) { int base = 0; if (F.lane == 0) base = (int)__hip_atomic_fetch_add(queue, 16u, __ATOMIC_RELAXED, __HIP_MEMORY_SCOPE_AGENT);
            base = __builtin_amdgcn_readfirstlane(base); if (base >= NIT) break; it = base; lim = base + 16 < NIT ? base + 16 : NIT; step = 1; }
        for (; it < lim; it += step) {
            int r = it;
            if (set < 2) {
                if (r < I_FI) { conv_item<1>(fwi, D, 2 * DFF, WFI, scr, r, F.lane); continue; } r -= I_FI;
                conv_item<0>(fwo, DFF, D, WFO, scr, r, F.lane);
            } else {
                if (r < I_Z) { conv_item<2>(F.in[I_WIN] + (size_t)l * D * INC, D, INC, WZ, scr, r, F.lane); continue; } r -= I_Z;
                if (r < 4 * I_B) { const int n = r / I_B; conv_item<0>(F.in[I_WBR] + ((size_t)l * 4 + n) * 512 * D, 512, D, WB + (size_t)n * D * 512, scr, r % I_B, F.lane); continue; } r -= 4 * I_B;
                conv_item<0>(F.in[I_WOUT] + (size_t)l * D * D, D, D, WO, scr, r, F.lane);
            }
        }
        if (!queue) break;
    }
    if (set == 2 && (!queue || blockIdx.x < 32)) {
        GAS v4u* z = (GAS v4u*)(WZ + (size_t)(ZC_SMALL + 32) * D); const int n16 = 224 * D * 2 / 16; const int nb = queue ? 32 : F.G;
        for (int i = blockIdx.x * (NWAVES * 64) + F.tid; i < n16; i += nb * NWAVES * 64) z[i] = (v4u){0u, 0u, 0u, 0u};
    }
}
template <bool COPY, bool ADDP, bool ZSM> __device__ __forceinline__ void phase_norm(Frame& F, const float* xl, const float* xc, const float* gain, const float* mod  , int nrows) {
    bf16* H = (bf16*)(F.ws + WS_H);
    const int gw = blockIdx.x * NWAVES + F.wave, NGW = F.G * NWAVES;
    if (ZSM) {
        const GAS v4u* src = (const GAS v4u*)((const bf16*)(F.ws + WS_WZ) + (size_t)ZC_SMALL * D);
        for (int i = F.tid; i < 32 * D * 2 / 16; i += NWAVES * 64) *(LAS v4u*)(F.lds + RING_OFF + i * 16) = src[i];
        __syncthreads();
    }
    for (int row = gw; row < nrows; row += NGW) {
        const bool isc = row >= ML; const int b9 = isc ? 8 : row / SEQ;
        const GAS f32x4* xr = (const GAS f32x4*)(isc ? xc + (size_t)(row - ML) * D : xl + (size_t)row * D) + F.lane;
        f32x4 v[8]; float s = 0.f;
#pragma unroll
        for (int j = 0; j < 8; ++j) v[j] = xr[64 * j];
        if (ADDP && isc) {
            const GAS f32x4* pr = (const GAS f32x4*)((const float*)(F.ws + WS_MIX) + (size_t)(row - ML) * D) + F.lane;
#pragma unroll
            for (int q = 0; q < 4; ++q)
#pragma unroll
                for (int j = 0; j < 8; ++j) v[j] = v[j] + pr[(size_t)q * (2048 * 2048 / 4) + 64 * j];
            GAS f32x4* xw = (GAS f32x4*)((float*)(F.ws + WS_XC) + (size_t)(row - ML) * D) + F.lane;
#pragma unroll
            for (int j = 0; j < 8; ++j) xw[64 * j] = v[j];
        }
#pragma unroll
        for (int j = 0; j < 8; ++j) s += (v[j].x * v[j].x + v[j].y * v[j].y) + (v[j].z * v[j].z + v[j].w * v[j].w);
        if (COPY) { GAS f32x4* cp = (GAS f32x4*)(isc ? (float*)(F.ws + WS_XC) + (size_t)(row - ML) * D : F.out + (size_t)row * D) + F.lane;
#pragma unroll
            for (int j = 0; j < 8; ++j) cp[64 * j] = v[j]; }
        const float rstd = 1.0f / sqrtf(wave_sum(s) * (1.0f / D) + EPS);
        const float* sh = mod + (size_t)b9 * MODW; const float* sc = sh + D;
        GAS v2u* o8 = (GAS v2u*)(H + (size_t)row * D) + F.lane;
#pragma unroll
        for (int j = 0; j < 8; ++j) { const int c = 4 * F.lane + 256 * j;
            const f32x4 g = *(const f32x4*)(gain + c), a = *(const f32x4*)(sc + c), b = *(const f32x4*)(sh + c);
            const f32x4 y = (v[j] * rstd * g) * (a + 1.0f) + b;
            if (ZSM) v[j] = y;
            v2u w; w.x = pk2(y.x, y.y); w.y = pk2(y.z, y.w); o8[64 * j] = w; }
        if (ZSM && isc) {
            float res = 0.f;
            for (int c = 0; c < 32; ++c) { const LAS v2u* wr = (const LAS v2u*)(F.lds + RING_OFF + c * (D * 2)) + F.lane; float s = 0.f;
#pragma unroll
                for (int j = 0; j < 8; ++j) { const v2u w = wr[64 * j]; s += v[j].x * bflo(w.x) + v[j].y * bfhi(w.x) + v[j].z * bflo(w.y) + v[j].w * bfhi(w.y); }
                s = wave_sum(s); res = (F.lane == c) ? s : res; }
            if (F.lane < 32) ((float*)(F.ws + WS_ZS))[(size_t)row * 32 + F.lane] = res;
        }
    }
}
#include <hip/hip_bf16.h>
namespace attn {
using bf16 = __hip_bfloat16;
constexpr int   D = 128, NW = 8, QBLK = 32, KVBLK = 64;
constexpr float SCALE = 0.088388347648318440f;
constexpr float THR = 8.f;
constexpr int SDEPTH = 2;
constexpr int LDQ = 512, LDK = 256, LDO = 512;
constexpr size_t SHM_V = KVBLK * D * 2, SHM_K = KVBLK * D * 2, SHM_ATTN = 2 * SHM_V + 2 * SHM_K + NW * 64 * 4;
using bf16x8 = __attribute__((ext_vector_type(8))) short;
using s16x4  = __attribute__((ext_vector_type(4))) short;
using f32x16 = __attribute__((ext_vector_type(16))) float;
using f32x8  = __attribute__((ext_vector_type(8))) float;
using u32x4  = __attribute__((ext_vector_type(4))) unsigned;
#define KSWZ(row, colB) ((row) * 256 + ((colB) ^ (((row) & 7) << 4)))
#define SBAR() __builtin_amdgcn_sched_barrier(0)
__device__ __forceinline__ int crow(int r, int hi) { return (r & 3) + 8 * (r >> 2) + 4 * hi; }
__device__ __forceinline__ unsigned cvtpk(float lo, float hi) {
  unsigned r; asm volatile("v_cvt_pk_bf16_f32 %0, %1, %2" : "=v"(r) : "v"(lo), "v"(hi)); return r;
}
template <typename TIn> struct Stage;
template <> struct Stage<bf16>  { using T = bf16x8;
  __device__ static __forceinline__ T ld8(const bf16* p) { return *reinterpret_cast<const bf16x8*>(p); }
  __device__ static __forceinline__ bf16x8 tobf(T x) { return x; } };
template <> struct Stage<float> { using T = f32x8;
  __device__ static __forceinline__ T ld8(const float* p) { return *reinterpret_cast<const f32x8*>(p); }
  __device__ static __forceinline__ bf16x8 tobf(T x) {
    u32x4 w = {cvtpk(x[0], x[1]), cvtpk(x[2], x[3]), cvtpk(x[4], x[5]), cvtpk(x[6], x[7])}; return *reinterpret_cast<bf16x8*>(&w); } };

__device__ __forceinline__ void partialSM(f32x16& p0, f32x16& p1, float& m_reg, float& mn, float& alpha) {
  constexpr float C = SCALE * 1.4426950408889634f;
  float pmax = p0[0]; for (int r = 1; r < 16; ++r) pmax = fmaxf(pmax, p0[r]); for (int r = 0; r < 16; ++r) pmax = fmaxf(pmax, p1[r]);
  { auto rr = __builtin_amdgcn_permlane32_swap(__float_as_uint(pmax), __float_as_uint(pmax), false, false);
    pmax = fmaxf(__uint_as_float(rr[0]), __uint_as_float(rr[1])); }
  if (__builtin_expect(__all(pmax - m_reg <= THR / SCALE), 1)) { mn = m_reg; alpha = 1.f; }
  else { mn = fmaxf(m_reg, pmax); alpha = __builtin_amdgcn_exp2f((m_reg - mn) * C); m_reg = mn; }
  float mnC = -mn * C;
  for (int r = 0; r < 16; ++r) p0[r] = fmaf(p0[r], C, mnC); for (int r = 0; r < 16; ++r) p1[r] = fmaf(p1[r], C, mnC);
  for (int r = 0; r < 16; ++r) p0[r] = __builtin_amdgcn_exp2f(p0[r]);
}
__device__ __forceinline__ void finishSM(f32x16& p0, f32x16& p1, float alpha, float& l_reg, bf16x8& pa0, bf16x8& pa1, bf16x8& pa2, bf16x8& pa3) {
  for (int r = 0; r < 16; ++r) p1[r] = __builtin_amdgcn_exp2f(p1[r]);
  float ps = 0; for (int r = 0; r < 16; ++r) ps += p0[r]; for (int r = 0; r < 16; ++r) ps += p1[r];
  { auto rr = __builtin_amdgcn_permlane32_swap(__float_as_uint(ps), __float_as_uint(ps), false, false);
    ps = __uint_as_float(rr[0]) + __uint_as_float(rr[1]); }
  l_reg = l_reg * alpha + ps;
#define PK4(P, BASE, OUT) do { unsigned a0 = cvtpk(P[BASE + 0], P[BASE + 1]), a1 = cvtpk(P[BASE + 2], P[BASE + 3]);   \
    unsigned b0 = cvtpk(P[BASE + 4], P[BASE + 5]), b1 = cvtpk(P[BASE + 6], P[BASE + 7]);                              \
    auto r0 = __builtin_amdgcn_permlane32_swap(a0, b0, false, false); auto r1 = __builtin_amdgcn_permlane32_swap(a1, b1, false, false); \
    u32x4 w = {r0[0], r1[0], r0[1], r1[1]}; OUT = *reinterpret_cast<bf16x8*>(&w); } while (0)
  PK4(p0, 0, pa0); PK4(p0, 8, pa1); PK4(p1, 0, pa2); PK4(p1, 8, pa3);
#undef PK4
}
__device__ __forceinline__ void qkt(f32x16& p0, f32x16& p1, const bf16* Ks, const bf16x8* qr, int r32, int hi) {
  p0 = f32x16{}; p1 = f32x16{};
  for (int d0 = 0; d0 < 8; ++d0) { int cb = (d0 * 16 + hi * 8) * 2;
    bf16x8 b0 = *reinterpret_cast<const bf16x8*>((const char*)Ks + KSWZ(r32, cb));
    bf16x8 b1 = *reinterpret_cast<const bf16x8*>((const char*)Ks + KSWZ(32 + r32, cb));
    p0 = __builtin_amdgcn_mfma_f32_32x32x16_bf16(b0, qr[d0], p0, 0, 0, 0);
    p1 = __builtin_amdgcn_mfma_f32_32x32x16_bf16(b1, qr[d0], p1, 0, 0, 0); }
}
__device__ __forceinline__ int v_st(int k, int c) { const int kk = (k & ~0xC) | ((k & 4) << 1) | ((k & 8) >> 1); return ((kk >> 3) * 4 + (c >> 5)) * 512 + ((kk & 7) * 32 + (c & 31)) * 2; }
__device__ __forceinline__ int v_rd_base(int lane) { return ((lane & 3) << 3) | (((lane >> 2) & 3) << 6) | (((lane >> 4) & 1) << 5) | (((lane >> 5) & 1) << 8); }
constexpr int v_rd_off(int d0, int ks, int half) { return d0 * 512 + ks * 4096 + half * 2048; }
template <int OFF> __device__ __forceinline__ s16x4 tr_read(int vb) {
  s16x4 r; asm volatile("ds_read_b64_tr_b16 %0, %1 offset:%2" : "=&v"(r) : "v"(vb), "i"(OFF) : "memory"); return r;
}
template <int D0> __device__ __forceinline__ void pv_one(f32x16& od, int vb, bf16x8 pa0, bf16x8 pa1, bf16x8 pa2, bf16x8 pa3) {
  const s16x4 l0 = tr_read<v_rd_off(D0, 0, 0)>(vb), h0 = tr_read<v_rd_off(D0, 0, 1)>(vb), l1 = tr_read<v_rd_off(D0, 1, 0)>(vb), h1 = tr_read<v_rd_off(D0, 1, 1)>(vb);
  const s16x4 l2 = tr_read<v_rd_off(D0, 2, 0)>(vb), h2 = tr_read<v_rd_off(D0, 2, 1)>(vb), l3 = tr_read<v_rd_off(D0, 3, 0)>(vb), h3 = tr_read<v_rd_off(D0, 3, 1)>(vb);
  asm volatile("s_waitcnt lgkmcnt(0)" ::: "memory"); SBAR();
#define PK(L, H) (bf16x8){L[0], L[1], L[2], L[3], H[0], H[1], H[2], H[3]}
  od = __builtin_amdgcn_mfma_f32_32x32x16_bf16(pa0, PK(l0, h0), od, 0, 0, 0);
  od = __builtin_amdgcn_mfma_f32_32x32x16_bf16(pa1, PK(l1, h1), od, 0, 0, 0);
  od = __builtin_amdgcn_mfma_f32_32x32x16_bf16(pa2, PK(l2, h2), od, 0, 0, 0);
  od = __builtin_amdgcn_mfma_f32_32x32x16_bf16(pa3, PK(l3, h3), od, 0, 0, 0);
#undef PK
}
__device__ __forceinline__ void pv_d0(f32x16* o, int vb, bf16x8 pa0, bf16x8 pa1, bf16x8 pa2, bf16x8 pa3) {
  pv_one<0>(o[0], vb, pa0, pa1, pa2, pa3); pv_one<1>(o[1], vb, pa0, pa1, pa2, pa3); pv_one<2>(o[2], vb, pa0, pa1, pa2, pa3); pv_one<3>(o[3], vb, pa0, pa1, pa2, pa3);
}

template <typename TQ>
__device__ __forceinline__ void attn_dense_body(const TQ* __restrict__ Qb, const bf16* __restrict__ Kh, const bf16* __restrict__ Vh,
                                                bf16* __restrict__ Ob, int seq, char* lds) {
  using St = Stage<bf16>; using SQ = Stage<TQ>;
  const int tid = threadIdx.x, wid = tid >> 6, lane = tid & 63, r32 = lane & 31, hi = lane >> 5;
  bf16* V_lds = (bf16*)lds; bf16* K_lds = (bf16*)(lds + 2 * SHM_V);
  float* ws = (float*)(lds + 2 * SHM_V + 2 * SHM_K) + wid * 64; float* li_l = ws; float* al_l = ws + 32;
  float m_reg = -1e30f, l_reg = 0; f32x16 o[4] = {}; bf16x8 qr[8];
  const TQ* Qw = Qb + (long)(wid * QBLK + r32) * LDQ + hi * 8;
#pragma unroll
  for (int d0 = 0; d0 < 8; ++d0) qr[d0] = SQ::tobf(SQ::ld8(Qw + d0 * 16));
  const int sr = tid >> 4, sc = (tid & 15) * 8, vst0 = v_st(sr, sc), vst1 = v_st(32 + sr, sc);
  const int vb0 = (int)(uintptr_t)V_lds + v_rd_base(lane);
  struct { typename St::T vs0, vs1, ks0, ks1; } sr_[SDEPTH];
#define SLOAD(i, k0) do { sr_[i].vs0 = St::ld8(&Vh[(long)((k0) + sr) * LDK + sc]); sr_[i].vs1 = St::ld8(&Vh[(long)((k0) + 32 + sr) * LDK + sc]); \
    sr_[i].ks0 = St::ld8(&Kh[(long)((k0) + sr) * LDK + sc]); sr_[i].ks1 = St::ld8(&Kh[(long)((k0) + 32 + sr) * LDK + sc]); } while (0)
#define SWRITE(b, i) do { *(bf16x8*)((char*)V_lds + (b) * SHM_V + vst0) = St::tobf(sr_[i].vs0);          \
    *(bf16x8*)((char*)V_lds + (b) * SHM_V + vst1) = St::tobf(sr_[i].vs1); int kc = sc * 2;               \
    *(bf16x8*)((char*)K_lds + (b) * SHM_K + KSWZ(sr, kc)) = St::tobf(sr_[i].ks0);                       \
    *(bf16x8*)((char*)K_lds + (b) * SHM_K + KSWZ(32 + sr, kc)) = St::tobf(sr_[i].ks1); } while (0)
#define SWAIT() do { if constexpr (SDEPTH == 2) asm volatile("s_waitcnt vmcnt(4)" ::: "memory"); else asm volatile("s_waitcnt vmcnt(0)" ::: "memory"); } while (0)
#define RESC(a) do { if (__any((a) < 1.f)) { if (hi == 0) al_l[r32] = (a); asm volatile("s_waitcnt lgkmcnt(0)" ::: "memory"); \
    for (int d = 0; d < 4; ++d) for (int r = 0; r < 16; ++r) o[d][r] *= al_l[crow(r, hi)]; } } while (0)
  f32x16 pA0, pA1, pB0, pB1; float mnA, mnB, alA, alB; bf16x8 pa0, pa1, pa2, pa3; const int NT = seq / KVBLK;
  constexpr int SE = 0, SO = SDEPTH - 1;
  SLOAD(SE, 0); asm volatile("s_waitcnt vmcnt(0)" ::: "memory"); SWRITE(0, SE); __syncthreads();
  qkt(pA0, pA1, K_lds, qr, r32, hi); partialSM(pA0, pA1, m_reg, mnA, alA);
  SLOAD(SO, KVBLK); if constexpr (SDEPTH == 2) { if (2 < NT) SLOAD(SE, 2 * KVBLK); }
  SWAIT(); SWRITE(1, SO); __syncthreads();
  for (int j = 1; j + 1 < NT; j += 2) {
    SBAR(); qkt(pB0, pB1, (bf16*)((char*)K_lds + SHM_K), qr, r32, hi);
    finishSM(pA0, pA1, alA, l_reg, pa0, pa1, pa2, pa3); SBAR();
    SLOAD(SO, (j + SDEPTH) * KVBLK); SBAR();
    pv_d0(o, vb0, pa0, pa1, pa2, pa3); partialSM(pB0, pB1, m_reg, mnB, alB);
    __syncthreads(); SWAIT(); SWRITE(0, SE);
    RESC(alB); __syncthreads();
    SBAR(); qkt(pA0, pA1, K_lds, qr, r32, hi);
    finishSM(pB0, pB1, alB, l_reg, pa0, pa1, pa2, pa3); SBAR();
    if (SDEPTH == 1 || j + 3 < NT) SLOAD(SE, (j + 1 + SDEPTH) * KVBLK); SBAR();
    pv_d0(o, vb0 + (int)SHM_V, pa0, pa1, pa2, pa3); partialSM(pA0, pA1, m_reg, mnA, alA);
    __syncthreads(); SWAIT(); SWRITE(1, SO);
    RESC(alA); __syncthreads();
  }
  SBAR(); qkt(pB0, pB1, (bf16*)((char*)K_lds + SHM_K), qr, r32, hi);
  finishSM(pA0, pA1, alA, l_reg, pa0, pa1, pa2, pa3); SBAR();
  pv_d0(o, vb0, pa0, pa1, pa2, pa3); partialSM(pB0, pB1, m_reg, mnB, alB);
  __syncthreads(); RESC(alB);
  finishSM(pB0, pB1, alB, l_reg, pa0, pa1, pa2, pa3); SBAR();
  pv_d0(o, vb0 + (int)SHM_V, pa0, pa1, pa2, pa3);
  if (hi == 0) li_l[r32] = l_reg; asm volatile("s_waitcnt lgkmcnt(0)" ::: "memory");
  float rli[16];
#pragma unroll
  for (int r = 0; r < 16; ++r) rli[r] = __builtin_amdgcn_rcpf(li_l[crow(r, hi)]);
  bf16* Ow = Ob + (long)(wid * QBLK) * LDO;
#pragma unroll
  for (int r = 0; r < 16; ++r) { int orow = crow(r, hi);
    for (int d0 = 0; d0 < 4; ++d0) Ow[(long)orow * LDO + d0 * 32 + r32] = __float2bfloat16(o[d0][r] * rli[r]); }
#undef SLOAD
#undef SWRITE
#undef SWAIT
#undef RESC
}

#undef KSWZ
#undef SBAR
}
constexpr size_t MX_CL = 0;
constexpr size_t MX_CP = 36 * MiB;
constexpr size_t MX_NL = 72 * MiB;
constexpr size_t MX_NP = 73 * MiB;
constexpr size_t MX_ST = 74 * MiB;
constexpr size_t MX_SP = 75 * MiB;
constexpr size_t MX_GQ = 76 * MiB, MX_GK = 94 * MiB, MX_GV = 112 * MiB;
constexpr size_t MX_GG = 130 * MiB, MX_GB = 131 * MiB;
constexpr size_t MX_GD1 = 132 * MiB;
constexpr size_t GD1_ITEM = 73728;
constexpr size_t MX_GE = 294 * MiB;
static_assert(MX_GD1 + (size_t)2304 * GD1_ITEM <= MX_GE && WS_MIX + MX_GE + 2304 * 128 <= WS_END, "mixer scratch map");

typedef float f32x4m __attribute__((ext_vector_type(4)));
#define MFMA16(a, b, c) __builtin_amdgcn_mfma_f32_16x16x32_bf16((a), (b), (c), 0, 0, 0)
__device__ __forceinline__ bf16x8 lds_frag(const LAS unsigned char* base, int stride, int row0, int kb, int lane) {
    return *(const LAS bf16x8*)(base + (row0 + (lane & 15)) * stride + kb + (lane >> 4) * 16);
}
__device__ __forceinline__ float gelu_tanh(float x) { const float y = 0.7978845608028654f * (x + 0.044715f * x * x * x); const float t = 1.0f - 2.0f / (1.0f + __expf(2.0f * y)); return 0.5f * x * (1.0f + t); }
__device__ __forceinline__ float logsigmoid1(float x) { return fminf(x, 0.f) - log1pf(__expf(-fabsf(x))); }
__device__ __forceinline__ float softplus1(float x) { return fmaxf(x, 0.f) + log1pf(__expf(-fabsf(x))); }
__device__ __forceinline__ int perm32p(int jl) { return 8 * ((jl & 15) >> 2) + 4 * (jl >> 4) + (jl & 3); }

__device__ __forceinline__ float wscan_sum_f(float v, int lane) {
#pragma unroll
    for (int o = 1; o < 64; o <<= 1) { const float t = __shfl_up(v, o); if (lane >= o) v += t; }
    return v;
}
__device__ __forceinline__ float wscan_sum_b(float v, int lane) {
#pragma unroll
    for (int o = 1; o < 64; o <<= 1) { const float t = __shfl_down(v, o); if (lane + o < 64) v += t; }
    return v;
}
__device__ __forceinline__ float wscan_max_f(float v, int lane) {
#pragma unroll
    for (int o = 1; o < 64; o <<= 1) { const float t = __shfl_up(v, o); if (lane >= o) v = fmaxf(v, t); }
    return v;
}
__device__ __forceinline__ float wscan_max_b(float v, int lane) {
#pragma unroll
    for (int o = 1; o < 64; o <<= 1) { const float t = __shfl_down(v, o); if (lane + o < 64) v = fmaxf(v, t); }
    return v;
}
__device__ __forceinline__ void phase_attn_prep(Frame& F, int l, bool last) {
    const bf16* Z = (const bf16*)(F.ws + WS_Z); bf16* QA = (bf16*)(F.ws + WS_QA); bf16* KC = (bf16*)(F.ws + WS_KC); bf16* VC = (bf16*)(F.ws + WS_VC);
    const float* RC = (const float*)(F.ws + WS_ROPE); const float* RS = RC + 96 * 32;
    const float* gq = F.in[I_ATQN] + l * 128; const float* gk = F.in[I_ATKN] + l * 128;
    const int gw = blockIdx.x * NWAVES + F.wave, NGW = F.G * NWAVES;
    const int half = F.lane >> 5, i = F.lane & 31, da = 64 * half + i, db = da + 32;
    const float gqa = gq[da], gqb = gq[db], gka = gk[da], gkb = gk[db];
    for (int row = gw; row < MT; row += NGW) {
        const bool isc = row >= ML; const int b = isc ? (row - ML) / CTXL : row / SEQ, t = isc ? (row - ML) % CTXL : row % SEQ;
        const bf16* zr = Z + (size_t)row * NZ;
        float cs = 1.f, sn = 0.f;
        if (!isc) { const int pos = half ? 32 + (t & 63) : (t >> 6); cs = RC[pos * 32 + i]; sn = RS[pos * 32 + i]; }
        if (!(isc && last)) {
#pragma unroll
            for (int h = 0; h < 4; ++h) {
                const float a = bf1(zr[ZC_ATQ + h * 128 + da]), bb = bf1(zr[ZC_ATQ + h * 128 + db]);
                const float rs = 1.0f / sqrtf(wave_sum(a * a + bb * bb) * (1.0f / 128.0f) + EPS);
                const float ya = a * rs * gqa, yb = bb * rs * gqb;
                QA[(size_t)row * 512 + h * 128 + da] = f2bf1(ya * cs - yb * sn); QA[(size_t)row * 512 + h * 128 + db] = f2bf1(yb * cs + ya * sn);
            }
        }
        const size_t krow = (size_t)b * 2304 + (isc ? t : 256 + t);
#pragma unroll
        for (int h = 0; h < 2; ++h) {
            const float a = bf1(zr[ZC_ATK + h * 128 + da]), bb = bf1(zr[ZC_ATK + h * 128 + db]);
            const float rs = 1.0f / sqrtf(wave_sum(a * a + bb * bb) * (1.0f / 128.0f) + EPS);
            const float ya = a * rs * gka, yb = bb * rs * gkb;
            KC[krow * 256 + h * 128 + da] = f2bf1(ya * cs - yb * sn); KC[krow * 256 + h * 128 + db] = f2bf1(yb * cs + ya * sn);
        }
        *(GAS v2u*)(VC + krow * 256 + 4 * F.lane) = *(const GAS v2u*)(zr + ZC_ATV + 4 * F.lane);
    }
}
__device__ __forceinline__ void attn_item(Frame& F, int it) {
    const attn::bf16* QA = (const attn::bf16*)(F.ws + WS_QA); const attn::bf16* KC = (const attn::bf16*)(F.ws + WS_KC); const attn::bf16* VC = (const attn::bf16*)(F.ws + WS_VC);
    attn::bf16* Y3 = (attn::bf16*)(F.ws + WS_Y) + (size_t)3 * MT * 512;
    int h, b, seq; size_t r0;
    if (it < 256) { const int qb = it & 7; h = (it >> 3) & 3; b = it >> 5; r0 = (size_t)b * SEQ + qb * 256; seq = 2304; }
    else { const int j = it - 256; h = j & 3; b = j >> 2; r0 = (size_t)ML + b * CTXL; seq = 256; }
    attn::attn_dense_body<attn::bf16>(QA + r0 * 512 + h * 128, KC + (size_t)b * 2304 * 256 + (h >> 1) * 128, VC + (size_t)b * 2304 * 256 + (h >> 1) * 128, Y3 + r0 * 512 + h * 128, seq, (char*)F.lds + RING_OFF);
    __syncthreads();
}
__device__ __forceinline__ void phase_spatial(Frame& F, int l, bool last) {
    const bf16* Z = (const bf16*)(F.ws + WS_Z); bf16* Y0 = (bf16*)(F.ws + WS_Y);
    LAS unsigned char* Wl = F.lds + RING_OFF; LAS unsigned char* Vt = Wl + 34816;
    const int nchunk = last ? ML / 128 : MT / 128;
    const int tid = F.tid, r = tid >> 2, q = tid & 3;
    for (int it = F.G - 1 - (int)blockIdx.x; it < nchunk * 4; it += F.G) {
        const int ch = it >> 2, g = it & 3; const size_t row0 = (size_t)ch * 128;
        const bf16* zv = Z + (row0 + r) * NZ + ZC_SGV;
        float ss = 0.f;
#pragma unroll 4
        for (int j = 0; j < 16; ++j) { const v4u w = *(const GAS v4u*)(zv + q * 128 + j * 8);
            const float e0 = gelu_tanh(bflo(w.x)), e1 = gelu_tanh(bfhi(w.x)), e2 = gelu_tanh(bflo(w.y)), e3 = gelu_tanh(bfhi(w.y)), e4 = gelu_tanh(bflo(w.z)), e5 = gelu_tanh(bfhi(w.z)), e6 = gelu_tanh(bflo(w.w)), e7 = gelu_tanh(bfhi(w.w));
            ss += (e0 * e0 + e1 * e1) + (e2 * e2 + e3 * e3) + (e4 * e4 + e5 * e5) + (e6 * e6 + e7 * e7); }
        ss += __shfl_xor(ss, 1); ss += __shfl_xor(ss, 2);
        const float rstd = 1.0f / sqrtf(ss * (1.0f / 512.0f) + EPS);
        const float* gn = F.in[I_SGN] + l * 512 + g * 128 + q * 32;
#pragma unroll
        for (int j = 0; j < 4; ++j) { const v4u w = *(const GAS v4u*)(zv + g * 128 + q * 32 + j * 8);
            const float e[8] = {gelu_tanh(bflo(w.x)), gelu_tanh(bfhi(w.x)), gelu_tanh(bflo(w.y)), gelu_tanh(bfhi(w.y)), gelu_tanh(bflo(w.z)), gelu_tanh(bfhi(w.z)), gelu_tanh(bflo(w.w)), gelu_tanh(bfhi(w.w))};
#pragma unroll
            for (int k = 0; k < 8; ++k) { const int c = q * 32 + j * 8 + k; *(LAS bf16*)(Vt + c * 272 + r * 2) = f2bf1(e[k] * rstd * gn[j * 8 + k]); } }
        const float* wg = F.in[I_SGW] + ((size_t)(l * 4 + g) * 128 + r) * 128 + q * 32;
#pragma unroll
        for (int j = 0; j < 4; ++j) { const f32x4 a = *(const f32x4*)(wg + j * 8), b = *(const f32x4*)(wg + j * 8 + 4);
            v4u o; o.x = pk2(a.x, a.y); o.y = pk2(a.z, a.w); o.z = pk2(b.x, b.y); o.w = pk2(b.z, b.w);
            *(LAS v4u*)(Wl + r * 272 + (q * 32 + j * 8) * 2) = o; }
        __syncthreads();
        const int wr = F.wave >> 1, wc = F.wave & 1;
        f32x4 acc[2][4];
#pragma unroll
        for (int mi = 0; mi < 2; ++mi)
#pragma unroll
            for (int ni = 0; ni < 4; ++ni) acc[mi][ni] = (f32x4){0.f, 0.f, 0.f, 0.f};
#pragma unroll
        for (int ks = 0; ks < 4; ++ks) {
            bf16x8 a[2], b[4];
#pragma unroll
            for (int mi = 0; mi < 2; ++mi) a[mi] = lds_frag(Wl, 272, 32 * wr + 16 * mi, ks * 64, F.lane);
#pragma unroll
            for (int ni = 0; ni < 4; ++ni) b[ni] = lds_frag(Vt, 272, 64 * wc + 16 * ni, ks * 64, F.lane);
#pragma unroll
            for (int mi = 0; mi < 2; ++mi)
#pragma unroll
                for (int ni = 0; ni < 4; ++ni) acc[mi][ni] = MFMA16(a[mi], b[ni], acc[mi][ni]);
        }
        const float* bs = F.in[I_SGB] + (l * 4 + g) * 128;
#pragma unroll
        for (int mi = 0; mi < 2; ++mi)
#pragma unroll
            for (int rr = 0; rr < 4; ++rr) { const int t = 32 * wr + 16 * mi + 4 * (F.lane >> 4) + rr; const float bias = bs[t];
#pragma unroll
                for (int ni = 0; ni < 4; ++ni) { const int c = g * 128 + 64 * wc + 16 * ni + (F.lane & 15);
                    const float u = gelu_tanh(bf1(Z[(row0 + t) * NZ + ZC_SGU + c]));
                    Y0[(row0 + t) * 512 + c] = f2bf1(u * (acc[mi][ni][rr] + bias)); } }
        __syncthreads();
    }
}
__device__ __forceinline__ void ml_slot(int chain, int k, int& rowbase, int& h, int& dir) {
    const int b = chain >> 3; h = (chain >> 1) & 3; dir = chain & 1;
    if (k < 2) { const int j = dir ? 1 - k : k; rowbase = ML + b * CTXL + 128 * j; }
    else { const int n = k - 2, j = dir ? 15 - n : n; rowbase = b * SEQ + 128 * j; }
}
__device__ __forceinline__ void ml_gates(Frame& F, int l, int rowbase, int h, int dir, LAS float* li, LAS float* lf, LAS float* bc) {
    const float* ZS = (const float*)(F.ws + WS_ZS); const float* bias = F.in[I_MLIFB] + l * 16;
    float s = 0.f;
    if (F.tid < 128) { const float* zr = ZS + (size_t)(rowbase + F.tid) * 32;
        li[F.tid] = zr[dir * 4 + h] + bias[dir * 4 + h];
        const float f = logsigmoid1(zr[(2 + dir) * 4 + h] + bias[(2 + dir) * 4 + h]);
        s = dir ? wscan_sum_b(f, F.lane) : wscan_sum_f(f, F.lane);
        if (dir == 0 && F.tid == 63) lf[0] = s;
        if (dir == 1 && F.tid == 64) lf[0] = s; }
    __syncthreads();
    if (F.tid < 128) { if ((dir == 0 && F.tid >= 64) || (dir == 1 && F.tid < 64)) s += lf[0]; bc[F.tid] = s; }
    __syncthreads();
}
__device__ __forceinline__ void phase_ml1(Frame& F, int l) {
    const bf16* Z = (const bf16*)(F.ws + WS_Z);
    bf16* CL = (bf16*)(F.ws + WS_MIX + MX_CL); float* NL = (float*)(F.ws + WS_MIX + MX_NL); float* ST = (float*)(F.ws + WS_MIX + MX_ST);
    LAS unsigned char* kT = F.lds + RING_OFF; LAS unsigned char* vT = kT + 34816;
    LAS float* li = (LAS float*)(F.lds + RING_OFF + 69632); LAS float* lf = li + 128; LAS float* bc = lf + 128; LAS float* wg = bc + 128; LAS float* red = wg + 128;
    const int tid = F.tid, tau = tid >> 2, q = tid & 3;
    for (int it = blockIdx.x; it < 64 * 18; it += F.G) {
        const int chain = it / 18, k = it % 18; int rowbase, h, dir; ml_slot(chain, k, rowbase, h, dir);
        ml_gates(F, l, rowbase, h, dir, li, lf, bc);
        const float bend = dir ? bc[0] : bc[127];
        if (tid < 128) wg[tid] = bend - bc[tid] + li[tid];
        __syncthreads();
        if (tid < 64) { float m = fmaxf(wg[tid], wg[tid + 64]);
#pragma unroll
            for (int o = 1; o < 64; o <<= 1) m = fmaxf(m, __shfl_xor(m, o));
            if (tid == 0) red[0] = m; }
        __syncthreads();
        const float mloc = red[0];
        __syncthreads();
        if (tid < 128) wg[tid] = __expf(wg[tid] - mloc);
        __syncthreads();
        { const bf16* zk = Z + (size_t)(rowbase + tau) * NZ + ZC_MLK + h * 128 + q * 32; const bf16* zv = Z + (size_t)(rowbase + tau) * NZ + ZC_MLV + h * 128 + q * 32; const float w = wg[tau];
#pragma unroll
          for (int j = 0; j < 4; ++j) { const v4u a = *(const GAS v4u*)(zk + j * 8), b = *(const GAS v4u*)(zv + j * 8);
              const float ka[8] = {bflo(a.x), bfhi(a.x), bflo(a.y), bfhi(a.y), bflo(a.z), bfhi(a.z), bflo(a.w), bfhi(a.w)};
              const float va[8] = {bflo(b.x), bfhi(b.x), bflo(b.y), bfhi(b.y), bflo(b.z), bfhi(b.z), bflo(b.w), bfhi(b.w)};
#pragma unroll
              for (int c = 0; c < 8; ++c) { const int col = q * 32 + j * 8 + c;
                  *(LAS bf16*)(kT + col * 272 + tau * 2) = f2bf1(ka[c] * 0.08838834764831845f);
                  *(LAS bf16*)(vT + col * 272 + tau * 2) = f2bf1(va[c] * w); } } }
        __syncthreads();
        const int wr = F.wave >> 1, wc = F.wave & 1;
        f32x4 acc[2][4];
#pragma unroll
        for (int mi = 0; mi < 2; ++mi)
#pragma unroll
            for (int ni = 0; ni < 4; ++ni) acc[mi][ni] = (f32x4){0.f, 0.f, 0.f, 0.f};
#pragma unroll
        for (int ks = 0; ks < 4; ++ks) {
            bf16x8 a[2], b[4];
#pragma unroll
            for (int mi = 0; mi < 2; ++mi) a[mi] = lds_frag(vT, 272, 32 * wr + 16 * mi, ks * 64, F.lane);
#pragma unroll
            for (int ni = 0; ni < 4; ++ni) b[ni] = lds_frag(kT, 272, 64 * wc + 16 * ni, ks * 64, F.lane);
#pragma unroll
            for (int mi = 0; mi < 2; ++mi)
#pragma unroll
                for (int ni = 0; ni < 4; ++ni) acc[mi][ni] = MFMA16(a[mi], b[ni], acc[mi][ni]);
        }
        bf16* cl = CL + (size_t)it * 16384;
#pragma unroll
        for (int mi = 0; mi < 2; ++mi)
#pragma unroll
            for (int rr = 0; rr < 4; ++rr) { const int e = 32 * wr + 16 * mi + 4 * (F.lane >> 4) + rr;
#pragma unroll
                for (int ni = 0; ni < 4; ++ni) cl[e * 128 + 64 * wc + 16 * ni + (F.lane & 15)] = f2bf1(acc[mi][ni][rr]); }
        { float s = 0.f; const LAS bf16* kr = (const LAS bf16*)(kT + tau * 272) + q * 32;
#pragma unroll 8
          for (int t = 0; t < 32; ++t) s += wg[q * 32 + t] * bf1(kr[t]);
          s += __shfl_xor(s, 1); s += __shfl_xor(s, 2);
          if (q == 0) NL[(size_t)it * 128 + tau] = s; }
        if (tid == 0) { ST[it * 32 + 0] = mloc; ST[it * 32 + 1] = bend; }
        __syncthreads();
    }
}
__device__ __forceinline__ void phase_ml2(Frame& F, int wg0) {
    const bf16* CL = (const bf16*)(F.ws + WS_MIX + MX_CL); const float* NL = (const float*)(F.ws + WS_MIX + MX_NL); const float* ST = (const float*)(F.ws + WS_MIX + MX_ST);
    bf16* CP = (bf16*)(F.ws + WS_MIX + MX_CP); float* NP = (float*)(F.ws + WS_MIX + MX_NP); float* SP = (float*)(F.ws + WS_MIX + MX_SP);
    if ((int)blockIdx.x < wg0) return;
    const int gt = ((int)blockIdx.x - wg0) * (NWAVES * 64) + F.tid, NT = (F.G - wg0) * NWAVES * 64;
    for (int task = gt; task < 64 * 4096; task += NT) {
        const int chain = task >> 12, e4 = (task & 4095) * 4;
        v2u w[18]; float ml[18], be[18];
#pragma unroll
        for (int k = 0; k < 18; ++k) { const int it = chain * 18 + k; w[k] = *(const GAS v2u*)(CL + (size_t)it * 16384 + e4); ml[k] = ST[it * 32 + 0]; be[k] = ST[it * 32 + 1]; }
        float c0 = 0.f, c1 = 0.f, c2 = 0.f, c3 = 0.f, m = 0.f;
#pragma unroll
        for (int k = 0; k < 18; ++k) { const int it = chain * 18 + k;
            v2u o; o.x = pk2(c0, c1); o.y = pk2(c2, c3); *(GAS v2u*)(CP + (size_t)it * 16384 + e4) = o;
            const float mn = fmaxf(be[k] + m, ml[k]), sp = __expf(be[k] + m - mn), sl = __expf(ml[k] - mn);
            c0 = sp * c0 + sl * bflo(w[k].x); c1 = sp * c1 + sl * bfhi(w[k].x); c2 = sp * c2 + sl * bflo(w[k].y); c3 = sp * c3 + sl * bfhi(w[k].y); m = mn; }
    }
    for (int task = gt; task < 64 * 128; task += NT) {
        const int chain = task >> 7, d = task & 127; float n = 0.f, m = 0.f;
        float nl[18], ml[18], be[18];
#pragma unroll
        for (int k = 0; k < 18; ++k) { const int it = chain * 18 + k; nl[k] = NL[(size_t)it * 128 + d]; ml[k] = ST[it * 32 + 0]; be[k] = ST[it * 32 + 1]; }
#pragma unroll
        for (int k = 0; k < 18; ++k) { const int it = chain * 18 + k;
            NP[(size_t)it * 128 + d] = n;
            if (d == 0) SP[it * 32] = m;
            const float mn = fmaxf(be[k] + m, ml[k]), sp = __expf(be[k] + m - mn), sl = __expf(ml[k] - mn);
            n = sp * n + sl * nl[k]; m = mn; }
    }
}
__device__ __forceinline__ void ml3_item(Frame& F, int l, int it) {
    const bf16* Z = (const bf16*)(F.ws + WS_Z); bf16* Y1 = (bf16*)(F.ws + WS_Y) + (size_t)MT * 512;
    const bf16* CL = (const bf16*)(F.ws + WS_MIX + MX_CP); const float* NL = (const float*)(F.ws + WS_MIX + MX_NP); const float* ST = (const float*)(F.ws + WS_MIX + MX_SP);
    LAS unsigned char* qs = F.lds + RING_OFF; LAS unsigned char* ks = qs + 34816; LAS unsigned char* vT = ks + 34816;
    LAS float* li = (LAS float*)(F.lds + RING_OFF + 104448); LAS float* lf = li + 128; LAS float* bc = lf + 128; LAS float* cv = bc + 128; LAS float* Mt = cv + 128;
    LAS float* inter = Mt + 128; LAS float* rden = inter + 128; LAS float* emt = rden + 128; LAS float* rowss = emt + 128; LAS float* npv = rowss + 256;
    const int tid = F.tid, tau = tid >> 2, q = tid & 3, lane = F.lane, g4 = lane >> 4, l15 = lane & 15;
    {
        int b, h, j, rowbase, nch;
        if (it < 512) { b = it >> 6; h = (it >> 4) & 3; j = it & 15; rowbase = b * SEQ + 128 * j; nch = 16; }
        else { const int r = it - 512; b = r >> 3; h = (r >> 1) & 3; j = r & 1; rowbase = ML + b * CTXL + 128 * j; nch = 2; }
        { const bf16* zq = Z + (size_t)(rowbase + tau) * NZ + ZC_MLQ + h * 128 + q * 32; const bf16* zk = Z + (size_t)(rowbase + tau) * NZ + ZC_MLK + h * 128 + q * 32;
          const bf16* zv = Z + (size_t)(rowbase + tau) * NZ + ZC_MLV + h * 128 + q * 32;
#pragma unroll
          for (int jj = 0; jj < 4; ++jj) { const v4u a = *(const GAS v4u*)(zq + jj * 8), kk = *(const GAS v4u*)(zk + jj * 8), vv = *(const GAS v4u*)(zv + jj * 8);
              *(LAS v4u*)(qs + tau * 272 + (q * 32 + jj * 8) * 2) = a;
              v4u ko; const float s = 0.08838834764831845f;
              ko.x = pk2(bflo(kk.x) * s, bfhi(kk.x) * s); ko.y = pk2(bflo(kk.y) * s, bfhi(kk.y) * s); ko.z = pk2(bflo(kk.z) * s, bfhi(kk.z) * s); ko.w = pk2(bflo(kk.w) * s, bfhi(kk.w) * s);
              *(LAS v4u*)(ks + tau * 272 + (q * 32 + jj * 8) * 2) = ko;
              const unsigned vw[4] = {vv.x, vv.y, vv.z, vv.w};
#pragma unroll
              for (int c = 0; c < 4; ++c) { const int col = q * 32 + jj * 8 + 2 * c;
                  *(LAS bf16*)(vT + col * 272 + tau * 2) = (bf16)(vw[c] & 0xffffu); *(LAS bf16*)(vT + (col + 1) * 272 + tau * 2) = (bf16)(vw[c] >> 16); } } }
        __syncthreads();
        const int wr = F.wave >> 1, wc = F.wave & 1;
        f32x4 accS[2][4];
#pragma unroll
        for (int mi = 0; mi < 2; ++mi)
#pragma unroll
            for (int ni = 0; ni < 4; ++ni) accS[mi][ni] = (f32x4){0.f, 0.f, 0.f, 0.f};
#pragma unroll
        for (int kk = 0; kk < 4; ++kk) {
            bf16x8 a[2], bq[4];
#pragma unroll
            for (int mi = 0; mi < 2; ++mi) a[mi] = lds_frag(ks, 272, 32 * wr + 16 * mi, kk * 64, lane);
#pragma unroll
            for (int ni = 0; ni < 4; ++ni) bq[ni] = lds_frag(qs, 272, 64 * wc + 16 * ni, kk * 64, lane);
#pragma unroll
            for (int mi = 0; mi < 2; ++mi)
#pragma unroll
                for (int ni = 0; ni < 4; ++ni) accS[mi][ni] = MFMA16(a[mi], bq[ni], accS[mi][ni]);
        }
        f32x4 hsum[2][4];
#pragma unroll
        for (int mi = 0; mi < 2; ++mi)
#pragma unroll
            for (int ni = 0; ni < 4; ++ni) hsum[mi][ni] = (f32x4){0.f, 0.f, 0.f, 0.f};
        for (int dir = 0; dir < 2; ++dir) {
            const int n = dir ? nch - 1 - j : j, slot = (it < 512) ? 2 + n : n, chain = (b * 4 + h) * 2 + dir, sit = chain * 18 + slot;
            __syncthreads();
            ml_gates(F, l, rowbase, h, dir, li, lf, bc);
            const float mprev = ST[sit * 32];
            if (tid < 128) { cv[tid] = li[tid] - bc[tid]; npv[tid] = NL[(size_t)sit * 128 + tid]; }
            __syncthreads();
            float mx = -3.0e38f;
            if (tid < 128) { mx = dir ? wscan_max_b(cv[tid], lane) : wscan_max_f(cv[tid], lane);
                if (dir == 0 && tid == 63) lf[1] = mx; if (dir == 1 && tid == 64) lf[1] = mx; }
            __syncthreads();
            if (tid < 128) { if ((dir == 0 && tid >= 64) || (dir == 1 && tid < 64)) mx = fmaxf(mx, lf[1]);
                const float M = fmaxf(mx, mprev); Mt[tid] = M; inter[tid] = __expf(mprev - M); emt[tid] = __expf(-(bc[tid] + M)); }
            __syncthreads();
#pragma unroll
            for (int mi = 0; mi < 2; ++mi)
#pragma unroll
                for (int ni = 0; ni < 4; ++ni) { const int t = 64 * wc + 16 * ni + l15, s0 = 32 * wr + 16 * mi + 4 * g4; const float M = Mt[t];
                    float p[4];
#pragma unroll
                    for (int rr = 0; rr < 4; ++rr) { const int s = s0 + rr; const bool ok = dir ? (s >= t) : (s <= t); p[rr] = ok ? __expf(cv[s] - M) * accS[mi][ni][rr] : 0.f; }
                    v2u o; o.x = pk2(p[0], p[1]); o.y = pk2(p[2], p[3]); *(LAS v2u*)(ks + t * 272 + s0 * 2) = o; }
            __syncthreads();
            { float sp = 0.f, sn = 0.f; const LAS bf16* pr = (const LAS bf16*)(ks + tau * 272) + q * 32; const LAS bf16* qr = (const LAS bf16*)(qs + tau * 272) + q * 32;
#pragma unroll 8
              for (int c = 0; c < 32; ++c) { sp += bf1(pr[c]); sn += npv[q * 32 + c] * bf1(qr[c]); }
              sp += __shfl_xor(sp, 1); sp += __shfl_xor(sp, 2); sn += __shfl_xor(sn, 1); sn += __shfl_xor(sn, 2);
              if (q == 0) { const float den = sp + inter[tau] * sn; rden[tau] = 1.0f / fmaxf(fabsf(den), emt[tau]); } }
            f32x4 acc[2][4];
#pragma unroll
            for (int mi = 0; mi < 2; ++mi)
#pragma unroll
                for (int ni = 0; ni < 4; ++ni) acc[mi][ni] = (f32x4){0.f, 0.f, 0.f, 0.f};
            const bf16* cp = CL + (size_t)sit * 16384;
#pragma unroll
            for (int kk = 0; kk < 4; ++kk) {
                bf16x8 a[2], bb[4];
#pragma unroll
                for (int mi = 0; mi < 2; ++mi) a[mi] = lds_frag(qs, 272, 32 * wr + 16 * mi, kk * 64, lane);
#pragma unroll
                for (int ni = 0; ni < 4; ++ni) bb[ni] = *(const GAS bf16x8*)(cp + (64 * wc + 16 * ni + l15) * 128 + kk * 32 + g4 * 8);
#pragma unroll
                for (int mi = 0; mi < 2; ++mi)
#pragma unroll
                    for (int ni = 0; ni < 4; ++ni) acc[mi][ni] = MFMA16(a[mi], bb[ni], acc[mi][ni]);
            }
#pragma unroll
            for (int mi = 0; mi < 2; ++mi)
#pragma unroll
                for (int rr = 0; rr < 4; ++rr) { const float sc = inter[32 * wr + 16 * mi + 4 * g4 + rr];
#pragma unroll
                    for (int ni = 0; ni < 4; ++ni) acc[mi][ni][rr] *= sc; }
#pragma unroll
            for (int kk = 0; kk < 4; ++kk) {
                bf16x8 a[2], bb[4];
#pragma unroll
                for (int mi = 0; mi < 2; ++mi) a[mi] = lds_frag(ks, 272, 32 * wr + 16 * mi, kk * 64, lane);
#pragma unroll
                for (int ni = 0; ni < 4; ++ni) bb[ni] = lds_frag(vT, 272, 64 * wc + 16 * ni, kk * 64, lane);
#pragma unroll
                for (int mi = 0; mi < 2; ++mi)
#pragma unroll
                    for (int ni = 0; ni < 4; ++ni) acc[mi][ni] = MFMA16(a[mi], bb[ni], acc[mi][ni]);
            }
            __syncthreads();
#pragma unroll
            for (int mi = 0; mi < 2; ++mi)
#pragma unroll
                for (int rr = 0; rr < 4; ++rr) { const float sc = rden[32 * wr + 16 * mi + 4 * g4 + rr];
#pragma unroll
                    for (int ni = 0; ni < 4; ++ni) hsum[mi][ni][rr] += acc[mi][ni][rr] * sc; }
        }
        __syncthreads();
#pragma unroll
        for (int mi = 0; mi < 2; ++mi)
#pragma unroll
            for (int rr = 0; rr < 4; ++rr) { float s = 0.f;
#pragma unroll
                for (int ni = 0; ni < 4; ++ni) s += hsum[mi][ni][rr] * hsum[mi][ni][rr];
                s += __shfl_xor(s, 1); s += __shfl_xor(s, 2); s += __shfl_xor(s, 4); s += __shfl_xor(s, 8);
                if (l15 == 0) rowss[wc * 128 + 32 * wr + 16 * mi + 4 * g4 + rr] = s; }
        __syncthreads();
        const float* gn = F.in[I_MLN] + l * 512 + h * 128;
#pragma unroll
        for (int mi = 0; mi < 2; ++mi)
#pragma unroll
            for (int rr = 0; rr < 4; ++rr) { const int t = 32 * wr + 16 * mi + 4 * g4 + rr; const float rs = 1.0f / sqrtf((rowss[t] + rowss[128 + t]) * (1.0f / 128.0f) + EPS);
#pragma unroll
                for (int ni = 0; ni < 4; ++ni) { const int e = 64 * wc + 16 * ni + l15;
                    const float og = sigm1(bf1(Z[(size_t)(rowbase + t) * NZ + ZC_MLO + h * 128 + e]));
                    Y1[(size_t)(rowbase + t) * 512 + h * 128 + e] = f2bf1(og * hsum[mi][ni][rr] * rs * gn[e]); } }
        __syncthreads();
    }
}
__device__ __forceinline__ void gd_slot(int chain, int k, int& seqbase, int& T, int& n, int& h, int& dir) {
    const int b = chain >> 3; h = (chain >> 1) & 3; dir = chain & 1;
    if (k < 4) { seqbase = ML + b * CTXL; T = CTXL; n = k; } else { seqbase = b * SEQ; T = SEQ; n = k - 4; }
}
__device__ __forceinline__ void phase_gd0(Frame& F, int l, bool last) {
    const bf16* Z = (const bf16*)(F.ws + WS_Z); const float* ZS = (const float*)(F.ws + WS_ZS);
    bf16* GQ = (bf16*)(F.ws + WS_MIX + MX_GQ); bf16* GK = (bf16*)(F.ws + WS_MIX + MX_GK); bf16* GV = (bf16*)(F.ws + WS_MIX + MX_GV);
    float* GG = (float*)(F.ws + WS_MIX + MX_GG); float* GB = (float*)(F.ws + WS_MIX + MX_GB);
    const float* cw = F.in[I_GDCONV] + (size_t)l * 3 * 1536;
    const int gw = blockIdx.x * NWAVES + F.wave, NGW = F.G * NWAVES, c8 = F.lane * 8;
    for (int row = gw; row < MT; row += NGW) {
        const bool isc = row >= ML; const int t = isc ? (row - ML) % CTXL : row % SEQ, T = isc ? CTXL : SEQ;
        const bool hp = t > 0, hn = t < T - 1;
#pragma unroll
        for (int seg = 0; seg < 3; ++seg) {
            if (seg == 0 && isc && last) continue;
            const int zc = (seg == 0 ? ZC_GDQ : seg == 1 ? ZC_GDK : ZC_GDV) + c8;
            const bf16* zr = Z + (size_t)row * NZ + zc;
            const v4u x1 = *(const GAS v4u*)zr;
            v4u x0 = (v4u){0u, 0u, 0u, 0u}, x2 = (v4u){0u, 0u, 0u, 0u};
            if (hp) x0 = *(const GAS v4u*)(zr - NZ);
            if (hn) x2 = *(const GAS v4u*)(zr + NZ);
            const float* w0 = cw + seg * 512 + c8; const float* w1 = w0 + 1536; const float* w2 = w1 + 1536;
            const unsigned a0[4] = {x0.x, x0.y, x0.z, x0.w}, a1[4] = {x1.x, x1.y, x1.z, x1.w}, a2[4] = {x2.x, x2.y, x2.z, x2.w};
            float y[8]; float ss = 0.f;
#pragma unroll
            for (int j = 0; j < 4; ++j) {
                const float lo = bflo(a0[j]) * w0[2 * j] + bflo(a1[j]) * w1[2 * j] + bflo(a2[j]) * w2[2 * j];
                const float hi = bfhi(a0[j]) * w0[2 * j + 1] + bfhi(a1[j]) * w1[2 * j + 1] + bfhi(a2[j]) * w2[2 * j + 1];
                y[2 * j] = silu1(lo); y[2 * j + 1] = silu1(hi); ss += y[2 * j] * y[2 * j] + y[2 * j + 1] * y[2 * j + 1]; }
            float sc = 1.f;
            if (seg < 2) { ss += __shfl_xor(ss, 1); ss += __shfl_xor(ss, 2); ss += __shfl_xor(ss, 4); ss += __shfl_xor(ss, 8);
                sc = 1.0f / sqrtf(ss + EPS); if (seg == 0) sc *= 0.08838834764831845f; }
            v4u o; o.x = pk2(y[0] * sc, y[1] * sc); o.y = pk2(y[2] * sc, y[3] * sc); o.z = pk2(y[4] * sc, y[5] * sc); o.w = pk2(y[6] * sc, y[7] * sc);
            bf16* dst = (seg == 0 ? GQ : seg == 1 ? GK : GV) + (size_t)row * 512 + c8;
            *(GAS v4u*)dst = o;
        }
        if (F.lane < 8) {
            const int dir = F.lane >> 2, h = F.lane & 3; const float* zs = ZS + (size_t)row * 32 + 16;
            const float beta = sigm1(zs[dir * 4 + h]);
            const float g = -__expf(F.in[I_GDALOG][l * 8 + dir * 4 + h]) * softplus1(zs[(2 + dir) * 4 + h] + F.in[I_GDDTB][l * 8 + dir * 4 + h]);
            GG[((size_t)dir * MT + row) * 4 + h] = g; GB[((size_t)dir * MT + row) * 4 + h] = beta;
        }
    }
}
__device__ __forceinline__ void phase_gd1(Frame& F) {
    const bf16* GQ = (const bf16*)(F.ws + WS_MIX + MX_GQ); const bf16* GK = (const bf16*)(F.ws + WS_MIX + MX_GK); const bf16* GV = (const bf16*)(F.ws + WS_MIX + MX_GV);
    const float* GG = (const float*)(F.ws + WS_MIX + MX_GG); const float* GB = (const float*)(F.ws + WS_MIX + MX_GB);
    unsigned char* G1 = F.ws + WS_MIX + MX_GD1; float* GE = (float*)(F.ws + WS_MIX + MX_GE);
    LAS unsigned char* kl = F.lds + RING_OFF; LAS unsigned char* ql = kl + 17408; LAS unsigned char* vl = ql + 17408;
    LAS float* Mf = (LAS float*)(F.lds + RING_OFF + 52224);
    LAS unsigned char* Tl = F.lds + RING_OFF + 69632;
    LAS unsigned char* vsT = F.lds + RING_OFF + 78848; LAS unsigned char* ksT = F.lds + RING_OFF + 97280;
    LAS float* gc = (LAS float*)(F.lds + RING_OFF + 115712); LAS float* bt = gc + 64;
    const int tid = F.tid, lane = F.lane, g4 = lane >> 4, l15 = lane & 15;
    for (int it = blockIdx.x; it < 64 * 36; it += F.G) {
        const int chain = it / 36, k = it % 36; int seqbase, T, n, h, dir; gd_slot(chain, k, seqbase, T, n, h, dir);
        unsigned char* out = G1 + (size_t)it * GD1_ITEM;
        bf16* WN = (bf16*)out; bf16* QD = (bf16*)(out + 16384); bf16* KT = (bf16*)(out + 32768); bf16* UT = (bf16*)(out + 49152); bf16* QKM = (bf16*)(out + 65536);
        const int sp = tid >> 3, sc0 = (tid & 7) * 16;
        { const int tok = dir ? T - 1 - (64 * n + sp) : 64 * n + sp; const size_t off = (size_t)(seqbase + tok) * 512 + h * 128 + sc0;
          *(LAS v4u*)(kl + sp * 272 + sc0 * 2) = *(const GAS v4u*)(GK + off); *(LAS v4u*)(kl + sp * 272 + sc0 * 2 + 16) = *(const GAS v4u*)(GK + off + 8);
          *(LAS v4u*)(ql + sp * 272 + sc0 * 2) = *(const GAS v4u*)(GQ + off); *(LAS v4u*)(ql + sp * 272 + sc0 * 2 + 16) = *(const GAS v4u*)(GQ + off + 8);
          *(LAS v4u*)(vl + sp * 272 + sc0 * 2) = *(const GAS v4u*)(GV + off); *(LAS v4u*)(vl + sp * 272 + sc0 * 2 + 16) = *(const GAS v4u*)(GV + off + 8); }
        if (tid < 64) { const int tok = dir ? T - 1 - (64 * n + tid) : 64 * n + tid; const size_t gi = ((size_t)dir * MT + seqbase + tok) * 4 + h;
            gc[tid] = wscan_sum_f(GG[gi], lane); bt[tid] = GB[gi]; }
        __syncthreads();
        const float gcend = gc[63];
        { const float bj = bt[sp], bk = bj * __expf(gc[sp]);
#pragma unroll
          for (int hh = 0; hh < 2; ++hh) { const v4u vv = *(const LAS v4u*)(vl + sp * 272 + sc0 * 2 + 16 * hh), kk = *(const LAS v4u*)(kl + sp * 272 + sc0 * 2 + 16 * hh);
              const unsigned vw[4] = {vv.x, vv.y, vv.z, vv.w}, kw[4] = {kk.x, kk.y, kk.z, kk.w};
#pragma unroll
              for (int c = 0; c < 4; ++c) { const int col = sc0 + 8 * hh + 2 * c;
                  *(LAS bf16*)(vsT + col * 144 + sp * 2) = f2bf1(bflo(vw[c]) * bj); *(LAS bf16*)(vsT + (col + 1) * 144 + sp * 2) = f2bf1(bfhi(vw[c]) * bj);
                  *(LAS bf16*)(ksT + col * 144 + sp * 2) = f2bf1(bflo(kw[c]) * bk); *(LAS bf16*)(ksT + (col + 1) * 144 + sp * 2) = f2bf1(bfhi(kw[c]) * bk); } } }
        if (F.wave < 4) {
            const int i0 = 16 * F.wave; f32x4 acc[4];
#pragma unroll
            for (int ni = 0; ni < 4; ++ni) acc[ni] = (f32x4){0.f, 0.f, 0.f, 0.f};
#pragma unroll
            for (int ks = 0; ks < 4; ++ks) { const bf16x8 a = lds_frag(kl, 272, i0, ks * 64, lane);
#pragma unroll
                for (int ni = 0; ni < 4; ++ni) acc[ni] = MFMA16(a, lds_frag(kl, 272, 16 * ni, ks * 64, lane), acc[ni]); }
#pragma unroll
            for (int ni = 0; ni < 4; ++ni)
#pragma unroll
                for (int rr = 0; rr < 4; ++rr) { const int i = i0 + 4 * g4 + rr, j = 16 * ni + l15;
                    Mf[i * 65 + j] = (j < i) ? bt[i] * acc[ni][rr] * __expf(gc[i] - gc[j]) : 0.f; }
        } else {
            const int j0 = 16 * (F.wave - 4); f32x4 acc[4];
#pragma unroll
            for (int ni = 0; ni < 4; ++ni) acc[ni] = (f32x4){0.f, 0.f, 0.f, 0.f};
#pragma unroll
            for (int ks = 0; ks < 4; ++ks) { const bf16x8 a = lds_frag(kl, 272, j0, ks * 64, lane);
#pragma unroll
                for (int ni = 0; ni < 4; ++ni) acc[ni] = MFMA16(a, lds_frag(ql, 272, 16 * ni, ks * 64, lane), acc[ni]); }
            const int jt = F.wave - 4;
#pragma unroll
            for (int ni = 0; ni < 4; ++ni) { const int i = 16 * ni + l15; float v[4];
#pragma unroll
                for (int rr = 0; rr < 4; ++rr) { const int j = j0 + 4 * g4 + rr; v[rr] = (j <= i) ? acc[ni][rr] * __expf(gc[i] - gc[j]) : 0.f; }
                v2u o; o.x = pk2(v[0], v[1]); o.y = pk2(v[2], v[3]);
                *(GAS v2u*)(QKM + i * 64 + 32 * (jt >> 1) + 8 * g4 + 4 * (jt & 1)) = o; }
        }
        { const int d = tid & 127, lq = tid >> 7; float v[16];
#pragma unroll
          for (int ll = 0; ll < 16; ++ll) { const int lp = 16 * lq + ll; v[ll] = bf1(((const LAS bf16*)(kl + lp * 272))[d]) * __expf(gcend - gc[lp]); }
#pragma unroll
          for (int g = 0; g < 4; ++g) { v2u o; o.x = pk2(v[4 * g], v[4 * g + 1]); o.y = pk2(v[4 * g + 2], v[4 * g + 3]);
              *(GAS v2u*)(KT + d * 64 + 32 * (lq >> 1) + 8 * g + 4 * (lq & 1)) = o; } }
        { const int lq = tid & 63, db = tid >> 6; const float e = __expf(gc[lq]); const LAS bf16* qr = (const LAS bf16*)(ql + lq * 272) + 16 * db; float v[16];
#pragma unroll
          for (int dd = 0; dd < 16; ++dd) v[dd] = bf1(qr[dd]) * e;
#pragma unroll
          for (int g = 0; g < 4; ++g) { v2u o; o.x = pk2(v[4 * g], v[4 * g + 1]); o.y = pk2(v[4 * g + 2], v[4 * g + 3]);
              *(GAS v2u*)(QD + lq * 128 + 32 * (db >> 1) + 8 * g + 4 * (db & 1)) = o; } }
        if (tid == 0) GE[it * 32] = __expf(gcend);
        __syncthreads();
        { const int cb = 8 * F.wave; float res[8];
#pragma unroll
          for (int cc = 0; cc < 8; ++cc) res[cc] = (lane == cb + cc) ? 1.0f : 0.0f;
          for (int j = cb; j < 63; ++j) { const float mj = Mf[lane * 65 + j];
#pragma unroll
              for (int cc = 0; cc < 8; ++cc) { const float xj = __builtin_bit_cast(float, __builtin_amdgcn_readlane(__builtin_bit_cast(int, res[cc]), j)); res[cc] -= mj * xj; } }
          v4u o; o.x = pk2(res[0], res[1]); o.y = pk2(res[2], res[3]); o.z = pk2(res[4], res[5]); o.w = pk2(res[6], res[7]);
          *(LAS v4u*)(Tl + lane * 144 + cb * 2) = o; }
        __syncthreads();
        if (F.wave < 4) {
            f32x4 acc[8];
#pragma unroll
            for (int ni = 0; ni < 8; ++ni) acc[ni] = (f32x4){0.f, 0.f, 0.f, 0.f};
#pragma unroll
            for (int ks = 0; ks < 2; ++ks) { const bf16x8 a = lds_frag(Tl, 144, 16 * F.wave, ks * 64, lane);
#pragma unroll
                for (int ni = 0; ni < 8; ++ni) acc[ni] = MFMA16(a, lds_frag(vsT, 144, 16 * ni, ks * 64, lane), acc[ni]); }
#pragma unroll
            for (int ni = 0; ni < 8; ++ni) { v2u o; o.x = pk2(acc[ni][0], acc[ni][1]); o.y = pk2(acc[ni][2], acc[ni][3]);
                *(GAS v2u*)(UT + (16 * ni + l15) * 64 + 16 * F.wave + 4 * g4) = o; }
        } else {
            const int it4 = F.wave - 4; f32x4 acc[8];
#pragma unroll
            for (int mi = 0; mi < 8; ++mi) acc[mi] = (f32x4){0.f, 0.f, 0.f, 0.f};
#pragma unroll
            for (int ks = 0; ks < 2; ++ks) { const bf16x8 bfr = lds_frag(Tl, 144, 16 * it4, ks * 64, lane);
#pragma unroll
                for (int mi = 0; mi < 8; ++mi) acc[mi] = MFMA16(lds_frag(ksT, 144, 16 * mi, ks * 64, lane), bfr, acc[mi]); }
#pragma unroll
            for (int mi = 0; mi < 8; ++mi) { v2u o; o.x = pk2(-acc[mi][0], -acc[mi][1]); o.y = pk2(-acc[mi][2], -acc[mi][3]);
                *(GAS v2u*)(WN + (16 * it4 + l15) * 128 + 32 * (mi >> 1) + 8 * g4 + 4 * (mi & 1)) = o; }
        }
        __syncthreads();
    }
}
constexpr int GD2_BUF = 62464;
__device__ __forceinline__ void gd2_load(const unsigned char* src, v4u (&r)[7], int tid) {
#pragma unroll
    for (int j = 0; j < 7; ++j) r[j] = *(const GAS v4u*)(src + (size_t)(tid + 512 * j) * 16);
}
__device__ __forceinline__ void gd2_store(LAS unsigned char* buf, const v4u (&r)[7], int tid) {
#pragma unroll
    for (int j = 0; j < 7; ++j) { const int pc = tid + 512 * j;
        int off;
        if (pc < 1024) off = (pc >> 4) * 272 + (pc & 15) * 16;
        else if (pc < 2048) off = 17408 + ((pc - 1024) >> 4) * 272 + (pc & 15) * 16;
        else if (pc < 3072) off = 44032 + ((pc - 2048) >> 3) * 144 + (pc & 7) * 16;
        else off = 34816 + ((pc - 3072) >> 3) * 144 + (pc & 7) * 16;
        *(LAS v4u*)(buf + off) = r[j]; }
}
__device__ __forceinline__ void phase_gd2(Frame& F, bool last) {
    const unsigned char* G1 = F.ws + WS_MIX + MX_GD1; const float* GE = (const float*)(F.ws + WS_MIX + MX_GE);
    float* GO = (float*)(F.ws + WS_H);
    const int tid = F.tid, lane = F.lane, g4 = lane >> 4, l15 = lane & 15, e0 = 16 * F.wave;
    for (int chain = blockIdx.x; chain < 64; chain += F.G) {
        const int h = (chain >> 1) & 3, dir = chain & 1, b = chain >> 3;
        f32x4 S[8];
#pragma unroll
        for (int db = 0; db < 8; ++db) S[db] = (f32x4){0.f, 0.f, 0.f, 0.f};
        v4u r[7];
        { const unsigned char* it0 = G1 + (size_t)(chain * 36) * GD1_ITEM;
#pragma unroll
          for (int j = 0; j < 7; ++j) { const int pc = tid + 512 * j; const int gp = pc < 3072 ? pc : pc + 1024; r[j] = *(const GAS v4u*)(it0 + (size_t)gp * 16); } }
        gd2_store(F.lds + RING_OFF, r, tid);
        v2u un[4]; float gn;
        { const unsigned char* it0 = G1 + (size_t)(chain * 36) * GD1_ITEM; const bf16* UT0 = (const bf16*)(it0 + 49152);
#pragma unroll
          for (int lb = 0; lb < 4; ++lb) un[lb] = *(const GAS v2u*)(UT0 + (e0 + l15) * 64 + 16 * lb + 4 * g4);
          gn = GE[(chain * 36) * 32]; }
        __syncthreads();
        for (int k = 0; k < 36; ++k) {
            LAS unsigned char* buf = F.lds + RING_OFF + (k & 1) * GD2_BUF;
            const unsigned char* item = G1 + (size_t)(chain * 36 + k) * GD1_ITEM;
            if (k + 1 < 36) { const unsigned char* nx = item + GD1_ITEM;
#pragma unroll
                for (int j = 0; j < 7; ++j) { const int pc = tid + 512 * j; const int gp = pc < 3072 ? pc : pc + 1024; r[j] = *(const GAS v4u*)(nx + (size_t)gp * 16); } }
            v2u uc[4];
#pragma unroll
            for (int lb = 0; lb < 4; ++lb) uc[lb] = un[lb];
            const float gend = gn;
            if (k + 1 < 36) { const bf16* UTn = (const bf16*)(item + GD1_ITEM + 49152);
#pragma unroll
                for (int lb = 0; lb < 4; ++lb) un[lb] = *(const GAS v2u*)(UTn + (e0 + l15) * 64 + 16 * lb + 4 * g4);
                gn = GE[(chain * 36 + k + 1) * 32]; }
            int seqbase, T, n; if (k < 4) { seqbase = ML + b * CTXL; T = CTXL; n = k; } else { seqbase = b * SEQ; T = SEQ; n = k - 4; }
            bf16x8 Sb[4];
#pragma unroll
            for (int ks = 0; ks < 4; ++ks) { v4u w; w.x = pk2(S[2 * ks][0], S[2 * ks][1]); w.y = pk2(S[2 * ks][2], S[2 * ks][3]); w.z = pk2(S[2 * ks + 1][0], S[2 * ks + 1][1]); w.w = pk2(S[2 * ks + 1][2], S[2 * ks + 1][3]);
                Sb[ks] = __builtin_bit_cast(bf16x8, w); }
            f32x4 vn[4];
#pragma unroll
            for (int lb = 0; lb < 4; ++lb) { const v2u uu = uc[lb];
                f32x4 acc = (f32x4){bflo(uu.x), bfhi(uu.x), bflo(uu.y), bfhi(uu.y)};
#pragma unroll
                for (int ks = 0; ks < 4; ++ks) acc = MFMA16(lds_frag(buf, 272, 16 * lb, ks * 64, lane), Sb[ks], acc);
                vn[lb] = acc; }
            bf16x8 Vb[2];
#pragma unroll
            for (int ks = 0; ks < 2; ++ks) { v4u w; w.x = pk2(vn[2 * ks][0], vn[2 * ks][1]); w.y = pk2(vn[2 * ks][2], vn[2 * ks][3]); w.z = pk2(vn[2 * ks + 1][0], vn[2 * ks + 1][1]); w.w = pk2(vn[2 * ks + 1][2], vn[2 * ks + 1][3]);
                Vb[ks] = __builtin_bit_cast(bf16x8, w); }
            const bool wr_o = !(last && k < 4);
#pragma unroll
            for (int lb = 0; lb < 4; ++lb) { f32x4 acc = (f32x4){0.f, 0.f, 0.f, 0.f};
#pragma unroll
                for (int ks = 0; ks < 4; ++ks) acc = MFMA16(lds_frag(buf + 17408, 272, 16 * lb, ks * 64, lane), Sb[ks], acc);
#pragma unroll
                for (int ks = 0; ks < 2; ++ks) acc = MFMA16(lds_frag(buf + 34816, 144, 16 * lb, ks * 64, lane), Vb[ks], acc);
                if (wr_o) {
#pragma unroll
                    for (int rr = 0; rr < 4; ++rr) { const int p = 16 * lb + 4 * g4 + rr; const int tok = dir ? T - 1 - (64 * n + p) : 64 * n + p;
                        GO[((size_t)dir * MT + seqbase + tok) * 512 + h * 128 + e0 + l15] = acc[rr]; } } }
#pragma unroll
            for (int db = 0; db < 8; ++db) { f32x4 acc = S[db] * gend;
#pragma unroll
                for (int ks = 0; ks < 2; ++ks) acc = MFMA16(lds_frag(buf + 44032, 144, 16 * db, ks * 64, lane), Vb[ks], acc);
                S[db] = acc; }
            if (k + 1 < 36) gd2_store(F.lds + RING_OFF + ((k + 1) & 1) * GD2_BUF, r, tid);
            __syncthreads();
        }
    }
}
__device__ __forceinline__ void phase_gd3(Frame& F, int l, bool last) {
    const float* GO = (const float*)(F.ws + WS_H); const bf16* Z = (const bf16*)(F.ws + WS_Z); bf16* Y2 = (bf16*)(F.ws + WS_Y) + (size_t)2 * MT * 512;
    const int gw = blockIdx.x * NWAVES + F.wave, NGW = F.G * NWAVES, c8 = F.lane * 8; const int nrows = last ? ML : MT;
    const float* gn = F.in[I_GDN] + l * 128 + (c8 & 127);
    for (int row = gw; row < nrows; row += NGW) {
        const f32x4 a0 = *(const f32x4*)(GO + (size_t)row * 512 + c8), a1 = *(const f32x4*)(GO + (size_t)row * 512 + c8 + 4);
        const f32x4 b0 = *(const f32x4*)(GO + ((size_t)MT + row) * 512 + c8), b1 = *(const f32x4*)(GO + ((size_t)MT + row) * 512 + c8 + 4);
        const f32x4 s0 = a0 + b0, s1 = a1 + b1;
        float ss = (s0.x * s0.x + s0.y * s0.y) + (s0.z * s0.z + s0.w * s0.w) + (s1.x * s1.x + s1.y * s1.y) + (s1.z * s1.z + s1.w * s1.w);
        ss += __shfl_xor(ss, 1); ss += __shfl_xor(ss, 2); ss += __shfl_xor(ss, 4); ss += __shfl_xor(ss, 8);
        const float rs = 1.0f / sqrtf(ss * (1.0f / 128.0f) + EPS);
        const v4u zz = *(const GAS v4u*)(Z + (size_t)row * NZ + ZC_GDZ + c8);
        const float o[8] = {s0.x, s0.y, s0.z, s0.w, s1.x, s1.y, s1.z, s1.w}; const float zf[8] = {bflo(zz.x), bfhi(zz.x), bflo(zz.y), bfhi(zz.y), bflo(zz.z), bfhi(zz.z), bflo(zz.w), bfhi(zz.w)};
        float y[8];
#pragma unroll
        for (int j = 0; j < 8; ++j) y[j] = o[j] * rs * gn[j] * silu1(zf[j]);
        v4u w; w.x = pk2(y[0], y[1]); w.y = pk2(y[2], y[3]); w.z = pk2(y[4], y[5]); w.w = pk2(y[6], y[7]);
        *(GAS v4u*)(Y2 + (size_t)row * 512 + c8) = w;
    }
}
#ifndef DUPC
#define DUPC 0
#endif
constexpr int CW_Q = 2048;
__device__ __forceinline__ int q_pull(Frame& F, int qi) {
    volatile LAS unsigned* slot = F.MISC + 16;
    __syncthreads();
    if (F.tid == 0) *slot = __hip_atomic_fetch_add((unsigned*)(F.ctl + CW_Q + 64 * qi), 1u, __ATOMIC_RELAXED, __HIP_MEMORY_SCOPE_AGENT);
    __syncthreads();
    return (int)*slot;
}
__device__ __forceinline__ void phase_mixc(Frame& F, int l, bool last, int qo = 0) {
    for (int rep = 0; rep < ((DUPC & 4) ? 2 : 1); ++rep) if ((int)blockIdx.x < 64 || F.G < 128) phase_gd2(F, last);
    const int n_att = last ? 256 : 288, n_ml3 = last ? 512 : 576;
    for (int rep = 0; rep < ((DUPC & 1) ? 2 : 1); ++rep) for (;;) { const int idx = q_pull(F, 2 * l + 8 * rep); if (idx >= n_att) break; attn_item(F, idx); }
    for (int rep = 0; rep < ((DUPC & 2) ? 2 : 1); ++rep) for (;;) { const int idx = q_pull(F, 2 * l + 1 + 8 * rep); if (idx >= n_ml3) break; ml3_item(F, l, idx); }
}
#ifndef DUPA
#define DUPA 0
#endif
#define MIX_PHASE_1 for (int rep = 0; rep < ((DUPA & 1) ? 2 : 1); ++rep) phase_attn_prep(F, l, last); for (int rep = 0; rep < ((DUPA & 2) ? 2 : 1); ++rep) { __syncthreads(); phase_spatial(F, l, last); } \
    for (int rep = 0; rep < ((DUPA & 4) ? 2 : 1); ++rep) phase_gd0(F, l, last); for (int rep = 0; rep < ((DUPA & 8) ? 2 : 1); ++rep) { __syncthreads(); phase_ml1(F, l); }
#define MIX_PHASE_2 for (int rep = 0; rep < ((DUPA & 16) ? 2 : 1); ++rep) { __syncthreads(); phase_gd1(F); } for (int rep = 0; rep < ((DUPA & 32) ? 2 : 1); ++rep) phase_ml2(F, 0);
#define MIX_PHASE_3 phase_mixc(F, l, last);
#define MIX_PHASE_4 phase_gd3(F, l, last);
#ifndef PROBE
#define PROBE 0
#endif
#ifndef DUPMIX
#define DUPMIX 0
#endif
#ifndef DUPG
#define DUPG 0
#endif
#ifdef DUPAUX
#define DUP_AUX(x) x
#else
#define DUP_AUX(x)
#endif
#ifndef TPROBE
#define TPROBE 0
#endif
constexpr int PH_PER_LAYER = 15, N_PHASES = PROBE ? (1 + PH_PER_LAYER + 1) : (1 + NLAYER * PH_PER_LAYER + (TPROBE ? 1 : 0));
#ifndef PHMASK
#define PHMASK 0xffff
#endif
#define PHEN(k) ((PHMASK >> (k)) & 1)
#define IN(p) (lo <= (p) && (p) < hi)
#ifndef TPROBE
#define TPROBE 0
#endif
#if TPROBE
#define SEAM(p) do { if (lo <= (p) && (p) + 1 < hi) { xcd_barrier(bar); if (blockIdx.x == 0 && F.tid == 0) ((unsigned long long*)(F.ws + WS_CTL + 524288))[(p) + 1] = wall_clock64(); } } while (0)
#else
#ifdef DUPBAR
#define SEAM(p) do { if (lo <= (p) && (p) + 1 < hi) { xcd_barrier(bar); xcd_barrier(bar); } } while (0)
#else
#define SEAM(p) do { if (lo <= (p) && (p) + 1 < hi) xcd_barrier(bar); } while (0)
#endif
#endif
struct Args { const float* in[27]; float* out; unsigned char* ws; int ph_lo, ph_hi, li, pad; };
template <int l> __device__ __forceinline__ void layer_body(Frame& F, const XcdBarrier& bar, const int lo, const int hi) {
    float* MOD = (float*)(F.ws + WS_MOD);
    float* XC = (float*)(F.ws + WS_XC);
    bf16* Hb = (bf16*)(F.ws + WS_H); bf16* Zb = (bf16*)(F.ws + WS_Z); bf16* ACT = (bf16*)(F.ws + WS_Z); float* ZS = (float*)(F.ws + WS_ZS);
    bf16* WFI = (bf16*)(F.ws + WS_WFI); bf16* WFO = (bf16*)(F.ws + WS_WFO); bf16* WZ = (bf16*)(F.ws + WS_WZ); bf16* WB = (bf16*)(F.ws + WS_WB); bf16* WO = (bf16*)(F.ws + WS_WO);
    bf16* Yb = (bf16*)(F.ws + WS_Y); float* PB = (float*)(F.ws + WS_MIX);
    const int vc = (F.G % 8 == 0) ? ((int)blockIdx.x % 8) * (F.G / 8) + (int)blockIdx.x / 8 : (int)blockIdx.x;
        constexpr int P = 1 + l * PH_PER_LAYER;
        constexpr bool last = (l == NLAYER - 1);
        const float* modl = MOD + (size_t)l * 9 * MODW;
        const float* xin_l = (l == 0) ? F.in[I_X] : F.out;
        const float* xin_c = (l == 0) ? F.in[I_CTX] : XC;
        constexpr int nPM = last ? 64 : 72;

        if (PHEN(0) && IN(P + 0)) { if (l == 0) { phase_mod(F); phase_rope(F); __syncthreads(); } conv_set(F, l, 0, nullptr); if (l == 0) conv_set(F, l, 2, nullptr); }
        SEAM(P + 0);
        if (PHEN(1) && IN(P + 1)) phase_norm<(l == 0), (l > 0), false>(F, xin_l, xin_c, F.in[I_F1N] + (size_t)l * D, modl + 0 * D, MT);
        SEAM(P + 1);
        if (PHEN(2) && IN(P + 2)) {
            pg8::Gemm g{Hb, WFI, MT, 2 * DFF, D}; pg8::TileOrder S; S.init(72, 44, 0, 0, 0, F.G, (int)blockIdx.x, 32);
            pg8::EpiSwiglu E{ACT, DFF};
            pg8::gemm_phase<pg8::EpiSwiglu, pg8::TileOrder, PG8_ALIGN, PG8_SP2>(F.lds + RING_OFF, g, S, E);
            if (DUPG & 2) { __syncthreads(); pg8::gemm_phase<pg8::EpiSwiglu, pg8::TileOrder, PG8_ALIGN, PG8_SP2>(F.lds + RING_OFF, g, S, E); }
        }
        SEAM(P + 2);
        if (PHEN(3) && IN(P + 3)) {
            pg8::Gemm g{ACT, WFO, MT, D, DFF};
            { pg8::TileOrder S; S.init(64, 8, 0, 0, 0, F.G, (int)blockIdx.x, DFF / 64); pg8::EpiRes<false> E{F.out, XC, modl + 2 * D, 0.5f};
              pg8::gemm_phase<pg8::EpiRes<false>, pg8::TileOrder, PG8_ALIGN, PG8_SP2>(F.lds + RING_OFF, g, S, E); }
            { pg8::QuarterOrder S; S.init(8, 64, DFF / 256, F.G, (int)blockIdx.x); pg8::EpiRes<true> E{nullptr, PB, modl + 2 * D, 0.5f};
              pg8::gemm_phase<pg8::EpiRes<true>, pg8::QuarterOrder, PG8_ALIGN, PG8_SP2>(F.lds + RING_OFF, g, S, E); }
        }
        SEAM(P + 3);
        if (PHEN(4) && IN(P + 4)) phase_norm<false, true, !last>(F, F.out, XC, F.in[I_MIXN] + (size_t)l * D, modl + 3 * D, MT);
        SEAM(P + 4);
        if (PHEN(5) && IN(P + 5)) {
            pg8::Gemm g{Hb, WZ, MT, NZ, D}; pg8::TileOrder S;
            if (last) S.init(64, 57, 8, NKV_TILES, 64, F.G, (int)blockIdx.x, 32); else S.init(64, 57, 8, 56, 64, F.G, (int)blockIdx.x, 32, 10);
            pg8::EpiZ E{Zb, ZS, NZ};
            pg8::gemm_phase<pg8::EpiZ, pg8::TileOrder, PG8_ALIGN, PG8_SP2>(F.lds + RING_OFF, g, S, E);
            if (DUPG & 1) { __syncthreads(); pg8::gemm_phase<pg8::EpiZ, pg8::TileOrder, PG8_ALIGN, PG8_SP2>(F.lds + RING_OFF, g, S, E); }
            if (last) conv_set(F, l, 1, (unsigned*)(F.ctl + 2048 + 64 * 14));
        }
        SEAM(P + 5);
        if (PHEN(6) && IN(P + 6)) { if (l == 0) conv_set(F, l, 1, nullptr); MIX_PHASE_1 if (DUPMIX & 1) { __syncthreads(); MIX_PHASE_1 } }
        SEAM(P + 6);
        if (PHEN(7) && IN(P + 7)) { MIX_PHASE_2 if (DUPMIX & 2) { __syncthreads(); MIX_PHASE_2 } }
        SEAM(P + 7);
        if (PHEN(8) && IN(P + 8)) { MIX_PHASE_3 }
        SEAM(P + 8);
        if (PHEN(9) && IN(P + 9)) { MIX_PHASE_4 if (DUPMIX & 8) { __syncthreads(); MIX_PHASE_4 } }
        SEAM(P + 9);
        if (PHEN(10) && IN(P + 10)) {
            pg8::Gemm g{Yb, WB, 4 * MT, 4 * D, 512}; pg8::BranchOrder S; S.init(nPM, 72, F.G, (int)blockIdx.x);
            pg8::EpiBranch E{Zb, NZ, ZC_GATE, Hb, 72};
            pg8::gemm_phase<pg8::EpiBranch, pg8::BranchOrder, PG8_ALIGN, PG8_SP2>(F.lds + RING_OFF, g, S, E);
            if (DUPG & 4) { __syncthreads(); pg8::gemm_phase<pg8::EpiBranch, pg8::BranchOrder, PG8_ALIGN, PG8_SP2>(F.lds + RING_OFF, g, S, E); }
        }
        SEAM(P + 10);
        if (PHEN(11) && IN(P + 11)) {
            pg8::Gemm g{Hb, WO, MT, D, D};
            { pg8::TileOrder S; S.init(64, 8, 0, 0, 0, F.G, (int)blockIdx.x, D / 64); pg8::EpiRes<false> E{F.out, XC, modl + 5 * D, 1.0f};
              pg8::gemm_phase<pg8::EpiRes<false>, pg8::TileOrder, PG8_ALIGN, PG8_SP2>(F.lds + RING_OFF, g, S, E); }
            if constexpr (nPM == 72) { pg8::QuarterOrder S; S.init(8, 64, D / 256, F.G, (int)blockIdx.x); pg8::EpiRes<true> E{nullptr, PB, modl + 5 * D, 1.0f};
              pg8::gemm_phase<pg8::EpiRes<true>, pg8::QuarterOrder, PG8_ALIGN, PG8_SP2>(F.lds + RING_OFF, g, S, E); }
        }
        SEAM(P + 11);
        if (PHEN(12) && IN(P + 12)) { phase_norm<false, (nPM == 72), false>(F, F.out, XC, F.in[I_F2N] + (size_t)l * D, modl + 6 * D, nPM * 256);
#ifdef DUPN
            if (nPM == 64) { phase_norm<false, false, false>(F, F.out, XC, F.in[I_F2N] + (size_t)l * D, modl + 6 * D, nPM * 256); phase_norm<false, false, false>(F, F.out, XC, F.in[I_F2N] + (size_t)l * D, modl + 6 * D, nPM * 256); }
#endif
        }
        SEAM(P + 12);
        if (PHEN(13) && IN(P + 13)) {
            pg8::Gemm g{Hb, WFI, MT, 2 * DFF, D}; pg8::TileOrder S; S.init(nPM, 44, 0, 0, 0, F.G, (int)blockIdx.x, 32);
            pg8::EpiSwiglu E{ACT, DFF};
            pg8::gemm_phase<pg8::EpiSwiglu, pg8::TileOrder, PG8_ALIGN, PG8_SP2>(F.lds + RING_OFF, g, S, E);
            if (!last) conv_set(F, l + 1, 2, (unsigned*)(F.ctl + 2048 + 64 * 15));
        }
        SEAM(P + 13);
        if (PHEN(14) && IN(P + 14)) {
            pg8::Gemm g{ACT, WFO, MT, D, DFF};
            { pg8::TileOrder S; S.init(64, 8, 0, 0, 0, F.G, (int)blockIdx.x, DFF / 64); pg8::EpiRes<false> E{F.out, XC, modl + 8 * D, 0.5f};
              pg8::gemm_phase<pg8::EpiRes<false>, pg8::TileOrder, PG8_ALIGN, PG8_SP2>(F.lds + RING_OFF, g, S, E); }
            if constexpr (nPM == 72) { pg8::QuarterOrder S; S.init(8, 64, DFF / 256, F.G, (int)blockIdx.x); pg8::EpiRes<true> E{nullptr, PB, modl + 8 * D, 0.5f};
              pg8::gemm_phase<pg8::EpiRes<true>, pg8::QuarterOrder, PG8_ALIGN, PG8_SP2>(F.lds + RING_OFF, g, S, E); }
        }
        SEAM(P + 14);
    }
__global__ void __launch_bounds__(NWAVES * 64, 2) mk_fwd(Args args) {
    extern __shared__ __attribute__((aligned(16))) unsigned char lds[];
    Frame F;
    F.lds = (LAS unsigned char*)lds;
    F.MISC = (volatile LAS unsigned*)(F.lds + MISC_OFF);
    F.tid = threadIdx.x; F.lane = F.tid & 63; F.wave = __builtin_amdgcn_readfirstlane(F.tid >> 6);
    F.G = gridDim.x;
    F.ws = args.ws; F.ctl = (gu32*)(args.ws + WS_CTL); F.out = args.out;
    F.in = args.in;
    for (int u = F.tid; u < (LDS_BYTES - LDSCTL_OFF) / 4; u += NWAVES * 64) ((LAS unsigned*)(F.lds + LDSCTL_OFF))[u] = 0u;
    __syncthreads();
    const int lo = args.ph_lo, hi = args.ph_hi;
#if TPROBE
    if (blockIdx.x == 0 && F.tid == 0) ((unsigned long long*)(F.ws + WS_CTL + 524288))[0] = wall_clock64();
#endif
    XcdBarrier bar; bar.bar = (unsigned*)(F.ctl + CW_BAR) + args.li * XCD_BAR_WORDS; bar.x = 0; bar.st = nullptr;
    if (hi - lo > 1) bar = xcd_barrier_post((unsigned*)(F.ctl + CW_BAR) + args.li * XCD_BAR_WORDS, F.MISC + 8);


    layer_body<0>(F, bar, lo, hi);
#if !PROBE
    layer_body<1>(F, bar, lo, hi);
#endif
#if TPROBE
    if (IN(31)) {
        const unsigned long long* TS = (const unsigned long long*)(F.ws + WS_CTL + 524288);
        const float tot = (float)(TS[31] - TS[0]);
        const float fa = (float)(TS[TP_A2] - TS[TP_A1]) / tot, fb = (float)(TS[TP_B2] - TS[TP_B1]) / tot;
        const size_t n = (size_t)ML * D; float* o = F.out;
        for (size_t i = (size_t)blockIdx.x * 512 + F.tid; i < n; i += (size_t)F.G * 512) { float v = o[i] * (1.0f + fa); if (i == 0) v += 10000.0f * fb; o[i] = v; }
    }
#endif
#if PROBE
    if (IN(16)) {
        const size_t n = (size_t)ML * D; float* o = F.out;
        for (size_t i = (size_t)blockIdx.x * 512 + F.tid; i < n; i += (size_t)F.G * 512) { const size_t r = i / D, c = i % D;
#if PROBE == 1
            o[i] = bf1(((const bf16*)(F.ws + WS_Y))[(size_t)MT * 512 + r * 512 + (c & 511)]);
#elif PROBE == 2
            o[i] = bf1(((const bf16*)(F.ws + WS_MIX + MX_CP))[(i % ((size_t)1152 * 16384))]);
#elif PROBE == 3
            o[i] = bf1(((const bf16*)(F.ws + WS_MIX + MX_CL))[(i % ((size_t)1152 * 16384))]);
#elif PROBE == 4
            o[i] = ((const float*)(F.ws + WS_ZS))[(i % ((size_t)ML * 32))];
#endif
        }
    }
#endif
#undef IN
#undef SEAM
}

#ifndef MK_N_LAUNCHES
#define MK_N_LAUNCHES 1
#endif
extern "C" void kernel_launch(void* const* d_in, const int* in_sizes, int n_in, void* d_out, int out_size, void* d_ws, size_t ws_size, hipStream_t stream) {
    static int grid = 0;
    if (grid == 0) {
        if (n_in != 27 || in_sizes[0] != ML * D || out_size != ML * D || ws_size < WS_END) { fprintf(stderr, "kernel_launch: shape mismatch n_in %d in0 %d out %d ws %zu (need %zu)\n", n_in, n_in > 0 ? in_sizes[0] : -1, out_size, ws_size, (size_t)WS_END); grid = -1; return; }
        int dev = 0, cus = 0, per_cu = 0;
        if (hipGetDevice(&dev) != hipSuccess || hipDeviceGetAttribute(&cus, hipDeviceAttributeMultiprocessorCount, dev) != hipSuccess) { grid = -1; return; }
        if (hipFuncSetAttribute((const void*)mk_fwd, hipFuncAttributeMaxDynamicSharedMemorySize, LDS_BYTES) != hipSuccess) { fprintf(stderr, "kernel_launch: hipFuncSetAttribute failed\n"); grid = -1; return; }
        if (hipOccupancyMaxActiveBlocksPerMultiprocessor(&per_cu, (const void*)mk_fwd, NWAVES * 64, LDS_BYTES) != hipSuccess || per_cu < 1)
            fprintf(stderr, "kernel_launch: note: occupancy query reports %d workgroups per CU\n", per_cu);
        (void)hipGetLastError();
        grid = cus;
    }
    if (grid < 0) return;
    if (hipMemsetAsync((char*)d_ws + WS_CTL, 0, CTL_ZERO_BYTES, stream) != hipSuccess) return;
    Args a{};
    for (int i = 0; i < 27; ++i) a.in[i] = (const float*)d_in[i];
    a.out = (float*)d_out; a.ws = (unsigned char*)d_ws; a.pad = 0;
#if MK_N_LAUNCHES == 1
    a.ph_lo = 0; a.ph_hi = N_PHASES; a.li = 0;
    hipLaunchKernelGGL(mk_fwd, dim3(grid), dim3(NWAVES * 64), LDS_BYTES, stream, a);
#else
    for (int p = 0; p < N_PHASES; ++p) { a.ph_lo = p; a.ph_hi = p + 1; a.li = 0;
        hipLaunchKernelGGL(mk_fwd, dim3(grid), dim3(NWAVES * 64), LDS_BYTES, stream, a); }
#endif
    const hipError_t le = hipPeekAtLastError();
    if (le != hipSuccess) fprintf(stderr, "kernel_launch: launch failed: %s\n", hipGetErrorName(le));
}
```

```cpp
#include <hip/hip_runtime.h>
#include <cstdio>
#include <cstdint>
namespace pg8 {
#define PG8_LAS __attribute__((address_space(3)))
typedef unsigned short bf16_t;
typedef short bf16x8 __attribute__((ext_vector_type(8)));
typedef float f32x4 __attribute__((ext_vector_type(4)));
typedef unsigned u32x4 __attribute__((ext_vector_type(4)));
constexpr int BM = 256, BK = 64, HALF = 128, HTB = HALF * BK * 2  , STAGE_BYTES = 8 * HTB, NXCD = 8, WGM = 8;

__host__ __device__ __forceinline__ int lds_byte(int r, int c) { const int st = (r >> 4) * 2 + (c >> 5), rr = r & 15, cc = c & 31, ob = rr * 64 + cc * 2; return st * 1024 + (ob ^ (((ob >> 9) & 1) << 5)); }
__host__ __device__ __forceinline__ void stage_rc(int b, int& R, int& C) { const int st = b / 1024, sb = b % 1024, swz = sb ^ (((sb >> 9) & 1) << 5); R = (st >> 1) * 16 + swz / 64; C = (st & 1) * 32 + (swz % 64) / 2; }
__host__ __device__ __forceinline__ int perm32(int rho) { const int n = rho >> 4, i = rho & 15; return 8 * (i >> 2) + 4 * n + (i & 3); }

__host__ __device__ __forceinline__ int perm32_inv(int x) { return 16 * ((x >> 2) & 1) + 4 * (x >> 3) + (x & 3); }
__host__ __device__ __forceinline__ size_t sw_off(int row, int k, int K, bool perm) {
    const int tile = row >> 8, h = (row >> 7) & 1, Rp = row & 127, R = perm ? ((Rp & ~31) + perm32_inv(Rp & 31)) : Rp;
    return ((size_t)(tile * 2 + h) * (K >> 6) + (k >> 6)) * 8192 + (size_t)(lds_byte(R, k & 63) >> 1);
}
struct Unit { int pm, pn, k0, nt; };
struct Gemm { const bf16_t* A; const bf16_t* Bt; int M, N, K; int swb = 0; };

struct StaticOrder {
    int nM, nN, nwg, G, c;
    __host__ __device__ void init(int M, int N, int G_, int c_) { nM = M / BM; nN = N / BM; nwg = nM * nN; G = G_; c = c_; }
    __host__ __device__ bool next(int i, Unit& u) const {
        const long L = (long)i * G + c; if (L >= nwg) return false;
        int wgid = (int)L; { const int q = nwg / NXCD, r = nwg % NXCD, xcd = wgid % NXCD, off = wgid / NXCD; wgid = (xcd < r ? xcd * (q + 1) : r * (q + 1) + (xcd - r) * q) + off; }
        const int nig = WGM * nN, gid = wgid / nig, fm = gid * WGM, gsz = (nM - fm) < WGM ? (nM - fm) : WGM;
        u.pm = fm + ((wgid % nig) % gsz); u.pn = (wgid % nig) / gsz; u.k0 = 0; u.nt = 0; return true;
    }
    __device__ __forceinline__ void a_ready(const Unit&) const {}
    __device__ __forceinline__ void done(const Unit&) const {}
};

typedef float f32x2c_t __attribute__((ext_vector_type(2)));
typedef __bf16 bf16x2c_t __attribute__((ext_vector_type(2)));
__device__ __forceinline__ unsigned cvt_pk_bf16(float lo, float hi) { const f32x2c_t v = {lo, hi}; const bf16x2c_t b = __builtin_convertvector(v, bf16x2c_t); return __builtin_bit_cast(unsigned, b); }
typedef float f32x2 __attribute__((ext_vector_type(2)));
__device__ __forceinline__ void tile_map(int nM, int nN, int wgid, int& pm, int& pn) {
    const int nwg = nM * nN;
    { const int q = nwg / NXCD, r = nwg % NXCD, xcd = wgid % NXCD, off = wgid / NXCD; wgid = (xcd < r ? xcd * (q + 1) : r * (q + 1) + (xcd - r) * q) + off; }
    const int nig = WGM * nN, gid = wgid / nig, fm = gid * WGM, gsz = (nM - fm) < WGM ? (nM - fm) : WGM;
    pm = fm + ((wgid % nig) % gsz); pn = (wgid % nig) / gsz;
}
struct TileOrder {
    int nM0, nN0, n0, nM1, nN1, n1, pm1, G, c, ntK, skip1;
    __device__ __forceinline__ void init(int nM0_, int nN0_, int nM1_, int nN1_, int pm1_, int G_, int c_, int ntK_, int skip1_ = -1) { skip1 = skip1_; ntK = ntK_; nM0 = nM0_; nN0 = nN0_; n0 = nM0_ * nN0_; nM1 = nM1_; nN1 = nN1_; n1 = nM1_ * nN1_; pm1 = pm1_; G = G_; c = c_; }
    __device__ __forceinline__ bool next(int i, Unit& u) const {
        long L = (long)i * G + c; u.k0 = 0; u.nt = ntK;
        if (L < n0) { tile_map(nM0, nN0, (int)L, u.pm, u.pn); return true; }
        L -= n0;
        if (L < n1) { tile_map(nM1, nN1, (int)L, u.pm, u.pn); u.pm += pm1; if (skip1 >= 0 && u.pn >= skip1) ++u.pn; return true; }
        return false;
    }
    __device__ __forceinline__ void a_ready(const Unit&) const {}
    __device__ __forceinline__ void done(const Unit&) const {}
};
struct QuarterOrder {
    int n, pm0, G, c, ntK;
    __device__ __forceinline__ void init(int nM, int pm0_, int ntq, int G_, int c_) { n = nM * 8 * 4; pm0 = pm0_; ntK = ntq; G = G_; c = c_; }
    __device__ __forceinline__ bool next(int i, Unit& u) const {
        const long L = (long)i * G + c; if (L >= n) return false;
        const int t = (int)L >> 2, qq = (int)L & 3; u.pm = pm0 + (t >> 3); u.pn = t & 7; u.k0 = qq * ntK; u.nt = ntK; return true;
    }
    __device__ __forceinline__ void a_ready(const Unit&) const {}
    __device__ __forceinline__ void done(const Unit&) const {}
};
struct BranchOrder {
    int nM, NPM, G, c; static constexpr int ntK = 8;
    __device__ __forceinline__ void init(int nM_, int NPM_, int G_, int c_) { nM = nM_; NPM = NPM_; G = G_; c = c_; }
    __device__ __forceinline__ bool next(int i, Unit& u) const {
        const long L = (long)(i >> 2) * G + c; if (L >= nM * 8) return false;
        int pm, pn; tile_map(nM, 8, (int)L, pm, pn); const int n = i & 3;
        u.pm = n * NPM + pm; u.pn = n * 8 + pn; u.k0 = 0; u.nt = 8; return true;
    }
    __device__ __forceinline__ void a_ready(const Unit&) const {}
    __device__ __forceinline__ void done(const Unit&) const {}
};

__device__ __forceinline__ float silu_f(float a) { return a * __builtin_amdgcn_rcpf(1.0f + __expf(-a)); }
__device__ __forceinline__ float sigmoid_f(float a) { return __builtin_amdgcn_rcpf(1.0f + __expf(-a)); }
struct EpiSwiglu {
    static constexpr bool PERM = true, AFTER_DRAIN = false, CHAIN = false;
    bf16_t* O; int ldc;
    __device__ __forceinline__ void operator()(const f32x4 (&acc)[2][2][4][2], const Unit& u, int wr, int wc, int fr, int fq) const {
        const int row0 = u.pm * BM + wr * 64 + fr, col0 = u.pn * HALF + wc * 32 + 8 * fq;
#pragma unroll
        for (int ai = 0; ai < 2; ++ai)
#pragma unroll
            for (int m = 0; m < 4; ++m) { bf16_t* rowp = O + (size_t)(row0 + ai * HALF + m * 16) * ldc + col0;
                const f32x4 a0 = acc[ai][0][m][0], a1 = acc[ai][0][m][1], b0 = acc[ai][1][m][0], b1 = acc[ai][1][m][1];
                f32x4 v0, v1;
#pragma unroll
                for (int j = 0; j < 4; ++j) { v0[j] = silu_f(a0[j]) * b0[j]; v1[j] = silu_f(a1[j]) * b1[j]; }
                u32x4 w; w.x = cvt_pk_bf16(v0[0], v0[1]); w.y = cvt_pk_bf16(v0[2], v0[3]); w.z = cvt_pk_bf16(v1[0], v1[1]); w.w = cvt_pk_bf16(v1[2], v1[3]);
                *(u32x4*)rowp = w; }
    }
};
template <bool ATOMIC  > struct EpiRes {
    static constexpr bool PERM = false, AFTER_DRAIN = false, CHAIN = false;
    float* out_l; float* out_c; const float* gate; float coef;
    __device__ __forceinline__ void operator()(const f32x4 (&acc)[2][2][4][2], const Unit& u, int wr, int wc, int fr, int fq) const {
        const bool isc = u.pm >= 64; const int b9 = isc ? 8 : (u.pm >> 3);
        const int prow = (isc ? (u.pm - 64) : u.pm) * BM + wr * 64 + fr, col0 = u.pn * BM + wc * 32 + 4 * fq;
        float* op = isc ? out_c : out_l;
        const float* gp = gate + (size_t)b9 * 18432 + col0;
        f32x4 gv[2][2];
#pragma unroll
        for (int bj = 0; bj < 2; ++bj)
#pragma unroll
            for (int n = 0; n < 2; ++n) gv[bj][n] = *(const f32x4*)(gp + bj * HALF + n * 16) * coef;
        if constexpr (!ATOMIC) {
#pragma unroll
            for (int ai = 0; ai < 2; ++ai)
#pragma unroll
                for (int m = 0; m < 4; ++m) { const size_t off = (size_t)(prow + ai * HALF + m * 16) * 2048 + col0;
#pragma unroll
                    for (int bj = 0; bj < 2; ++bj)
#pragma unroll
                        for (int n = 0; n < 2; ++n) { const f32x4 bs = *(const f32x4*)(op + off + bj * HALF + n * 16); *(f32x4*)(op + off + bj * HALF + n * 16) = bs + gv[bj][n] * acc[ai][bj][m][n]; }
                    asm volatile("" ::: "memory"); }
        } else {
            float* pp = op + (size_t)(u.k0 / u.nt) * ((size_t)2048 * 2048);
#pragma unroll
            for (int ai = 0; ai < 2; ++ai)
#pragma unroll
                for (int m = 0; m < 4; ++m) { const size_t off = (size_t)(prow + ai * HALF + m * 16) * 2048 + col0;
#pragma unroll
                    for (int bj = 0; bj < 2; ++bj)
#pragma unroll
                        for (int n = 0; n < 2; ++n) *(f32x4*)(pp + off + bj * HALF + n * 16) = gv[bj][n] * acc[ai][bj][m][n]; }
        }
    }
};
struct EpiZ {
    static constexpr bool PERM = true, AFTER_DRAIN = false, CHAIN = false;
    bf16_t* Z; float* ZS; int ldz; bf16_t* GT;
    __device__ __forceinline__ void operator()(const f32x4 (&acc)[2][2][4][2], const Unit& u, int wr, int wc, int fr, int fq) const {
        const int row0 = u.pm * BM + wr * 64 + fr, col0 = u.pn * BM + wc * 32 + 8 * fq;
        if (u.pn >= 25) {
            bf16_t* tb = GT + ((size_t)u.pm * 32 + (u.pn - 25)) * 65536 + (size_t)threadIdx.x * 8;
#pragma unroll
            for (int ai = 0; ai < 2; ++ai)
#pragma unroll
                for (int m = 0; m < 4; ++m)
#pragma unroll
                    for (int bj = 0; bj < 2; ++bj) { const f32x4 v0 = acc[ai][bj][m][0], v1 = acc[ai][bj][m][1];
                        u32x4 w; w.x = cvt_pk_bf16(v0[0], v0[1]); w.y = cvt_pk_bf16(v0[2], v0[3]); w.z = cvt_pk_bf16(v1[0], v1[1]); w.w = cvt_pk_bf16(v1[2], v1[3]);
                        *(u32x4*)(tb + ((ai * 4 + m) * 2 + bj) * 4096) = w; }
            return;
        }
        if (u.pn == 10) {
            if (wc == 0) {
#pragma unroll
                for (int ai = 0; ai < 2; ++ai)
#pragma unroll
                    for (int m = 0; m < 4; ++m) { float* zp = ZS + (size_t)(row0 + ai * HALF + m * 16) * 32 + 8 * fq;
                        *(f32x4*)zp = acc[ai][0][m][0]; *(f32x4*)(zp + 4) = acc[ai][0][m][1]; }
            }
            return;
        }
#pragma unroll
        for (int ai = 0; ai < 2; ++ai)
#pragma unroll
            for (int m = 0; m < 4; ++m) { bf16_t* rowp = Z + (size_t)(row0 + ai * HALF + m * 16) * ldz + col0;
#pragma unroll
                for (int bj = 0; bj < 2; ++bj) { const f32x4 v0 = acc[ai][bj][m][0], v1 = acc[ai][bj][m][1];
                    u32x4 w; w.x = cvt_pk_bf16(v0[0], v0[1]); w.y = cvt_pk_bf16(v0[2], v0[3]); w.z = cvt_pk_bf16(v1[0], v1[1]); w.w = cvt_pk_bf16(v1[2], v1[3]);
                    *(u32x4*)(rowp + bj * HALF) = w; } }
    }
};
struct EpiBranch {
    static constexpr bool PERM = true, AFTER_DRAIN = false, CHAIN = true;
    const bf16_t* GT; bf16_t* Hout; int NPM;
    static __device__ __forceinline__ float epos(float g) { return __expf(-fminf(fmaxf(g, -40.f), 40.f)); }
    __device__ __forceinline__ void chain(f32x4 (&acc)[2][2][4][2], const Unit& u, int wr, int wc, int fr, int fq) const {
        const int n = u.pn >> 3, pn = u.pn & 7, pm = u.pm - n * NPM;
        const int row0 = pm * BM + wr * 64 + fr, col0 = pn * BM + wc * 32 + 8 * fq;
#pragma unroll
        for (int ai = 0; ai < 2; ++ai) {
            u32x4 gaa[4][2], gbb[4][2];
#pragma unroll
            for (int m = 0; m < 4; ++m)
#pragma unroll
                for (int bj = 0; bj < 2; ++bj) { const bf16_t* gp = GT + ((size_t)pm * 32 + n * 8 + pn) * 65536 + ((ai * 4 + m) * 2 + bj) * 4096 + (size_t)threadIdx.x * 8; gaa[m][bj] = *(const u32x4*)gp; gbb[m][bj] = (n < 3) ? *(const u32x4*)(gp + 8 * 65536) : gaa[m][bj]; }
#pragma unroll
            for (int m = 0; m < 4; ++m) { const size_t r = (size_t)(row0 + ai * HALF + m * 16);
#pragma unroll
                for (int bj = 0; bj < 2; ++bj) {
                    const unsigned wa[4] = {gaa[m][bj].x, gaa[m][bj].y, gaa[m][bj].z, gaa[m][bj].w}, wb[4] = {gbb[m][bj].x, gbb[m][bj].y, gbb[m][bj].z, gbb[m][bj].w};
                    f32x4 f0, f1;
#pragma unroll
                    for (int j = 0; j < 4; ++j) { const float ea = epos((j & 1) ? __uint_as_float(wa[j >> 1] & 0xffff0000u) : __uint_as_float(wa[j >> 1] << 16));
                        const float eb = epos((j & 1) ? __uint_as_float(wb[j >> 1] & 0xffff0000u) : __uint_as_float(wb[j >> 1] << 16));
                        f0[j] = ((n < 3) ? (1.0f + eb) : 1.0f) * __builtin_amdgcn_rcpf(1.0f + ea); }
#pragma unroll
                    for (int j = 0; j < 4; ++j) { const float ea = epos((j & 1) ? __uint_as_float(wa[2 + (j >> 1)] & 0xffff0000u) : __uint_as_float(wa[2 + (j >> 1)] << 16));
                        const float eb = epos((j & 1) ? __uint_as_float(wb[2 + (j >> 1)] & 0xffff0000u) : __uint_as_float(wb[2 + (j >> 1)] << 16));
                        f1[j] = ((n < 3) ? (1.0f + eb) : 1.0f) * __builtin_amdgcn_rcpf(1.0f + ea); }
                    const f32x4 s0 = acc[ai][bj][m][0] * f0, s1 = acc[ai][bj][m][1] * f1;
                    if (n < 3) { acc[ai][bj][m][0] = s0; acc[ai][bj][m][1] = s1; }
                    else { u32x4 w; w.x = cvt_pk_bf16(s0[0], s0[1]); w.y = cvt_pk_bf16(s0[2], s0[3]); w.z = cvt_pk_bf16(s1[0], s1[1]); w.w = cvt_pk_bf16(s1[2], s1[3]);
                        *(u32x4*)(Hout + r * 2048 + col0 + bj * HALF) = w;
                        acc[ai][bj][m][0] = (f32x4){0.f, 0.f, 0.f, 0.f}; acc[ai][bj][m][1] = (f32x4){0.f, 0.f, 0.f, 0.f}; } } }
        }
    }
};
template <class Epi, class Sched, bool ALIGN_EPI = false, bool SP2 = false>
__device__ __forceinline__ void gemm_phase(PG8_LAS unsigned char* lds, const Gemm g, const Sched& S, const Epi& E) {
    const int tid = threadIdx.x, wid = __builtin_amdgcn_readfirstlane(tid >> 6), lane = tid & 63, wr = wid >> 2, wc = wid & 3, fr = lane & 15, fq = lane >> 4;
    const int K = g.K, nt = S.ntK;
    unsigned voffA[2], voffB[2];
#pragma unroll
    for (int i = 0; i < 2; ++i) { int R, C; stage_rc(tid * 16 + i * 8192, R, C); const int Rb = Epi::PERM ? ((R & ~31) + perm32(R & 31)) : R;
        voffA[i] = (unsigned)(R * K + C) * 2u; voffB[i] = g.swb ? (unsigned)(tid * 16 + i * 8192) : (unsigned)(Rb * K + C) * 2u; }
    const size_t kstep = (size_t)(BK * 2);
    const size_t hstep = (size_t)HALF * K * 2;
    const size_t tstep = 2 * hstep;
    const size_t kstepB = g.swb ? (size_t)HTB : kstep, hstepB = g.swb ? (size_t)(K / BK) * HTB : hstep, tstepB = 2 * hstepB;
    const unsigned ldsw = (unsigned)wid * 1024u;
    const int aoff = lds_byte(wr * 64 + fr, fq * 8), boff = lds_byte(wc * 32 + fr, fq * 8);
#define PG8_SA(b, h) (((b) * 2 + (h)) * HTB)
#define PG8_SB(b, h) ((4 + (b) * 2 + (h)) * HTB)
#define PG8_STAGE(bufoff, gbase, voff) do { _Pragma("unroll") for (int _i = 0; _i < 2; ++_i) \
        __builtin_amdgcn_global_load_lds((const unsigned*)((const char*)(gbase) + (voff)[_i]), (PG8_LAS unsigned*)(lds + (bufoff) + ldsw + _i * 8192), 16, 0, 0); } while (0)
#define PG8_LDA(dst, b, h) do { _Pragma("unroll") for (int m = 0; m < 4; ++m) _Pragma("unroll") for (int k = 0; k < 2; ++k) dst[m][k] = *(const PG8_LAS bf16x8*)(lds + PG8_SA(b, h) + aoff + m * 2048 + k * 1024); } while (0)
#define PG8_LDB(dst, b, h) do { _Pragma("unroll") for (int n = 0; n < 2; ++n) _Pragma("unroll") for (int k = 0; k < 2; ++k) dst[n][k] = *(const PG8_LAS bf16x8*)(lds + PG8_SB(b, h) + boff + n * 2048 + k * 1024); } while (0)
#define PG8_MMA(ai, bj, At, Bt) do { __builtin_amdgcn_s_setprio(1); _Pragma("unroll") for (int m = 0; m < 4; ++m) _Pragma("unroll") for (int n = 0; n < 2; ++n) _Pragma("unroll") for (int k = 0; k < 2; ++k) \
        acc[ai][bj][m][n] = __builtin_amdgcn_mfma_f32_16x16x32_bf16(Bt[n][k], At[m][k], acc[ai][bj][m][n], 0, 0, 0); __builtin_amdgcn_s_setprio(0); } while (0)
#define PG8_WAIT_V(n) asm volatile("s_waitcnt vmcnt(" #n ")" ::: "memory")
#define PG8_WAIT_L(n) asm volatile("s_waitcnt lgkmcnt(" #n ")" ::: "memory")
#define PG8_BAR __builtin_amdgcn_s_barrier()
#define PG8_SCHED __builtin_amdgcn_sched_barrier(0)
    Unit cur, nxt; int ui = 0;
    if (!S.next(0, cur)) return;
    f32x4 acc[2][2][4][2];
#pragma unroll
    for (int a = 0; a < 2; ++a)
#pragma unroll
        for (int b = 0; b < 2; ++b)
#pragma unroll
            for (int m = 0; m < 4; ++m)
#pragma unroll
                for (int n = 0; n < 2; ++n) acc[a][b][m][n] = (f32x4){0.f, 0.f, 0.f, 0.f};
    bf16x8 At[4][2], B0[2][2], B1[2][2];
    const char* cA = (const char*)g.A + (size_t)cur.pm * tstep + (size_t)cur.k0 * kstep; const char* cB = (const char*)g.Bt + (size_t)cur.pn * tstepB + (size_t)cur.k0 * kstepB;
    S.a_ready(cur);
    if constexpr (SP2) {
        PG8_STAGE(PG8_SB(0, 0), cB, voffB); PG8_STAGE(PG8_SB(0, 1), cB + hstepB, voffB); PG8_STAGE(PG8_SA(0, 0), cA, voffA); PG8_STAGE(PG8_SA(0, 1), cA + hstep, voffA);
        if (wr == 1) PG8_BAR;
        PG8_WAIT_V(2); PG8_BAR;
        PG8_STAGE(PG8_SB(1, 0), cB + kstepB, voffB); PG8_STAGE(PG8_SA(1, 0), cA + kstep, voffA); PG8_STAGE(PG8_SB(1, 1), cB + hstepB + kstepB, voffB);
        PG8_WAIT_V(6); PG8_BAR;
    } else {
        PG8_STAGE(PG8_SB(0, 0), cB, voffB); PG8_STAGE(PG8_SA(0, 0), cA, voffA); PG8_STAGE(PG8_SB(0, 1), cB + hstepB, voffB); PG8_STAGE(PG8_SA(0, 1), cA + hstep, voffA);
        if (wr == 1) PG8_BAR;
        PG8_WAIT_V(4); PG8_BAR;
        PG8_STAGE(PG8_SB(1, 0), cB + kstepB, voffB); PG8_STAGE(PG8_SA(1, 0), cA + kstep, voffA); PG8_STAGE(PG8_SB(1, 1), cB + hstepB + kstepB, voffB);
        PG8_WAIT_V(6); PG8_BAR;
    }
    for (;;) {
        const bool has_next = S.next(ui + 1, nxt);
        const char* nA = has_next ? (const char*)g.A + (size_t)nxt.pm * tstep + (size_t)nxt.k0 * kstep : cA; const char* nB = has_next ? (const char*)g.Bt + (size_t)nxt.pn * tstepB + (size_t)nxt.k0 * kstepB : cB;
        for (int t = 0; t < nt; t += 2) {
            const bool last = (t == nt - 2);
            const char* a1 = cA + (size_t)(t + 1) * kstep;
            const char* a2 = last ? nA : cA + (size_t)(t + 2) * kstep; const char* b2 = last ? nB : cB + (size_t)(t + 2) * kstepB;
            const char* a3 = a2 + kstep; const char* b3 = b2 + kstepB;
            if (last && has_next) S.a_ready(nxt);
            if constexpr (SP2) {
            PG8_LDB(B0, 0, 0); PG8_LDB(B1, 0, 1); PG8_SCHED; PG8_LDA(At, 0, 0); PG8_STAGE(PG8_SA(1, 1), a1 + hstep, voffA);
            PG8_WAIT_V(8); PG8_WAIT_L(0); PG8_BAR; PG8_MMA(0, 0, At, B0); PG8_MMA(0, 1, At, B1); PG8_BAR; PG8_SCHED;
            PG8_LDA(At, 0, 1); PG8_STAGE(PG8_SB(0, 0), b2, voffB); PG8_STAGE(PG8_SB(0, 1), b2 + hstepB, voffB); PG8_STAGE(PG8_SA(0, 0), a2, voffA);
            PG8_WAIT_V(8); PG8_WAIT_L(0); PG8_BAR; PG8_MMA(1, 0, At, B0); PG8_MMA(1, 1, At, B1); PG8_BAR; PG8_SCHED;
            PG8_LDB(B0, 1, 0); PG8_LDB(B1, 1, 1); PG8_SCHED; PG8_LDA(At, 1, 0); PG8_STAGE(PG8_SA(0, 1), a2 + hstep, voffA);
            PG8_WAIT_V(8); PG8_WAIT_L(0); PG8_BAR; PG8_MMA(0, 0, At, B0); PG8_MMA(0, 1, At, B1); PG8_BAR; PG8_SCHED;
            PG8_LDA(At, 1, 1); PG8_STAGE(PG8_SB(1, 0), b3, voffB); PG8_STAGE(PG8_SB(1, 1), b3 + hstepB, voffB); PG8_STAGE(PG8_SA(1, 0), a3, voffA);
            PG8_WAIT_V(8); PG8_WAIT_L(0); PG8_BAR; PG8_MMA(1, 0, At, B0); PG8_MMA(1, 1, At, B1); PG8_BAR; PG8_SCHED;
            } else {
            PG8_LDB(B0, 0, 0); PG8_SCHED; PG8_LDA(At, 0, 0); PG8_STAGE(PG8_SA(1, 1), a1 + hstep, voffA);
            PG8_WAIT_L(8); PG8_BAR; PG8_WAIT_L(0); PG8_MMA(0, 0, At, B0); PG8_BAR; PG8_SCHED;
            PG8_LDB(B1, 0, 1); PG8_STAGE(PG8_SB(0, 0), b2, voffB);
            PG8_BAR; PG8_WAIT_L(0); PG8_MMA(0, 1, At, B1); PG8_BAR;
            PG8_LDA(At, 0, 1); PG8_STAGE(PG8_SA(0, 0), a2, voffA);
            PG8_BAR; PG8_WAIT_L(0); PG8_MMA(1, 0, At, B0); PG8_BAR; PG8_SCHED;
            PG8_STAGE(PG8_SB(0, 1), b2 + hstepB, voffB);
            PG8_WAIT_V(6); PG8_BAR; PG8_MMA(1, 1, At, B1); PG8_BAR;
            PG8_LDB(B0, 1, 0); PG8_SCHED; PG8_LDA(At, 1, 0); PG8_STAGE(PG8_SA(0, 1), a2 + hstep, voffA);
            PG8_WAIT_L(8); PG8_BAR; PG8_WAIT_L(0); PG8_MMA(0, 0, At, B0); PG8_BAR; PG8_SCHED;
            PG8_LDB(B1, 1, 1); PG8_STAGE(PG8_SB(1, 0), b3, voffB);
            PG8_BAR; PG8_WAIT_L(0); PG8_MMA(0, 1, At, B1); PG8_BAR;
            PG8_LDA(At, 1, 1); PG8_STAGE(PG8_SA(1, 0), a3, voffA);
            PG8_BAR; PG8_WAIT_L(0); PG8_MMA(1, 0, At, B0); PG8_BAR; PG8_SCHED;
            PG8_STAGE(PG8_SB(1, 1), b3 + hstepB, voffB);
            PG8_WAIT_V(6); PG8_BAR; PG8_MMA(1, 1, At, B1); PG8_BAR;
            }
        }
        if constexpr (ALIGN_EPI) { if (wr == 0) PG8_BAR; }
        if constexpr (Epi::CHAIN) { E.chain(acc, cur, wr, wc, fr, fq); S.done(cur); }
        else if constexpr (!Epi::AFTER_DRAIN) { E(acc, cur, wr, wc, fr, fq); S.done(cur); }
        if (!has_next) break;
        if constexpr (!Epi::CHAIN) {
#pragma unroll
        for (int a = 0; a < 2; ++a)
#pragma unroll
            for (int b = 0; b < 2; ++b)
#pragma unroll
                for (int m = 0; m < 4; ++m)
#pragma unroll
                    for (int n = 0; n < 2; ++n) acc[a][b][m][n] = (f32x4){0.f, 0.f, 0.f, 0.f};
        }
        cur = nxt; cA = nA; cB = nB; ++ui;
        if constexpr (ALIGN_EPI) { if (wr == 1) PG8_BAR; }
    }
    PG8_WAIT_V(0);
    if constexpr (!ALIGN_EPI) { if (wr == 0) PG8_BAR; }
    PG8_BAR;
    if constexpr (Epi::AFTER_DRAIN) { E.fused(acc, cur, wr, wc, fr, fq, lds, wid, lane); S.done(cur); }
#undef PG8_SA
#undef PG8_SB
#undef PG8_STAGE
#undef PG8_LDA
#undef PG8_LDB
#undef PG8_MMA
#undef PG8_WAIT_V
#undef PG8_WAIT_L
#undef PG8_BAR
#undef PG8_SCHED
}
}
#ifndef PG8_SP2
#define PG8_SP2 true
#endif
#ifndef PG8_ALIGN
#define PG8_ALIGN true
#endif
constexpr int NWAVES = 8;
constexpr int D = 2048, BATCH = 8, SEQ = 2048, CTXL = 256, DFF = 5632, NLAYER = 2;
constexpr int ML = BATCH * SEQ, MC = BATCH * CTXL, MT = ML + MC;
constexpr int ZLD = 6400;
constexpr int NZ = 14592;
constexpr int MODW = 9 * D;
constexpr int INC = 14368;
constexpr float EPS = 1e-6f;
constexpr int ZC_MLK = 0, ZC_MLV = 512, ZC_GDK = 1024, ZC_GDV = 1536, ZC_ATK = 2048, ZC_ATV = 2304, ZC_SMALL = 2560, ZC_SGU = 2816, ZC_SGV = 3328,
              ZC_MLQ = 3840, ZC_MLO = 4352, ZC_GDQ = 4864, ZC_GDZ = 5376, ZC_ATQ = 5888, ZC_GATE = 6400;
constexpr int NKV_TILES = 11;

constexpr size_t MiB = 1u << 20;
constexpr size_t WS_CTL = 0, CTL_ZERO_BYTES = 1 * MiB;
constexpr size_t WS_MOD = 1 * MiB;
constexpr size_t WS_ROPE = 3 * MiB;
constexpr size_t WS_XC = 4 * MiB;
constexpr size_t WS_WFI = 20 * MiB;
constexpr size_t WS_WFO = 64 * MiB;
constexpr size_t WS_WZ = 86 * MiB;
constexpr size_t WS_WB = 143 * MiB;
constexpr size_t WS_WO = 151 * MiB;
constexpr size_t WS_H = 159 * MiB;
constexpr size_t WS_Z = 231 * MiB;
constexpr size_t WS_GT = WS_Z + (size_t)18432 * 6400 * 2;
constexpr size_t WS_ZS = 744 * MiB;
constexpr size_t WS_Y = 747 * MiB;
constexpr size_t WS_QA = 819 * MiB;
constexpr size_t WS_KC = 837 * MiB;
constexpr size_t WS_VC = 846 * MiB;
constexpr size_t WS_MIX = 855 * MiB;
constexpr size_t WS_END = 1150 * MiB;
static_assert(WS_GT + (size_t)72 * 32 * 131072 <= WS_ZS && WS_Z + (size_t)MT * NZ * 2 <= WS_ZS && WS_H + (size_t)MT * D * 2 <= WS_Z && WS_Y + (size_t)4 * MT * 512 * 2 <= WS_QA, "d_ws map");
static_assert(WS_WFI + (size_t)2 * DFF * D * 2 <= WS_WFO && WS_WFO + (size_t)D * DFF * 2 <= WS_WZ && WS_WZ + (size_t)NZ * D * 2 <= WS_WB, "d_ws map (weights)");
constexpr int CW_TMO = 0, CW_CODE = 1, CW_BAR = 4096;

constexpr int RING_OFF = 0, RING_BYTES = 131072;
constexpr int LDSCTL_OFF = RING_BYTES, MISC_OFF = LDSCTL_OFF + 320;
constexpr int LDS_BYTES = 147456;

#define GAS __attribute__((address_space(1)))
#define LAS __attribute__((address_space(3)))
typedef unsigned short bf16;
typedef unsigned v4u __attribute__((ext_vector_type(4)));
typedef unsigned v2u __attribute__((ext_vector_type(2)));
typedef float f32x4 __attribute__((ext_vector_type(4)));
typedef short bf16x8 __attribute__((ext_vector_type(8)));
typedef GAS unsigned gu32;
#define RLX_AGENT __ATOMIC_RELAXED, __HIP_MEMORY_SCOPE_AGENT
#define LDS_WAIT() asm volatile("s_waitcnt lgkmcnt(0)" ::: "memory")
#define VM_WAIT() asm volatile("s_waitcnt vmcnt(0)" ::: "memory")
typedef float f32x2_t __attribute__((ext_vector_type(2)));
typedef __bf16 bf16x2_t __attribute__((ext_vector_type(2)));
__device__ __forceinline__ unsigned pk2(float lo, float hi) { const f32x2_t v = {lo, hi}; const bf16x2_t b = __builtin_convertvector(v, bf16x2_t); return __builtin_bit_cast(unsigned, b); }
__device__ __forceinline__ float bflo(unsigned w) { return __uint_as_float(w << 16); }
__device__ __forceinline__ float bfhi(unsigned w) { return __uint_as_float(w & 0xffff0000u); }
__device__ __forceinline__ float bf1(bf16 b) { return __uint_as_float(((unsigned)b) << 16); }
__device__ __forceinline__ bf16 f2bf1(float f) { return (bf16)(pk2(f, 0.f) & 0xffffu); }
__device__ __forceinline__ float silu1(float a) { return a / (1.0f + __expf(-a)); }
__device__ __forceinline__ float sigm1(float a) { return 1.0f / (1.0f + __expf(-a)); }
__device__ __forceinline__ float wave_sum(float v) {
#pragma unroll
    for (int o = 1; o < 64; o <<= 1) v += __shfl_xor(v, o);
    return v;
}
#define XB_TMO      128
#define XB_XCNT(j)  (256  + 64 * (j))
#define XB_XSUB(j)  (1280 + 64 * (j))
#define XB_XGEN(j)  (2304 + 64 * (j))
#define XB_TOP      3328
#define XB_TOPGEN   3392
#define XCD_BAR_WORDS 3456
#define XB_SPIN_CAP (1u << 18)

__device__ __forceinline__ unsigned xb_ld(unsigned* p)              { return __hip_atomic_load(p, __ATOMIC_RELAXED, __HIP_MEMORY_SCOPE_AGENT); }
__device__ __forceinline__ unsigned xb_add(unsigned* p, unsigned v) { return __hip_atomic_fetch_add(p, v, __ATOMIC_RELAXED, __HIP_MEMORY_SCOPE_AGENT); }
__device__ __forceinline__ unsigned xb_xcc_id() { return (unsigned)__builtin_amdgcn_s_getreg((3 << 11) | 20) & 0xFu; }
#define XB_SPIN(cond, bar) do { unsigned _sp = 0; while (cond) { __builtin_amdgcn_s_sleep(1); \
    if ((++_sp & 255u) == 0u) { if (xb_ld(&(bar)[XB_TMO])) break; if (_sp > XB_SPIN_CAP) { atomicAdd(&(bar)[XB_TMO], 1u); break; } } } } while (0)

struct XcdBarrier {
    unsigned* bar; unsigned x;
    volatile LAS unsigned* st;
};

__device__ __forceinline__ XcdBarrier xcd_barrier_post(unsigned* bar, volatile LAS unsigned* st) {
    XcdBarrier b; b.bar = bar; b.x = xb_xcc_id(); b.st = st;
    if (threadIdx.x == 0) (void)xb_add(&bar[XB_XCNT(b.x)], 1u);
    return b;
}
__device__ __forceinline__ void xcd_barrier_complete(unsigned* bar, unsigned x, unsigned& nloc, unsigned& nx) {
    const unsigned G = gridDim.x * gridDim.y * gridDim.z;
    unsigned sum, cnt, mine, sp = 0u;
    for (;;) {
        sum = 0u; cnt = 0u; mine = 0u;
#pragma unroll
        for (unsigned j = 0; j < 16; ++j) { const unsigned c = xb_ld(&bar[XB_XCNT(j)]); sum += c; cnt += (c > 0u) ? 1u : 0u; mine = (j == x) ? c : mine; }
        if (sum == G) break;
        __builtin_amdgcn_s_sleep(1);
        if ((++sp & 255u) == 0u) { if (xb_ld(&bar[XB_TMO])) break; if (sp > XB_SPIN_CAP) { atomicAdd(&bar[XB_TMO], 1u); break; } }
    }
    nloc = mine > 0u ? mine : 1u; nx = cnt > 0u ? cnt : 1u;
}

__device__ __forceinline__ void xcd_barrier(const XcdBarrier& b) {
    asm volatile("s_waitcnt vmcnt(0)" ::: "memory");
    __syncthreads();
    if (threadIdx.x == 0) {
        unsigned* bar = b.bar;
        __builtin_amdgcn_s_waitcnt(0);
        unsigned nloc = b.st[0], nx = b.st[1];
        if (nloc == 0u) { xcd_barrier_complete(bar, b.x, nloc, nx); b.st[0] = nloc; b.st[1] = nx; }
        const unsigned old = xb_add(&bar[XB_XSUB(b.x)], 1u);
        const unsigned gen = old / nloc;
        if (old + 1u == (gen + 1u) * nloc) {
            __builtin_amdgcn_fence(__ATOMIC_RELEASE, "agent");
            asm volatile("s_waitcnt vmcnt(0)" ::: "memory");
            const unsigned og = xb_add(&bar[XB_TOP], 1u);
            const unsigned tg = og / nx;
            if (og + 1u == (tg + 1u) * nx) xb_add(&bar[XB_TOPGEN], 1u);
            else XB_SPIN(xb_ld(&bar[XB_TOPGEN]) == tg, bar);
            __builtin_amdgcn_fence(__ATOMIC_ACQUIRE, "agent");
            xb_add(&bar[XB_XGEN(b.x)], 1u);
            asm volatile("s_waitcnt vmcnt(0)" ::: "memory");
        } else {
            XB_SPIN(xb_ld(&bar[XB_XGEN(b.x)]) == gen, bar);
            __builtin_amdgcn_fence(__ATOMIC_ACQUIRE, "agent");
            asm volatile("s_waitcnt vmcnt(0)" ::: "memory");
        }
    }
    __syncthreads();
}
struct Frame {
    LAS unsigned char* lds;
    volatile LAS unsigned* MISC;
    gu32* ctl;
    int tid, lane, wave, G;
    unsigned char* ws;
    const float* const* in;
    float* out;
};
enum { I_X = 0, I_C, I_CTX, I_CCTX, I_MODW, I_MODB, I_F1N, I_F1WI, I_F1WO, I_MIXN, I_WIN, I_SGN, I_SGW, I_SGB, I_MLIFB, I_MLN, I_GDCONV, I_GDALOG, I_GDDTB, I_GDN,
       I_ATQN, I_ATKN, I_WBR, I_WOUT, I_F2N, I_F2WI, I_F2WO };

__device__ __forceinline__ void phase_mod(Frame& F) {
    LAS float* tab = (LAS float*)(F.lds + RING_OFF);
    LAS float* red = (LAS float*)(F.lds + RING_OFF + 98304);
    const float* c = F.in[I_C]; const float* cc = F.in[I_CCTX];
    for (int i = F.tid; i < 9 * D; i += NWAVES * 64) { const int b = i / D, k = i % D; const float x = b < 8 ? c[b * D + k] : cc[k]; tab[k * 12 + b] = silu1(x); }
    __syncthreads();
    float* MOD = (float*)(F.ws + WS_MOD);
    for (int item = blockIdx.x; item < 2 * 288; item += F.G) {
        const int l = item / 288, n0 = (item % 288) * 64;
        const float* W = F.in[I_MODW] + (size_t)l * D * MODW + n0 + F.lane;
        float acc[9];
#pragma unroll
        for (int b = 0; b < 9; ++b) acc[b] = 0.f;
        const int k0 = F.wave * 256;
        for (int k = k0; k < k0 + 256; k += 8) {
            float w[8];
#pragma unroll
            for (int j = 0; j < 8; ++j) w[j] = W[(size_t)(k + j) * MODW];
#pragma unroll
            for (int j = 0; j < 8; ++j) { const LAS f32x4* tp = (const LAS f32x4*)(tab + (k + j) * 12); const f32x4 s0 = tp[0], s1 = tp[1], s2 = tp[2];
                acc[0] += s0[0] * w[j]; acc[1] += s0[1] * w[j]; acc[2] += s0[2] * w[j]; acc[3] += s0[3] * w[j];
                acc[4] += s1[0] * w[j]; acc[5] += s1[1] * w[j]; acc[6] += s1[2] * w[j]; acc[7] += s1[3] * w[j]; acc[8] += s2[0] * w[j]; }
        }
#pragma unroll
        for (int b = 0; b < 9; ++b) red[(F.wave * 9 + b) * 64 + F.lane] = acc[b];
        __syncthreads();
        for (int i = F.tid; i < 576; i += NWAVES * 64) { const int b = i / 64, cc2 = i % 64; float s = 0.f;
#pragma unroll
            for (int w = 0; w < 8; ++w) s += red[(w * 9 + b) * 64 + cc2];
            MOD[(size_t)(l * 9 + b) * MODW + n0 + cc2] = s + F.in[I_MODB][(size_t)l * MODW + n0 + cc2]; }
        __syncthreads();
    }
}
__device__ __forceinline__ void phase_rope(Frame& F) {
    float* RC = (float*)(F.ws + WS_ROPE); float* RS = RC + 96 * 32;
    const int idx = blockIdx.x * (NWAVES * 64) + F.tid;
    if (idx < 96 * 32) {
        const int pos = idx >> 5, i = idx & 31; const float p = (float)(pos < 32 ? pos : pos - 32);
        const float inv = exp2f(-(float)i * (13.287712379549449f / 32.0f));
        const float x = p * inv;
        const float kf = rintf(x * 0.6366197723675814f);
        float r = fmaf(-kf, 1.5707963705062866f, x); r = fmaf(-kf, -4.371138828673793e-8f, r);
        const float r2 = r * r;
        const float sn = r + r * r2 * (-1.6666667163e-1f + r2 * (8.3333337680e-3f + r2 * (-1.9841270114e-4f + r2 * 2.7557314297e-6f)));
        const float cs = 1.0f + r2 * (-0.5f + r2 * (4.1666667908e-2f + r2 * (-1.3888889225e-3f + r2 * (2.4801587642e-5f + r2 * -2.7557314297e-7f))));
        const int q = ((int)kf) & 3;
        const float sv = (q == 0) ? sn : (q == 1) ? cs : (q == 2) ? -sn : -cs;
        const float cv = (q == 0) ? cs : (q == 1) ? -sn : (q == 2) ? -cs : sn;
        RC[idx] = cv; RS[idx] = sv;
    }
}
template <int MAP> __device__ __forceinline__ int dst_row(int n) {
    if (MAP == 0) return n;
    if (MAP == 1) { const int half = n >= DFF ? 1 : 0, j = n - half * DFF; return (j >> 7) * 256 + half * 128 + (j & 127); }
    if (n < 1024) return n;
    if (n < 1040) return ZC_SMALL + (n - 1024);
    if (n < 2064) return 1024 + (n - 1040);
    if (n < 2080) return ZC_SMALL + 16 + (n - 2064);
    if (n < 2592) return 2048 + (n - 2080);
    return n + 224;
}
template <int MAP, bool PERMB> __device__ __forceinline__ void conv_item(const float* W, int K, int N, bf16* WT, LAS float* scr, int item, int lane) {
    const int nblk = N / 32, kb = item / nblk, nb = item % nblk, k0 = 64 * kb, n0 = 32 * nb;
#pragma unroll 8
    for (int i = 0; i < 32; ++i) { const int kk = 2 * i + (lane >> 5); scr[kk * 33 + (lane & 31)] = W[(size_t)(k0 + kk) * N + n0 + (lane & 31)]; }
    LDS_WAIT(); asm volatile("" ::: "memory");
    const int c = lane & 7;
#pragma unroll
    for (int j = 0; j < 4; ++j) { const int n = (lane >> 3) + 8 * j; const LAS float* s = scr + (8 * c) * 33 + n;
        v4u o; o.x = pk2(s[0 * 33], s[1 * 33]); o.y = pk2(s[2 * 33], s[3 * 33]); o.z = pk2(s[4 * 33], s[5 * 33]); o.w = pk2(s[6 * 33], s[7 * 33]);
        *(GAS v4u*)(WT + pg8::sw_off(dst_row<MAP>(n0 + n), k0 + 8 * c, K, PERMB)) = o; }
    LDS_WAIT(); asm volatile("" ::: "memory");
}
__device__ __forceinline__ void conv_set(Frame& F, int l, int set, unsigned* queue) {
    LAS float* scr = (LAS float*)(F.lds + RING_OFF + F.wave * 16384);
    const int gw = blockIdx.x * NWAVES + F.wave, NGW = F.G * NWAVES;
    constexpr int I_FI = (D / 64) * (2 * DFF / 32), I_FO = (DFF / 64) * (D / 32), I_Z = (D / 64) * (INC / 32), I_B = (512 / 64) * (D / 32), I_O = (D / 64) * (D / 32);
    bf16* WFI = (bf16*)(F.ws + WS_WFI); bf16* WFO = (bf16*)(F.ws + WS_WFO); bf16* WZ = (bf16*)(F.ws + WS_WZ); bf16* WB = (bf16*)(F.ws + WS_WB); bf16* WO = (bf16*)(F.ws + WS_WO);
    const float* fwi = F.in[set == 1 ? I_F2WI : I_F1WI] + (size_t)l * D * 2 * DFF; const float* fwo = F.in[set == 1 ? I_F2WO : I_F1WO] + (size_t)l * DFF * D;
    const int NIT = set < 2 ? (I_FI + I_FO) : (I_Z + 4 * I_B + I_O);
    int it = gw, lim = NIT, step = NGW;
    for (;;) {
        if (queue) { int base = 0; if (F.lane == 0) base = (int)__hip_atomic_fetch_add(queue, 16u, __ATOMIC_RELAXED, __HIP_MEMORY_SCOPE_AGENT);
            base = __builtin_amdgcn_readfirstlane(base); if (base >= NIT) break; it = base; lim = base + 16 < NIT ? base + 16 : NIT; step = 1; }
        for (; it < lim; it += step) {
            int r = it;
            if (set < 2) {
                if (r < I_FI) { conv_item<1, true>(fwi, D, 2 * DFF, WFI, scr, r, F.lane); continue; } r -= I_FI;
                conv_item<0, false>(fwo, DFF, D, WFO, scr, r, F.lane);
            } else {
                if (r < I_Z) { conv_item<2, true>(F.in[I_WIN] + (size_t)l * D * INC, D, INC, WZ, scr, r, F.lane); continue; } r -= I_Z;
                if (r < 4 * I_B) { const int n = r / I_B; conv_item<0, true>(F.in[I_WBR] + ((size_t)l * 4 + n) * 512 * D, 512, D, WB + (size_t)n * D * 512, scr, r % I_B, F.lane); continue; } r -= 4 * I_B;
                conv_item<0, false>(F.in[I_WOUT] + (size_t)l * D * D, D, D, WO, scr, r, F.lane);
            }
        }
        if (!queue) break;
    }
    if (set == 2 && (!queue || blockIdx.x < 32)) {
        GAS v4u* z = (GAS v4u*)(WZ + (size_t)(10 * 2) * (D / 64) * 8192); const int npc = 2 * (D / 64) * 1024; const int nb = queue ? 32 : F.G;
        for (int i = blockIdx.x * (NWAVES * 64) + F.tid; i < npc; i += nb * NWAVES * 64) { int R, C; pg8::stage_rc((i & 1023) * 16, R, C); const int h = i / (1024 * (D / 64));
            const int rowt = 128 * h + ((R & ~31) + pg8::perm32(R & 31)); if (rowt >= 32) z[i] = (v4u){0u, 0u, 0u, 0u}; }
    }
}
template <bool COPY, bool ADDP, bool ZSM> __device__ __forceinline__ void phase_norm(Frame& F, const float* xl, const float* xc, const float* gain, const float* mod  , int nrows) {
    bf16* H = (bf16*)(F.ws + WS_H);
    const int gw = blockIdx.x * NWAVES + F.wave, NGW = F.G * NWAVES;
    if (ZSM) {
        const bf16* wz = (const bf16*)(F.ws + WS_WZ);
        for (int i = F.tid; i < 32 * D * 2 / 16; i += NWAVES * 64) { const int c = i / (D / 8), k8 = (i % (D / 8)) * 8;
            *(LAS v4u*)(F.lds + RING_OFF + i * 16) = *(const GAS v4u*)(wz + pg8::sw_off(ZC_SMALL + c, k8, D, true)); }
        __syncthreads();
    }
    for (int row = gw; row < nrows; row += NGW) {
        const bool isc = row >= ML; const int b9 = isc ? 8 : row / SEQ;
        const GAS f32x4* xr = (const GAS f32x4*)(isc ? xc + (size_t)(row - ML) * D : xl + (size_t)row * D) + F.lane;
        f32x4 v[8]; float s = 0.f;
#pragma unroll
        for (int j = 0; j < 8; ++j) v[j] = xr[64 * j];
        if (ADDP && isc) {
            const GAS f32x4* pr = (const GAS f32x4*)((const float*)(F.ws + WS_MIX) + (size_t)(row - ML) * D) + F.lane;
#pragma unroll
            for (int q = 0; q < 4; ++q)
#pragma unroll
                for (int j = 0; j < 8; ++j) v[j] = v[j] + pr[(size_t)q * (2048 * 2048 / 4) + 64 * j];
            GAS f32x4* xw = (GAS f32x4*)((float*)(F.ws + WS_XC) + (size_t)(row - ML) * D) + F.lane;
#pragma unroll
            for (int j = 0; j < 8; ++j) xw[64 * j] = v[j];
        }
#pragma unroll
        for (int j = 0; j < 8; ++j) s += (v[j].x * v[j].x + v[j].y * v[j].y) + (v[j].z * v[j].z + v[j].w * v[j].w);
        if (COPY) { GAS f32x4* cp = (GAS f32x4*)(isc ? (float*)(F.ws + WS_XC) + (size_t)(row - ML) * D : F.out + (size_t)row * D) + F.lane;
#pragma unroll
            for (int j = 0; j < 8; ++j) cp[64 * j] = v[j]; }
        const float rstd = 1.0f / sqrtf(wave_sum(s) * (1.0f / D) + EPS);
        const float* sh = mod + (size_t)b9 * MODW; const float* sc = sh + D;
        GAS v2u* o8 = (GAS v2u*)(H + (size_t)row * D) + F.lane;
#pragma unroll
        for (int j = 0; j < 8; ++j) { const int c = 4 * F.lane + 256 * j;
            const f32x4 g = *(const f32x4*)(gain + c), a = *(const f32x4*)(sc + c), b = *(const f32x4*)(sh + c);
            const f32x4 y = (v[j] * rstd * g) * (a + 1.0f) + b;
            if (ZSM) v[j] = y;
            v2u w; w.x = pk2(y.x, y.y); w.y = pk2(y.z, y.w); o8[64 * j] = w; }
        if (ZSM && isc) {
            float res = 0.f;
            for (int c = 0; c < 32; ++c) { const LAS v2u* wr = (const LAS v2u*)(F.lds + RING_OFF + c * (D * 2)) + F.lane; float s = 0.f;
#pragma unroll
                for (int j = 0; j < 8; ++j) { const v2u w = wr[64 * j]; s += v[j].x * bflo(w.x) + v[j].y * bfhi(w.x) + v[j].z * bflo(w.y) + v[j].w * bfhi(w.y); }
                s = wave_sum(s); res = (F.lane == c) ? s : res; }
            if (F.lane < 32) ((float*)(F.ws + WS_ZS))[(size_t)row * 32 + F.lane] = res;
        }
    }
}
#include <hip/hip_bf16.h>
namespace attn {
using bf16 = __hip_bfloat16;
constexpr int   D = 128, NW = 8, QBLK = 32, KVBLK = 64;
constexpr float SCALE = 0.088388347648318440f;
constexpr float THR = 8.f;
constexpr int SDEPTH = 2;
constexpr int LDQ = 512, LDK = 256, LDO = 512;
constexpr size_t SHM_V = KVBLK * D * 2, SHM_K = KVBLK * D * 2, SHM_ATTN = 2 * SHM_V + 2 * SHM_K + NW * 64 * 4;
using bf16x8 = __attribute__((ext_vector_type(8))) short;
using s16x4  = __attribute__((ext_vector_type(4))) short;
using f32x16 = __attribute__((ext_vector_type(16))) float;
using f32x8  = __attribute__((ext_vector_type(8))) float;
using u32x4  = __attribute__((ext_vector_type(4))) unsigned;
#define KSWZ(row, colB) ((row) * 256 + ((colB) ^ (((row) & 7) << 4)))
#define SBAR() __builtin_amdgcn_sched_barrier(0)
__device__ __forceinline__ int crow(int r, int hi) { return (r & 3) + 8 * (r >> 2) + 4 * hi; }
__device__ __forceinline__ unsigned cvtpk(float lo, float hi) {
  unsigned r; asm volatile("v_cvt_pk_bf16_f32 %0, %1, %2" : "=v"(r) : "v"(lo), "v"(hi)); return r;
}
template <typename TIn> struct Stage;
template <> struct Stage<bf16>  { using T = bf16x8;
  __device__ static __forceinline__ T ld8(const bf16* p) { return *reinterpret_cast<const bf16x8*>(p); }
  __device__ static __forceinline__ bf16x8 tobf(T x) { return x; } };
template <> struct Stage<float> { using T = f32x8;
  __device__ static __forceinline__ T ld8(const float* p) { return *reinterpret_cast<const f32x8*>(p); }
  __device__ static __forceinline__ bf16x8 tobf(T x) {
    u32x4 w = {cvtpk(x[0], x[1]), cvtpk(x[2], x[3]), cvtpk(x[4], x[5]), cvtpk(x[6], x[7])}; return *reinterpret_cast<bf16x8*>(&w); } };

__device__ __forceinline__ void partialSM(f32x16& p0, f32x16& p1, float& m_reg, float& mn, float& alpha) {
  constexpr float C = SCALE * 1.4426950408889634f;
  float pmax = p0[0]; for (int r = 1; r < 16; ++r) pmax = fmaxf(pmax, p0[r]); for (int r = 0; r < 16; ++r) pmax = fmaxf(pmax, p1[r]);
  { auto rr = __builtin_amdgcn_permlane32_swap(__float_as_uint(pmax), __float_as_uint(pmax), false, false);
    pmax = fmaxf(__uint_as_float(rr[0]), __uint_as_float(rr[1])); }
  if (__builtin_expect(__all(pmax - m_reg <= THR / SCALE), 1)) { mn = m_reg; alpha = 1.f; }
  else { mn = fmaxf(m_reg, pmax); alpha = __builtin_amdgcn_exp2f((m_reg - mn) * C); m_reg = mn; }
  float mnC = -mn * C;
  for (int r = 0; r < 16; ++r) p0[r] = fmaf(p0[r], C, mnC); for (int r = 0; r < 16; ++r) p1[r] = fmaf(p1[r], C, mnC);
  for (int r = 0; r < 16; ++r) p0[r] = __builtin_amdgcn_exp2f(p0[r]);
}
__device__ __forceinline__ void finishSM(f32x16& p0, f32x16& p1, float alpha, float& l_reg, bf16x8& pa0, bf16x8& pa1, bf16x8& pa2, bf16x8& pa3) {
  for (int r = 0; r < 16; ++r) p1[r] = __builtin_amdgcn_exp2f(p1[r]);
  float ps = 0; for (int r = 0; r < 16; ++r) ps += p0[r]; for (int r = 0; r < 16; ++r) ps += p1[r];
  { auto rr = __builtin_amdgcn_permlane32_swap(__float_as_uint(ps), __float_as_uint(ps), false, false);
    ps = __uint_as_float(rr[0]) + __uint_as_float(rr[1]); }
  l_reg = l_reg * alpha + ps;
#define PK4(P, BASE, OUT) do { unsigned a0 = cvtpk(P[BASE + 0], P[BASE + 1]), a1 = cvtpk(P[BASE + 2], P[BASE + 3]);   \
    unsigned b0 = cvtpk(P[BASE + 4], P[BASE + 5]), b1 = cvtpk(P[BASE + 6], P[BASE + 7]);                              \
    auto r0 = __builtin_amdgcn_permlane32_swap(a0, b0, false, false); auto r1 = __builtin_amdgcn_permlane32_swap(a1, b1, false, false); \
    u32x4 w = {r0[0], r1[0], r0[1], r1[1]}; OUT = *reinterpret_cast<bf16x8*>(&w); } while (0)
  PK4(p0, 0, pa0); PK4(p0, 8, pa1); PK4(p1, 0, pa2); PK4(p1, 8, pa3);
#undef PK4
}
__device__ __forceinline__ void qkt(f32x16& p0, f32x16& p1, const bf16* Ks, const bf16x8* qr, int r32, int hi) {
  p0 = f32x16{}; p1 = f32x16{};
  for (int d0 = 0; d0 < 8; ++d0) { int cb = (d0 * 16 + hi * 8) * 2;
    bf16x8 b0 = *reinterpret_cast<const bf16x8*>((const char*)Ks + KSWZ(r32, cb));
    bf16x8 b1 = *reinterpret_cast<const bf16x8*>((const char*)Ks + KSWZ(32 + r32, cb));
    p0 = __builtin_amdgcn_mfma_f32_32x32x16_bf16(b0, qr[d0], p0, 0, 0, 0);
    p1 = __builtin_amdgcn_mfma_f32_32x32x16_bf16(b1, qr[d0], p1, 0, 0, 0); }
}
__device__ __forceinline__ int v_st(int k, int c) { const int kk = (k & ~0xC) | ((k & 4) << 1) | ((k & 8) >> 1); return ((kk >> 3) * 4 + (c >> 5)) * 512 + ((kk & 7) * 32 + (c & 31)) * 2; }
__device__ __forceinline__ int v_rd_base(int lane) { return ((lane & 3) << 3) | (((lane >> 2) & 3) << 6) | (((lane >> 4) & 1) << 5) | (((lane >> 5) & 1) << 8); }
constexpr int v_rd_off(int d0, int ks, int half) { return d0 * 512 + ks * 4096 + half * 2048; }
template <int OFF> __device__ __forceinline__ s16x4 tr_read(int vb) {
  s16x4 r; asm volatile("ds_read_b64_tr_b16 %0, %1 offset:%2" : "=&v"(r) : "v"(vb), "i"(OFF) : "memory"); return r;
}
template <int D0> __device__ __forceinline__ void pv_one(f32x16& od, int vb, bf16x8 pa0, bf16x8 pa1, bf16x8 pa2, bf16x8 pa3) {
  const s16x4 l0 = tr_read<v_rd_off(D0, 0, 0)>(vb), h0 = tr_read<v_rd_off(D0, 0, 1)>(vb), l1 = tr_read<v_rd_off(D0, 1, 0)>(vb), h1 = tr_read<v_rd_off(D0, 1, 1)>(vb);
  const s16x4 l2 = tr_read<v_rd_off(D0, 2, 0)>(vb), h2 = tr_read<v_rd_off(D0, 2, 1)>(vb), l3 = tr_read<v_rd_off(D0, 3, 0)>(vb), h3 = tr_read<v_rd_off(D0, 3, 1)>(vb);
  asm volatile("s_waitcnt lgkmcnt(0)" ::: "memory"); SBAR();
#define PK(L, H) (bf16x8){L[0], L[1], L[2], L[3], H[0], H[1], H[2], H[3]}
  od = __builtin_amdgcn_mfma_f32_32x32x16_bf16(pa0, PK(l0, h0), od, 0, 0, 0);
  od = __builtin_amdgcn_mfma_f32_32x32x16_bf16(pa1, PK(l1, h1), od, 0, 0, 0);
  od = __builtin_amdgcn_mfma_f32_32x32x16_bf16(pa2, PK(l2, h2), od, 0, 0, 0);
  od = __builtin_amdgcn_mfma_f32_32x32x16_bf16(pa3, PK(l3, h3), od, 0, 0, 0);
#undef PK
}
__device__ __forceinline__ void pv_d0(f32x16* o, int vb, bf16x8 pa0, bf16x8 pa1, bf16x8 pa2, bf16x8 pa3) {
  pv_one<0>(o[0], vb, pa0, pa1, pa2, pa3); pv_one<1>(o[1], vb, pa0, pa1, pa2, pa3); pv_one<2>(o[2], vb, pa0, pa1, pa2, pa3); pv_one<3>(o[3], vb, pa0, pa1, pa2, pa3);
}

template <typename TQ>
__device__ __forceinline__ void attn_dense_body(const TQ* __restrict__ Qb, const bf16* __restrict__ Kh, const bf16* __restrict__ Vh,
                                                bf16* __restrict__ Ob, int seq, char* lds) {
  using St = Stage<bf16>; using SQ = Stage<TQ>;
  const int tid = threadIdx.x, wid = tid >> 6, lane = tid & 63, r32 = lane & 31, hi = lane >> 5;
  bf16* V_lds = (bf16*)lds; bf16* K_lds = (bf16*)(lds + 2 * SHM_V);
  float* ws = (float*)(lds + 2 * SHM_V + 2 * SHM_K) + wid * 64; float* li_l = ws; float* al_l = ws + 32;
  float m_reg = -1e30f, l_reg = 0; f32x16 o[4] = {}; bf16x8 qr[8];
  const TQ* Qw = Qb + (long)(wid * QBLK + r32) * LDQ + hi * 8;
#pragma unroll
  for (int d0 = 0; d0 < 8; ++d0) qr[d0] = SQ::tobf(SQ::ld8(Qw + d0 * 16));
  const int sr = tid >> 4, sc = (tid & 15) * 8, vst0 = v_st(sr, sc), vst1 = v_st(32 + sr, sc);
  const int vb0 = (int)(uintptr_t)V_lds + v_rd_base(lane);
  struct { typename St::T vs0, vs1, ks0, ks1; } sr_[SDEPTH];
#define SLOAD(i, k0) do { sr_[i].vs0 = St::ld8(&Vh[(long)((k0) + sr) * LDK + sc]); sr_[i].vs1 = St::ld8(&Vh[(long)((k0) + 32 + sr) * LDK + sc]); \
    sr_[i].ks0 = St::ld8(&Kh[(long)((k0) + sr) * LDK + sc]); sr_[i].ks1 = St::ld8(&Kh[(long)((k0) + 32 + sr) * LDK + sc]); } while (0)
#define SWRITE(b, i) do { *(bf16x8*)((char*)V_lds + (b) * SHM_V + vst0) = St::tobf(sr_[i].vs0);          \
    *(bf16x8*)((char*)V_lds + (b) * SHM_V + vst1) = St::tobf(sr_[i].vs1); int kc = sc * 2;               \
    *(bf16x8*)((char*)K_lds + (b) * SHM_K + KSWZ(sr, kc)) = St::tobf(sr_[i].ks0);                       \
    *(bf16x8*)((char*)K_lds + (b) * SHM_K + KSWZ(32 + sr, kc)) = St::tobf(sr_[i].ks1); } while (0)
#define SWAIT() do { if constexpr (SDEPTH == 2) asm volatile("s_waitcnt vmcnt(4)" ::: "memory"); else asm volatile("s_waitcnt vmcnt(0)" ::: "memory"); } while (0)
#define RESC(a) do { if (__any((a) < 1.f)) { if (hi == 0) al_l[r32] = (a); asm volatile("s_waitcnt lgkmcnt(0)" ::: "memory"); \
    for (int d = 0; d < 4; ++d) for (int r = 0; r < 16; ++r) o[d][r] *= al_l[crow(r, hi)]; } } while (0)
  f32x16 pA0, pA1, pB0, pB1; float mnA, mnB, alA, alB; bf16x8 pa0, pa1, pa2, pa3; const int NT = seq / KVBLK;
  constexpr int SE = 0, SO = SDEPTH - 1;
  SLOAD(SE, 0); asm volatile("s_waitcnt vmcnt(0)" ::: "memory"); SWRITE(0, SE); __syncthreads();
  qkt(pA0, pA1, K_lds, qr, r32, hi); partialSM(pA0, pA1, m_reg, mnA, alA);
  SLOAD(SO, KVBLK); if constexpr (SDEPTH == 2) { if (2 < NT) SLOAD(SE, 2 * KVBLK); }
  SWAIT(); SWRITE(1, SO); __syncthreads();
  for (int j = 1; j + 1 < NT; j += 2) {
    SBAR(); qkt(pB0, pB1, (bf16*)((char*)K_lds + SHM_K), qr, r32, hi);
    finishSM(pA0, pA1, alA, l_reg, pa0, pa1, pa2, pa3); SBAR();
    SLOAD(SO, (j + SDEPTH) * KVBLK); SBAR();
    pv_d0(o, vb0, pa0, pa1, pa2, pa3); partialSM(pB0, pB1, m_reg, mnB, alB);
    __syncthreads(); SWAIT(); SWRITE(0, SE);
    RESC(alB); __syncthreads();
    SBAR(); qkt(pA0, pA1, K_lds, qr, r32, hi);
    finishSM(pB0, pB1, alB, l_reg, pa0, pa1, pa2, pa3); SBAR();
    if (SDEPTH == 1 || j + 3 < NT) SLOAD(SE, (j + 1 + SDEPTH) * KVBLK); SBAR();
    pv_d0(o, vb0 + (int)SHM_V, pa0, pa1, pa2, pa3); partialSM(pA0, pA1, m_reg, mnA, alA);
    __syncthreads(); SWAIT(); SWRITE(1, SO);
    RESC(alA); __syncthreads();
  }
  SBAR(); qkt(pB0, pB1, (bf16*)((char*)K_lds + SHM_K), qr, r32, hi);
  finishSM(pA0, pA1, alA, l_reg, pa0, pa1, pa2, pa3); SBAR();
  pv_d0(o, vb0, pa0, pa1, pa2, pa3); partialSM(pB0, pB1, m_reg, mnB, alB);
  __syncthreads(); RESC(alB);
  finishSM(pB0, pB1, alB, l_reg, pa0, pa1, pa2, pa3); SBAR();
  pv_d0(o, vb0 + (int)SHM_V, pa0, pa1, pa2, pa3);
  if (hi == 0) li_l[r32] = l_reg; asm volatile("s_waitcnt lgkmcnt(0)" ::: "memory");
  float rli[16];
#pragma unroll
  for (int r = 0; r < 16; ++r) rli[r] = __builtin_amdgcn_rcpf(li_l[crow(r, hi)]);
  bf16* Ow = Ob + (long)(wid * QBLK) * LDO;
#pragma unroll
  for (int r = 0; r < 16; ++r) { int orow = crow(r, hi);
    for (int d0 = 0; d0 < 4; ++d0) Ow[(long)orow * LDO + d0 * 32 + r32] = __float2bfloat16(o[d0][r] * rli[r]); }
#undef SLOAD
#undef SWRITE
#undef SWAIT
#undef RESC
}

#undef KSWZ
#undef SBAR
}
constexpr size_t MX_CL = 0;
constexpr size_t MX_CP = 36 * MiB;
constexpr size_t MX_NL = 72 * MiB;
constexpr size_t MX_NP = 73 * MiB;
constexpr size_t MX_ST = 74 * MiB;
constexpr size_t MX_SP = 75 * MiB;
constexpr size_t MX_GQ = 76 * MiB, MX_GK = 94 * MiB, MX_GV = 112 * MiB;
constexpr size_t MX_GG = 130 * MiB, MX_GB = 131 * MiB;
constexpr size_t MX_GD1 = 132 * MiB;
constexpr size_t GD1_ITEM = 73728;
constexpr size_t MX_GE = 294 * MiB;
static_assert(MX_GD1 + (size_t)2304 * GD1_ITEM <= MX_GE && WS_MIX + MX_GE + 2304 * 128 <= WS_END, "mixer scratch map");

typedef float f32x4m __attribute__((ext_vector_type(4)));
#define MFMA16(a, b, c) __builtin_amdgcn_mfma_f32_16x16x32_bf16((a), (b), (c), 0, 0, 0)
__device__ __forceinline__ bf16x8 lds_frag(const LAS unsigned char* base, int stride, int row0, int kb, int lane) {
    return *(const LAS bf16x8*)(base + (row0 + (lane & 15)) * stride + kb + (lane >> 4) * 16);
}
__device__ __forceinline__ float gelu_tanh(float x) { const float y = 0.7978845608028654f * (x + 0.044715f * x * x * x); const float t = 1.0f - 2.0f / (1.0f + __expf(2.0f * y)); return 0.5f * x * (1.0f + t); }
__device__ __forceinline__ float logsigmoid1(float x) { return fminf(x, 0.f) - log1pf(__expf(-fabsf(x))); }
__device__ __forceinline__ float softplus1(float x) { return fmaxf(x, 0.f) + log1pf(__expf(-fabsf(x))); }
__device__ __forceinline__ int perm32p(int jl) { return 8 * ((jl & 15) >> 2) + 4 * (jl >> 4) + (jl & 3); }

__device__ __forceinline__ float wscan_sum_f(float v, int lane) {
#pragma unroll
    for (int o = 1; o < 64; o <<= 1) { const float t = __shfl_up(v, o); if (lane >= o) v += t; }
    return v;
}
__device__ __forceinline__ float wscan_sum_b(float v, int lane) {
#pragma unroll
    for (int o = 1; o < 64; o <<= 1) { const float t = __shfl_down(v, o); if (lane + o < 64) v += t; }
    return v;
}
__device__ __forceinline__ float wscan_max_f(float v, int lane) {
#pragma unroll
    for (int o = 1; o < 64; o <<= 1) { const float t = __shfl_up(v, o); if (lane >= o) v = fmaxf(v, t); }
    return v;
}
__device__ __forceinline__ float wscan_max_b(float v, int lane) {
#pragma unroll
    for (int o = 1; o < 64; o <<= 1) { const float t = __shfl_down(v, o); if (lane + o < 64) v = fmaxf(v, t); }
    return v;
}
__device__ __forceinline__ void phase_attn_prep(Frame& F, int l, bool last) {
    const bf16* Z = (const bf16*)(F.ws + WS_Z); bf16* QA = (bf16*)(F.ws + WS_QA); bf16* KC = (bf16*)(F.ws + WS_KC); bf16* VC = (bf16*)(F.ws + WS_VC);
    const float* RC = (const float*)(F.ws + WS_ROPE); const float* RS = RC + 96 * 32;
    const float* gq = F.in[I_ATQN] + l * 128; const float* gk = F.in[I_ATKN] + l * 128;
    const int gw = blockIdx.x * NWAVES + F.wave, NGW = F.G * NWAVES;
    const int half = F.lane >> 5, i = F.lane & 31, da = 64 * half + i, db = da + 32;
    const float gqa = gq[da], gqb = gq[db], gka = gk[da], gkb = gk[db];
    for (int row = gw; row < MT; row += NGW) {
        const bool isc = row >= ML; const int b = isc ? (row - ML) / CTXL : row / SEQ, t = isc ? (row - ML) % CTXL : row % SEQ;
        const bf16* zr = Z + (size_t)row * ZLD;
        float cs = 1.f, sn = 0.f;
        if (!isc) { const int pos = half ? 32 + (t & 63) : (t >> 6); cs = RC[pos * 32 + i]; sn = RS[pos * 32 + i]; }
        if (!(isc && last)) {
#pragma unroll
            for (int h = 0; h < 4; ++h) {
                const float a = bf1(zr[ZC_ATQ + h * 128 + da]), bb = bf1(zr[ZC_ATQ + h * 128 + db]);
                const float rs = 1.0f / sqrtf(wave_sum(a * a + bb * bb) * (1.0f / 128.0f) + EPS);
                const float ya = a * rs * gqa, yb = bb * rs * gqb;
                QA[(size_t)row * 512 + h * 128 + da] = f2bf1(ya * cs - yb * sn); QA[(size_t)row * 512 + h * 128 + db] = f2bf1(yb * cs + ya * sn);
            }
        }
        const size_t krow = (size_t)b * 2304 + (isc ? t : 256 + t);
#pragma unroll
        for (int h = 0; h < 2; ++h) {
            const float a = bf1(zr[ZC_ATK + h * 128 + da]), bb = bf1(zr[ZC_ATK + h * 128 + db]);
            const float rs = 1.0f / sqrtf(wave_sum(a * a + bb * bb) * (1.0f / 128.0f) + EPS);
            const float ya = a * rs * gka, yb = bb * rs * gkb;
            KC[krow * 256 + h * 128 + da] = f2bf1(ya * cs - yb * sn); KC[krow * 256 + h * 128 + db] = f2bf1(yb * cs + ya * sn);
        }
        *(GAS v2u*)(VC + krow * 256 + 4 * F.lane) = *(const GAS v2u*)(zr + ZC_ATV + 4 * F.lane);
    }
}
__device__ __forceinline__ void attn_item(Frame& F, int it) {
    const attn::bf16* QA = (const attn::bf16*)(F.ws + WS_QA); const attn::bf16* KC = (const attn::bf16*)(F.ws + WS_KC); const attn::bf16* VC = (const attn::bf16*)(F.ws + WS_VC);
    attn::bf16* Y3 = (attn::bf16*)(F.ws + WS_Y) + (size_t)3 * MT * 512;
    int h, b, seq; size_t r0;
    if (it < 256) { const int qb = it & 7; h = (it >> 3) & 3; b = it >> 5; r0 = (size_t)b * SEQ + qb * 256; seq = 2304; }
    else { const int j = it - 256; h = j & 3; b = j >> 2; r0 = (size_t)ML + b * CTXL; seq = 256; }
    attn::attn_dense_body<attn::bf16>(QA + r0 * 512 + h * 128, KC + (size_t)b * 2304 * 256 + (h >> 1) * 128, VC + (size_t)b * 2304 * 256 + (h >> 1) * 128, Y3 + r0 * 512 + h * 128, seq, (char*)F.lds + RING_OFF);
    __syncthreads();
}
__device__ __forceinline__ void phase_spatial(Frame& F, int l, bool last) {
    const bf16* Z = (const bf16*)(F.ws + WS_Z); bf16* Y0 = (bf16*)(F.ws + WS_Y);
    LAS unsigned char* Wl = F.lds + RING_OFF; LAS unsigned char* Vt = Wl + 34816;
    const int nchunk = last ? ML / 128 : MT / 128;
    const int tid = F.tid, r = tid >> 2, q = tid & 3;
    for (int it = F.G - 1 - (int)blockIdx.x; it < nchunk * 4; it += F.G) {
        const int ch = it >> 2, g = it & 3; const size_t row0 = (size_t)ch * 128;
        const bf16* zv = Z + (row0 + r) * ZLD + ZC_SGV;
        float ss = 0.f;
#pragma unroll 4
        for (int j = 0; j < 16; ++j) { const v4u w = *(const GAS v4u*)(zv + q * 128 + j * 8);
            const float e0 = gelu_tanh(bflo(w.x)), e1 = gelu_tanh(bfhi(w.x)), e2 = gelu_tanh(bflo(w.y)), e3 = gelu_tanh(bfhi(w.y)), e4 = gelu_tanh(bflo(w.z)), e5 = gelu_tanh(bfhi(w.z)), e6 = gelu_tanh(bflo(w.w)), e7 = gelu_tanh(bfhi(w.w));
            ss += (e0 * e0 + e1 * e1) + (e2 * e2 + e3 * e3) + (e4 * e4 + e5 * e5) + (e6 * e6 + e7 * e7); }
        ss += __shfl_xor(ss, 1); ss += __shfl_xor(ss, 2);
        const float rstd = 1.0f / sqrtf(ss * (1.0f / 512.0f) + EPS);
        const float* gn = F.in[I_SGN] + l * 512 + g * 128 + q * 32;
#pragma unroll
        for (int j = 0; j < 4; ++j) { const v4u w = *(const GAS v4u*)(zv + g * 128 + q * 32 + j * 8);
            const float e[8] = {gelu_tanh(bflo(w.x)), gelu_tanh(bfhi(w.x)), gelu_tanh(bflo(w.y)), gelu_tanh(bfhi(w.y)), gelu_tanh(bflo(w.z)), gelu_tanh(bfhi(w.z)), gelu_tanh(bflo(w.w)), gelu_tanh(bfhi(w.w))};
#pragma unroll
            for (int k = 0; k < 8; ++k) { const int c = q * 32 + j * 8 + k; *(LAS bf16*)(Vt + c * 272 + r * 2) = f2bf1(e[k] * rstd * gn[j * 8 + k]); } }
        const float* wg = F.in[I_SGW] + ((size_t)(l * 4 + g) * 128 + r) * 128 + q * 32;
#pragma unroll
        for (int j = 0; j < 4; ++j) { const f32x4 a = *(const f32x4*)(wg + j * 8), b = *(const f32x4*)(wg + j * 8 + 4);
            v4u o; o.x = pk2(a.x, a.y); o.y = pk2(a.z, a.w); o.z = pk2(b.x, b.y); o.w = pk2(b.z, b.w);
            *(LAS v4u*)(Wl + r * 272 + (q * 32 + j * 8) * 2) = o; }
        __syncthreads();
        const int wr = F.wave >> 1, wc = F.wave & 1;
        f32x4 acc[2][4];
#pragma unroll
        for (int mi = 0; mi < 2; ++mi)
#pragma unroll
            for (int ni = 0; ni < 4; ++ni) acc[mi][ni] = (f32x4){0.f, 0.f, 0.f, 0.f};
#pragma unroll
        for (int ks = 0; ks < 4; ++ks) {
            bf16x8 a[2], b[4];
#pragma unroll
            for (int mi = 0; mi < 2; ++mi) a[mi] = lds_frag(Wl, 272, 32 * wr + 16 * mi, ks * 64, F.lane);
#pragma unroll
            for (int ni = 0; ni < 4; ++ni) b[ni] = lds_frag(Vt, 272, 64 * wc + 16 * ni, ks * 64, F.lane);
#pragma unroll
            for (int mi = 0; mi < 2; ++mi)
#pragma unroll
                for (int ni = 0; ni < 4; ++ni) acc[mi][ni] = MFMA16(a[mi], b[ni], acc[mi][ni]);
        }
        const float* bs = F.in[I_SGB] + (l * 4 + g) * 128;
#pragma unroll
        for (int mi = 0; mi < 2; ++mi)
#pragma unroll
            for (int rr = 0; rr < 4; ++rr) { const int t = 32 * wr + 16 * mi + 4 * (F.lane >> 4) + rr; const float bias = bs[t];
#pragma unroll
                for (int ni = 0; ni < 4; ++ni) { const int c = g * 128 + 64 * wc + 16 * ni + (F.lane & 15);
                    const float u = gelu_tanh(bf1(Z[(row0 + t) * ZLD + ZC_SGU + c]));
                    Y0[(row0 + t) * 512 + c] = f2bf1(u * (acc[mi][ni][rr] + bias)); } }
        __syncthreads();
    }
}
__device__ __forceinline__ void ml_slot(int chain, int k, int& rowbase, int& h, int& dir) {
    const int b = chain >> 3; h = (chain >> 1) & 3; dir = chain & 1;
    if (k < 2) { const int j = dir ? 1 - k : k; rowbase = ML + b * CTXL + 128 * j; }
    else { const int n = k - 2, j = dir ? 15 - n : n; rowbase = b * SEQ + 128 * j; }
}
__device__ __forceinline__ void ml_gates(Frame& F, int l, int rowbase, int h, int dir, LAS float* li, LAS float* lf, LAS float* bc) {
    const float* ZS = (const float*)(F.ws + WS_ZS); const float* bias = F.in[I_MLIFB] + l * 16;
    float s = 0.f;
    if (F.tid < 128) { const float* zr = ZS + (size_t)(rowbase + F.tid) * 32;
        li[F.tid] = zr[dir * 4 + h] + bias[dir * 4 + h];
        const float f = logsigmoid1(zr[(2 + dir) * 4 + h] + bias[(2 + dir) * 4 + h]);
        s = dir ? wscan_sum_b(f, F.lane) : wscan_sum_f(f, F.lane);
        if (dir == 0 && F.tid == 63) lf[0] = s;
        if (dir == 1 && F.tid == 64) lf[0] = s; }
    __syncthreads();
    if (F.tid < 128) { if ((dir == 0 && F.tid >= 64) || (dir == 1 && F.tid < 64)) s += lf[0]; bc[F.tid] = s; }
    __syncthreads();
}
__device__ __forceinline__ void phase_ml1(Frame& F, int l) {
    const bf16* Z = (const bf16*)(F.ws + WS_Z);
    bf16* CL = (bf16*)(F.ws + WS_MIX + MX_CL); float* NL = (float*)(F.ws + WS_MIX + MX_NL); float* ST = (float*)(F.ws + WS_MIX + MX_ST);
    LAS unsigned char* kT = F.lds + RING_OFF; LAS unsigned char* vT = kT + 34816;
    LAS float* li = (LAS float*)(F.lds + RING_OFF + 69632); LAS float* lf = li + 128; LAS float* bc = lf + 128; LAS float* wg = bc + 128; LAS float* red = wg + 128;
    const int tid = F.tid, tau = tid >> 2, q = tid & 3;
    for (int it = blockIdx.x; it < 64 * 18; it += F.G) {
        const int chain = it / 18, k = it % 18; int rowbase, h, dir; ml_slot(chain, k, rowbase, h, dir);
        ml_gates(F, l, rowbase, h, dir, li, lf, bc);
        const float bend = dir ? bc[0] : bc[127];
        if (tid < 128) wg[tid] = bend - bc[tid] + li[tid];
        __syncthreads();
        if (tid < 64) { float m = fmaxf(wg[tid], wg[tid + 64]);
#pragma unroll
            for (int o = 1; o < 64; o <<= 1) m = fmaxf(m, __shfl_xor(m, o));
            if (tid == 0) red[0] = m; }
        __syncthreads();
        const float mloc = red[0];
        __syncthreads();
        if (tid < 128) wg[tid] = __expf(wg[tid] - mloc);
        __syncthreads();
        { const bf16* zk = Z + (size_t)(rowbase + tau) * ZLD + ZC_MLK + h * 128 + q * 32; const bf16* zv = Z + (size_t)(rowbase + tau) * ZLD + ZC_MLV + h * 128 + q * 32; const float w = wg[tau];
#pragma unroll
          for (int j = 0; j < 4; ++j) { const v4u a = *(const GAS v4u*)(zk + j * 8), b = *(const GAS v4u*)(zv + j * 8);
              const float ka[8] = {bflo(a.x), bfhi(a.x), bflo(a.y), bfhi(a.y), bflo(a.z), bfhi(a.z), bflo(a.w), bfhi(a.w)};
              const float va[8] = {bflo(b.x), bfhi(b.x), bflo(b.y), bfhi(b.y), bflo(b.z), bfhi(b.z), bflo(b.w), bfhi(b.w)};
#pragma unroll
              for (int c = 0; c < 8; ++c) { const int col = q * 32 + j * 8 + c;
                  *(LAS bf16*)(kT + col * 272 + tau * 2) = f2bf1(ka[c] * 0.08838834764831845f);
                  *(LAS bf16*)(vT + col * 272 + tau * 2) = f2bf1(va[c] * w); } } }
        __syncthreads();
        const int wr = F.wave >> 1, wc = F.wave & 1;
        f32x4 acc[2][4];
#pragma unroll
        for (int mi = 0; mi < 2; ++mi)
#pragma unroll
            for (int ni = 0; ni < 4; ++ni) acc[mi][ni] = (f32x4){0.f, 0.f, 0.f, 0.f};
#pragma unroll
        for (int ks = 0; ks < 4; ++ks) {
            bf16x8 a[2], b[4];
#pragma unroll
            for (int mi = 0; mi < 2; ++mi) a[mi] = lds_frag(vT, 272, 32 * wr + 16 * mi, ks * 64, F.lane);
#pragma unroll
            for (int ni = 0; ni < 4; ++ni) b[ni] = lds_frag(kT, 272, 64 * wc + 16 * ni, ks * 64, F.lane);
#pragma unroll
            for (int mi = 0; mi < 2; ++mi)
#pragma unroll
                for (int ni = 0; ni < 4; ++ni) acc[mi][ni] = MFMA16(a[mi], b[ni], acc[mi][ni]);
        }
        bf16* cl = CL + (size_t)it * 16384;
#pragma unroll
        for (int mi = 0; mi < 2; ++mi)
#pragma unroll
            for (int rr = 0; rr < 4; ++rr) { const int e = 32 * wr + 16 * mi + 4 * (F.lane >> 4) + rr;
#pragma unroll
                for (int ni = 0; ni < 4; ++ni) cl[e * 128 + 64 * wc + 16 * ni + (F.lane & 15)] = f2bf1(acc[mi][ni][rr]); }
        { float s = 0.f; const LAS bf16* kr = (const LAS bf16*)(kT + tau * 272) + q * 32;
#pragma unroll 8
          for (int t = 0; t < 32; ++t) s += wg[q * 32 + t] * bf1(kr[t]);
          s += __shfl_xor(s, 1); s += __shfl_xor(s, 2);
          if (q == 0) NL[(size_t)it * 128 + tau] = s; }
        if (tid == 0) { ST[it * 32 + 0] = mloc; ST[it * 32 + 1] = bend; }
        __syncthreads();
    }
}
__device__ __forceinline__ void phase_ml2(Frame& F, int wg0) {
    const bf16* CL = (const bf16*)(F.ws + WS_MIX + MX_CL); const float* NL = (const float*)(F.ws + WS_MIX + MX_NL); const float* ST = (const float*)(F.ws + WS_MIX + MX_ST);
    bf16* CP = (bf16*)(F.ws + WS_MIX + MX_CP); float* NP = (float*)(F.ws + WS_MIX + MX_NP); float* SP = (float*)(F.ws + WS_MIX + MX_SP);
    if ((int)blockIdx.x < wg0) return;
    const int gt = ((int)blockIdx.x - wg0) * (NWAVES * 64) + F.tid, NT = (F.G - wg0) * NWAVES * 64;
    for (int task = gt; task < 64 * 4096; task += NT) {
        const int chain = task >> 12, e4 = (task & 4095) * 4;
        v2u w[18]; float ml[18], be[18];
#pragma unroll
        for (int k = 0; k < 18; ++k) { const int it = chain * 18 + k; w[k] = *(const GAS v2u*)(CL + (size_t)it * 16384 + e4); ml[k] = ST[it * 32 + 0]; be[k] = ST[it * 32 + 1]; }
        float c0 = 0.f, c1 = 0.f, c2 = 0.f, c3 = 0.f, m = 0.f;
#pragma unroll
        for (int k = 0; k < 18; ++k) { const int it = chain * 18 + k;
            v2u o; o.x = pk2(c0, c1); o.y = pk2(c2, c3); *(GAS v2u*)(CP + (size_t)it * 16384 + e4) = o;
            const float mn = fmaxf(be[k] + m, ml[k]), sp = __expf(be[k] + m - mn), sl = __expf(ml[k] - mn);
            c0 = sp * c0 + sl * bflo(w[k].x); c1 = sp * c1 + sl * bfhi(w[k].x); c2 = sp * c2 + sl * bflo(w[k].y); c3 = sp * c3 + sl * bfhi(w[k].y); m = mn; }
    }
    for (int task = gt; task < 64 * 128; task += NT) {
        const int chain = task >> 7, d = task & 127; float n = 0.f, m = 0.f;
        float nl[18], ml[18], be[18];
#pragma unroll
        for (int k = 0; k < 18; ++k) { const int it = chain * 18 + k; nl[k] = NL[(size_t)it * 128 + d]; ml[k] = ST[it * 32 + 0]; be[k] = ST[it * 32 + 1]; }
#pragma unroll
        for (int k = 0; k < 18; ++k) { const int it = chain * 18 + k;
            NP[(size_t)it * 128 + d] = n;
            if (d == 0) SP[it * 32] = m;
            const float mn = fmaxf(be[k] + m, ml[k]), sp = __expf(be[k] + m - mn), sl = __expf(ml[k] - mn);
            n = sp * n + sl * nl[k]; m = mn; }
    }
}
__device__ __forceinline__ void ml3_item(Frame& F, int l, int it) {
    const bf16* Z = (const bf16*)(F.ws + WS_Z); bf16* Y1 = (bf16*)(F.ws + WS_Y) + (size_t)MT * 512;
    const bf16* CL = (const bf16*)(F.ws + WS_MIX + MX_CP); const float* NL = (const float*)(F.ws + WS_MIX + MX_NP); const float* ST = (const float*)(F.ws + WS_MIX + MX_SP);
    LAS unsigned char* qs = F.lds + RING_OFF; LAS unsigned char* ks = qs + 34816; LAS unsigned char* vT = ks + 34816;
    LAS float* li = (LAS float*)(F.lds + RING_OFF + 104448); LAS float* lf = li + 128; LAS float* bc = lf + 128; LAS float* cv = bc + 128; LAS float* Mt = cv + 128;
    LAS float* inter = Mt + 128; LAS float* rden = inter + 128; LAS float* emt = rden + 128; LAS float* rowss = emt + 128; LAS float* npv = rowss + 256;
    const int tid = F.tid, tau = tid >> 2, q = tid & 3, lane = F.lane, g4 = lane >> 4, l15 = lane & 15;
    {
        int b, h, j, rowbase, nch;
        if (it < 512) { b = it >> 6; h = (it >> 4) & 3; j = it & 15; rowbase = b * SEQ + 128 * j; nch = 16; }
        else { const int r = it - 512; b = r >> 3; h = (r >> 1) & 3; j = r & 1; rowbase = ML + b * CTXL + 128 * j; nch = 2; }
        { const bf16* zq = Z + (size_t)(rowbase + tau) * ZLD + ZC_MLQ + h * 128 + q * 32; const bf16* zk = Z + (size_t)(rowbase + tau) * ZLD + ZC_MLK + h * 128 + q * 32;
          const bf16* zv = Z + (size_t)(rowbase + tau) * ZLD + ZC_MLV + h * 128 + q * 32;
#pragma unroll
          for (int jj = 0; jj < 4; ++jj) { const v4u a = *(const GAS v4u*)(zq + jj * 8), kk = *(const GAS v4u*)(zk + jj * 8), vv = *(const GAS v4u*)(zv + jj * 8);
              *(LAS v4u*)(qs + tau * 272 + (q * 32 + jj * 8) * 2) = a;
              v4u ko; const float s = 0.08838834764831845f;
              ko.x = pk2(bflo(kk.x) * s, bfhi(kk.x) * s); ko.y = pk2(bflo(kk.y) * s, bfhi(kk.y) * s); ko.z = pk2(bflo(kk.z) * s, bfhi(kk.z) * s); ko.w = pk2(bflo(kk.w) * s, bfhi(kk.w) * s);
              *(LAS v4u*)(ks + tau * 272 + (q * 32 + jj * 8) * 2) = ko;
              const unsigned vw[4] = {vv.x, vv.y, vv.z, vv.w};
#pragma unroll
              for (int c = 0; c < 4; ++c) { const int col = q * 32 + jj * 8 + 2 * c;
                  *(LAS bf16*)(vT + col * 272 + tau * 2) = (bf16)(vw[c] & 0xffffu); *(LAS bf16*)(vT + (col + 1) * 272 + tau * 2) = (bf16)(vw[c] >> 16); } } }
        __syncthreads();
        const int wr = F.wave >> 1, wc = F.wave & 1;
        f32x4 accS[2][4];
#pragma unroll
        for (int mi = 0; mi < 2; ++mi)
#pragma unroll
            for (int ni = 0; ni < 4; ++ni) accS[mi][ni] = (f32x4){0.f, 0.f, 0.f, 0.f};
#pragma unroll
        for (int kk = 0; kk < 4; ++kk) {
            bf16x8 a[2], bq[4];
#pragma unroll
            for (int mi = 0; mi < 2; ++mi) a[mi] = lds_frag(ks, 272, 32 * wr + 16 * mi, kk * 64, lane);
#pragma unroll
            for (int ni = 0; ni < 4; ++ni) bq[ni] = lds_frag(qs, 272, 64 * wc + 16 * ni, kk * 64, lane);
#pragma unroll
            for (int mi = 0; mi < 2; ++mi)
#pragma unroll
                for (int ni = 0; ni < 4; ++ni) accS[mi][ni] = MFMA16(a[mi], bq[ni], accS[mi][ni]);
        }
        f32x4 hsum[2][4];
#pragma unroll
        for (int mi = 0; mi < 2; ++mi)
#pragma unroll
            for (int ni = 0; ni < 4; ++ni) hsum[mi][ni] = (f32x4){0.f, 0.f, 0.f, 0.f};
        for (int dir = 0; dir < 2; ++dir) {
            const int n = dir ? nch - 1 - j : j, slot = (it < 512) ? 2 + n : n, chain = (b * 4 + h) * 2 + dir, sit = chain * 18 + slot;
            __syncthreads();
            ml_gates(F, l, rowbase, h, dir, li, lf, bc);
            const float mprev = ST[sit * 32];
            if (tid < 128) { cv[tid] = li[tid] - bc[tid]; npv[tid] = NL[(size_t)sit * 128 + tid]; }
            __syncthreads();
            float mx = -3.0e38f;
            if (tid < 128) { mx = dir ? wscan_max_b(cv[tid], lane) : wscan_max_f(cv[tid], lane);
                if (dir == 0 && tid == 63) lf[1] = mx; if (dir == 1 && tid == 64) lf[1] = mx; }
            __syncthreads();
            if (tid < 128) { if ((dir == 0 && tid >= 64) || (dir == 1 && tid < 64)) mx = fmaxf(mx, lf[1]);
                const float M = fmaxf(mx, mprev); Mt[tid] = M; inter[tid] = __expf(mprev - M); emt[tid] = __expf(-(bc[tid] + M)); }
            __syncthreads();
#pragma unroll
            for (int mi = 0; mi < 2; ++mi)
#pragma unroll
                for (int ni = 0; ni < 4; ++ni) { const int t = 64 * wc + 16 * ni + l15, s0 = 32 * wr + 16 * mi + 4 * g4; const float M = Mt[t];
                    float p[4];
#pragma unroll
                    for (int rr = 0; rr < 4; ++rr) { const int s = s0 + rr; const bool ok = dir ? (s >= t) : (s <= t); p[rr] = ok ? __expf(cv[s] - M) * accS[mi][ni][rr] : 0.f; }
                    v2u o; o.x = pk2(p[0], p[1]); o.y = pk2(p[2], p[3]); *(LAS v2u*)(ks + t * 272 + s0 * 2) = o; }
            __syncthreads();
            { float sp = 0.f, sn = 0.f; const LAS bf16* pr = (const LAS bf16*)(ks + tau * 272) + q * 32; const LAS bf16* qr = (const LAS bf16*)(qs + tau * 272) + q * 32;
#pragma unroll 8
              for (int c = 0; c < 32; ++c) { sp += bf1(pr[c]); sn += npv[q * 32 + c] * bf1(qr[c]); }
              sp += __shfl_xor(sp, 1); sp += __shfl_xor(sp, 2); sn += __shfl_xor(sn, 1); sn += __shfl_xor(sn, 2);
              if (q == 0) { const float den = sp + inter[tau] * sn; rden[tau] = 1.0f / fmaxf(fabsf(den), emt[tau]); } }
            f32x4 acc[2][4];
#pragma unroll
            for (int mi = 0; mi < 2; ++mi)
#pragma unroll
                for (int ni = 0; ni < 4; ++ni) acc[mi][ni] = (f32x4){0.f, 0.f, 0.f, 0.f};
            const bf16* cp = CL + (size_t)sit * 16384;
#pragma unroll
            for (int kk = 0; kk < 4; ++kk) {
                bf16x8 a[2], bb[4];
#pragma unroll
                for (int mi = 0; mi < 2; ++mi) a[mi] = lds_frag(qs, 272, 32 * wr + 16 * mi, kk * 64, lane);
#pragma unroll
                for (int ni = 0; ni < 4; ++ni) bb[ni] = *(const GAS bf16x8*)(cp + (64 * wc + 16 * ni + l15) * 128 + kk * 32 + g4 * 8);
#pragma unroll
                for (int mi = 0; mi < 2; ++mi)
#pragma unroll
                    for (int ni = 0; ni < 4; ++ni) acc[mi][ni] = MFMA16(a[mi], bb[ni], acc[mi][ni]);
            }
#pragma unroll
            for (int mi = 0; mi < 2; ++mi)
#pragma unroll
                for (int rr = 0; rr < 4; ++rr) { const float sc = inter[32 * wr + 16 * mi + 4 * g4 + rr];
#pragma unroll
                    for (int ni = 0; ni < 4; ++ni) acc[mi][ni][rr] *= sc; }
#pragma unroll
            for (int kk = 0; kk < 4; ++kk) {
                bf16x8 a[2], bb[4];
#pragma unroll
                for (int mi = 0; mi < 2; ++mi) a[mi] = lds_frag(ks, 272, 32 * wr + 16 * mi, kk * 64, lane);
#pragma unroll
                for (int ni = 0; ni < 4; ++ni) bb[ni] = lds_frag(vT, 272, 64 * wc + 16 * ni, kk * 64, lane);
#pragma unroll
                for (int mi = 0; mi < 2; ++mi)
#pragma unroll
                    for (int ni = 0; ni < 4; ++ni) acc[mi][ni] = MFMA16(a[mi], bb[ni], acc[mi][ni]);
            }
            __syncthreads();
#pragma unroll
            for (int mi = 0; mi < 2; ++mi)
#pragma unroll
                for (int rr = 0; rr < 4; ++rr) { const float sc = rden[32 * wr + 16 * mi + 4 * g4 + rr];
#pragma unroll
                    for (int ni = 0; ni < 4; ++ni) hsum[mi][ni][rr] += acc[mi][ni][rr] * sc; }
        }
        __syncthreads();
#pragma unroll
        for (int mi = 0; mi < 2; ++mi)
#pragma unroll
            for (int rr = 0; rr < 4; ++rr) { float s = 0.f;
#pragma unroll
                for (int ni = 0; ni < 4; ++ni) s += hsum[mi][ni][rr] * hsum[mi][ni][rr];
                s += __shfl_xor(s, 1); s += __shfl_xor(s, 2); s += __shfl_xor(s, 4); s += __shfl_xor(s, 8);
                if (l15 == 0) rowss[wc * 128 + 32 * wr + 16 * mi + 4 * g4 + rr] = s; }
        __syncthreads();
        const float* gn = F.in[I_MLN] + l * 512 + h * 128;
#pragma unroll
        for (int mi = 0; mi < 2; ++mi)
#pragma unroll
            for (int rr = 0; rr < 4; ++rr) { const int t = 32 * wr + 16 * mi + 4 * g4 + rr; const float rs = 1.0f / sqrtf((rowss[t] + rowss[128 + t]) * (1.0f / 128.0f) + EPS);
#pragma unroll
                for (int ni = 0; ni < 4; ++ni) { const int e = 64 * wc + 16 * ni + l15;
                    const float og = sigm1(bf1(Z[(size_t)(rowbase + t) * ZLD + ZC_MLO + h * 128 + e]));
                    Y1[(size_t)(rowbase + t) * 512 + h * 128 + e] = f2bf1(og * hsum[mi][ni][rr] * rs * gn[e]); } }
        __syncthreads();
    }
}
__device__ __forceinline__ void gd_slot(int chain, int k, int& seqbase, int& T, int& n, int& h, int& dir) {
    const int b = chain >> 3; h = (chain >> 1) & 3; dir = chain & 1;
    if (k < 4) { seqbase = ML + b * CTXL; T = CTXL; n = k; } else { seqbase = b * SEQ; T = SEQ; n = k - 4; }
}
__device__ __forceinline__ void phase_gd0(Frame& F, int l, bool last) {
    const bf16* Z = (const bf16*)(F.ws + WS_Z); const float* ZS = (const float*)(F.ws + WS_ZS);
    bf16* GQ = (bf16*)(F.ws + WS_MIX + MX_GQ); bf16* GK = (bf16*)(F.ws + WS_MIX + MX_GK); bf16* GV = (bf16*)(F.ws + WS_MIX + MX_GV);
    float* GG = (float*)(F.ws + WS_MIX + MX_GG); float* GB = (float*)(F.ws + WS_MIX + MX_GB);
    const float* cw = F.in[I_GDCONV] + (size_t)l * 3 * 1536;
    const int gw = blockIdx.x * NWAVES + F.wave, NGW = F.G * NWAVES, c8 = F.lane * 8;
    for (int row = gw; row < MT; row += NGW) {
        const bool isc = row >= ML; const int t = isc ? (row - ML) % CTXL : row % SEQ, T = isc ? CTXL : SEQ;
        const bool hp = t > 0, hn = t < T - 1;
#pragma unroll
        for (int seg = 0; seg < 3; ++seg) {
            if (seg == 0 && isc && last) continue;
            const int zc = (seg == 0 ? ZC_GDQ : seg == 1 ? ZC_GDK : ZC_GDV) + c8;
            const bf16* zr = Z + (size_t)row * ZLD + zc;
            const v4u x1 = *(const GAS v4u*)zr;
            v4u x0 = (v4u){0u, 0u, 0u, 0u}, x2 = (v4u){0u, 0u, 0u, 0u};
            if (hp) x0 = *(const GAS v4u*)(zr - ZLD);
            if (hn) x2 = *(const GAS v4u*)(zr + ZLD);
            const float* w0 = cw + seg * 512 + c8; const float* w1 = w0 + 1536; const float* w2 = w1 + 1536;
            const unsigned a0[4] = {x0.x, x0.y, x0.z, x0.w}, a1[4] = {x1.x, x1.y, x1.z, x1.w}, a2[4] = {x2.x, x2.y, x2.z, x2.w};
            float y[8]; float ss = 0.f;
#pragma unroll
            for (int j = 0; j < 4; ++j) {
                const float lo = bflo(a0[j]) * w0[2 * j] + bflo(a1[j]) * w1[2 * j] + bflo(a2[j]) * w2[2 * j];
                const float hi = bfhi(a0[j]) * w0[2 * j + 1] + bfhi(a1[j]) * w1[2 * j + 1] + bfhi(a2[j]) * w2[2 * j + 1];
                y[2 * j] = silu1(lo); y[2 * j + 1] = silu1(hi); ss += y[2 * j] * y[2 * j] + y[2 * j + 1] * y[2 * j + 1]; }
            float sc = 1.f;
            if (seg < 2) { ss += __shfl_xor(ss, 1); ss += __shfl_xor(ss, 2); ss += __shfl_xor(ss, 4); ss += __shfl_xor(ss, 8);
                sc = 1.0f / sqrtf(ss + EPS); if (seg == 0) sc *= 0.08838834764831845f; }
            v4u o; o.x = pk2(y[0] * sc, y[1] * sc); o.y = pk2(y[2] * sc, y[3] * sc); o.z = pk2(y[4] * sc, y[5] * sc); o.w = pk2(y[6] * sc, y[7] * sc);
            bf16* dst = (seg == 0 ? GQ : seg == 1 ? GK : GV) + (size_t)row * 512 + c8;
            *(GAS v4u*)dst = o;
        }
        if (F.lane < 8) {
            const int dir = F.lane >> 2, h = F.lane & 3; const float* zs = ZS + (size_t)row * 32 + 16;
            const float beta = sigm1(zs[dir * 4 + h]);
            const float g = -__expf(F.in[I_GDALOG][l * 8 + dir * 4 + h]) * softplus1(zs[(2 + dir) * 4 + h] + F.in[I_GDDTB][l * 8 + dir * 4 + h]);
            GG[((size_t)dir * MT + row) * 4 + h] = g; GB[((size_t)dir * MT + row) * 4 + h] = beta;
        }
    }
}
__device__ __forceinline__ void phase_gd1(Frame& F) {
    const bf16* GQ = (const bf16*)(F.ws + WS_MIX + MX_GQ); const bf16* GK = (const bf16*)(F.ws + WS_MIX + MX_GK); const bf16* GV = (const bf16*)(F.ws + WS_MIX + MX_GV);
    const float* GG = (const float*)(F.ws + WS_MIX + MX_GG); const float* GB = (const float*)(F.ws + WS_MIX + MX_GB);
    unsigned char* G1 = F.ws + WS_MIX + MX_GD1; float* GE = (float*)(F.ws + WS_MIX + MX_GE);
    LAS unsigned char* kl = F.lds + RING_OFF; LAS unsigned char* ql = kl + 17408; LAS unsigned char* vl = ql + 17408;
    LAS float* Mf = (LAS float*)(F.lds + RING_OFF + 52224);
    LAS unsigned char* Tl = F.lds + RING_OFF + 69632;
    LAS unsigned char* vsT = F.lds + RING_OFF + 78848; LAS unsigned char* ksT = F.lds + RING_OFF + 97280;
    LAS float* gc = (LAS float*)(F.lds + RING_OFF + 115712); LAS float* bt = gc + 64;
    const int tid = F.tid, lane = F.lane, g4 = lane >> 4, l15 = lane & 15;
    for (int it = blockIdx.x; it < 64 * 36; it += F.G) {
        const int chain = it / 36, k = it % 36; int seqbase, T, n, h, dir; gd_slot(chain, k, seqbase, T, n, h, dir);
        unsigned char* out = G1 + (size_t)it * GD1_ITEM;
        bf16* WN = (bf16*)out; bf16* QD = (bf16*)(out + 16384); bf16* KT = (bf16*)(out + 32768); bf16* UT = (bf16*)(out + 49152); bf16* QKM = (bf16*)(out + 65536);
        const int sp = tid >> 3, sc0 = (tid & 7) * 16;
        { const int tok = dir ? T - 1 - (64 * n + sp) : 64 * n + sp; const size_t off = (size_t)(seqbase + tok) * 512 + h * 128 + sc0;
          *(LAS v4u*)(kl + sp * 272 + sc0 * 2) = *(const GAS v4u*)(GK + off); *(LAS v4u*)(kl + sp * 272 + sc0 * 2 + 16) = *(const GAS v4u*)(GK + off + 8);
          *(LAS v4u*)(ql + sp * 272 + sc0 * 2) = *(const GAS v4u*)(GQ + off); *(LAS v4u*)(ql + sp * 272 + sc0 * 2 + 16) = *(const GAS v4u*)(GQ + off + 8);
          *(LAS v4u*)(vl + sp * 272 + sc0 * 2) = *(const GAS v4u*)(GV + off); *(LAS v4u*)(vl + sp * 272 + sc0 * 2 + 16) = *(const GAS v4u*)(GV + off + 8); }
        if (tid < 64) { const int tok = dir ? T - 1 - (64 * n + tid) : 64 * n + tid; const size_t gi = ((size_t)dir * MT + seqbase + tok) * 4 + h;
            gc[tid] = wscan_sum_f(GG[gi], lane); bt[tid] = GB[gi]; }
        __syncthreads();
        const float gcend = gc[63];
        { const float bj = bt[sp], bk = bj * __expf(gc[sp]);
#pragma unroll
          for (int hh = 0; hh < 2; ++hh) { const v4u vv = *(const LAS v4u*)(vl + sp * 272 + sc0 * 2 + 16 * hh), kk = *(const LAS v4u*)(kl + sp * 272 + sc0 * 2 + 16 * hh);
              const unsigned vw[4] = {vv.x, vv.y, vv.z, vv.w}, kw[4] = {kk.x, kk.y, kk.z, kk.w};
#pragma unroll
              for (int c = 0; c < 4; ++c) { const int col = sc0 + 8 * hh + 2 * c;
                  *(LAS bf16*)(vsT + col * 144 + sp * 2) = f2bf1(bflo(vw[c]) * bj); *(LAS bf16*)(vsT + (col + 1) * 144 + sp * 2) = f2bf1(bfhi(vw[c]) * bj);
                  *(LAS bf16*)(ksT + col * 144 + sp * 2) = f2bf1(bflo(kw[c]) * bk); *(LAS bf16*)(ksT + (col + 1) * 144 + sp * 2) = f2bf1(bfhi(kw[c]) * bk); } } }
        if (F.wave < 4) {
            const int i0 = 16 * F.wave; f32x4 acc[4];
#pragma unroll
            for (int ni = 0; ni < 4; ++ni) acc[ni] = (f32x4){0.f, 0.f, 0.f, 0.f};
#pragma unroll
            for (int ks = 0; ks < 4; ++ks) { const bf16x8 a = lds_frag(kl, 272, i0, ks * 64, lane);
#pragma unroll
                for (int ni = 0; ni < 4; ++ni) acc[ni] = MFMA16(a, lds_frag(kl, 272, 16 * ni, ks * 64, lane), acc[ni]); }
#pragma unroll
            for (int ni = 0; ni < 4; ++ni)
#pragma unroll
                for (int rr = 0; rr < 4; ++rr) { const int i = i0 + 4 * g4 + rr, j = 16 * ni + l15;
                    Mf[i * 65 + j] = (j < i) ? bt[i] * acc[ni][rr] * __expf(gc[i] - gc[j]) : 0.f; }
        } else {
            const int j0 = 16 * (F.wave - 4); f32x4 acc[4];
#pragma unroll
            for (int ni = 0; ni < 4; ++ni) acc[ni] = (f32x4){0.f, 0.f, 0.f, 0.f};
#pragma unroll
            for (int ks = 0; ks < 4; ++ks) { const bf16x8 a = lds_frag(kl, 272, j0, ks * 64, lane);
#pragma unroll
                for (int ni = 0; ni < 4; ++ni) acc[ni] = MFMA16(a, lds_frag(ql, 272, 16 * ni, ks * 64, lane), acc[ni]); }
            const int jt = F.wave - 4;
#pragma unroll
            for (int ni = 0; ni < 4; ++ni) { const int i = 16 * ni + l15; float v[4];
#pragma unroll
                for (int rr = 0; rr < 4; ++rr) { const int j = j0 + 4 * g4 + rr; v[rr] = (j <= i) ? acc[ni][rr] * __expf(gc[i] - gc[j]) : 0.f; }
                v2u o; o.x = pk2(v[0], v[1]); o.y = pk2(v[2], v[3]);
                *(GAS v2u*)(QKM + i * 64 + 32 * (jt >> 1) + 8 * g4 + 4 * (jt & 1)) = o; }
        }
        { const int d = tid & 127, lq = tid >> 7; float v[16];
#pragma unroll
          for (int ll = 0; ll < 16; ++ll) { const int lp = 16 * lq + ll; v[ll] = bf1(((const LAS bf16*)(kl + lp * 272))[d]) * __expf(gcend - gc[lp]); }
#pragma unroll
          for (int g = 0; g < 4; ++g) { v2u o; o.x = pk2(v[4 * g], v[4 * g + 1]); o.y = pk2(v[4 * g + 2], v[4 * g + 3]);
              *(GAS v2u*)(KT + d * 64 + 32 * (lq >> 1) + 8 * g + 4 * (lq & 1)) = o; } }
        { const int lq = tid & 63, db = tid >> 6; const float e = __expf(gc[lq]); const LAS bf16* qr = (const LAS bf16*)(ql + lq * 272) + 16 * db; float v[16];
#pragma unroll
          for (int dd = 0; dd < 16; ++dd) v[dd] = bf1(qr[dd]) * e;
#pragma unroll
          for (int g = 0; g < 4; ++g) { v2u o; o.x = pk2(v[4 * g], v[4 * g + 1]); o.y = pk2(v[4 * g + 2], v[4 * g + 3]);
              *(GAS v2u*)(QD + lq * 128 + 32 * (db >> 1) + 8 * g + 4 * (db & 1)) = o; } }
        if (tid == 0) GE[it * 32] = __expf(gcend);
        __syncthreads();
        { const int cb = 8 * F.wave; float res[8];
#pragma unroll
          for (int cc = 0; cc < 8; ++cc) res[cc] = (lane == cb + cc) ? 1.0f : 0.0f;
          for (int j = cb; j < 63; ++j) { const float mj = Mf[lane * 65 + j];
#pragma unroll
              for (int cc = 0; cc < 8; ++cc) { const float xj = __builtin_bit_cast(float, __builtin_amdgcn_readlane(__builtin_bit_cast(int, res[cc]), j)); res[cc] -= mj * xj; } }
          v4u o; o.x = pk2(res[0], res[1]); o.y = pk2(res[2], res[3]); o.z = pk2(res[4], res[5]); o.w = pk2(res[6], res[7]);
          *(LAS v4u*)(Tl + lane * 144 + cb * 2) = o; }
        __syncthreads();
        if (F.wave < 4) {
            f32x4 acc[8];
#pragma unroll
            for (int ni = 0; ni < 8; ++ni) acc[ni] = (f32x4){0.f, 0.f, 0.f, 0.f};
#pragma unroll
            for (int ks = 0; ks < 2; ++ks) { const bf16x8 a = lds_frag(Tl, 144, 16 * F.wave, ks * 64, lane);
#pragma unroll
                for (int ni = 0; ni < 8; ++ni) acc[ni] = MFMA16(a, lds_frag(vsT, 144, 16 * ni, ks * 64, lane), acc[ni]); }
#pragma unroll
            for (int ni = 0; ni < 8; ++ni) { v2u o; o.x = pk2(acc[ni][0], acc[ni][1]); o.y = pk2(acc[ni][2], acc[ni][3]);
                *(GAS v2u*)(UT + (16 * ni + l15) * 64 + 16 * F.wave + 4 * g4) = o; }
        } else {
            const int it4 = F.wave - 4; f32x4 acc[8];
#pragma unroll
            for (int mi = 0; mi < 8; ++mi) acc[mi] = (f32x4){0.f, 0.f, 0.f, 0.f};
#pragma unroll
            for (int ks = 0; ks < 2; ++ks) { const bf16x8 bfr = lds_frag(Tl, 144, 16 * it4, ks * 64, lane);
#pragma unroll
                for (int mi = 0; mi < 8; ++mi) acc[mi] = MFMA16(lds_frag(ksT, 144, 16 * mi, ks * 64, lane), bfr, acc[mi]); }
#pragma unroll
            for (int mi = 0; mi < 8; ++mi) { v2u o; o.x = pk2(-acc[mi][0], -acc[mi][1]); o.y = pk2(-acc[mi][2], -acc[mi][3]);
                *(GAS v2u*)(WN + (16 * it4 + l15) * 128 + 32 * (mi >> 1) + 8 * g4 + 4 * (mi & 1)) = o; }
        }
        __syncthreads();
    }
}
constexpr int GD2_BUF = 62464;
__device__ __forceinline__ void gd2_load(const unsigned char* src, v4u (&r)[7], int tid) {
#pragma unroll
    for (int j = 0; j < 7; ++j) r[j] = *(const GAS v4u*)(src + (size_t)(tid + 512 * j) * 16);
}
__device__ __forceinline__ void gd2_store(LAS unsigned char* buf, const v4u (&r)[7], int tid) {
#pragma unroll
    for (int j = 0; j < 7; ++j) { const int pc = tid + 512 * j;
        int off;
        if (pc < 1024) off = (pc >> 4) * 272 + (pc & 15) * 16;
        else if (pc < 2048) off = 17408 + ((pc - 1024) >> 4) * 272 + (pc & 15) * 16;
        else if (pc < 3072) off = 44032 + ((pc - 2048) >> 3) * 144 + (pc & 7) * 16;
        else off = 34816 + ((pc - 3072) >> 3) * 144 + (pc & 7) * 16;
        *(LAS v4u*)(buf + off) = r[j]; }
}
__device__ __forceinline__ void phase_gd2(Frame& F, bool last) {
    const unsigned char* G1 = F.ws + WS_MIX + MX_GD1; const float* GE = (const float*)(F.ws + WS_MIX + MX_GE);
    float* GO = (float*)(F.ws + WS_H);
    const int tid = F.tid, lane = F.lane, g4 = lane >> 4, l15 = lane & 15, e0 = 16 * F.wave;
    for (int chain = blockIdx.x; chain < 64; chain += F.G) {
        const int h = (chain >> 1) & 3, dir = chain & 1, b = chain >> 3;
        f32x4 S[8];
#pragma unroll
        for (int db = 0; db < 8; ++db) S[db] = (f32x4){0.f, 0.f, 0.f, 0.f};
        v4u r[7];
        { const unsigned char* it0 = G1 + (size_t)(chain * 36) * GD1_ITEM;
#pragma unroll
          for (int j = 0; j < 7; ++j) { const int pc = tid + 512 * j; const int gp = pc < 3072 ? pc : pc + 1024; r[j] = *(const GAS v4u*)(it0 + (size_t)gp * 16); } }
        gd2_store(F.lds + RING_OFF, r, tid);
        v2u un[4]; float gn;
        { const unsigned char* it0 = G1 + (size_t)(chain * 36) * GD1_ITEM; const bf16* UT0 = (const bf16*)(it0 + 49152);
#pragma unroll
          for (int lb = 0; lb < 4; ++lb) un[lb] = *(const GAS v2u*)(UT0 + (e0 + l15) * 64 + 16 * lb + 4 * g4);
          gn = GE[(chain * 36) * 32]; }
        __syncthreads();
        for (int k = 0; k < 36; ++k) {
            LAS unsigned char* buf = F.lds + RING_OFF + (k & 1) * GD2_BUF;
            const unsigned char* item = G1 + (size_t)(chain * 36 + k) * GD1_ITEM;
            if (k + 1 < 36) { const unsigned char* nx = item + GD1_ITEM;
#pragma unroll
                for (int j = 0; j < 7; ++j) { const int pc = tid + 512 * j; const int gp = pc < 3072 ? pc : pc + 1024; r[j] = *(const GAS v4u*)(nx + (size_t)gp * 16); } }
            v2u uc[4];
#pragma unroll
            for (int lb = 0; lb < 4; ++lb) uc[lb] = un[lb];
            const float gend = gn;
            if (k + 1 < 36) { const bf16* UTn = (const bf16*)(item + GD1_ITEM + 49152);
#pragma unroll
                for (int lb = 0; lb < 4; ++lb) un[lb] = *(const GAS v2u*)(UTn + (e0 + l15) * 64 + 16 * lb + 4 * g4);
                gn = GE[(chain * 36 + k + 1) * 32]; }
            int seqbase, T, n; if (k < 4) { seqbase = ML + b * CTXL; T = CTXL; n = k; } else { seqbase = b * SEQ; T = SEQ; n = k - 4; }
            bf16x8 Sb[4];
#pragma unroll
            for (int ks = 0; ks < 4; ++ks) { v4u w; w.x = pk2(S[2 * ks][0], S[2 * ks][1]); w.y = pk2(S[2 * ks][2], S[2 * ks][3]); w.z = pk2(S[2 * ks + 1][0], S[2 * ks + 1][1]); w.w = pk2(S[2 * ks + 1][2], S[2 * ks + 1][3]);
                Sb[ks] = __builtin_bit_cast(bf16x8, w); }
            f32x4 vn[4];
#pragma unroll
            for (int lb = 0; lb < 4; ++lb) { const v2u uu = uc[lb];
                f32x4 acc = (f32x4){bflo(uu.x), bfhi(uu.x), bflo(uu.y), bfhi(uu.y)};
#pragma unroll
                for (int ks = 0; ks < 4; ++ks) acc = MFMA16(lds_frag(buf, 272, 16 * lb, ks * 64, lane), Sb[ks], acc);
                vn[lb] = acc; }
            bf16x8 Vb[2];
#pragma unroll
            for (int ks = 0; ks < 2; ++ks) { v4u w; w.x = pk2(vn[2 * ks][0], vn[2 * ks][1]); w.y = pk2(vn[2 * ks][2], vn[2 * ks][3]); w.z = pk2(vn[2 * ks + 1][0], vn[2 * ks + 1][1]); w.w = pk2(vn[2 * ks + 1][2], vn[2 * ks + 1][3]);
                Vb[ks] = __builtin_bit_cast(bf16x8, w); }
            const bool wr_o = !(last && k < 4);
#pragma unroll
            for (int lb = 0; lb < 4; ++lb) { f32x4 acc = (f32x4){0.f, 0.f, 0.f, 0.f};
#pragma unroll
                for (int ks = 0; ks < 4; ++ks) acc = MFMA16(lds_frag(buf + 17408, 272, 16 * lb, ks * 64, lane), Sb[ks], acc);
#pragma unroll
                for (int ks = 0; ks < 2; ++ks) acc = MFMA16(lds_frag(buf + 34816, 144, 16 * lb, ks * 64, lane), Vb[ks], acc);
                if (wr_o) {
#pragma unroll
                    for (int rr = 0; rr < 4; ++rr) { const int p = 16 * lb + 4 * g4 + rr; const int tok = dir ? T - 1 - (64 * n + p) : 64 * n + p;
                        GO[((size_t)dir * MT + seqbase + tok) * 512 + h * 128 + e0 + l15] = acc[rr]; } } }
#pragma unroll
            for (int db = 0; db < 8; ++db) { f32x4 acc = S[db] * gend;
#pragma unroll
                for (int ks = 0; ks < 2; ++ks) acc = MFMA16(lds_frag(buf + 44032, 144, 16 * db, ks * 64, lane), Vb[ks], acc);
                S[db] = acc; }
            if (k + 1 < 36) gd2_store(F.lds + RING_OFF + ((k + 1) & 1) * GD2_BUF, r, tid);
            __syncthreads();
        }
    }
}
__device__ __forceinline__ void phase_gd3(Frame& F, int l, bool last) {
    const float* GO = (const float*)(F.ws + WS_H); const bf16* Z = (const bf16*)(F.ws + WS_Z); bf16* Y2 = (bf16*)(F.ws + WS_Y) + (size_t)2 * MT * 512;
    const int gw = blockIdx.x * NWAVES + F.wave, NGW = F.G * NWAVES, c8 = F.lane * 8; const int nrows = last ? ML : MT;
    const float* gn = F.in[I_GDN] + l * 128 + (c8 & 127);
    for (int row = gw; row < nrows; row += NGW) {
        const f32x4 a0 = *(const f32x4*)(GO + (size_t)row * 512 + c8), a1 = *(const f32x4*)(GO + (size_t)row * 512 + c8 + 4);
        const f32x4 b0 = *(const f32x4*)(GO + ((size_t)MT + row) * 512 + c8), b1 = *(const f32x4*)(GO + ((size_t)MT + row) * 512 + c8 + 4);
        const f32x4 s0 = a0 + b0, s1 = a1 + b1;
        float ss = (s0.x * s0.x + s0.y * s0.y) + (s0.z * s0.z + s0.w * s0.w) + (s1.x * s1.x + s1.y * s1.y) + (s1.z * s1.z + s1.w * s1.w);
        ss += __shfl_xor(ss, 1); ss += __shfl_xor(ss, 2); ss += __shfl_xor(ss, 4); ss += __shfl_xor(ss, 8);
        const float rs = 1.0f / sqrtf(ss * (1.0f / 128.0f) + EPS);
        const v4u zz = *(const GAS v4u*)(Z + (size_t)row * ZLD + ZC_GDZ + c8);
        const float o[8] = {s0.x, s0.y, s0.z, s0.w, s1.x, s1.y, s1.z, s1.w}; const float zf[8] = {bflo(zz.x), bfhi(zz.x), bflo(zz.y), bfhi(zz.y), bflo(zz.z), bfhi(zz.z), bflo(zz.w), bfhi(zz.w)};
        float y[8];
#pragma unroll
        for (int j = 0; j < 8; ++j) y[j] = o[j] * rs * gn[j] * silu1(zf[j]);
        v4u w; w.x = pk2(y[0], y[1]); w.y = pk2(y[2], y[3]); w.z = pk2(y[4], y[5]); w.w = pk2(y[6], y[7]);
        *(GAS v4u*)(Y2 + (size_t)row * 512 + c8) = w;
    }
}
#ifndef DUPC
#define DUPC 0
#endif
constexpr int CW_Q = 2048;
__device__ __forceinline__ int q_pull(Frame& F, int qi) {
    volatile LAS unsigned* slot = F.MISC + 16;
    __syncthreads();
    if (F.tid == 0) *slot = __hip_atomic_fetch_add((unsigned*)(F.ctl + CW_Q + 64 * qi), 1u, __ATOMIC_RELAXED, __HIP_MEMORY_SCOPE_AGENT);
    __syncthreads();
    return (int)*slot;
}
__device__ __forceinline__ void phase_mixc(Frame& F, int l, bool last, int qo = 0) {
    for (int rep = 0; rep < ((DUPC & 4) ? 2 : 1); ++rep) if ((int)blockIdx.x < 64 || F.G < 128) phase_gd2(F, last);
    const int n_att = last ? 256 : 288, n_ml3 = last ? 512 : 576;
    for (int rep = 0; rep < ((DUPC & 1) ? 2 : 1); ++rep) for (;;) { const int idx = q_pull(F, 2 * l + 8 * rep); if (idx >= n_att) break; attn_item(F, idx); }
    for (int rep = 0; rep < ((DUPC & 2) ? 2 : 1); ++rep) for (;;) { const int idx = q_pull(F, 2 * l + 1 + 8 * rep); if (idx >= n_ml3) break; ml3_item(F, l, idx); }
}
#ifndef DUPA
#define DUPA 0
#endif
#define MIX_PHASE_1 for (int rep = 0; rep < ((DUPA & 1) ? 2 : 1); ++rep) phase_attn_prep(F, l, last); for (int rep = 0; rep < ((DUPA & 2) ? 2 : 1); ++rep) { __syncthreads(); phase_spatial(F, l, last); } \
    for (int rep = 0; rep < ((DUPA & 4) ? 2 : 1); ++rep) phase_gd0(F, l, last); for (int rep = 0; rep < ((DUPA & 8) ? 2 : 1); ++rep) { __syncthreads(); phase_ml1(F, l); }
#define MIX_PHASE_2 for (int rep = 0; rep < ((DUPA & 16) ? 2 : 1); ++rep) { __syncthreads(); phase_gd1(F); } for (int rep = 0; rep < ((DUPA & 32) ? 2 : 1); ++rep) phase_ml2(F, 0);
#define MIX_PHASE_3 phase_mixc(F, l, last);
#define MIX_PHASE_4 phase_gd3(F, l, last);
#ifndef PROBE
#define PROBE 0
#endif
#ifndef DUPMIX
#define DUPMIX 0
#endif
#ifndef DUPG
#define DUPG 0
#endif
#ifdef DUPAUX
#define DUP_AUX(x) x
#else
#define DUP_AUX(x)
#endif
#ifndef TPROBE
#define TPROBE 0
#endif
constexpr int PH_PER_LAYER = 15, N_PHASES = PROBE ? (1 + PH_PER_LAYER + 1) : (1 + NLAYER * PH_PER_LAYER + (TPROBE ? 1 : 0));
#ifndef PHMASK
#define PHMASK 0xffff
#endif
#define PHEN(k) ((PHMASK >> (k)) & 1)
#define IN(p) (lo <= (p) && (p) < hi)
#ifndef TPROBE
#define TPROBE 0
#endif
#if TPROBE
#define SEAM(p) do { if (lo <= (p) && (p) + 1 < hi) { xcd_barrier(bar); if (blockIdx.x == 0 && F.tid == 0) ((unsigned long long*)(F.ws + WS_CTL + 524288))[(p) + 1] = wall_clock64(); } } while (0)
#else
#ifdef DUPBAR
#define SEAM(p) do { if (lo <= (p) && (p) + 1 < hi) { xcd_barrier(bar); xcd_barrier(bar); } } while (0)
#else
#define SEAM(p) do { if (lo <= (p) && (p) + 1 < hi) xcd_barrier(bar); } while (0)
#endif
#endif
struct Args { const float* in[27]; float* out; unsigned char* ws; int ph_lo, ph_hi, li, pad; };
template <int l> __device__ __forceinline__ void layer_body(Frame& F, const XcdBarrier& bar, const int lo, const int hi) {
    float* MOD = (float*)(F.ws + WS_MOD);
    float* XC = (float*)(F.ws + WS_XC);
    bf16* Hb = (bf16*)(F.ws + WS_H); bf16* Zb = (bf16*)(F.ws + WS_Z); bf16* ACT = (bf16*)(F.ws + WS_Z); float* ZS = (float*)(F.ws + WS_ZS);
    bf16* WFI = (bf16*)(F.ws + WS_WFI); bf16* WFO = (bf16*)(F.ws + WS_WFO); bf16* WZ = (bf16*)(F.ws + WS_WZ); bf16* WB = (bf16*)(F.ws + WS_WB); bf16* WO = (bf16*)(F.ws + WS_WO);
    bf16* Yb = (bf16*)(F.ws + WS_Y); float* PB = (float*)(F.ws + WS_MIX);
    const int vc = (F.G % 8 == 0) ? ((int)blockIdx.x % 8) * (F.G / 8) + (int)blockIdx.x / 8 : (int)blockIdx.x;
        constexpr int P = 1 + l * PH_PER_LAYER;
        constexpr bool last = (l == NLAYER - 1);
        const float* modl = MOD + (size_t)l * 9 * MODW;
        const float* xin_l = (l == 0) ? F.in[I_X] : F.out;
        const float* xin_c = (l == 0) ? F.in[I_CTX] : XC;
        constexpr int nPM = last ? 64 : 72;

        if (PHEN(0) && IN(P + 0)) { if (l == 0) { phase_mod(F); phase_rope(F); __syncthreads(); } conv_set(F, l, 0, nullptr); if (l == 0) conv_set(F, l, 2, nullptr); }
        SEAM(P + 0);
        if (PHEN(1) && IN(P + 1)) phase_norm<(l == 0), (l > 0), false>(F, xin_l, xin_c, F.in[I_F1N] + (size_t)l * D, modl + 0 * D, MT);
        SEAM(P + 1);
        if (PHEN(2) && IN(P + 2)) {
            pg8::Gemm g{Hb, WFI, MT, 2 * DFF, D, 1}; pg8::TileOrder S; S.init(72, 44, 0, 0, 0, F.G, (int)blockIdx.x, 32);
            pg8::EpiSwiglu E{ACT, DFF};
            pg8::gemm_phase<pg8::EpiSwiglu, pg8::TileOrder, PG8_ALIGN, PG8_SP2>(F.lds + RING_OFF, g, S, E);
            if (DUPG & 2) { __syncthreads(); pg8::gemm_phase<pg8::EpiSwiglu, pg8::TileOrder, PG8_ALIGN, PG8_SP2>(F.lds + RING_OFF, g, S, E); }
        }
        SEAM(P + 2);
        if (PHEN(3) && IN(P + 3)) {
            pg8::Gemm g{ACT, WFO, MT, D, DFF, 1};
            { pg8::TileOrder S; S.init(64, 8, 0, 0, 0, F.G, (int)blockIdx.x, DFF / 64); pg8::EpiRes<false> E{F.out, XC, modl + 2 * D, 0.5f};
              pg8::gemm_phase<pg8::EpiRes<false>, pg8::TileOrder, PG8_ALIGN, PG8_SP2>(F.lds + RING_OFF, g, S, E); }
            { pg8::QuarterOrder S; S.init(8, 64, DFF / 256, F.G, (int)blockIdx.x); pg8::EpiRes<true> E{nullptr, PB, modl + 2 * D, 0.5f};
              pg8::gemm_phase<pg8::EpiRes<true>, pg8::QuarterOrder, PG8_ALIGN, PG8_SP2>(F.lds + RING_OFF, g, S, E); }
        }
        SEAM(P + 3);
        if (PHEN(4) && IN(P + 4)) phase_norm<false, true, !last>(F, F.out, XC, F.in[I_MIXN] + (size_t)l * D, modl + 3 * D, MT);
        SEAM(P + 4);
        if (PHEN(5) && IN(P + 5)) {
            pg8::Gemm g{Hb, WZ, MT, NZ, D, 1}; pg8::TileOrder S;
            if (last) S.init(64, 57, 8, NKV_TILES, 64, F.G, (int)blockIdx.x, 32); else S.init(64, 57, 8, 56, 64, F.G, (int)blockIdx.x, 32, 10);
            pg8::EpiZ E{Zb, ZS, ZLD, (bf16*)(F.ws + WS_GT)};
            pg8::gemm_phase<pg8::EpiZ, pg8::TileOrder, PG8_ALIGN, PG8_SP2>(F.lds + RING_OFF, g, S, E);
            if (DUPG & 1) { __syncthreads(); pg8::gemm_phase<pg8::EpiZ, pg8::TileOrder, PG8_ALIGN, PG8_SP2>(F.lds + RING_OFF, g, S, E); }
            if (last) conv_set(F, l, 1, (unsigned*)(F.ctl + 2048 + 64 * 14));
        }
        SEAM(P + 5);
        if (PHEN(6) && IN(P + 6)) { if (l == 0) conv_set(F, l, 1, nullptr); MIX_PHASE_1 if (DUPMIX & 1) { __syncthreads(); MIX_PHASE_1 } }
        SEAM(P + 6);
        if (PHEN(7) && IN(P + 7)) { MIX_PHASE_2 if (DUPMIX & 2) { __syncthreads(); MIX_PHASE_2 } }
        SEAM(P + 7);
        if (PHEN(8) && IN(P + 8)) { MIX_PHASE_3 }
        SEAM(P + 8);
        if (PHEN(9) && IN(P + 9)) { MIX_PHASE_4 if (DUPMIX & 8) { __syncthreads(); MIX_PHASE_4 } }
        SEAM(P + 9);
        if (PHEN(10) && IN(P + 10)) {
            pg8::Gemm g{Yb, WB, 4 * MT, 4 * D, 512, 1}; pg8::BranchOrder S; S.init(nPM, 72, F.G, (int)blockIdx.x);
            pg8::EpiBranch E{(const bf16*)(F.ws + WS_GT), Hb, 72};
            pg8::gemm_phase<pg8::EpiBranch, pg8::BranchOrder, PG8_ALIGN, PG8_SP2>(F.lds + RING_OFF, g, S, E);
            if (DUPG & 4) { __syncthreads(); pg8::gemm_phase<pg8::EpiBranch, pg8::BranchOrder, PG8_ALIGN, PG8_SP2>(F.lds + RING_OFF, g, S, E); }
        }
        SEAM(P + 10);
        if (PHEN(11) && IN(P + 11)) {
            pg8::Gemm g{Hb, WO, MT, D, D, 1};
            { pg8::TileOrder S; S.init(64, 8, 0, 0, 0, F.G, (int)blockIdx.x, D / 64); pg8::EpiRes<false> E{F.out, XC, modl + 5 * D, 1.0f};
              pg8::gemm_phase<pg8::EpiRes<false>, pg8::TileOrder, PG8_ALIGN, PG8_SP2>(F.lds + RING_OFF, g, S, E); }
            if constexpr (nPM == 72) { pg8::QuarterOrder S; S.init(8, 64, D / 256, F.G, (int)blockIdx.x); pg8::EpiRes<true> E{nullptr, PB, modl + 5 * D, 1.0f};
              pg8::gemm_phase<pg8::EpiRes<true>, pg8::QuarterOrder, PG8_ALIGN, PG8_SP2>(F.lds + RING_OFF, g, S, E); }
        }
        SEAM(P + 11);
        if (PHEN(12) && IN(P + 12)) { phase_norm<false, (nPM == 72), false>(F, F.out, XC, F.in[I_F2N] + (size_t)l * D, modl + 6 * D, nPM * 256);
#ifdef DUPN
            if (nPM == 64) { phase_norm<false, false, false>(F, F.out, XC, F.in[I_F2N] + (size_t)l * D, modl + 6 * D, nPM * 256); phase_norm<false, false, false>(F, F.out, XC, F.in[I_F2N] + (size_t)l * D, modl + 6 * D, nPM * 256); }
#endif
        }
        SEAM(P + 12);
        if (PHEN(13) && IN(P + 13)) {
            pg8::Gemm g{Hb, WFI, MT, 2 * DFF, D, 1}; pg8::TileOrder S; S.init(nPM, 44, 0, 0, 0, F.G, (int)blockIdx.x, 32);
            pg8::EpiSwiglu E{ACT, DFF};
            pg8::gemm_phase<pg8::EpiSwiglu, pg8::TileOrder, PG8_ALIGN, PG8_SP2>(F.lds + RING_OFF, g, S, E);
            if (!last) conv_set(F, l + 1, 2, (unsigned*)(F.ctl + 2048 + 64 * 15));
        }
        SEAM(P + 13);
        if (PHEN(14) && IN(P + 14)) {
            pg8::Gemm g{ACT, WFO, MT, D, DFF, 1};
            { pg8::TileOrder S; S.init(64, 8, 0, 0, 0, F.G, (int)blockIdx.x, DFF / 64); pg8::EpiRes<false> E{F.out, XC, modl + 8 * D, 0.5f};
              pg8::gemm_phase<pg8::EpiRes<false>, pg8::TileOrder, PG8_ALIGN, PG8_SP2>(F.lds + RING_OFF, g, S, E); }
            if constexpr (nPM == 72) { pg8::QuarterOrder S; S.init(8, 64, DFF / 256, F.G, (int)blockIdx.x); pg8::EpiRes<true> E{nullptr, PB, modl + 8 * D, 0.5f};
              pg8::gemm_phase<pg8::EpiRes<true>, pg8::QuarterOrder, PG8_ALIGN, PG8_SP2>(F.lds + RING_OFF, g, S, E); }
        }
        SEAM(P + 14);
    }
__global__ void __launch_bounds__(NWAVES * 64, 2) mk_fwd(Args args) {
    extern __shared__ __attribute__((aligned(16))) unsigned char lds[];
    Frame F;
    F.lds = (LAS unsigned char*)lds;
    F.MISC = (volatile LAS unsigned*)(F.lds + MISC_OFF);
    F.tid = threadIdx.x; F.lane = F.tid & 63; F.wave = __builtin_amdgcn_readfirstlane(F.tid >> 6);
    F.G = gridDim.x;
    F.ws = args.ws; F.ctl = (gu32*)(args.ws + WS_CTL); F.out = args.out;
    F.in = args.in;
    for (int u = F.tid; u < (LDS_BYTES - LDSCTL_OFF) / 4; u += NWAVES * 64) ((LAS unsigned*)(F.lds + LDSCTL_OFF))[u] = 0u;
    __syncthreads();
    const int lo = args.ph_lo, hi = args.ph_hi;
#if TPROBE
    if (blockIdx.x == 0 && F.tid == 0) ((unsigned long long*)(F.ws + WS_CTL + 524288))[0] = wall_clock64();
#endif
    XcdBarrier bar; bar.bar = (unsigned*)(F.ctl + CW_BAR) + args.li * XCD_BAR_WORDS; bar.x = 0; bar.st = nullptr;
    if (hi - lo > 1) bar = xcd_barrier_post((unsigned*)(F.ctl + CW_BAR) + args.li * XCD_BAR_WORDS, F.MISC + 8);


    layer_body<0>(F, bar, lo, hi);
#if !PROBE
    layer_body<1>(F, bar, lo, hi);
#endif
#if TPROBE
    if (IN(31)) {
        const unsigned long long* TS = (const unsigned long long*)(F.ws + WS_CTL + 524288);
        const float tot = (float)(TS[31] - TS[0]);
        const float fa = (float)(TS[TP_A2] - TS[TP_A1]) / tot, fb = (float)(TS[TP_B2] - TS[TP_B1]) / tot;
        const size_t n = (size_t)ML * D; float* o = F.out;
        for (size_t i = (size_t)blockIdx.x * 512 + F.tid; i < n; i += (size_t)F.G * 512) { float v = o[i] * (1.0f + fa); if (i == 0) v += 10000.0f * fb; o[i] = v; }
    }
#endif
#if PROBE
    if (IN(16)) {
        const size_t n = (size_t)ML * D; float* o = F.out;
        for (size_t i = (size_t)blockIdx.x * 512 + F.tid; i < n; i += (size_t)F.G * 512) { const size_t r = i / D, c = i % D;
#if PROBE == 1
            o[i] = bf1(((const bf16*)(F.ws + WS_Y))[(size_t)MT * 512 + r * 512 + (c & 511)]);
#elif PROBE == 2
            o[i] = bf1(((const bf16*)(F.ws + WS_MIX + MX_CP))[(i % ((size_t)1152 * 16384))]);
#elif PROBE == 3
            o[i] = bf1(((const bf16*)(F.ws + WS_MIX + MX_CL))[(i % ((size_t)1152 * 16384))]);
#elif PROBE == 4
            o[i] = ((const float*)(F.ws + WS_ZS))[(i % ((size_t)ML * 32))];
#endif
        }
    }
#endif
#undef IN
#undef SEAM
}

#ifndef MK_N_LAUNCHES
#define MK_N_LAUNCHES 1
#endif
extern "C" void kernel_launch(void* const* d_in, const int* in_sizes, int n_in, void* d_out, int out_size, void* d_ws, size_t ws_size, hipStream_t stream) {
    static int grid = 0;
    if (grid == 0) {
        if (n_in != 27 || in_sizes[0] != ML * D || out_size != ML * D || ws_size < WS_END) { fprintf(stderr, "kernel_launch: shape mismatch n_in %d in0 %d out %d ws %zu (need %zu)\n", n_in, n_in > 0 ? in_sizes[0] : -1, out_size, ws_size, (size_t)WS_END); grid = -1; return; }
        int dev = 0, cus = 0, per_cu = 0;
        if (hipGetDevice(&dev) != hipSuccess || hipDeviceGetAttribute(&cus, hipDeviceAttributeMultiprocessorCount, dev) != hipSuccess) { grid = -1; return; }
        if (hipFuncSetAttribute((const void*)mk_fwd, hipFuncAttributeMaxDynamicSharedMemorySize, LDS_BYTES) != hipSuccess) { fprintf(stderr, "kernel_launch: hipFuncSetAttribute failed\n"); grid = -1; return; }
        if (hipOccupancyMaxActiveBlocksPerMultiprocessor(&per_cu, (const void*)mk_fwd, NWAVES * 64, LDS_BYTES) != hipSuccess || per_cu < 1)
            fprintf(stderr, "kernel_launch: note: occupancy query reports %d workgroups per CU\n", per_cu);
        (void)hipGetLastError();
        grid = cus;
    }
    if (grid < 0) return;
    if (hipMemsetAsync((char*)d_ws + WS_CTL, 0, CTL_ZERO_BYTES, stream) != hipSuccess) return;
    Args a{};
    for (int i = 0; i < 27; ++i) a.in[i] = (const float*)d_in[i];
    a.out = (float*)d_out; a.ws = (unsigned char*)d_ws; a.pad = 0;
#if MK_N_LAUNCHES == 1
    a.ph_lo = 0; a.ph_hi = N_PHASES; a.li = 0;
    hipLaunchKernelGGL(mk_fwd, dim3(grid), dim3(NWAVES * 64), LDS_BYTES, stream, a);
#else
    for (int p = 0; p < N_PHASES; ++p) { a.ph_lo = p; a.ph_hi = p + 1; a.li = 0;
        hipLaunchKernelGGL(mk_fwd, dim3(grid), dim3(NWAVES * 64), LDS_BYTES, stream, a); }
#endif
    const hipError_t le = hipPeekAtLastError();
    if (le != hipSuccess) fprintf(stderr, "kernel_launch: launch failed: %s\n", hipGetErrorName(le));
}
```

```cpp
#include <hip/hip_runtime.h>
#include <cstdio>
#include <cstdint>
namespace pg8 {
#define PG8_LAS __attribute__((address_space(3)))
typedef unsigned short bf16_t;
typedef short bf16x8 __attribute__((ext_vector_type(8)));
typedef float f32x4 __attribute__((ext_vector_type(4)));
typedef unsigned u32x4 __attribute__((ext_vector_type(4)));
constexpr int BM = 256, BK = 64, HALF = 128, HTB = HALF * BK * 2  , STAGE_BYTES = 8 * HTB, NXCD = 8, WGM = 8;

__host__ __device__ __forceinline__ int lds_byte(int r, int c) { const int st = (r >> 4) * 2 + (c >> 5), rr = r & 15, cc = c & 31, ob = rr * 64 + cc * 2; return st * 1024 + (ob ^ (((ob >> 9) & 1) << 5)); }
__host__ __device__ __forceinline__ void stage_rc(int b, int& R, int& C) { const int st = b / 1024, sb = b % 1024, swz = sb ^ (((sb >> 9) & 1) << 5); R = (st >> 1) * 16 + swz / 64; C = (st & 1) * 32 + (swz % 64) / 2; }
__host__ __device__ __forceinline__ int perm32(int rho) { const int n = rho >> 4, i = rho & 15; return 8 * (i >> 2) + 4 * n + (i & 3); }

__host__ __device__ __forceinline__ int perm32_inv(int x) { return 16 * ((x >> 2) & 1) + 4 * (x >> 3) + (x & 3); }
__host__ __device__ __forceinline__ size_t sw_off(int row, int k, int K, bool perm) {
    const int tile = row >> 8, h = (row >> 7) & 1, Rp = row & 127, R = perm ? ((Rp & ~31) + perm32_inv(Rp & 31)) : Rp;
    return ((size_t)(tile * 2 + h) * (K >> 6) + (k >> 6)) * 8192 + (size_t)(lds_byte(R, k & 63) >> 1);
}
struct Unit { int pm, pn, k0, nt; };
struct Gemm { const bf16_t* A; const bf16_t* Bt; int M, N, K; int swb = 0, swa = 0; };

struct StaticOrder {
    int nM, nN, nwg, G, c;
    __host__ __device__ void init(int M, int N, int G_, int c_) { nM = M / BM; nN = N / BM; nwg = nM * nN; G = G_; c = c_; }
    __host__ __device__ bool next(int i, Unit& u) const {
        const long L = (long)i * G + c; if (L >= nwg) return false;
        int wgid = (int)L; { const int q = nwg / NXCD, r = nwg % NXCD, xcd = wgid % NXCD, off = wgid / NXCD; wgid = (xcd < r ? xcd * (q + 1) : r * (q + 1) + (xcd - r) * q) + off; }
        const int nig = WGM * nN, gid = wgid / nig, fm = gid * WGM, gsz = (nM - fm) < WGM ? (nM - fm) : WGM;
        u.pm = fm + ((wgid % nig) % gsz); u.pn = (wgid % nig) / gsz; u.k0 = 0; u.nt = 0; return true;
    }
    __device__ __forceinline__ void a_ready(const Unit&) const {}
    __device__ __forceinline__ void done(const Unit&) const {}
};

typedef float f32x2c_t __attribute__((ext_vector_type(2)));
typedef __bf16 bf16x2c_t __attribute__((ext_vector_type(2)));
__device__ __forceinline__ unsigned cvt_pk_bf16(float lo, float hi) { const f32x2c_t v = {lo, hi}; const bf16x2c_t b = __builtin_convertvector(v, bf16x2c_t); return __builtin_bit_cast(unsigned, b); }
typedef float f32x2 __attribute__((ext_vector_type(2)));
#ifndef WGM_DEF
#define WGM_DEF 4
#endif
#ifndef WGM_BR
#define WGM_BR 4
#endif
#ifndef WGM_N8
#define WGM_N8 4
#endif
__device__ __forceinline__ void tile_map(int nM, int nN, int wgid, int& pm, int& pn, int wgm = WGM_DEF) {
    const int nwg = nM * nN;
    { const int q = nwg / NXCD, r = nwg % NXCD, xcd = wgid % NXCD, off = wgid / NXCD; wgid = (xcd < r ? xcd * (q + 1) : r * (q + 1) + (xcd - r) * q) + off; }
    const int nig = wgm * nN, gid = wgid / nig, fm = gid * wgm, gsz = (nM - fm) < wgm ? (nM - fm) : wgm;
    pm = fm + ((wgid % nig) % gsz); pn = (wgid % nig) / gsz;
}
struct TileOrder {
    int nM0, nN0, n0, nM1, nN1, n1, pm1, G, c, ntK, skip1, wgm = WGM_DEF;
    __device__ __forceinline__ void init(int nM0_, int nN0_, int nM1_, int nN1_, int pm1_, int G_, int c_, int ntK_, int skip1_ = -1) { skip1 = skip1_; ntK = ntK_; nM0 = nM0_; nN0 = nN0_; n0 = nM0_ * nN0_; nM1 = nM1_; nN1 = nN1_; n1 = nM1_ * nN1_; pm1 = pm1_; G = G_; c = c_; }
    __device__ __forceinline__ bool next(int i, Unit& u) const {
        long L = (long)i * G + c; u.k0 = 0; u.nt = ntK;
        if (L < n0) { tile_map(nM0, nN0, (int)L, u.pm, u.pn, wgm); return true; }
        L -= n0;
        if (L < n1) { tile_map(nM1, nN1, (int)L, u.pm, u.pn, wgm); u.pm += pm1; if (skip1 >= 0 && u.pn >= skip1) ++u.pn; return true; }
        return false;
    }
    __device__ __forceinline__ void a_ready(const Unit&) const {}
    __device__ __forceinline__ void done(const Unit&) const {}
};
struct QuarterOrder {
    int n, pm0, G, c, ntK;
    __device__ __forceinline__ void init(int nM, int pm0_, int ntq, int G_, int c_) { n = nM * 8 * 4; pm0 = pm0_; ntK = ntq; G = G_; c = c_; }
    __device__ __forceinline__ bool next(int i, Unit& u) const {
        const long L = (long)i * G + c; if (L >= n) return false;
        const int t = (int)L >> 2, qq = (int)L & 3; u.pm = pm0 + (t >> 3); u.pn = t & 7; u.k0 = qq * ntK; u.nt = ntK; return true;
    }
    __device__ __forceinline__ void a_ready(const Unit&) const {}
    __device__ __forceinline__ void done(const Unit&) const {}
};
struct BranchOrder {
    int nM, NPM, G, c; static constexpr int ntK = 8;
    __device__ __forceinline__ void init(int nM_, int NPM_, int G_, int c_) { nM = nM_; NPM = NPM_; G = G_; c = c_; }
    __device__ __forceinline__ bool next(int i, Unit& u) const {
        const long L = (long)(i >> 2) * G + c; if (L >= nM * 8) return false;
        int pm, pn; tile_map(nM, 8, (int)L, pm, pn, WGM_BR); const int n = i & 3;
        u.pm = n * NPM + pm; u.pn = n * 8 + pn; u.k0 = 0; u.nt = 8; return true;
    }
    __device__ __forceinline__ void a_ready(const Unit&) const {}
    __device__ __forceinline__ void done(const Unit&) const {}
};

__device__ __forceinline__ float silu_f(float a) { return a * __builtin_amdgcn_rcpf(1.0f + __expf(-a)); }
__device__ __forceinline__ float sigmoid_f(float a) { return __builtin_amdgcn_rcpf(1.0f + __expf(-a)); }
struct EpiSwiglu {
    static constexpr bool PERM = true, AFTER_DRAIN = false, CHAIN = false;
    bf16_t* O; int ldc;
    __device__ __forceinline__ void operator()(const f32x4 (&acc)[2][2][4][2], const Unit& u, int wr, int wc, int fr, int fq) const {
        const int row0 = u.pm * BM + wr * 64 + fr, col0 = u.pn * HALF + wc * 32 + 8 * fq;
#pragma unroll
        for (int ai = 0; ai < 2; ++ai)
#pragma unroll
            for (int m = 0; m < 4; ++m) { bf16_t* rowp = O + sw_off(row0 + ai * HALF + m * 16, col0, ldc, false);
                const f32x4 a0 = acc[ai][0][m][0], a1 = acc[ai][0][m][1], b0 = acc[ai][1][m][0], b1 = acc[ai][1][m][1];
                f32x4 v0, v1;
#pragma unroll
                for (int j = 0; j < 4; ++j) { v0[j] = silu_f(a0[j]) * b0[j]; v1[j] = silu_f(a1[j]) * b1[j]; }
                u32x4 w; w.x = cvt_pk_bf16(v0[0], v0[1]); w.y = cvt_pk_bf16(v0[2], v0[3]); w.z = cvt_pk_bf16(v1[0], v1[1]); w.w = cvt_pk_bf16(v1[2], v1[3]);
                *(u32x4*)rowp = w; }
    }
};
template <bool ATOMIC  > struct EpiRes {
    static constexpr bool PERM = false, AFTER_DRAIN = false, CHAIN = false;
    float* out_l; float* out_c; const float* gate; float coef;
    __device__ __forceinline__ void operator()(const f32x4 (&acc)[2][2][4][2], const Unit& u, int wr, int wc, int fr, int fq) const {
        const bool isc = u.pm >= 64; const int b9 = isc ? 8 : (u.pm >> 3);
        const int prow = (isc ? (u.pm - 64) : u.pm) * BM + wr * 64 + fr, col0 = u.pn * BM + wc * 32 + 4 * fq;
        float* op = isc ? out_c : out_l;
        const float* gp = gate + (size_t)b9 * 18432 + col0;
        f32x4 gv[2][2];
#pragma unroll
        for (int bj = 0; bj < 2; ++bj)
#pragma unroll
            for (int n = 0; n < 2; ++n) gv[bj][n] = *(const f32x4*)(gp + bj * HALF + n * 16) * coef;
        if constexpr (!ATOMIC) {
#pragma unroll
            for (int ai = 0; ai < 2; ++ai)
#pragma unroll
                for (int m = 0; m < 4; ++m) { const size_t off = (size_t)(prow + ai * HALF + m * 16) * 2048 + col0;
#pragma unroll
                    for (int bj = 0; bj < 2; ++bj)
#pragma unroll
                        for (int n = 0; n < 2; ++n) { const f32x4 bs = *(const f32x4*)(op + off + bj * HALF + n * 16); *(f32x4*)(op + off + bj * HALF + n * 16) = bs + gv[bj][n] * acc[ai][bj][m][n]; }
                    asm volatile("" ::: "memory"); }
        } else {
            float* pp = op + (size_t)(u.k0 / u.nt) * ((size_t)2048 * 2048);
#pragma unroll
            for (int ai = 0; ai < 2; ++ai)
#pragma unroll
                for (int m = 0; m < 4; ++m) { const size_t off = (size_t)(prow + ai * HALF + m * 16) * 2048 + col0;
#pragma unroll
                    for (int bj = 0; bj < 2; ++bj)
#pragma unroll
                        for (int n = 0; n < 2; ++n) *(f32x4*)(pp + off + bj * HALF + n * 16) = gv[bj][n] * acc[ai][bj][m][n]; }
        }
    }
};
struct EpiZ {
    static constexpr bool PERM = true, AFTER_DRAIN = false, CHAIN = false;
    bf16_t* Z; float* ZS; int ldz; bf16_t* GT;
    __device__ __forceinline__ void operator()(const f32x4 (&acc)[2][2][4][2], const Unit& u, int wr, int wc, int fr, int fq) const {
        const int row0 = u.pm * BM + wr * 64 + fr, col0 = u.pn * BM + wc * 32 + 8 * fq;
        if (u.pn >= 25) {
            bf16_t* tb = GT + ((size_t)u.pm * 32 + (u.pn - 25)) * 65536 + (size_t)threadIdx.x * 8;
#pragma unroll
            for (int ai = 0; ai < 2; ++ai)
#pragma unroll
                for (int m = 0; m < 4; ++m)
#pragma unroll
                    for (int bj = 0; bj < 2; ++bj) { f32x4 v0 = acc[ai][bj][m][0], v1 = acc[ai][bj][m][1];
#pragma unroll
                        for (int j = 0; j < 4; ++j) { v0[j] = 1.0f + __expf(-fminf(fmaxf(v0[j], -40.f), 40.f)); v1[j] = 1.0f + __expf(-fminf(fmaxf(v1[j], -40.f), 40.f)); }
                        u32x4 w; w.x = cvt_pk_bf16(v0[0], v0[1]); w.y = cvt_pk_bf16(v0[2], v0[3]); w.z = cvt_pk_bf16(v1[0], v1[1]); w.w = cvt_pk_bf16(v1[2], v1[3]);
                        *(u32x4*)(tb + ((ai * 4 + m) * 2 + bj) * 4096) = w; }
            return;
        }
        if (u.pn == 10) {
            if (wc == 0) {
#pragma unroll
                for (int ai = 0; ai < 2; ++ai)
#pragma unroll
                    for (int m = 0; m < 4; ++m) { float* zp = ZS + (size_t)(row0 + ai * HALF + m * 16) * 32 + 8 * fq;
                        *(f32x4*)zp = acc[ai][0][m][0]; *(f32x4*)(zp + 4) = acc[ai][0][m][1]; }
            }
            return;
        }
#pragma unroll
        for (int ai = 0; ai < 2; ++ai)
#pragma unroll
            for (int m = 0; m < 4; ++m) { bf16_t* rowp = Z + (size_t)(row0 + ai * HALF + m * 16) * ldz + col0;
#pragma unroll
                for (int bj = 0; bj < 2; ++bj) { const f32x4 v0 = acc[ai][bj][m][0], v1 = acc[ai][bj][m][1];
                    u32x4 w; w.x = cvt_pk_bf16(v0[0], v0[1]); w.y = cvt_pk_bf16(v0[2], v0[3]); w.z = cvt_pk_bf16(v1[0], v1[1]); w.w = cvt_pk_bf16(v1[2], v1[3]);
                    *(u32x4*)(rowp + bj * HALF) = w; } }
    }
};
struct EpiBranch {
    static constexpr bool PERM = true, AFTER_DRAIN = false, CHAIN = true;
    const bf16_t* GT; bf16_t* Hout; int NPM;
    static __device__ __forceinline__ float epos(float g) { return __expf(-fminf(fmaxf(g, -40.f), 40.f)); }
    __device__ __forceinline__ void chain(f32x4 (&acc)[2][2][4][2], const Unit& u, int wr, int wc, int fr, int fq) const {
        const int n = u.pn >> 3, pn = u.pn & 7, pm = u.pm - n * NPM;
        const int row0 = pm * BM + wr * 64 + fr, col0 = pn * BM + wc * 32 + 8 * fq;
#pragma unroll
        for (int ai = 0; ai < 2; ++ai) {
            u32x4 gaa[4][2], gbb[4][2];
#pragma unroll
            for (int m = 0; m < 4; ++m)
#pragma unroll
                for (int bj = 0; bj < 2; ++bj) { const bf16_t* gp = GT + ((size_t)pm * 32 + n * 8 + pn) * 65536 + ((ai * 4 + m) * 2 + bj) * 4096 + (size_t)threadIdx.x * 8; gaa[m][bj] = *(const u32x4*)gp; gbb[m][bj] = (n < 3) ? *(const u32x4*)(gp + 8 * 65536) : gaa[m][bj]; }
#pragma unroll
            for (int m = 0; m < 4; ++m) { const size_t r = (size_t)(row0 + ai * HALF + m * 16);
#pragma unroll
                for (int bj = 0; bj < 2; ++bj) {
                    const unsigned wa[4] = {gaa[m][bj].x, gaa[m][bj].y, gaa[m][bj].z, gaa[m][bj].w}, wb[4] = {gbb[m][bj].x, gbb[m][bj].y, gbb[m][bj].z, gbb[m][bj].w};
                    f32x4 f0, f1;
#pragma unroll
                    for (int j = 0; j < 4; ++j) { const float ea = (j & 1) ? __uint_as_float(wa[j >> 1] & 0xffff0000u) : __uint_as_float(wa[j >> 1] << 16);
                        const float eb = (j & 1) ? __uint_as_float(wb[j >> 1] & 0xffff0000u) : __uint_as_float(wb[j >> 1] << 16);
                        f0[j] = ((n < 3) ? eb : 1.0f) * __builtin_amdgcn_rcpf(ea); }
#pragma unroll
                    for (int j = 0; j < 4; ++j) { const float ea = (j & 1) ? __uint_as_float(wa[2 + (j >> 1)] & 0xffff0000u) : __uint_as_float(wa[2 + (j >> 1)] << 16);
                        const float eb = (j & 1) ? __uint_as_float(wb[2 + (j >> 1)] & 0xffff0000u) : __uint_as_float(wb[2 + (j >> 1)] << 16);
                        f1[j] = ((n < 3) ? eb : 1.0f) * __builtin_amdgcn_rcpf(ea); }
                    const f32x4 s0 = acc[ai][bj][m][0] * f0, s1 = acc[ai][bj][m][1] * f1;
                    if (n < 3) { acc[ai][bj][m][0] = s0; acc[ai][bj][m][1] = s1; }
                    else { u32x4 w; w.x = cvt_pk_bf16(s0[0], s0[1]); w.y = cvt_pk_bf16(s0[2], s0[3]); w.z = cvt_pk_bf16(s1[0], s1[1]); w.w = cvt_pk_bf16(s1[2], s1[3]);
                        *(u32x4*)(Hout + sw_off((int)r, col0 + bj * HALF, 2048, false)) = w;
                        acc[ai][bj][m][0] = (f32x4){0.f, 0.f, 0.f, 0.f}; acc[ai][bj][m][1] = (f32x4){0.f, 0.f, 0.f, 0.f}; } } }
        }
    }
};
template <class Epi, class Sched, bool ALIGN_EPI = false, bool SP2 = false>
__device__ __forceinline__ void gemm_phase(PG8_LAS unsigned char* lds, const Gemm g, const Sched& S, const Epi& E) {
    const int tid = threadIdx.x, wid = __builtin_amdgcn_readfirstlane(tid >> 6), lane = tid & 63, wr = wid >> 2, wc = wid & 3, fr = lane & 15, fq = lane >> 4;
    const int K = g.K, nt = S.ntK;
    unsigned voffA[2], voffB[2];
#pragma unroll
    for (int i = 0; i < 2; ++i) { int R, C; stage_rc(tid * 16 + i * 8192, R, C); const int Rb = Epi::PERM ? ((R & ~31) + perm32(R & 31)) : R;
        voffA[i] = g.swa ? (unsigned)(tid * 16 + i * 8192) : (unsigned)(R * K + C) * 2u; voffB[i] = g.swb ? (unsigned)(tid * 16 + i * 8192) : (unsigned)(Rb * K + C) * 2u; }
    const size_t kstep = (size_t)(BK * 2);
    const size_t hstep = (size_t)HALF * K * 2;
    const size_t tstep = 2 * hstep;
    const size_t kstepA = g.swa ? (size_t)HTB : kstep, hstepA = g.swa ? (size_t)(K / BK) * HTB : hstep, tstepA = 2 * hstepA;
    const size_t kstepB = g.swb ? (size_t)HTB : kstep, hstepB = g.swb ? (size_t)(K / BK) * HTB : hstep, tstepB = 2 * hstepB;
    const unsigned ldsw = (unsigned)wid * 1024u;
    const int aoff = lds_byte(wr * 64 + fr, fq * 8), boff = lds_byte(wc * 32 + fr, fq * 8);
#define PG8_SA(b, h) (((b) * 2 + (h)) * HTB)
#define PG8_SB(b, h) ((4 + (b) * 2 + (h)) * HTB)
#define PG8_STAGE(bufoff, gbase, voff) do { _Pragma("unroll") for (int _i = 0; _i < 2; ++_i) \
        __builtin_amdgcn_global_load_lds((const unsigned*)((const char*)(gbase) + (voff)[_i]), (PG8_LAS unsigned*)(lds + (bufoff) + ldsw + _i * 8192), 16, 0, 0); } while (0)
#define PG8_LDA(dst, b, h) do { _Pragma("unroll") for (int m = 0; m < 4; ++m) _Pragma("unroll") for (int k = 0; k < 2; ++k) dst[m][k] = *(const PG8_LAS bf16x8*)(lds + PG8_SA(b, h) + aoff + m * 2048 + k * 1024); } while (0)
#define PG8_LDB(dst, b, h) do { _Pragma("unroll") for (int n = 0; n < 2; ++n) _Pragma("unroll") for (int k = 0; k < 2; ++k) dst[n][k] = *(const PG8_LAS bf16x8*)(lds + PG8_SB(b, h) + boff + n * 2048 + k * 1024); } while (0)
#define PG8_MMA(ai, bj, At, Bt) do { __builtin_amdgcn_s_setprio(1); _Pragma("unroll") for (int m = 0; m < 4; ++m) _Pragma("unroll") for (int n = 0; n < 2; ++n) _Pragma("unroll") for (int k = 0; k < 2; ++k) \
        acc[ai][bj][m][n] = __builtin_amdgcn_mfma_f32_16x16x32_bf16(Bt[n][k], At[m][k], acc[ai][bj][m][n], 0, 0, 0); __builtin_amdgcn_s_setprio(0); } while (0)
#define PG8_WAIT_V(n) asm volatile("s_waitcnt vmcnt(" #n ")" ::: "memory")
#define PG8_WAIT_L(n) asm volatile("s_waitcnt lgkmcnt(" #n ")" ::: "memory")
#define PG8_BAR __builtin_amdgcn_s_barrier()
#define PG8_SCHED __builtin_amdgcn_sched_barrier(0)
    Unit cur, nxt; int ui = 0;
    if (!S.next(0, cur)) return;
    f32x4 acc[2][2][4][2];
#pragma unroll
    for (int a = 0; a < 2; ++a)
#pragma unroll
        for (int b = 0; b < 2; ++b)
#pragma unroll
            for (int m = 0; m < 4; ++m)
#pragma unroll
                for (int n = 0; n < 2; ++n) acc[a][b][m][n] = (f32x4){0.f, 0.f, 0.f, 0.f};
    bf16x8 At[4][2], B0[2][2], B1[2][2];
    const char* cA = (const char*)g.A + (size_t)cur.pm * tstepA + (size_t)cur.k0 * kstepA; const char* cB = (const char*)g.Bt + (size_t)cur.pn * tstepB + (size_t)cur.k0 * kstepB;
    S.a_ready(cur);
    if constexpr (SP2) {
        PG8_STAGE(PG8_SB(0, 0), cB, voffB); PG8_STAGE(PG8_SB(0, 1), cB + hstepB, voffB); PG8_STAGE(PG8_SA(0, 0), cA, voffA); PG8_STAGE(PG8_SA(0, 1), cA + hstepA, voffA);
        if (wr == 1) PG8_BAR;
        PG8_WAIT_V(2); PG8_BAR;
        PG8_STAGE(PG8_SB(1, 0), cB + kstepB, voffB); PG8_STAGE(PG8_SA(1, 0), cA + kstepA, voffA); PG8_STAGE(PG8_SB(1, 1), cB + hstepB + kstepB, voffB);
        PG8_WAIT_V(6); PG8_BAR;
    } else {
        PG8_STAGE(PG8_SB(0, 0), cB, voffB); PG8_STAGE(PG8_SA(0, 0), cA, voffA); PG8_STAGE(PG8_SB(0, 1), cB + hstepB, voffB); PG8_STAGE(PG8_SA(0, 1), cA + hstepA, voffA);
        if (wr == 1) PG8_BAR;
        PG8_WAIT_V(4); PG8_BAR;
        PG8_STAGE(PG8_SB(1, 0), cB + kstepB, voffB); PG8_STAGE(PG8_SA(1, 0), cA + kstepA, voffA); PG8_STAGE(PG8_SB(1, 1), cB + hstepB + kstepB, voffB);
        PG8_WAIT_V(6); PG8_BAR;
    }
    for (;;) {
        const bool has_next = S.next(ui + 1, nxt);
        const char* nA = has_next ? (const char*)g.A + (size_t)nxt.pm * tstepA + (size_t)nxt.k0 * kstepA : cA; const char* nB = has_next ? (const char*)g.Bt + (size_t)nxt.pn * tstepB + (size_t)nxt.k0 * kstepB : cB;
        for (int t = 0; t < nt; t += 2) {
            const bool last = (t == nt - 2);
            const char* a1 = cA + (size_t)(t + 1) * kstepA;
            const char* a2 = last ? nA : cA + (size_t)(t + 2) * kstepA; const char* b2 = last ? nB : cB + (size_t)(t + 2) * kstepB;
            const char* a3 = a2 + kstepA; const char* b3 = b2 + kstepB;
            if (last && has_next) S.a_ready(nxt);
            if constexpr (SP2) {
            PG8_LDB(B0, 0, 0); PG8_LDB(B1, 0, 1); PG8_SCHED; PG8_LDA(At, 0, 0); PG8_STAGE(PG8_SA(1, 1), a1 + hstepA, voffA);
            PG8_WAIT_V(8); PG8_WAIT_L(0); PG8_BAR; PG8_MMA(0, 0, At, B0); PG8_MMA(0, 1, At, B1); PG8_BAR; PG8_SCHED;
            PG8_LDA(At, 0, 1); PG8_STAGE(PG8_SB(0, 0), b2, voffB); PG8_STAGE(PG8_SB(0, 1), b2 + hstepB, voffB); PG8_STAGE(PG8_SA(0, 0), a2, voffA);
            PG8_WAIT_V(8); PG8_WAIT_L(0); PG8_BAR; PG8_MMA(1, 0, At, B0); PG8_MMA(1, 1, At, B1); PG8_BAR; PG8_SCHED;
            PG8_LDB(B0, 1, 0); PG8_LDB(B1, 1, 1); PG8_SCHED; PG8_LDA(At, 1, 0); PG8_STAGE(PG8_SA(0, 1), a2 + hstepA, voffA);
            PG8_WAIT_V(8); PG8_WAIT_L(0); PG8_BAR; PG8_MMA(0, 0, At, B0); PG8_MMA(0, 1, At, B1); PG8_BAR; PG8_SCHED;
            PG8_LDA(At, 1, 1); PG8_STAGE(PG8_SB(1, 0), b3, voffB); PG8_STAGE(PG8_SB(1, 1), b3 + hstepB, voffB); PG8_STAGE(PG8_SA(1, 0), a3, voffA);
            PG8_WAIT_V(8); PG8_WAIT_L(0); PG8_BAR; PG8_MMA(1, 0, At, B0); PG8_MMA(1, 1, At, B1); PG8_BAR; PG8_SCHED;
            } else {
            PG8_LDB(B0, 0, 0); PG8_SCHED; PG8_LDA(At, 0, 0); PG8_STAGE(PG8_SA(1, 1), a1 + hstepA, voffA);
            PG8_WAIT_L(8); PG8_BAR; PG8_WAIT_L(0); PG8_MMA(0, 0, At, B0); PG8_BAR; PG8_SCHED;
            PG8_LDB(B1, 0, 1); PG8_STAGE(PG8_SB(0, 0), b2, voffB);
            PG8_BAR; PG8_WAIT_L(0); PG8_MMA(0, 1, At, B1); PG8_BAR;
            PG8_LDA(At, 0, 1); PG8_STAGE(PG8_SA(0, 0), a2, voffA);
            PG8_BAR; PG8_WAIT_L(0); PG8_MMA(1, 0, At, B0); PG8_BAR; PG8_SCHED;
            PG8_STAGE(PG8_SB(0, 1), b2 + hstepB, voffB);
            PG8_WAIT_V(6); PG8_BAR; PG8_MMA(1, 1, At, B1); PG8_BAR;
            PG8_LDB(B0, 1, 0); PG8_SCHED; PG8_LDA(At, 1, 0); PG8_STAGE(PG8_SA(0, 1), a2 + hstepA, voffA);
            PG8_WAIT_L(8); PG8_BAR; PG8_WAIT_L(0); PG8_MMA(0, 0, At, B0); PG8_BAR; PG8_SCHED;
            PG8_LDB(B1, 1, 1); PG8_STAGE(PG8_SB(1, 0), b3, voffB);
            PG8_BAR; PG8_WAIT_L(0); PG8_MMA(0, 1, At, B1); PG8_BAR;
            PG8_LDA(At, 1, 1); PG8_STAGE(PG8_SA(1, 0), a3, voffA);
            PG8_BAR; PG8_WAIT_L(0); PG8_MMA(1, 0, At, B0); PG8_BAR; PG8_SCHED;
            PG8_STAGE(PG8_SB(1, 1), b3 + hstepB, voffB);
            PG8_WAIT_V(6); PG8_BAR; PG8_MMA(1, 1, At, B1); PG8_BAR;
            }
        }
        if constexpr (ALIGN_EPI) { if (wr == 0) PG8_BAR; }
        if constexpr (Epi::CHAIN) { E.chain(acc, cur, wr, wc, fr, fq); S.done(cur); }
        else if constexpr (!Epi::AFTER_DRAIN) { E(acc, cur, wr, wc, fr, fq); S.done(cur); }
        if (!has_next) break;
        if constexpr (!Epi::CHAIN) {
#pragma unroll
        for (int a = 0; a < 2; ++a)
#pragma unroll
            for (int b = 0; b < 2; ++b)
#pragma unroll
                for (int m = 0; m < 4; ++m)
#pragma unroll
                    for (int n = 0; n < 2; ++n) acc[a][b][m][n] = (f32x4){0.f, 0.f, 0.f, 0.f};
        }
        cur = nxt; cA = nA; cB = nB; ++ui;
        if constexpr (ALIGN_EPI) { if (wr == 1) PG8_BAR; }
    }
    PG8_WAIT_V(0);
    if constexpr (!ALIGN_EPI) { if (wr == 0) PG8_BAR; }
    PG8_BAR;
    if constexpr (Epi::AFTER_DRAIN) { E.fused(acc, cur, wr, wc, fr, fq, lds, wid, lane); S.done(cur); }
#undef PG8_SA
#undef PG8_SB
#undef PG8_STAGE
#undef PG8_LDA
#undef PG8_LDB
#undef PG8_MMA
#undef PG8_WAIT_V
#undef PG8_WAIT_L
#undef PG8_BAR
#undef PG8_SCHED
}
}
#ifndef PG8_SP2
#define PG8_SP2 true
#endif
#ifndef PG8_ALIGN
#define PG8_ALIGN true
#endif
constexpr int NWAVES = 8;
constexpr int D = 2048, BATCH = 8, SEQ = 2048, CTXL = 256, DFF = 5632, NLAYER = 2;
constexpr int ML = BATCH * SEQ, MC = BATCH * CTXL, MT = ML + MC;
constexpr int ZLD = 6400;
constexpr int NZ = 14592;
constexpr int MODW = 9 * D;
constexpr int INC = 14368;
constexpr float EPS = 1e-6f;
constexpr int ZC_MLK = 0, ZC_MLV = 512, ZC_GDK = 1024, ZC_GDV = 1536, ZC_ATK = 2048, ZC_ATV = 2304, ZC_SMALL = 2560, ZC_SGU = 2816, ZC_SGV = 3328,
              ZC_MLQ = 3840, ZC_MLO = 4352, ZC_GDQ = 4864, ZC_GDZ = 5376, ZC_ATQ = 5888, ZC_GATE = 6400;
constexpr int NKV_TILES = 11;

constexpr size_t MiB = 1u << 20;
constexpr size_t WS_CTL = 0, CTL_ZERO_BYTES = 1 * MiB;
constexpr size_t WS_MOD = 1 * MiB;
constexpr size_t WS_ROPE = 3 * MiB;
constexpr size_t WS_XC = 4 * MiB;
constexpr size_t WS_WFI = 20 * MiB;
constexpr size_t WS_WFO = 64 * MiB;
constexpr size_t WS_WZ = 86 * MiB;
constexpr size_t WS_WB = 143 * MiB;
constexpr size_t WS_WO = 151 * MiB;
constexpr size_t WS_H = 159 * MiB;
constexpr size_t WS_Z = 231 * MiB;
constexpr size_t WS_GT = WS_Z + (size_t)18432 * 6400 * 2;
constexpr size_t WS_ZS = 744 * MiB;
constexpr size_t WS_Y = 747 * MiB;
constexpr size_t WS_QA = 819 * MiB;
constexpr size_t WS_KC = 837 * MiB;
constexpr size_t WS_VC = 846 * MiB;
constexpr size_t WS_MIX = 855 * MiB;
constexpr size_t WS_END = 1150 * MiB;
static_assert(WS_GT + (size_t)72 * 32 * 131072 <= WS_ZS && WS_Z + (size_t)MT * NZ * 2 <= WS_ZS && WS_H + (size_t)MT * D * 2 <= WS_Z && WS_Y + (size_t)4 * MT * 512 * 2 <= WS_QA, "d_ws map");
static_assert(WS_WFI + (size_t)2 * DFF * D * 2 <= WS_WFO && WS_WFO + (size_t)D * DFF * 2 <= WS_WZ && WS_WZ + (size_t)NZ * D * 2 <= WS_WB, "d_ws map (weights)");
constexpr int CW_TMO = 0, CW_CODE = 1, CW_BAR = 4096;

constexpr int RING_OFF = 0, RING_BYTES = 131072;
constexpr int LDSCTL_OFF = RING_BYTES, MISC_OFF = LDSCTL_OFF + 320;
constexpr int LDS_BYTES = 147456;

#define GAS __attribute__((address_space(1)))
#define LAS __attribute__((address_space(3)))
typedef unsigned short bf16;
typedef unsigned v4u __attribute__((ext_vector_type(4)));
typedef unsigned v2u __attribute__((ext_vector_type(2)));
typedef float f32x4 __attribute__((ext_vector_type(4)));
typedef short bf16x8 __attribute__((ext_vector_type(8)));
typedef GAS unsigned gu32;
#define RLX_AGENT __ATOMIC_RELAXED, __HIP_MEMORY_SCOPE_AGENT
#define LDS_WAIT() asm volatile("s_waitcnt lgkmcnt(0)" ::: "memory")
#define VM_WAIT() asm volatile("s_waitcnt vmcnt(0)" ::: "memory")
typedef float f32x2_t __attribute__((ext_vector_type(2)));
typedef __bf16 bf16x2_t __attribute__((ext_vector_type(2)));
__device__ __forceinline__ unsigned pk2(float lo, float hi) { const f32x2_t v = {lo, hi}; const bf16x2_t b = __builtin_convertvector(v, bf16x2_t); return __builtin_bit_cast(unsigned, b); }
__device__ __forceinline__ float bflo(unsigned w) { return __uint_as_float(w << 16); }
__device__ __forceinline__ float bfhi(unsigned w) { return __uint_as_float(w & 0xffff0000u); }
__device__ __forceinline__ float bf1(bf16 b) { return __uint_as_float(((unsigned)b) << 16); }
__device__ __forceinline__ bf16 f2bf1(float f) { return (bf16)(pk2(f, 0.f) & 0xffffu); }
__device__ __forceinline__ float silu1(float a) { return a / (1.0f + __expf(-a)); }
__device__ __forceinline__ float sigm1(float a) { return 1.0f / (1.0f + __expf(-a)); }
__device__ __forceinline__ float wave_sum(float v) {
#pragma unroll
    for (int o = 1; o < 64; o <<= 1) v += __shfl_xor(v, o);
    return v;
}
#define XB_TMO      128
#define XB_XCNT(j)  (256  + 64 * (j))
#define XB_XSUB(j)  (1280 + 64 * (j))
#define XB_XGEN(j)  (2304 + 64 * (j))
#define XB_TOP      3328
#define XB_TOPGEN   3392
#define XCD_BAR_WORDS 3456
#define XB_SPIN_CAP (1u << 18)

__device__ __forceinline__ unsigned xb_ld(unsigned* p)              { return __hip_atomic_load(p, __ATOMIC_RELAXED, __HIP_MEMORY_SCOPE_AGENT); }
__device__ __forceinline__ unsigned xb_add(unsigned* p, unsigned v) { return __hip_atomic_fetch_add(p, v, __ATOMIC_RELAXED, __HIP_MEMORY_SCOPE_AGENT); }
__device__ __forceinline__ unsigned xb_xcc_id() { return (unsigned)__builtin_amdgcn_s_getreg((3 << 11) | 20) & 0xFu; }
#define XB_SPIN(cond, bar) do { unsigned _sp = 0; while (cond) { __builtin_amdgcn_s_sleep(1); \
    if ((++_sp & 255u) == 0u) { if (xb_ld(&(bar)[XB_TMO])) break; if (_sp > XB_SPIN_CAP) { atomicAdd(&(bar)[XB_TMO], 1u); break; } } } } while (0)

struct XcdBarrier {
    unsigned* bar; unsigned x;
    volatile LAS unsigned* st;
};

__device__ __forceinline__ XcdBarrier xcd_barrier_post(unsigned* bar, volatile LAS unsigned* st) {
    XcdBarrier b; b.bar = bar; b.x = xb_xcc_id(); b.st = st;
    if (threadIdx.x == 0) (void)xb_add(&bar[XB_XCNT(b.x)], 1u);
    return b;
}
__device__ __forceinline__ void xcd_barrier_complete(unsigned* bar, unsigned x, unsigned& nloc, unsigned& nx) {
    const unsigned G = gridDim.x * gridDim.y * gridDim.z;
    unsigned sum, cnt, mine, sp = 0u;
    for (;;) {
        sum = 0u; cnt = 0u; mine = 0u;
#pragma unroll
        for (unsigned j = 0; j < 16; ++j) { const unsigned c = xb_ld(&bar[XB_XCNT(j)]); sum += c; cnt += (c > 0u) ? 1u : 0u; mine = (j == x) ? c : mine; }
        if (sum == G) break;
        __builtin_amdgcn_s_sleep(1);
        if ((++sp & 255u) == 0u) { if (xb_ld(&bar[XB_TMO])) break; if (sp > XB_SPIN_CAP) { atomicAdd(&bar[XB_TMO], 1u); break; } }
    }
    nloc = mine > 0u ? mine : 1u; nx = cnt > 0u ? cnt : 1u;
}

__device__ __forceinline__ void xcd_barrier(const XcdBarrier& b) {
    asm volatile("s_waitcnt vmcnt(0)" ::: "memory");
    __syncthreads();
    if (threadIdx.x == 0) {
        unsigned* bar = b.bar;
        __builtin_amdgcn_s_waitcnt(0);
        unsigned nloc = b.st[0], nx = b.st[1];
        if (nloc == 0u) { xcd_barrier_complete(bar, b.x, nloc, nx); b.st[0] = nloc; b.st[1] = nx; }
        const unsigned old = xb_add(&bar[XB_XSUB(b.x)], 1u);
        const unsigned gen = old / nloc;
        if (old + 1u == (gen + 1u) * nloc) {
            __builtin_amdgcn_fence(__ATOMIC_RELEASE, "agent");
            asm volatile("s_waitcnt vmcnt(0)" ::: "memory");
            const unsigned og = xb_add(&bar[XB_TOP], 1u);
            const unsigned tg = og / nx;
            if (og + 1u == (tg + 1u) * nx) xb_add(&bar[XB_TOPGEN], 1u);
            else XB_SPIN(xb_ld(&bar[XB_TOPGEN]) == tg, bar);
            __builtin_amdgcn_fence(__ATOMIC_ACQUIRE, "agent");
            xb_add(&bar[XB_XGEN(b.x)], 1u);
            asm volatile("s_waitcnt vmcnt(0)" ::: "memory");
        } else {
            XB_SPIN(xb_ld(&bar[XB_XGEN(b.x)]) == gen, bar);
            __builtin_amdgcn_fence(__ATOMIC_ACQUIRE, "agent");
            asm volatile("s_waitcnt vmcnt(0)" ::: "memory");
        }
    }
    __syncthreads();
}
struct Frame {
    LAS unsigned char* lds;
    volatile LAS unsigned* MISC;
    gu32* ctl;
    int tid, lane, wave, G;
    unsigned char* ws;
    const float* const* in;
    float* out;
};
enum { I_X = 0, I_C, I_CTX, I_CCTX, I_MODW, I_MODB, I_F1N, I_F1WI, I_F1WO, I_MIXN, I_WIN, I_SGN, I_SGW, I_SGB, I_MLIFB, I_MLN, I_GDCONV, I_GDALOG, I_GDDTB, I_GDN,
       I_ATQN, I_ATKN, I_WBR, I_WOUT, I_F2N, I_F2WI, I_F2WO };

__device__ __forceinline__ void phase_mod(Frame& F) {
    LAS float* tab = (LAS float*)(F.lds + RING_OFF);
    LAS float* red = (LAS float*)(F.lds + RING_OFF + 98304);
    const float* c = F.in[I_C]; const float* cc = F.in[I_CCTX];
    for (int i = F.tid; i < 9 * D; i += NWAVES * 64) { const int b = i / D, k = i % D; const float x = b < 8 ? c[b * D + k] : cc[k]; tab[k * 12 + b] = silu1(x); }
    __syncthreads();
    float* MOD = (float*)(F.ws + WS_MOD);
    for (int item = blockIdx.x; item < 2 * 288; item += F.G) {
        const int l = item / 288, n0 = (item % 288) * 64;
        const float* W = F.in[I_MODW] + (size_t)l * D * MODW + n0 + F.lane;
        float acc[9];
#pragma unroll
        for (int b = 0; b < 9; ++b) acc[b] = 0.f;
        const int k0 = F.wave * 256;
        for (int k = k0; k < k0 + 256; k += 8) {
            float w[8];
#pragma unroll
            for (int j = 0; j < 8; ++j) w[j] = W[(size_t)(k + j) * MODW];
#pragma unroll
            for (int j = 0; j < 8; ++j) { const LAS f32x4* tp = (const LAS f32x4*)(tab + (k + j) * 12); const f32x4 s0 = tp[0], s1 = tp[1], s2 = tp[2];
                acc[0] += s0[0] * w[j]; acc[1] += s0[1] * w[j]; acc[2] += s0[2] * w[j]; acc[3] += s0[3] * w[j];
                acc[4] += s1[0] * w[j]; acc[5] += s1[1] * w[j]; acc[6] += s1[2] * w[j]; acc[7] += s1[3] * w[j]; acc[8] += s2[0] * w[j]; }
        }
#pragma unroll
        for (int b = 0; b < 9; ++b) red[(F.wave * 9 + b) * 64 + F.lane] = acc[b];
        __syncthreads();
        for (int i = F.tid; i < 576; i += NWAVES * 64) { const int b = i / 64, cc2 = i % 64; float s = 0.f;
#pragma unroll
            for (int w = 0; w < 8; ++w) s += red[(w * 9 + b) * 64 + cc2];
            MOD[(size_t)(l * 9 + b) * MODW + n0 + cc2] = s + F.in[I_MODB][(size_t)l * MODW + n0 + cc2]; }
        __syncthreads();
    }
}
__device__ __forceinline__ void phase_rope(Frame& F) {
    float* RC = (float*)(F.ws + WS_ROPE); float* RS = RC + 96 * 32;
    const int idx = blockIdx.x * (NWAVES * 64) + F.tid;
    if (idx < 96 * 32) {
        const int pos = idx >> 5, i = idx & 31; const float p = (float)(pos < 32 ? pos : pos - 32);
        const float inv = exp2f(-(float)i * (13.287712379549449f / 32.0f));
        const float x = p * inv;
        const float kf = rintf(x * 0.6366197723675814f);
        float r = fmaf(-kf, 1.5707963705062866f, x); r = fmaf(-kf, -4.371138828673793e-8f, r);
        const float r2 = r * r;
        const float sn = r + r * r2 * (-1.6666667163e-1f + r2 * (8.3333337680e-3f + r2 * (-1.9841270114e-4f + r2 * 2.7557314297e-6f)));
        const float cs = 1.0f + r2 * (-0.5f + r2 * (4.1666667908e-2f + r2 * (-1.3888889225e-3f + r2 * (2.4801587642e-5f + r2 * -2.7557314297e-7f))));
        const int q = ((int)kf) & 3;
        const float sv = (q == 0) ? sn : (q == 1) ? cs : (q == 2) ? -sn : -cs;
        const float cv = (q == 0) ? cs : (q == 1) ? -sn : (q == 2) ? -cs : sn;
        RC[idx] = cv; RS[idx] = sv;
    }
}
template <int MAP> __device__ __forceinline__ int dst_row(int n) {
    if (MAP == 0) return n;
    if (MAP == 1) { const int half = n >= DFF ? 1 : 0, j = n - half * DFF; return (j >> 7) * 256 + half * 128 + (j & 127); }
    if (n < 1024) return n;
    if (n < 1040) return ZC_SMALL + (n - 1024);
    if (n < 2064) return 1024 + (n - 1040);
    if (n < 2080) return ZC_SMALL + 16 + (n - 2064);
    if (n < 2592) return 2048 + (n - 2080);
    return n + 224;
}
template <int MAP, bool PERMB> __device__ __forceinline__ void conv_item(const float* W, int K, int N, bf16* WT, LAS float* scr, int item, int lane) {
    const int nblk = N / 32, kb = item / nblk, nb = item % nblk, k0 = 64 * kb, n0 = 32 * nb;
#pragma unroll 8
    for (int i = 0; i < 32; ++i) { const int kk = 2 * i + (lane >> 5); scr[kk * 33 + (lane & 31)] = W[(size_t)(k0 + kk) * N + n0 + (lane & 31)]; }
    LDS_WAIT(); asm volatile("" ::: "memory");
    const int c = lane & 7;
#pragma unroll
    for (int j = 0; j < 4; ++j) { const int n = (lane >> 3) + 8 * j; const LAS float* s = scr + (8 * c) * 33 + n;
        v4u o; o.x = pk2(s[0 * 33], s[1 * 33]); o.y = pk2(s[2 * 33], s[3 * 33]); o.z = pk2(s[4 * 33], s[5 * 33]); o.w = pk2(s[6 * 33], s[7 * 33]);
        *(GAS v4u*)(WT + pg8::sw_off(dst_row<MAP>(n0 + n), k0 + 8 * c, K, PERMB)) = o; }
    LDS_WAIT(); asm volatile("" ::: "memory");
}
__device__ __forceinline__ void conv_set(Frame& F, int l, int set, unsigned* queue) {
    LAS float* scr = (LAS float*)(F.lds + RING_OFF + F.wave * 16384);
    const int gw = blockIdx.x * NWAVES + F.wave, NGW = F.G * NWAVES;
    constexpr int I_FI = (D / 64) * (2 * DFF / 32), I_FO = (DFF / 64) * (D / 32), I_Z = (D / 64) * (INC / 32), I_B = (512 / 64) * (D / 32), I_O = (D / 64) * (D / 32);
    bf16* WFI = (bf16*)(F.ws + WS_WFI); bf16* WFO = (bf16*)(F.ws + WS_WFO); bf16* WZ = (bf16*)(F.ws + WS_WZ); bf16* WB = (bf16*)(F.ws + WS_WB); bf16* WO = (bf16*)(F.ws + WS_WO);
    const float* fwi = F.in[set == 1 ? I_F2WI : I_F1WI] + (size_t)l * D * 2 * DFF; const float* fwo = F.in[set == 1 ? I_F2WO : I_F1WO] + (size_t)l * DFF * D;
    const int NIT = set < 2 ? (I_FI + I_FO) : (I_Z + 4 * I_B + I_O);
    int it = gw, lim = NIT, step = NGW;
    for (;;) {
        if (queue) { int base = 0; if (F.lane == 0) base = (int)__hip_atomic_fetch_add(queue, 16u, __ATOMIC_RELAXED, __HIP_MEMORY_SCOPE_AGENT);
            base = __builtin_amdgcn_readfirstlane(base); if (base >= NIT) break; it = base; lim = base + 16 < NIT ? base + 16 : NIT; step = 1; }
        for (; it < lim; it += step) {
            int r = it;
            if (set < 2) {
                if (r < I_FI) { conv_item<1, true>(fwi, D, 2 * DFF, WFI, scr, r, F.lane); continue; } r -= I_FI;
                conv_item<0, false>(fwo, DFF, D, WFO, scr, r, F.lane);
            } else {
                if (r < I_Z) { conv_item<2, true>(F.in[I_WIN] + (size_t)l * D * INC, D, INC, WZ, scr, r, F.lane); continue; } r -= I_Z;
                if (r < 4 * I_B) { const int n = r / I_B; conv_item<0, true>(F.in[I_WBR] + ((size_t)l * 4 + n) * 512 * D, 512, D, WB + (size_t)n * D * 512, scr, r % I_B, F.lane); continue; } r -= 4 * I_B;
                conv_item<0, false>(F.in[I_WOUT] + (size_t)l * D * D, D, D, WO, scr, r, F.lane);
            }
        }
        if (!queue) break;
    }
    if (set == 2 && (!queue || blockIdx.x < 32)) {
        GAS v4u* z = (GAS v4u*)(WZ + (size_t)(10 * 2) * (D / 64) * 8192); const int npc = 2 * (D / 64) * 1024; const int nb = queue ? 32 : F.G;
        for (int i = blockIdx.x * (NWAVES * 64) + F.tid; i < npc; i += nb * NWAVES * 64) { int R, C; pg8::stage_rc((i & 1023) * 16, R, C); const int h = i / (1024 * (D / 64));
            const int rowt = 128 * h + ((R & ~31) + pg8::perm32(R & 31)); if (rowt >= 32) z[i] = (v4u){0u, 0u, 0u, 0u}; }
    }
}
template <bool COPY, bool ADDP, bool ZSM> __device__ __forceinline__ void phase_norm(Frame& F, const float* xl, const float* xc, const float* gain, const float* mod  , int nrows) {
    bf16* H = (bf16*)(F.ws + WS_H);
    const int gw = blockIdx.x * NWAVES + F.wave, NGW = F.G * NWAVES;
    if (ZSM) {
        const bf16* wz = (const bf16*)(F.ws + WS_WZ);
        for (int i = F.tid; i < 32 * D * 2 / 16; i += NWAVES * 64) { const int c = i / (D / 8), k8 = (i % (D / 8)) * 8;
            *(LAS v4u*)(F.lds + RING_OFF + i * 16) = *(const GAS v4u*)(wz + pg8::sw_off(ZC_SMALL + c, k8, D, true)); }
        __syncthreads();
    }
    for (int row = gw; row < nrows; row += NGW) {
        const bool isc = row >= ML; const int b9 = isc ? 8 : row / SEQ;
        const GAS f32x4* xr = (const GAS f32x4*)(isc ? xc + (size_t)(row - ML) * D : xl + (size_t)row * D) + F.lane;
        f32x4 v[8]; float s = 0.f;
#pragma unroll
        for (int j = 0; j < 8; ++j) v[j] = xr[64 * j];
        if (ADDP && isc) {
            const GAS f32x4* pr = (const GAS f32x4*)((const float*)(F.ws + WS_MIX) + (size_t)(row - ML) * D) + F.lane;
#pragma unroll
            for (int q = 0; q < 4; ++q)
#pragma unroll
                for (int j = 0; j < 8; ++j) v[j] = v[j] + pr[(size_t)q * (2048 * 2048 / 4) + 64 * j];
            GAS f32x4* xw = (GAS f32x4*)((float*)(F.ws + WS_XC) + (size_t)(row - ML) * D) + F.lane;
#pragma unroll
            for (int j = 0; j < 8; ++j) xw[64 * j] = v[j];
        }
#pragma unroll
        for (int j = 0; j < 8; ++j) s += (v[j].x * v[j].x + v[j].y * v[j].y) + (v[j].z * v[j].z + v[j].w * v[j].w);
        if (COPY) { GAS f32x4* cp = (GAS f32x4*)(isc ? (float*)(F.ws + WS_XC) + (size_t)(row - ML) * D : F.out + (size_t)row * D) + F.lane;
#pragma unroll
            for (int j = 0; j < 8; ++j) cp[64 * j] = v[j]; }
        const float rstd = 1.0f / sqrtf(wave_sum(s) * (1.0f / D) + EPS);
        const float* sh = mod + (size_t)b9 * MODW; const float* sc = sh + D;
#pragma unroll
        for (int j = 0; j < 8; ++j) { const int c = 4 * F.lane + 256 * j;
            const f32x4 g = *(const f32x4*)(gain + c), a = *(const f32x4*)(sc + c), b = *(const f32x4*)(sh + c);
            const f32x4 y = (v[j] * rstd * g) * (a + 1.0f) + b;
            if (ZSM) v[j] = y;
            v2u w; w.x = pk2(y.x, y.y); w.y = pk2(y.z, y.w); *(GAS v2u*)(H + pg8::sw_off(row, c & ~7, D, false) + (c & 7)) = w; }
        if (ZSM && isc) {
            float res = 0.f;
            for (int c = 0; c < 32; ++c) { const LAS v2u* wr = (const LAS v2u*)(F.lds + RING_OFF + c * (D * 2)) + F.lane; float s = 0.f;
#pragma unroll
                for (int j = 0; j < 8; ++j) { const v2u w = wr[64 * j]; s += v[j].x * bflo(w.x) + v[j].y * bfhi(w.x) + v[j].z * bflo(w.y) + v[j].w * bfhi(w.y); }
                s = wave_sum(s); res = (F.lane == c) ? s : res; }
            if (F.lane < 32) ((float*)(F.ws + WS_ZS))[(size_t)row * 32 + F.lane] = res;
        }
    }
}
#include <hip/hip_bf16.h>
namespace attn {
using bf16 = __hip_bfloat16;
constexpr int   D = 128, NW = 8, QBLK = 32, KVBLK = 64;
constexpr float SCALE = 0.088388347648318440f;
constexpr float THR = 8.f;
constexpr int SDEPTH = 2;
constexpr int LDQ = 512, LDK = 256, LDO = 512;
constexpr size_t SHM_V = KVBLK * D * 2, SHM_K = KVBLK * D * 2, SHM_ATTN = 2 * SHM_V + 2 * SHM_K + NW * 64 * 4;
using bf16x8 = __attribute__((ext_vector_type(8))) short;
using s16x4  = __attribute__((ext_vector_type(4))) short;
using f32x16 = __attribute__((ext_vector_type(16))) float;
using f32x8  = __attribute__((ext_vector_type(8))) float;
using u32x4  = __attribute__((ext_vector_type(4))) unsigned;
#define KSWZ(row, colB) ((row) * 256 + ((colB) ^ (((row) & 7) << 4)))
#define SBAR() __builtin_amdgcn_sched_barrier(0)
__device__ __forceinline__ int crow(int r, int hi) { return (r & 3) + 8 * (r >> 2) + 4 * hi; }
__device__ __forceinline__ unsigned cvtpk(float lo, float hi) {
  unsigned r; asm volatile("v_cvt_pk_bf16_f32 %0, %1, %2" : "=v"(r) : "v"(lo), "v"(hi)); return r;
}
template <typename TIn> struct Stage;
template <> struct Stage<bf16>  { using T = bf16x8;
  __device__ static __forceinline__ T ld8(const bf16* p) { return *reinterpret_cast<const bf16x8*>(p); }
  __device__ static __forceinline__ bf16x8 tobf(T x) { return x; } };
template <> struct Stage<float> { using T = f32x8;
  __device__ static __forceinline__ T ld8(const float* p) { return *reinterpret_cast<const f32x8*>(p); }
  __device__ static __forceinline__ bf16x8 tobf(T x) {
    u32x4 w = {cvtpk(x[0], x[1]), cvtpk(x[2], x[3]), cvtpk(x[4], x[5]), cvtpk(x[6], x[7])}; return *reinterpret_cast<bf16x8*>(&w); } };

__device__ __forceinline__ void partialSM(f32x16& p0, f32x16& p1, float& m_reg, float& mn, float& alpha) {
  constexpr float C = SCALE * 1.4426950408889634f;
  float pmax = p0[0]; for (int r = 1; r < 16; ++r) pmax = fmaxf(pmax, p0[r]); for (int r = 0; r < 16; ++r) pmax = fmaxf(pmax, p1[r]);
  { auto rr = __builtin_amdgcn_permlane32_swap(__float_as_uint(pmax), __float_as_uint(pmax), false, false);
    pmax = fmaxf(__uint_as_float(rr[0]), __uint_as_float(rr[1])); }
  if (__builtin_expect(__all(pmax - m_reg <= THR / SCALE), 1)) { mn = m_reg; alpha = 1.f; }
  else { mn = fmaxf(m_reg, pmax); alpha = __builtin_amdgcn_exp2f((m_reg - mn) * C); m_reg = mn; }
  float mnC = -mn * C;
  for (int r = 0; r < 16; ++r) p0[r] = fmaf(p0[r], C, mnC); for (int r = 0; r < 16; ++r) p1[r] = fmaf(p1[r], C, mnC);
  for (int r = 0; r < 16; ++r) p0[r] = __builtin_amdgcn_exp2f(p0[r]);
}
__device__ __forceinline__ void finishSM(f32x16& p0, f32x16& p1, float alpha, float& l_reg, bf16x8& pa0, bf16x8& pa1, bf16x8& pa2, bf16x8& pa3) {
  for (int r = 0; r < 16; ++r) p1[r] = __builtin_amdgcn_exp2f(p1[r]);
  float ps = 0; for (int r = 0; r < 16; ++r) ps += p0[r]; for (int r = 0; r < 16; ++r) ps += p1[r];
  { auto rr = __builtin_amdgcn_permlane32_swap(__float_as_uint(ps), __float_as_uint(ps), false, false);
    ps = __uint_as_float(rr[0]) + __uint_as_float(rr[1]); }
  l_reg = l_reg * alpha + ps;
#define PK4(P, BASE, OUT) do { unsigned a0 = cvtpk(P[BASE + 0], P[BASE + 1]), a1 = cvtpk(P[BASE + 2], P[BASE + 3]);   \
    unsigned b0 = cvtpk(P[BASE + 4], P[BASE + 5]), b1 = cvtpk(P[BASE + 6], P[BASE + 7]);                              \
    auto r0 = __builtin_amdgcn_permlane32_swap(a0, b0, false, false); auto r1 = __builtin_amdgcn_permlane32_swap(a1, b1, false, false); \
    u32x4 w = {r0[0], r1[0], r0[1], r1[1]}; OUT = *reinterpret_cast<bf16x8*>(&w); } while (0)
  PK4(p0, 0, pa0); PK4(p0, 8, pa1); PK4(p1, 0, pa2); PK4(p1, 8, pa3);
#undef PK4
}
__device__ __forceinline__ void qkt(f32x16& p0, f32x16& p1, const bf16* Ks, const bf16x8* qr, int r32, int hi) {
  p0 = f32x16{}; p1 = f32x16{};
  for (int d0 = 0; d0 < 8; ++d0) { int cb = (d0 * 16 + hi * 8) * 2;
    bf16x8 b0 = *reinterpret_cast<const bf16x8*>((const char*)Ks + KSWZ(r32, cb));
    bf16x8 b1 = *reinterpret_cast<const bf16x8*>((const char*)Ks + KSWZ(32 + r32, cb));
    p0 = __builtin_amdgcn_mfma_f32_32x32x16_bf16(b0, qr[d0], p0, 0, 0, 0);
    p1 = __builtin_amdgcn_mfma_f32_32x32x16_bf16(b1, qr[d0], p1, 0, 0, 0); }
}
__device__ __forceinline__ int v_st(int k, int c) { const int kk = (k & ~0xC) | ((k & 4) << 1) | ((k & 8) >> 1); return ((kk >> 3) * 4 + (c >> 5)) * 512 + ((kk & 7) * 32 + (c & 31)) * 2; }
__device__ __forceinline__ int v_rd_base(int lane) { return ((lane & 3) << 3) | (((lane >> 2) & 3) << 6) | (((lane >> 4) & 1) << 5) | (((lane >> 5) & 1) << 8); }
constexpr int v_rd_off(int d0, int ks, int half) { return d0 * 512 + ks * 4096 + half * 2048; }
template <int OFF> __device__ __forceinline__ s16x4 tr_read(int vb) {
  s16x4 r; asm volatile("ds_read_b64_tr_b16 %0, %1 offset:%2" : "=&v"(r) : "v"(vb), "i"(OFF) : "memory"); return r;
}
template <int D0> __device__ __forceinline__ void pv_one(f32x16& od, int vb, bf16x8 pa0, bf16x8 pa1, bf16x8 pa2, bf16x8 pa3) {
  const s16x4 l0 = tr_read<v_rd_off(D0, 0, 0)>(vb), h0 = tr_read<v_rd_off(D0, 0, 1)>(vb), l1 = tr_read<v_rd_off(D0, 1, 0)>(vb), h1 = tr_read<v_rd_off(D0, 1, 1)>(vb);
  const s16x4 l2 = tr_read<v_rd_off(D0, 2, 0)>(vb), h2 = tr_read<v_rd_off(D0, 2, 1)>(vb), l3 = tr_read<v_rd_off(D0, 3, 0)>(vb), h3 = tr_read<v_rd_off(D0, 3, 1)>(vb);
  asm volatile("s_waitcnt lgkmcnt(0)" ::: "memory"); SBAR();
#define PK(L, H) (bf16x8){L[0], L[1], L[2], L[3], H[0], H[1], H[2], H[3]}
  od = __builtin_amdgcn_mfma_f32_32x32x16_bf16(pa0, PK(l0, h0), od, 0, 0, 0);
  od = __builtin_amdgcn_mfma_f32_32x32x16_bf16(pa1, PK(l1, h1), od, 0, 0, 0);
  od = __builtin_amdgcn_mfma_f32_32x32x16_bf16(pa2, PK(l2, h2), od, 0, 0, 0);
  od = __builtin_amdgcn_mfma_f32_32x32x16_bf16(pa3, PK(l3, h3), od, 0, 0, 0);
#undef PK
}
__device__ __forceinline__ void pv_d0(f32x16* o, int vb, bf16x8 pa0, bf16x8 pa1, bf16x8 pa2, bf16x8 pa3) {
  pv_one<0>(o[0], vb, pa0, pa1, pa2, pa3); pv_one<1>(o[1], vb, pa0, pa1, pa2, pa3); pv_one<2>(o[2], vb, pa0, pa1, pa2, pa3); pv_one<3>(o[3], vb, pa0, pa1, pa2, pa3);
}

template <typename TQ>
__device__ __forceinline__ void attn_dense_body(const TQ* __restrict__ Qb, const bf16* __restrict__ Kh, const bf16* __restrict__ Vh,
                                                bf16* __restrict__ Ob, int seq, char* lds) {
  using St = Stage<bf16>; using SQ = Stage<TQ>;
  const int tid = threadIdx.x, wid = tid >> 6, lane = tid & 63, r32 = lane & 31, hi = lane >> 5;
  bf16* V_lds = (bf16*)lds; bf16* K_lds = (bf16*)(lds + 2 * SHM_V);
  float* ws = (float*)(lds + 2 * SHM_V + 2 * SHM_K) + wid * 64; float* li_l = ws; float* al_l = ws + 32;
  float m_reg = -1e30f, l_reg = 0; f32x16 o[4] = {}; bf16x8 qr[8];
  const TQ* Qw = Qb + (long)(wid * QBLK + r32) * LDQ + hi * 8;
#pragma unroll
  for (int d0 = 0; d0 < 8; ++d0) qr[d0] = SQ::tobf(SQ::ld8(Qw + d0 * 16));
  const int sr = tid >> 4, sc = (tid & 15) * 8, vst0 = v_st(sr, sc), vst1 = v_st(32 + sr, sc);
  const int vb0 = (int)(uintptr_t)V_lds + v_rd_base(lane);
  struct { typename St::T vs0, vs1, ks0, ks1; } sr_[SDEPTH];
#define SLOAD(i, k0) do { sr_[i].vs0 = St::ld8(&Vh[(long)((k0) + sr) * LDK + sc]); sr_[i].vs1 = St::ld8(&Vh[(long)((k0) + 32 + sr) * LDK + sc]); \
    sr_[i].ks0 = St::ld8(&Kh[(long)((k0) + sr) * LDK + sc]); sr_[i].ks1 = St::ld8(&Kh[(long)((k0) + 32 + sr) * LDK + sc]); } while (0)
#define SWRITE(b, i) do { *(bf16x8*)((char*)V_lds + (b) * SHM_V + vst0) = St::tobf(sr_[i].vs0);          \
    *(bf16x8*)((char*)V_lds + (b) * SHM_V + vst1) = St::tobf(sr_[i].vs1); int kc = sc * 2;               \
    *(bf16x8*)((char*)K_lds + (b) * SHM_K + KSWZ(sr, kc)) = St::tobf(sr_[i].ks0);                       \
    *(bf16x8*)((char*)K_lds + (b) * SHM_K + KSWZ(32 + sr, kc)) = St::tobf(sr_[i].ks1); } while (0)
#define SWAIT() do { if constexpr (SDEPTH == 2) asm volatile("s_waitcnt vmcnt(4)" ::: "memory"); else asm volatile("s_waitcnt vmcnt(0)" ::: "memory"); } while (0)
#define RESC(a) do { if (__any((a) < 1.f)) { if (hi == 0) al_l[r32] = (a); asm volatile("s_waitcnt lgkmcnt(0)" ::: "memory"); \
    for (int d = 0; d < 4; ++d) for (int r = 0; r < 16; ++r) o[d][r] *= al_l[crow(r, hi)]; } } while (0)
  f32x16 pA0, pA1, pB0, pB1; float mnA, mnB, alA, alB; bf16x8 pa0, pa1, pa2, pa3; const int NT = seq / KVBLK;
  constexpr int SE = 0, SO = SDEPTH - 1;
  SLOAD(SE, 0); asm volatile("s_waitcnt vmcnt(0)" ::: "memory"); SWRITE(0, SE); __syncthreads();
  qkt(pA0, pA1, K_lds, qr, r32, hi); partialSM(pA0, pA1, m_reg, mnA, alA);
  SLOAD(SO, KVBLK); if constexpr (SDEPTH == 2) { if (2 < NT) SLOAD(SE, 2 * KVBLK); }
  SWAIT(); SWRITE(1, SO); __syncthreads();
  for (int j = 1; j + 1 < NT; j += 2) {
    SBAR(); qkt(pB0, pB1, (bf16*)((char*)K_lds + SHM_K), qr, r32, hi);
    finishSM(pA0, pA1, alA, l_reg, pa0, pa1, pa2, pa3); SBAR();
    SLOAD(SO, (j + SDEPTH) * KVBLK); SBAR();
    pv_d0(o, vb0, pa0, pa1, pa2, pa3); partialSM(pB0, pB1, m_reg, mnB, alB);
    __syncthreads(); SWAIT(); SWRITE(0, SE);
    RESC(alB); __syncthreads();
    SBAR(); qkt(pA0, pA1, K_lds, qr, r32, hi);
    finishSM(pB0, pB1, alB, l_reg, pa0, pa1, pa2, pa3); SBAR();
    if (SDEPTH == 1 || j + 3 < NT) SLOAD(SE, (j + 1 + SDEPTH) * KVBLK); SBAR();
    pv_d0(o, vb0 + (int)SHM_V, pa0, pa1, pa2, pa3); partialSM(pA0, pA1, m_reg, mnA, alA);
    __syncthreads(); SWAIT(); SWRITE(1, SO);
    RESC(alA); __syncthreads();
  }
  SBAR(); qkt(pB0, pB1, (bf16*)((char*)K_lds + SHM_K), qr, r32, hi);
  finishSM(pA0, pA1, alA, l_reg, pa0, pa1, pa2, pa3); SBAR();
  pv_d0(o, vb0, pa0, pa1, pa2, pa3); partialSM(pB0, pB1, m_reg, mnB, alB);
  __syncthreads(); RESC(alB);
  finishSM(pB0, pB1, alB, l_reg, pa0, pa1, pa2, pa3); SBAR();
  pv_d0(o, vb0 + (int)SHM_V, pa0, pa1, pa2, pa3);
  if (hi == 0) li_l[r32] = l_reg; asm volatile("s_waitcnt lgkmcnt(0)" ::: "memory");
  float rli[16];
#pragma unroll
  for (int r = 0; r < 16; ++r) rli[r] = __builtin_amdgcn_rcpf(li_l[crow(r, hi)]);
  bf16* Ow = Ob + (long)(wid * QBLK) * LDO;
#pragma unroll
  for (int r = 0; r < 16; ++r) { int orow = crow(r, hi);
    for (int d0 = 0; d0 < 4; ++d0) Ow[(long)orow * LDO + d0 * 32 + r32] = __float2bfloat16(o[d0][r] * rli[r]); }
#undef SLOAD
#undef SWRITE
#undef SWAIT
#undef RESC
}

#undef KSWZ
#undef SBAR
}
constexpr size_t MX_CL = 0;
constexpr size_t MX_CP = 36 * MiB;
constexpr size_t MX_NL = 72 * MiB;
constexpr size_t MX_NP = 73 * MiB;
constexpr size_t MX_ST = 74 * MiB;
constexpr size_t MX_SP = 75 * MiB;
constexpr size_t MX_GQ = 76 * MiB, MX_GK = 94 * MiB, MX_GV = 112 * MiB;
constexpr size_t MX_GG = 130 * MiB, MX_GB = 131 * MiB;
constexpr size_t MX_GD1 = 132 * MiB;
constexpr size_t GD1_ITEM = 73728;
constexpr size_t MX_GE = 294 * MiB;
static_assert(MX_GD1 + (size_t)2304 * GD1_ITEM <= MX_GE && WS_MIX + MX_GE + 2304 * 128 <= WS_END, "mixer scratch map");

typedef float f32x4m __attribute__((ext_vector_type(4)));
#define MFMA16(a, b, c) __builtin_amdgcn_mfma_f32_16x16x32_bf16((a), (b), (c), 0, 0, 0)
__device__ __forceinline__ bf16x8 lds_frag(const LAS unsigned char* base, int stride, int row0, int kb, int lane) {
    return *(const LAS bf16x8*)(base + (row0 + (lane & 15)) * stride + kb + (lane >> 4) * 16);
}
__device__ __forceinline__ float gelu_tanh(float x) { const float y = 0.7978845608028654f * (x + 0.044715f * x * x * x); const float t = 1.0f - 2.0f / (1.0f + __expf(2.0f * y)); return 0.5f * x * (1.0f + t); }
__device__ __forceinline__ float logsigmoid1(float x) { return fminf(x, 0.f) - log1pf(__expf(-fabsf(x))); }
__device__ __forceinline__ float softplus1(float x) { return fmaxf(x, 0.f) + log1pf(__expf(-fabsf(x))); }
__device__ __forceinline__ int perm32p(int jl) { return 8 * ((jl & 15) >> 2) + 4 * (jl >> 4) + (jl & 3); }

__device__ __forceinline__ float wscan_sum_f(float v, int lane) {
#pragma unroll
    for (int o = 1; o < 64; o <<= 1) { const float t = __shfl_up(v, o); if (lane >= o) v += t; }
    return v;
}
__device__ __forceinline__ float wscan_sum_b(float v, int lane) {
#pragma unroll
    for (int o = 1; o < 64; o <<= 1) { const float t = __shfl_down(v, o); if (lane + o < 64) v += t; }
    return v;
}
__device__ __forceinline__ float wscan_max_f(float v, int lane) {
#pragma unroll
    for (int o = 1; o < 64; o <<= 1) { const float t = __shfl_up(v, o); if (lane >= o) v = fmaxf(v, t); }
    return v;
}
__device__ __forceinline__ float wscan_max_b(float v, int lane) {
#pragma unroll
    for (int o = 1; o < 64; o <<= 1) { const float t = __shfl_down(v, o); if (lane + o < 64) v = fmaxf(v, t); }
    return v;
}
__device__ __forceinline__ void phase_attn_prep(Frame& F, int l, bool last) {
    const bf16* Z = (const bf16*)(F.ws + WS_Z); bf16* QA = (bf16*)(F.ws + WS_QA); bf16* KC = (bf16*)(F.ws + WS_KC); bf16* VC = (bf16*)(F.ws + WS_VC);
    const float* RC = (const float*)(F.ws + WS_ROPE); const float* RS = RC + 96 * 32;
    const float* gq = F.in[I_ATQN] + l * 128; const float* gk = F.in[I_ATKN] + l * 128;
    const int gw = blockIdx.x * NWAVES + F.wave, NGW = F.G * NWAVES;
    const int half = F.lane >> 5, i = F.lane & 31, da = 64 * half + i, db = da + 32;
    const float gqa = gq[da], gqb = gq[db], gka = gk[da], gkb = gk[db];
    for (int row = gw; row < MT; row += NGW) {
        const bool isc = row >= ML; const int b = isc ? (row - ML) / CTXL : row / SEQ, t = isc ? (row - ML) % CTXL : row % SEQ;
        const bf16* zr = Z + (size_t)row * ZLD;
        float cs = 1.f, sn = 0.f;
        if (!isc) { const int pos = half ? 32 + (t & 63) : (t >> 6); cs = RC[pos * 32 + i]; sn = RS[pos * 32 + i]; }
        if (!(isc && last)) {
#pragma unroll
            for (int h = 0; h < 4; ++h) {
                const float a = bf1(zr[ZC_ATQ + h * 128 + da]), bb = bf1(zr[ZC_ATQ + h * 128 + db]);
                const float rs = 1.0f / sqrtf(wave_sum(a * a + bb * bb) * (1.0f / 128.0f) + EPS);
                const float ya = a * rs * gqa, yb = bb * rs * gqb;
                QA[(size_t)row * 512 + h * 128 + da] = f2bf1(ya * cs - yb * sn); QA[(size_t)row * 512 + h * 128 + db] = f2bf1(yb * cs + ya * sn);
            }
        }
        const size_t krow = (size_t)b * 2304 + (isc ? t : 256 + t);
#pragma unroll
        for (int h = 0; h < 2; ++h) {
            const float a = bf1(zr[ZC_ATK + h * 128 + da]), bb = bf1(zr[ZC_ATK + h * 128 + db]);
            const float rs = 1.0f / sqrtf(wave_sum(a * a + bb * bb) * (1.0f / 128.0f) + EPS);
            const float ya = a * rs * gka, yb = bb * rs * gkb;
            KC[krow * 256 + h * 128 + da] = f2bf1(ya * cs - yb * sn); KC[krow * 256 + h * 128 + db] = f2bf1(yb * cs + ya * sn);
        }
        *(GAS v2u*)(VC + krow * 256 + 4 * F.lane) = *(const GAS v2u*)(zr + ZC_ATV + 4 * F.lane);
        if (!(isc && last)) {
            const v4u w = *(const GAS v4u*)(zr + ZC_SGV + 8 * F.lane);
            const float e0 = gelu_tanh(bflo(w.x)), e1 = gelu_tanh(bfhi(w.x)), e2 = gelu_tanh(bflo(w.y)), e3 = gelu_tanh(bfhi(w.y)), e4 = gelu_tanh(bflo(w.z)), e5 = gelu_tanh(bfhi(w.z)), e6 = gelu_tanh(bflo(w.w)), e7 = gelu_tanh(bfhi(w.w));
            const float ss = wave_sum((e0 * e0 + e1 * e1) + (e2 * e2 + e3 * e3) + (e4 * e4 + e5 * e5) + (e6 * e6 + e7 * e7));
            if (F.lane == 0) ((float*)(F.ws + WS_ROPE + 65536))[(row >> 3) * 32 + (row & 7)] = 1.0f / sqrtf(ss * (1.0f / 512.0f) + EPS);
        }
    }
}
__device__ __forceinline__ void attn_item(Frame& F, int it) {
    const attn::bf16* QA = (const attn::bf16*)(F.ws + WS_QA); const attn::bf16* KC = (const attn::bf16*)(F.ws + WS_KC); const attn::bf16* VC = (const attn::bf16*)(F.ws + WS_VC);
    attn::bf16* Y3 = (attn::bf16*)(F.ws + WS_Y) + (size_t)3 * MT * 512;
    int h, b, seq; size_t r0;
    if (it < 256) { const int qb = it & 7; h = (it >> 3) & 3; b = it >> 5; r0 = (size_t)b * SEQ + qb * 256; seq = 2304; }
    else { const int j = it - 256; h = j & 3; b = j >> 2; r0 = (size_t)ML + b * CTXL; seq = 256; }
    attn::attn_dense_body<attn::bf16>(QA + r0 * 512 + h * 128, KC + (size_t)b * 2304 * 256 + (h >> 1) * 128, VC + (size_t)b * 2304 * 256 + (h >> 1) * 128, Y3 + r0 * 512 + h * 128, seq, (char*)F.lds + RING_OFF);
    __syncthreads();
}
__device__ __forceinline__ void phase_spatial(Frame& F, int l, bool last) {
    const bf16* Z = (const bf16*)(F.ws + WS_Z); bf16* Y0 = (bf16*)(F.ws + WS_Y);
    LAS unsigned char* Wl = F.lds + RING_OFF; LAS unsigned char* Vt = Wl + 34816;
    const int nchunk = last ? ML / 128 : MT / 128;
    const int tid = F.tid, r = tid >> 2, q = tid & 3;
    for (int it = F.G - 1 - (int)blockIdx.x; it < nchunk * 4; it += F.G) {
        const int ch = it >> 2, g = it & 3; const size_t row0 = (size_t)ch * 128;
        const bf16* zv = Z + (row0 + r) * ZLD + ZC_SGV;
        const float rstd = ((const float*)(F.ws + WS_ROPE + 65536))[((row0 + r) >> 3) * 32 + ((row0 + r) & 7)];
        const float* gn = F.in[I_SGN] + l * 512 + g * 128 + q * 32;
#pragma unroll
        for (int j = 0; j < 4; ++j) { const v4u w = *(const GAS v4u*)(zv + g * 128 + q * 32 + j * 8);
            const float e[8] = {gelu_tanh(bflo(w.x)), gelu_tanh(bfhi(w.x)), gelu_tanh(bflo(w.y)), gelu_tanh(bfhi(w.y)), gelu_tanh(bflo(w.z)), gelu_tanh(bfhi(w.z)), gelu_tanh(bflo(w.w)), gelu_tanh(bfhi(w.w))};
#pragma unroll
            for (int k = 0; k < 8; ++k) { const int c = q * 32 + j * 8 + k; *(LAS bf16*)(Vt + c * 272 + r * 2) = f2bf1(e[k] * rstd * gn[j * 8 + k]); } }
        const float* wg = F.in[I_SGW] + ((size_t)(l * 4 + g) * 128 + r) * 128 + q * 32;
#pragma unroll
        for (int j = 0; j < 4; ++j) { const f32x4 a = *(const f32x4*)(wg + j * 8), b = *(const f32x4*)(wg + j * 8 + 4);
            v4u o; o.x = pk2(a.x, a.y); o.y = pk2(a.z, a.w); o.z = pk2(b.x, b.y); o.w = pk2(b.z, b.w);
            *(LAS v4u*)(Wl + r * 272 + (q * 32 + j * 8) * 2) = o; }
        __syncthreads();
        const int wr = F.wave >> 1, wc = F.wave & 1;
        f32x4 acc[2][4];
#pragma unroll
        for (int mi = 0; mi < 2; ++mi)
#pragma unroll
            for (int ni = 0; ni < 4; ++ni) acc[mi][ni] = (f32x4){0.f, 0.f, 0.f, 0.f};
#pragma unroll
        for (int ks = 0; ks < 4; ++ks) {
            bf16x8 a[2], b[4];
#pragma unroll
            for (int mi = 0; mi < 2; ++mi) a[mi] = lds_frag(Wl, 272, 32 * wr + 16 * mi, ks * 64, F.lane);
#pragma unroll
            for (int ni = 0; ni < 4; ++ni) b[ni] = lds_frag(Vt, 272, 64 * wc + 16 * ni, ks * 64, F.lane);
#pragma unroll
            for (int mi = 0; mi < 2; ++mi)
#pragma unroll
                for (int ni = 0; ni < 4; ++ni) acc[mi][ni] = MFMA16(a[mi], b[ni], acc[mi][ni]);
        }
        const float* bs = F.in[I_SGB] + (l * 4 + g) * 128;
#pragma unroll
        for (int mi = 0; mi < 2; ++mi)
#pragma unroll
            for (int rr = 0; rr < 4; ++rr) { const int t = 32 * wr + 16 * mi + 4 * (F.lane >> 4) + rr; const float bias = bs[t];
#pragma unroll
                for (int ni = 0; ni < 4; ++ni) { const int c = g * 128 + 64 * wc + 16 * ni + (F.lane & 15);
                    const float u = gelu_tanh(bf1(Z[(row0 + t) * ZLD + ZC_SGU + c]));
                    Y0[(row0 + t) * 512 + c] = f2bf1(u * (acc[mi][ni][rr] + bias)); } }
        __syncthreads();
    }
}
__device__ __forceinline__ void ml_slot(int chain, int k, int& rowbase, int& h, int& dir) {
    const int b = chain >> 3; h = (chain >> 1) & 3; dir = chain & 1;
    if (k < 2) { const int j = dir ? 1 - k : k; rowbase = ML + b * CTXL + 128 * j; }
    else { const int n = k - 2, j = dir ? 15 - n : n; rowbase = b * SEQ + 128 * j; }
}
__device__ __forceinline__ void ml_gates(Frame& F, int l, int rowbase, int h, int dir, LAS float* li, LAS float* lf, LAS float* bc) {
    const float* ZS = (const float*)(F.ws + WS_ZS); const float* bias = F.in[I_MLIFB] + l * 16;
    float s = 0.f;
    if (F.tid < 128) { const float* zr = ZS + (size_t)(rowbase + F.tid) * 32;
        li[F.tid] = zr[dir * 4 + h] + bias[dir * 4 + h];
        const float f = logsigmoid1(zr[(2 + dir) * 4 + h] + bias[(2 + dir) * 4 + h]);
        s = dir ? wscan_sum_b(f, F.lane) : wscan_sum_f(f, F.lane);
        if (dir == 0 && F.tid == 63) lf[0] = s;
        if (dir == 1 && F.tid == 64) lf[0] = s; }
    __syncthreads();
    if (F.tid < 128) { if ((dir == 0 && F.tid >= 64) || (dir == 1 && F.tid < 64)) s += lf[0]; bc[F.tid] = s; }
    __syncthreads();
}
__device__ __forceinline__ void phase_ml1(Frame& F, int l) {
    const bf16* Z = (const bf16*)(F.ws + WS_Z);
    bf16* CL = (bf16*)(F.ws + WS_MIX + MX_CL); float* NL = (float*)(F.ws + WS_MIX + MX_NL); float* ST = (float*)(F.ws + WS_MIX + MX_ST);
    LAS unsigned char* kT = F.lds + RING_OFF; LAS unsigned char* vT = kT + 34816;
    LAS float* li = (LAS float*)(F.lds + RING_OFF + 69632); LAS float* lf = li + 128; LAS float* bc = lf + 128; LAS float* wg = bc + 128; LAS float* red = wg + 128;
    const int tid = F.tid, tau = tid >> 2, q = tid & 3;
    for (int it = blockIdx.x; it < 64 * 18; it += F.G) {
        const int chain = it / 18, k = it % 18; int rowbase, h, dir; ml_slot(chain, k, rowbase, h, dir);
        ml_gates(F, l, rowbase, h, dir, li, lf, bc);
        const float bend = dir ? bc[0] : bc[127];
        if (tid < 128) wg[tid] = bend - bc[tid] + li[tid];
        __syncthreads();
        if (tid < 64) { float m = fmaxf(wg[tid], wg[tid + 64]);
#pragma unroll
            for (int o = 1; o < 64; o <<= 1) m = fmaxf(m, __shfl_xor(m, o));
            if (tid == 0) red[0] = m; }
        __syncthreads();
        const float mloc = red[0];
        __syncthreads();
        if (tid < 128) wg[tid] = __expf(wg[tid] - mloc);
        __syncthreads();
        { const bf16* zk = Z + (size_t)(rowbase + tau) * ZLD + ZC_MLK + h * 128 + q * 32; const bf16* zv = Z + (size_t)(rowbase + tau) * ZLD + ZC_MLV + h * 128 + q * 32; const float w = wg[tau];
#pragma unroll
          for (int j = 0; j < 4; ++j) { const v4u a = *(const GAS v4u*)(zk + j * 8), b = *(const GAS v4u*)(zv + j * 8);
              const float ka[8] = {bflo(a.x), bfhi(a.x), bflo(a.y), bfhi(a.y), bflo(a.z), bfhi(a.z), bflo(a.w), bfhi(a.w)};
              const float va[8] = {bflo(b.x), bfhi(b.x), bflo(b.y), bfhi(b.y), bflo(b.z), bfhi(b.z), bflo(b.w), bfhi(b.w)};
#pragma unroll
              for (int c = 0; c < 8; ++c) { const int col = q * 32 + j * 8 + c;
                  *(LAS bf16*)(kT + col * 272 + tau * 2) = f2bf1(ka[c] * 0.08838834764831845f);
                  *(LAS bf16*)(vT + col * 272 + tau * 2) = f2bf1(va[c] * w); } } }
        __syncthreads();
        const int wr = F.wave >> 1, wc = F.wave & 1;
        f32x4 acc[2][4];
#pragma unroll
        for (int mi = 0; mi < 2; ++mi)
#pragma unroll
            for (int ni = 0; ni < 4; ++ni) acc[mi][ni] = (f32x4){0.f, 0.f, 0.f, 0.f};
#pragma unroll
        for (int ks = 0; ks < 4; ++ks) {
            bf16x8 a[2], b[4];
#pragma unroll
            for (int mi = 0; mi < 2; ++mi) a[mi] = lds_frag(vT, 272, 32 * wr + 16 * mi, ks * 64, F.lane);
#pragma unroll
            for (int ni = 0; ni < 4; ++ni) b[ni] = lds_frag(kT, 272, 64 * wc + 16 * ni, ks * 64, F.lane);
#pragma unroll
            for (int mi = 0; mi < 2; ++mi)
#pragma unroll
                for (int ni = 0; ni < 4; ++ni) acc[mi][ni] = MFMA16(a[mi], b[ni], acc[mi][ni]);
        }
        bf16* cl = CL + (size_t)it * 16384;
#pragma unroll
        for (int mi = 0; mi < 2; ++mi)
#pragma unroll
            for (int rr = 0; rr < 4; ++rr) { const int e = 32 * wr + 16 * mi + 4 * (F.lane >> 4) + rr;
#pragma unroll
                for (int ni = 0; ni < 4; ++ni) cl[e * 128 + 64 * wc + 16 * ni + (F.lane & 15)] = f2bf1(acc[mi][ni][rr]); }
        { float s = 0.f; const LAS bf16* kr = (const LAS bf16*)(kT + tau * 272) + q * 32;
#pragma unroll 8
          for (int t = 0; t < 32; ++t) s += wg[q * 32 + t] * bf1(kr[t]);
          s += __shfl_xor(s, 1); s += __shfl_xor(s, 2);
          if (q == 0) NL[(size_t)it * 128 + tau] = s; }
        if (tid == 0) { ST[it * 32 + 0] = mloc; ST[it * 32 + 1] = bend; }
        __syncthreads();
    }
}
__device__ __forceinline__ void phase_ml2(Frame& F, int wg0) {
    const bf16* CL = (const bf16*)(F.ws + WS_MIX + MX_CL); const float* NL = (const float*)(F.ws + WS_MIX + MX_NL); const float* ST = (const float*)(F.ws + WS_MIX + MX_ST);
    bf16* CP = (bf16*)(F.ws + WS_MIX + MX_CP); float* NP = (float*)(F.ws + WS_MIX + MX_NP); float* SP = (float*)(F.ws + WS_MIX + MX_SP);
    if ((int)blockIdx.x < wg0) return;
    const int gt = ((int)blockIdx.x - wg0) * (NWAVES * 64) + F.tid, NT = (F.G - wg0) * NWAVES * 64;
    for (int task = gt; task < 64 * 4096; task += NT) {
        const int chain = task >> 12, e4 = (task & 4095) * 4;
        v2u w[18]; float ml[18], be[18];
#pragma unroll
        for (int k = 0; k < 18; ++k) { const int it = chain * 18 + k; w[k] = *(const GAS v2u*)(CL + (size_t)it * 16384 + e4); ml[k] = ST[it * 32 + 0]; be[k] = ST[it * 32 + 1]; }
        float c0 = 0.f, c1 = 0.f, c2 = 0.f, c3 = 0.f, m = 0.f;
#pragma unroll
        for (int k = 0; k < 18; ++k) { const int it = chain * 18 + k;
            v2u o; o.x = pk2(c0, c1); o.y = pk2(c2, c3); *(GAS v2u*)(CP + (size_t)it * 16384 + e4) = o;
            const float mn = fmaxf(be[k] + m, ml[k]), sp = __expf(be[k] + m - mn), sl = __expf(ml[k] - mn);
            c0 = sp * c0 + sl * bflo(w[k].x); c1 = sp * c1 + sl * bfhi(w[k].x); c2 = sp * c2 + sl * bflo(w[k].y); c3 = sp * c3 + sl * bfhi(w[k].y); m = mn; }
    }
    for (int task = gt; task < 64 * 128; task += NT) {
        const int chain = task >> 7, d = task & 127; float n = 0.f, m = 0.f;
        float nl[18], ml[18], be[18];
#pragma unroll
        for (int k = 0; k < 18; ++k) { const int it = chain * 18 + k; nl[k] = NL[(size_t)it * 128 + d]; ml[k] = ST[it * 32 + 0]; be[k] = ST[it * 32 + 1]; }
#pragma unroll
        for (int k = 0; k < 18; ++k) { const int it = chain * 18 + k;
            NP[(size_t)it * 128 + d] = n;
            if (d == 0) SP[it * 32] = m;
            const float mn = fmaxf(be[k] + m, ml[k]), sp = __expf(be[k] + m - mn), sl = __expf(ml[k] - mn);
            n = sp * n + sl * nl[k]; m = mn; }
    }
}
__device__ __forceinline__ void ml3_item(Frame& F, int l, int it) {
    const bf16* Z = (const bf16*)(F.ws + WS_Z); bf16* Y1 = (bf16*)(F.ws + WS_Y) + (size_t)MT * 512;
    const bf16* CL = (const bf16*)(F.ws + WS_MIX + MX_CP); const float* NL = (const float*)(F.ws + WS_MIX + MX_NP); const float* ST = (const float*)(F.ws + WS_MIX + MX_SP);
    LAS unsigned char* qs = F.lds + RING_OFF; LAS unsigned char* ks = qs + 34816; LAS unsigned char* vT = ks + 34816;
    LAS float* li = (LAS float*)(F.lds + RING_OFF + 104448); LAS float* lf = li + 128; LAS float* bc = lf + 128; LAS float* cv = bc + 128; LAS float* Mt = cv + 128;
    LAS float* inter = Mt + 128; LAS float* rden = inter + 128; LAS float* emt = rden + 128; LAS float* rowss = emt + 128; LAS float* npv = rowss + 256;
    const int tid = F.tid, tau = tid >> 2, q = tid & 3, lane = F.lane, g4 = lane >> 4, l15 = lane & 15;
    {
        int b, h, j, rowbase, nch;
        if (it < 512) { b = it >> 6; h = (it >> 4) & 3; j = it & 15; rowbase = b * SEQ + 128 * j; nch = 16; }
        else { const int r = it - 512; b = r >> 3; h = (r >> 1) & 3; j = r & 1; rowbase = ML + b * CTXL + 128 * j; nch = 2; }
        { const bf16* zq = Z + (size_t)(rowbase + tau) * ZLD + ZC_MLQ + h * 128 + q * 32; const bf16* zk = Z + (size_t)(rowbase + tau) * ZLD + ZC_MLK + h * 128 + q * 32;
          const bf16* zv = Z + (size_t)(rowbase + tau) * ZLD + ZC_MLV + h * 128 + q * 32;
#pragma unroll
          for (int jj = 0; jj < 4; ++jj) { const v4u a = *(const GAS v4u*)(zq + jj * 8), kk = *(const GAS v4u*)(zk + jj * 8), vv = *(const GAS v4u*)(zv + jj * 8);
              *(LAS v4u*)(qs + tau * 272 + (q * 32 + jj * 8) * 2) = a;
              v4u ko; const float s = 0.08838834764831845f;
              ko.x = pk2(bflo(kk.x) * s, bfhi(kk.x) * s); ko.y = pk2(bflo(kk.y) * s, bfhi(kk.y) * s); ko.z = pk2(bflo(kk.z) * s, bfhi(kk.z) * s); ko.w = pk2(bflo(kk.w) * s, bfhi(kk.w) * s);
              *(LAS v4u*)(ks + tau * 272 + (q * 32 + jj * 8) * 2) = ko;
              const unsigned vw[4] = {vv.x, vv.y, vv.z, vv.w};
#pragma unroll
              for (int c = 0; c < 4; ++c) { const int col = q * 32 + jj * 8 + 2 * c;
                  *(LAS bf16*)(vT + col * 272 + tau * 2) = (bf16)(vw[c] & 0xffffu); *(LAS bf16*)(vT + (col + 1) * 272 + tau * 2) = (bf16)(vw[c] >> 16); } } }
        __syncthreads();
        const int wr = F.wave >> 1, wc = F.wave & 1;
        f32x4 accS[2][4];
#pragma unroll
        for (int mi = 0; mi < 2; ++mi)
#pragma unroll
            for (int ni = 0; ni < 4; ++ni) accS[mi][ni] = (f32x4){0.f, 0.f, 0.f, 0.f};
#pragma unroll
        for (int kk = 0; kk < 4; ++kk) {
            bf16x8 a[2], bq[4];
#pragma unroll
            for (int mi = 0; mi < 2; ++mi) a[mi] = lds_frag(ks, 272, 32 * wr + 16 * mi, kk * 64, lane);
#pragma unroll
            for (int ni = 0; ni < 4; ++ni) bq[ni] = lds_frag(qs, 272, 64 * wc + 16 * ni, kk * 64, lane);
#pragma unroll
            for (int mi = 0; mi < 2; ++mi)
#pragma unroll
                for (int ni = 0; ni < 4; ++ni) accS[mi][ni] = MFMA16(a[mi], bq[ni], accS[mi][ni]);
        }
        f32x4 hsum[2][4];
#pragma unroll
        for (int mi = 0; mi < 2; ++mi)
#pragma unroll
            for (int ni = 0; ni < 4; ++ni) hsum[mi][ni] = (f32x4){0.f, 0.f, 0.f, 0.f};
        for (int dir = 0; dir < 2; ++dir) {
            const int n = dir ? nch - 1 - j : j, slot = (it < 512) ? 2 + n : n, chain = (b * 4 + h) * 2 + dir, sit = chain * 18 + slot;
            __syncthreads();
            ml_gates(F, l, rowbase, h, dir, li, lf, bc);
            const float mprev = ST[sit * 32];
            if (tid < 128) { cv[tid] = li[tid] - bc[tid]; npv[tid] = NL[(size_t)sit * 128 + tid]; }
            __syncthreads();
            float mx = -3.0e38f;
            if (tid < 128) { mx = dir ? wscan_max_b(cv[tid], lane) : wscan_max_f(cv[tid], lane);
                if (dir == 0 && tid == 63) lf[1] = mx; if (dir == 1 && tid == 64) lf[1] = mx; }
            __syncthreads();
            if (tid < 128) { if ((dir == 0 && tid >= 64) || (dir == 1 && tid < 64)) mx = fmaxf(mx, lf[1]);
                const float M = fmaxf(mx, mprev); Mt[tid] = M; inter[tid] = __expf(mprev - M); emt[tid] = __expf(-(bc[tid] + M)); }
            __syncthreads();
#pragma unroll
            for (int mi = 0; mi < 2; ++mi)
#pragma unroll
                for (int ni = 0; ni < 4; ++ni) { const int t = 64 * wc + 16 * ni + l15, s0 = 32 * wr + 16 * mi + 4 * g4; const float M = Mt[t];
                    float p[4];
#pragma unroll
                    for (int rr = 0; rr < 4; ++rr) { const int s = s0 + rr; const bool ok = dir ? (s >= t) : (s <= t); p[rr] = ok ? __expf(cv[s] - M) * accS[mi][ni][rr] : 0.f; }
                    v2u o; o.x = pk2(p[0], p[1]); o.y = pk2(p[2], p[3]); *(LAS v2u*)(ks + t * 272 + s0 * 2) = o; }
            __syncthreads();
            { float sp = 0.f, sn = 0.f; const LAS bf16* pr = (const LAS bf16*)(ks + tau * 272) + q * 32; const LAS bf16* qr = (const LAS bf16*)(qs + tau * 272) + q * 32;
#pragma unroll 8
              for (int c = 0; c < 32; ++c) { sp += bf1(pr[c]); sn += npv[q * 32 + c] * bf1(qr[c]); }
              sp += __shfl_xor(sp, 1); sp += __shfl_xor(sp, 2); sn += __shfl_xor(sn, 1); sn += __shfl_xor(sn, 2);
              if (q == 0) { const float den = sp + inter[tau] * sn; rden[tau] = 1.0f / fmaxf(fabsf(den), emt[tau]); } }
            f32x4 acc[2][4];
#pragma unroll
            for (int mi = 0; mi < 2; ++mi)
#pragma unroll
                for (int ni = 0; ni < 4; ++ni) acc[mi][ni] = (f32x4){0.f, 0.f, 0.f, 0.f};
            const bf16* cp = CL + (size_t)sit * 16384;
#pragma unroll
            for (int kk = 0; kk < 4; ++kk) {
                bf16x8 a[2], bb[4];
#pragma unroll
                for (int mi = 0; mi < 2; ++mi) a[mi] = lds_frag(qs, 272, 32 * wr + 16 * mi, kk * 64, lane);
#pragma unroll
                for (int ni = 0; ni < 4; ++ni) bb[ni] = *(const GAS bf16x8*)(cp + (64 * wc + 16 * ni + l15) * 128 + kk * 32 + g4 * 8);
#pragma unroll
                for (int mi = 0; mi < 2; ++mi)
#pragma unroll
                    for (int ni = 0; ni < 4; ++ni) acc[mi][ni] = MFMA16(a[mi], bb[ni], acc[mi][ni]);
            }
#pragma unroll
            for (int mi = 0; mi < 2; ++mi)
#pragma unroll
                for (int rr = 0; rr < 4; ++rr) { const float sc = inter[32 * wr + 16 * mi + 4 * g4 + rr];
#pragma unroll
                    for (int ni = 0; ni < 4; ++ni) acc[mi][ni][rr] *= sc; }
#pragma unroll
            for (int kk = 0; kk < 4; ++kk) {
                bf16x8 a[2], bb[4];
#pragma unroll
                for (int mi = 0; mi < 2; ++mi) a[mi] = lds_frag(ks, 272, 32 * wr + 16 * mi, kk * 64, lane);
#pragma unroll
                for (int ni = 0; ni < 4; ++ni) bb[ni] = lds_frag(vT, 272, 64 * wc + 16 * ni, kk * 64, lane);
#pragma unroll
                for (int mi = 0; mi < 2; ++mi)
#pragma unroll
                    for (int ni = 0; ni < 4; ++ni) acc[mi][ni] = MFMA16(a[mi], bb[ni], acc[mi][ni]);
            }
            __syncthreads();
#pragma unroll
            for (int mi = 0; mi < 2; ++mi)
#pragma unroll
                for (int rr = 0; rr < 4; ++rr) { const float sc = rden[32 * wr + 16 * mi + 4 * g4 + rr];
#pragma unroll
                    for (int ni = 0; ni < 4; ++ni) hsum[mi][ni][rr] += acc[mi][ni][rr] * sc; }
        }
        __syncthreads();
#pragma unroll
        for (int mi = 0; mi < 2; ++mi)
#pragma unroll
            for (int rr = 0; rr < 4; ++rr) { float s = 0.f;
#pragma unroll
                for (int ni = 0; ni < 4; ++ni) s += hsum[mi][ni][rr] * hsum[mi][ni][rr];
                s += __shfl_xor(s, 1); s += __shfl_xor(s, 2); s += __shfl_xor(s, 4); s += __shfl_xor(s, 8);
                if (l15 == 0) rowss[wc * 128 + 32 * wr + 16 * mi + 4 * g4 + rr] = s; }
        __syncthreads();
        const float* gn = F.in[I_MLN] + l * 512 + h * 128;
#pragma unroll
        for (int mi = 0; mi < 2; ++mi)
#pragma unroll
            for (int rr = 0; rr < 4; ++rr) { const int t = 32 * wr + 16 * mi + 4 * g4 + rr; const float rs = 1.0f / sqrtf((rowss[t] + rowss[128 + t]) * (1.0f / 128.0f) + EPS);
#pragma unroll
                for (int ni = 0; ni < 4; ++ni) { const int e = 64 * wc + 16 * ni + l15;
                    const float og = sigm1(bf1(Z[(size_t)(rowbase + t) * ZLD + ZC_MLO + h * 128 + e]));
                    Y1[(size_t)(rowbase + t) * 512 + h * 128 + e] = f2bf1(og * hsum[mi][ni][rr] * rs * gn[e]); } }
        __syncthreads();
    }
}
__device__ __forceinline__ void gd_slot(int chain, int k, int& seqbase, int& T, int& n, int& h, int& dir) {
    const int b = chain >> 3; h = (chain >> 1) & 3; dir = chain & 1;
    if (k < 4) { seqbase = ML + b * CTXL; T = CTXL; n = k; } else { seqbase = b * SEQ; T = SEQ; n = k - 4; }
}
__device__ __forceinline__ void phase_gd0(Frame& F, int l, bool last) {
    const bf16* Z = (const bf16*)(F.ws + WS_Z); const float* ZS = (const float*)(F.ws + WS_ZS);
    bf16* GQ = (bf16*)(F.ws + WS_MIX + MX_GQ); bf16* GK = (bf16*)(F.ws + WS_MIX + MX_GK); bf16* GV = (bf16*)(F.ws + WS_MIX + MX_GV);
    float* GG = (float*)(F.ws + WS_MIX + MX_GG); float* GB = (float*)(F.ws + WS_MIX + MX_GB);
    const float* cw = F.in[I_GDCONV] + (size_t)l * 3 * 1536;
    const int gw = blockIdx.x * NWAVES + F.wave, NGW = F.G * NWAVES, c8 = F.lane * 8;
    for (int row = gw; row < MT; row += NGW) {
        const bool isc = row >= ML; const int t = isc ? (row - ML) % CTXL : row % SEQ, T = isc ? CTXL : SEQ;
        const bool hp = t > 0, hn = t < T - 1;
#pragma unroll
        for (int seg = 0; seg < 3; ++seg) {
            if (seg == 0 && isc && last) continue;
            const int zc = (seg == 0 ? ZC_GDQ : seg == 1 ? ZC_GDK : ZC_GDV) + c8;
            const bf16* zr = Z + (size_t)row * ZLD + zc;
            const v4u x1 = *(const GAS v4u*)zr;
            v4u x0 = (v4u){0u, 0u, 0u, 0u}, x2 = (v4u){0u, 0u, 0u, 0u};
            if (hp) x0 = *(const GAS v4u*)(zr - ZLD);
            if (hn) x2 = *(const GAS v4u*)(zr + ZLD);
            const float* w0 = cw + seg * 512 + c8; const float* w1 = w0 + 1536; const float* w2 = w1 + 1536;
            const unsigned a0[4] = {x0.x, x0.y, x0.z, x0.w}, a1[4] = {x1.x, x1.y, x1.z, x1.w}, a2[4] = {x2.x, x2.y, x2.z, x2.w};
            float y[8]; float ss = 0.f;
#pragma unroll
            for (int j = 0; j < 4; ++j) {
                const float lo = bflo(a0[j]) * w0[2 * j] + bflo(a1[j]) * w1[2 * j] + bflo(a2[j]) * w2[2 * j];
                const float hi = bfhi(a0[j]) * w0[2 * j + 1] + bfhi(a1[j]) * w1[2 * j + 1] + bfhi(a2[j]) * w2[2 * j + 1];
                y[2 * j] = silu1(lo); y[2 * j + 1] = silu1(hi); ss += y[2 * j] * y[2 * j] + y[2 * j + 1] * y[2 * j + 1]; }
            float sc = 1.f;
            if (seg < 2) { ss += __shfl_xor(ss, 1); ss += __shfl_xor(ss, 2); ss += __shfl_xor(ss, 4); ss += __shfl_xor(ss, 8);
                sc = 1.0f / sqrtf(ss + EPS); if (seg == 0) sc *= 0.08838834764831845f; }
            v4u o; o.x = pk2(y[0] * sc, y[1] * sc); o.y = pk2(y[2] * sc, y[3] * sc); o.z = pk2(y[4] * sc, y[5] * sc); o.w = pk2(y[6] * sc, y[7] * sc);
            bf16* dst = (seg == 0 ? GQ : seg == 1 ? GK : GV) + (size_t)row * 512 + c8;
            *(GAS v4u*)dst = o;
        }
        if (F.lane < 8) {
            const int dir = F.lane >> 2, h = F.lane & 3; const float* zs = ZS + (size_t)row * 32 + 16;
            const float beta = sigm1(zs[dir * 4 + h]);
            const float g = -__expf(F.in[I_GDALOG][l * 8 + dir * 4 + h]) * softplus1(zs[(2 + dir) * 4 + h] + F.in[I_GDDTB][l * 8 + dir * 4 + h]);
            GG[((size_t)dir * MT + row) * 4 + h] = g; GB[((size_t)dir * MT + row) * 4 + h] = beta;
        }
    }
}
__device__ __forceinline__ void phase_gd1(Frame& F) {
    const bf16* GQ = (const bf16*)(F.ws + WS_MIX + MX_GQ); const bf16* GK = (const bf16*)(F.ws + WS_MIX + MX_GK); const bf16* GV = (const bf16*)(F.ws + WS_MIX + MX_GV);
    const float* GG = (const float*)(F.ws + WS_MIX + MX_GG); const float* GB = (const float*)(F.ws + WS_MIX + MX_GB);
    unsigned char* G1 = F.ws + WS_MIX + MX_GD1; float* GE = (float*)(F.ws + WS_MIX + MX_GE);
    LAS unsigned char* kl = F.lds + RING_OFF; LAS unsigned char* ql = kl + 17408; LAS unsigned char* vl = ql + 17408;
    LAS float* Mf = (LAS float*)(F.lds + RING_OFF + 52224);
    LAS unsigned char* Tl = F.lds + RING_OFF + 69632;
    LAS unsigned char* vsT = F.lds + RING_OFF + 78848; LAS unsigned char* ksT = F.lds + RING_OFF + 97280;
    LAS float* gc = (LAS float*)(F.lds + RING_OFF + 115712); LAS float* bt = gc + 64;
    const int tid = F.tid, lane = F.lane, g4 = lane >> 4, l15 = lane & 15;
    for (int it = blockIdx.x; it < 64 * 36; it += F.G) {
        const int chain = it / 36, k = it % 36; int seqbase, T, n, h, dir; gd_slot(chain, k, seqbase, T, n, h, dir);
        unsigned char* out = G1 + (size_t)it * GD1_ITEM;
        bf16* WN = (bf16*)out; bf16* QD = (bf16*)(out + 16384); bf16* KT = (bf16*)(out + 32768); bf16* UT = (bf16*)(out + 49152); bf16* QKM = (bf16*)(out + 65536);
        const int sp = tid >> 3, sc0 = (tid & 7) * 16;
        { const int tok = dir ? T - 1 - (64 * n + sp) : 64 * n + sp; const size_t off = (size_t)(seqbase + tok) * 512 + h * 128 + sc0;
          *(LAS v4u*)(kl + sp * 272 + sc0 * 2) = *(const GAS v4u*)(GK + off); *(LAS v4u*)(kl + sp * 272 + sc0 * 2 + 16) = *(const GAS v4u*)(GK + off + 8);
          *(LAS v4u*)(ql + sp * 272 + sc0 * 2) = *(const GAS v4u*)(GQ + off); *(LAS v4u*)(ql + sp * 272 + sc0 * 2 + 16) = *(const GAS v4u*)(GQ + off + 8);
          *(LAS v4u*)(vl + sp * 272 + sc0 * 2) = *(const GAS v4u*)(GV + off); *(LAS v4u*)(vl + sp * 272 + sc0 * 2 + 16) = *(const GAS v4u*)(GV + off + 8); }
        if (tid < 64) { const int tok = dir ? T - 1 - (64 * n + tid) : 64 * n + tid; const size_t gi = ((size_t)dir * MT + seqbase + tok) * 4 + h;
            gc[tid] = wscan_sum_f(GG[gi], lane); bt[tid] = GB[gi]; }
        __syncthreads();
        const float gcend = gc[63];
        { const float bj = bt[sp], bk = bj * __expf(gc[sp]);
#pragma unroll
          for (int hh = 0; hh < 2; ++hh) { const v4u vv = *(const LAS v4u*)(vl + sp * 272 + sc0 * 2 + 16 * hh), kk = *(const LAS v4u*)(kl + sp * 272 + sc0 * 2 + 16 * hh);
              const unsigned vw[4] = {vv.x, vv.y, vv.z, vv.w}, kw[4] = {kk.x, kk.y, kk.z, kk.w};
#pragma unroll
              for (int c = 0; c < 4; ++c) { const int col = sc0 + 8 * hh + 2 * c;
                  *(LAS bf16*)(vsT + col * 144 + sp * 2) = f2bf1(bflo(vw[c]) * bj); *(LAS bf16*)(vsT + (col + 1) * 144 + sp * 2) = f2bf1(bfhi(vw[c]) * bj);
                  *(LAS bf16*)(ksT + col * 144 + sp * 2) = f2bf1(bflo(kw[c]) * bk); *(LAS bf16*)(ksT + (col + 1) * 144 + sp * 2) = f2bf1(bfhi(kw[c]) * bk); } } }
        if (F.wave < 4) {
            const int i0 = 16 * F.wave; f32x4 acc[4];
#pragma unroll
            for (int ni = 0; ni < 4; ++ni) acc[ni] = (f32x4){0.f, 0.f, 0.f, 0.f};
#pragma unroll
            for (int ks = 0; ks < 4; ++ks) { const bf16x8 a = lds_frag(kl, 272, i0, ks * 64, lane);
#pragma unroll
                for (int ni = 0; ni < 4; ++ni) acc[ni] = MFMA16(a, lds_frag(kl, 272, 16 * ni, ks * 64, lane), acc[ni]); }
#pragma unroll
            for (int ni = 0; ni < 4; ++ni)
#pragma unroll
                for (int rr = 0; rr < 4; ++rr) { const int i = i0 + 4 * g4 + rr, j = 16 * ni + l15;
                    Mf[i * 65 + j] = (j < i) ? bt[i] * acc[ni][rr] * __expf(gc[i] - gc[j]) : 0.f; }
        } else {
            const int j0 = 16 * (F.wave - 4); f32x4 acc[4];
#pragma unroll
            for (int ni = 0; ni < 4; ++ni) acc[ni] = (f32x4){0.f, 0.f, 0.f, 0.f};
#pragma unroll
            for (int ks = 0; ks < 4; ++ks) { const bf16x8 a = lds_frag(kl, 272, j0, ks * 64, lane);
#pragma unroll
                for (int ni = 0; ni < 4; ++ni) acc[ni] = MFMA16(a, lds_frag(ql, 272, 16 * ni, ks * 64, lane), acc[ni]); }
            const int jt = F.wave - 4;
#pragma unroll
            for (int ni = 0; ni < 4; ++ni) { const int i = 16 * ni + l15; float v[4];
#pragma unroll
                for (int rr = 0; rr < 4; ++rr) { const int j = j0 + 4 * g4 + rr; v[rr] = (j <= i) ? acc[ni][rr] * __expf(gc[i] - gc[j]) : 0.f; }
                v2u o; o.x = pk2(v[0], v[1]); o.y = pk2(v[2], v[3]);
                *(GAS v2u*)(QKM + i * 64 + 32 * (jt >> 1) + 8 * g4 + 4 * (jt & 1)) = o; }
        }
        { const int d = tid & 127, lq = tid >> 7; float v[16];
#pragma unroll
          for (int ll = 0; ll < 16; ++ll) { const int lp = 16 * lq + ll; v[ll] = bf1(((const LAS bf16*)(kl + lp * 272))[d]) * __expf(gcend - gc[lp]); }
#pragma unroll
          for (int g = 0; g < 4; ++g) { v2u o; o.x = pk2(v[4 * g], v[4 * g + 1]); o.y = pk2(v[4 * g + 2], v[4 * g + 3]);
              *(GAS v2u*)(KT + d * 64 + 32 * (lq >> 1) + 8 * g + 4 * (lq & 1)) = o; } }
        { const int lq = tid & 63, db = tid >> 6; const float e = __expf(gc[lq]); const LAS bf16* qr = (const LAS bf16*)(ql + lq * 272) + 16 * db; float v[16];
#pragma unroll
          for (int dd = 0; dd < 16; ++dd) v[dd] = bf1(qr[dd]) * e;
#pragma unroll
          for (int g = 0; g < 4; ++g) { v2u o; o.x = pk2(v[4 * g], v[4 * g + 1]); o.y = pk2(v[4 * g + 2], v[4 * g + 3]);
              *(GAS v2u*)(QD + lq * 128 + 32 * (db >> 1) + 8 * g + 4 * (db & 1)) = o; } }
        if (tid == 0) GE[it * 32] = __expf(gcend);
        __syncthreads();
        { const int cb = 8 * F.wave; float res[8];
#pragma unroll
          for (int cc = 0; cc < 8; ++cc) res[cc] = (lane == cb + cc) ? 1.0f : 0.0f;
          for (int j = cb; j < 63; ++j) { const float mj = Mf[lane * 65 + j];
#pragma unroll
              for (int cc = 0; cc < 8; ++cc) { const float xj = __builtin_bit_cast(float, __builtin_amdgcn_readlane(__builtin_bit_cast(int, res[cc]), j)); res[cc] -= mj * xj; } }
          v4u o; o.x = pk2(res[0], res[1]); o.y = pk2(res[2], res[3]); o.z = pk2(res[4], res[5]); o.w = pk2(res[6], res[7]);
          *(LAS v4u*)(Tl + lane * 144 + cb * 2) = o; }
        __syncthreads();
        if (F.wave < 4) {
            f32x4 acc[8];
#pragma unroll
            for (int ni = 0; ni < 8; ++ni) acc[ni] = (f32x4){0.f, 0.f, 0.f, 0.f};
#pragma unroll
            for (int ks = 0; ks < 2; ++ks) { const bf16x8 a = lds_frag(Tl, 144, 16 * F.wave, ks * 64, lane);
#pragma unroll
                for (int ni = 0; ni < 8; ++ni) acc[ni] = MFMA16(a, lds_frag(vsT, 144, 16 * ni, ks * 64, lane), acc[ni]); }
#pragma unroll
            for (int ni = 0; ni < 8; ++ni) { v2u o; o.x = pk2(acc[ni][0], acc[ni][1]); o.y = pk2(acc[ni][2], acc[ni][3]);
                *(GAS v2u*)(UT + (16 * ni + l15) * 64 + 16 * F.wave + 4 * g4) = o; }
        } else {
            const int it4 = F.wave - 4; f32x4 acc[8];
#pragma unroll
            for (int mi = 0; mi < 8; ++mi) acc[mi] = (f32x4){0.f, 0.f, 0.f, 0.f};
#pragma unroll
            for (int ks = 0; ks < 2; ++ks) { const bf16x8 bfr = lds_frag(Tl, 144, 16 * it4, ks * 64, lane);
#pragma unroll
                for (int mi = 0; mi < 8; ++mi) acc[mi] = MFMA16(lds_frag(ksT, 144, 16 * mi, ks * 64, lane), bfr, acc[mi]); }
#pragma unroll
            for (int mi = 0; mi < 8; ++mi) { v2u o; o.x = pk2(-acc[mi][0], -acc[mi][1]); o.y = pk2(-acc[mi][2], -acc[mi][3]);
                *(GAS v2u*)(WN + (16 * it4 + l15) * 128 + 32 * (mi >> 1) + 8 * g4 + 4 * (mi & 1)) = o; }
        }
        __syncthreads();
    }
}
constexpr int GD2_BUF = 62464;
__device__ __forceinline__ void gd2_load(const unsigned char* src, v4u (&r)[7], int tid) {
#pragma unroll
    for (int j = 0; j < 7; ++j) r[j] = *(const GAS v4u*)(src + (size_t)(tid + 512 * j) * 16);
}
__device__ __forceinline__ void gd2_store(LAS unsigned char* buf, const v4u (&r)[7], int tid) {
#pragma unroll
    for (int j = 0; j < 7; ++j) { const int pc = tid + 512 * j;
        int off;
        if (pc < 1024) off = (pc >> 4) * 272 + (pc & 15) * 16;
        else if (pc < 2048) off = 17408 + ((pc - 1024) >> 4) * 272 + (pc & 15) * 16;
        else if (pc < 3072) off = 44032 + ((pc - 2048) >> 3) * 144 + (pc & 7) * 16;
        else off = 34816 + ((pc - 3072) >> 3) * 144 + (pc & 7) * 16;
        *(LAS v4u*)(buf + off) = r[j]; }
}
__device__ __forceinline__ void phase_gd2(Frame& F, bool last) {
    const unsigned char* G1 = F.ws + WS_MIX + MX_GD1; const float* GE = (const float*)(F.ws + WS_MIX + MX_GE);
    float* GO = (float*)(F.ws + WS_H);
    const int tid = F.tid, lane = F.lane, g4 = lane >> 4, l15 = lane & 15, e0 = 16 * F.wave;
    for (int chain = blockIdx.x; chain < 64; chain += F.G) {
        const int h = (chain >> 1) & 3, dir = chain & 1, b = chain >> 3;
        f32x4 S[8];
#pragma unroll
        for (int db = 0; db < 8; ++db) S[db] = (f32x4){0.f, 0.f, 0.f, 0.f};
        v4u r[7];
        { const unsigned char* it0 = G1 + (size_t)(chain * 36) * GD1_ITEM;
#pragma unroll
          for (int j = 0; j < 7; ++j) { const int pc = tid + 512 * j; const int gp = pc < 3072 ? pc : pc + 1024; r[j] = *(const GAS v4u*)(it0 + (size_t)gp * 16); } }
        gd2_store(F.lds + RING_OFF, r, tid);
        v2u un[4]; float gn;
        { const unsigned char* it0 = G1 + (size_t)(chain * 36) * GD1_ITEM; const bf16* UT0 = (const bf16*)(it0 + 49152);
#pragma unroll
          for (int lb = 0; lb < 4; ++lb) un[lb] = *(const GAS v2u*)(UT0 + (e0 + l15) * 64 + 16 * lb + 4 * g4);
          gn = GE[(chain * 36) * 32]; }
        __syncthreads();
        for (int k = 0; k < 36; ++k) {
            LAS unsigned char* buf = F.lds + RING_OFF + (k & 1) * GD2_BUF;
            const unsigned char* item = G1 + (size_t)(chain * 36 + k) * GD1_ITEM;
            if (k + 1 < 36) { const unsigned char* nx = item + GD1_ITEM;
#pragma unroll
                for (int j = 0; j < 7; ++j) { const int pc = tid + 512 * j; const int gp = pc < 3072 ? pc : pc + 1024; r[j] = *(const GAS v4u*)(nx + (size_t)gp * 16); } }
            v2u uc[4];
#pragma unroll
            for (int lb = 0; lb < 4; ++lb) uc[lb] = un[lb];
            const float gend = gn;
            if (k + 1 < 36) { const bf16* UTn = (const bf16*)(item + GD1_ITEM + 49152);
#pragma unroll
                for (int lb = 0; lb < 4; ++lb) un[lb] = *(const GAS v2u*)(UTn + (e0 + l15) * 64 + 16 * lb + 4 * g4);
                gn = GE[(chain * 36 + k + 1) * 32]; }
            int seqbase, T, n; if (k < 4) { seqbase = ML + b * CTXL; T = CTXL; n = k; } else { seqbase = b * SEQ; T = SEQ; n = k - 4; }
            bf16x8 Sb[4];
#pragma unroll
            for (int ks = 0; ks < 4; ++ks) { v4u w; w.x = pk2(S[2 * ks][0], S[2 * ks][1]); w.y = pk2(S[2 * ks][2], S[2 * ks][3]); w.z = pk2(S[2 * ks + 1][0], S[2 * ks + 1][1]); w.w = pk2(S[2 * ks + 1][2], S[2 * ks + 1][3]);
                Sb[ks] = __builtin_bit_cast(bf16x8, w); }
            f32x4 vn[4];
#pragma unroll
            for (int lb = 0; lb < 4; ++lb) { const v2u uu = uc[lb];
                f32x4 acc = (f32x4){bflo(uu.x), bfhi(uu.x), bflo(uu.y), bfhi(uu.y)};
#pragma unroll
                for (int ks = 0; ks < 4; ++ks) acc = MFMA16(lds_frag(buf, 272, 16 * lb, ks * 64, lane), Sb[ks], acc);
                vn[lb] = acc; }
            bf16x8 Vb[2];
#pragma unroll
            for (int ks = 0; ks < 2; ++ks) { v4u w; w.x = pk2(vn[2 * ks][0], vn[2 * ks][1]); w.y = pk2(vn[2 * ks][2], vn[2 * ks][3]); w.z = pk2(vn[2 * ks + 1][0], vn[2 * ks + 1][1]); w.w = pk2(vn[2 * ks + 1][2], vn[2 * ks + 1][3]);
                Vb[ks] = __builtin_bit_cast(bf16x8, w); }
            const bool wr_o = !(last && k < 4);
#pragma unroll
            for (int lb = 0; lb < 4; ++lb) { f32x4 acc = (f32x4){0.f, 0.f, 0.f, 0.f};
#pragma unroll
                for (int ks = 0; ks < 4; ++ks) acc = MFMA16(lds_frag(buf + 17408, 272, 16 * lb, ks * 64, lane), Sb[ks], acc);
#pragma unroll
                for (int ks = 0; ks < 2; ++ks) acc = MFMA16(lds_frag(buf + 34816, 144, 16 * lb, ks * 64, lane), Vb[ks], acc);
                if (wr_o) {
#pragma unroll
                    for (int rr = 0; rr < 4; ++rr) { const int p = 16 * lb + 4 * g4 + rr; const int tok = dir ? T - 1 - (64 * n + p) : 64 * n + p;
                        GO[((size_t)dir * MT + seqbase + tok) * 512 + h * 128 + e0 + l15] = acc[rr]; } } }
#pragma unroll
            for (int db = 0; db < 8; ++db) { f32x4 acc = S[db] * gend;
#pragma unroll
                for (int ks = 0; ks < 2; ++ks) acc = MFMA16(lds_frag(buf + 44032, 144, 16 * db, ks * 64, lane), Vb[ks], acc);
                S[db] = acc; }
            if (k + 1 < 36) gd2_store(F.lds + RING_OFF + ((k + 1) & 1) * GD2_BUF, r, tid);
            __syncthreads();
        }
    }
}
__device__ __forceinline__ void phase_gd3(Frame& F, int l, bool last) {
    const float* GO = (const float*)(F.ws + WS_H); const bf16* Z = (const bf16*)(F.ws + WS_Z); bf16* Y2 = (bf16*)(F.ws + WS_Y) + (size_t)2 * MT * 512;
    const int gw = blockIdx.x * NWAVES + F.wave, NGW = F.G * NWAVES, c8 = F.lane * 8; const int nrows = last ? ML : MT;
    const float* gn = F.in[I_GDN] + l * 128 + (c8 & 127);
    for (int row = gw; row < nrows; row += NGW) {
        const f32x4 a0 = *(const f32x4*)(GO + (size_t)row * 512 + c8), a1 = *(const f32x4*)(GO + (size_t)row * 512 + c8 + 4);
        const f32x4 b0 = *(const f32x4*)(GO + ((size_t)MT + row) * 512 + c8), b1 = *(const f32x4*)(GO + ((size_t)MT + row) * 512 + c8 + 4);
        const f32x4 s0 = a0 + b0, s1 = a1 + b1;
        float ss = (s0.x * s0.x + s0.y * s0.y) + (s0.z * s0.z + s0.w * s0.w) + (s1.x * s1.x + s1.y * s1.y) + (s1.z * s1.z + s1.w * s1.w);
        ss += __shfl_xor(ss, 1); ss += __shfl_xor(ss, 2); ss += __shfl_xor(ss, 4); ss += __shfl_xor(ss, 8);
        const float rs = 1.0f / sqrtf(ss * (1.0f / 128.0f) + EPS);
        const v4u zz = *(const GAS v4u*)(Z + (size_t)row * ZLD + ZC_GDZ + c8);
        const float o[8] = {s0.x, s0.y, s0.z, s0.w, s1.x, s1.y, s1.z, s1.w}; const float zf[8] = {bflo(zz.x), bfhi(zz.x), bflo(zz.y), bfhi(zz.y), bflo(zz.z), bfhi(zz.z), bflo(zz.w), bfhi(zz.w)};
        float y[8];
#pragma unroll
        for (int j = 0; j < 8; ++j) y[j] = o[j] * rs * gn[j] * silu1(zf[j]);
        v4u w; w.x = pk2(y[0], y[1]); w.y = pk2(y[2], y[3]); w.z = pk2(y[4], y[5]); w.w = pk2(y[6], y[7]);
        *(GAS v4u*)(Y2 + (size_t)row * 512 + c8) = w;
    }
}
#ifndef DUPC
#define DUPC 0
#endif
constexpr int CW_Q = 2048;
__device__ __forceinline__ int q_pull(Frame& F, int qi) {
    volatile LAS unsigned* slot = F.MISC + 16;
    __syncthreads();
    if (F.tid == 0) *slot = __hip_atomic_fetch_add((unsigned*)(F.ctl + CW_Q + 64 * qi), 1u, __ATOMIC_RELAXED, __HIP_MEMORY_SCOPE_AGENT);
    __syncthreads();
    return (int)*slot;
}
__device__ __forceinline__ void phase_mixc(Frame& F, int l, bool last, int qo = 0) {
    for (int rep = 0; rep < ((DUPC & 4) ? 2 : 1); ++rep) if ((int)blockIdx.x < 64 || F.G < 128) phase_gd2(F, last);
    const int n_att = last ? 256 : 288, n_ml3 = last ? 512 : 576;
    for (int rep = 0; rep < ((DUPC & 1) ? 2 : 1); ++rep) for (;;) { const int idx = q_pull(F, 2 * l + 8 * rep); if (idx >= n_att) break; attn_item(F, idx); }
    for (int rep = 0; rep < ((DUPC & 2) ? 2 : 1); ++rep) for (;;) { const int idx = q_pull(F, 2 * l + 1 + 8 * rep); if (idx >= n_ml3) break; ml3_item(F, l, idx); }
}
#ifndef DUPA
#define DUPA 0
#endif
#define MIX_PHASE_1 for (int rep = 0; rep < ((DUPA & 1) ? 2 : 1); ++rep) phase_attn_prep(F, l, last); \
    for (int rep = 0; rep < ((DUPA & 4) ? 2 : 1); ++rep) phase_gd0(F, l, last); for (int rep = 0; rep < ((DUPA & 8) ? 2 : 1); ++rep) { __syncthreads(); phase_ml1(F, l); }
#define MIX_PHASE_2 for (int rep = 0; rep < ((DUPA & 2) ? 2 : 1); ++rep) { __syncthreads(); phase_spatial(F, l, last); } for (int rep = 0; rep < ((DUPA & 16) ? 2 : 1); ++rep) { __syncthreads(); phase_gd1(F); } for (int rep = 0; rep < ((DUPA & 32) ? 2 : 1); ++rep) phase_ml2(F, 0);
#define MIX_PHASE_3 phase_mixc(F, l, last);
#define MIX_PHASE_4 phase_gd3(F, l, last);
#ifndef PROBE
#define PROBE 0
#endif
#ifndef DUPMIX
#define DUPMIX 0
#endif
#ifndef DUPG
#define DUPG 0
#endif
#ifdef DUPAUX
#define DUP_AUX(x) x
#else
#define DUP_AUX(x)
#endif
#ifndef TPROBE
#define TPROBE 0
#endif
constexpr int PH_PER_LAYER = 15, N_PHASES = PROBE ? (1 + PH_PER_LAYER + 1) : (1 + NLAYER * PH_PER_LAYER + (TPROBE ? 1 : 0));
#ifndef PHMASK
#define PHMASK 0xffff
#endif
#define PHEN(k) ((PHMASK >> (k)) & 1)
#define IN(p) (lo <= (p) && (p) < hi)
#ifndef TPROBE
#define TPROBE 0
#endif
#if TPROBE
#define SEAM(p) do { if (lo <= (p) && (p) + 1 < hi) { xcd_barrier(bar); if (blockIdx.x == 0 && F.tid == 0) ((unsigned long long*)(F.ws + WS_CTL + 524288))[(p) + 1] = wall_clock64(); } } while (0)
#else
#ifdef DUPBAR
#define SEAM(p) do { if (lo <= (p) && (p) + 1 < hi) { xcd_barrier(bar); xcd_barrier(bar); } } while (0)
#else
#define SEAM(p) do { if (lo <= (p) && (p) + 1 < hi) xcd_barrier(bar); } while (0)
#endif
#endif
struct Args { const float* in[27]; float* out; unsigned char* ws; int ph_lo, ph_hi, li, pad; };
template <int l> __device__ __forceinline__ void layer_body(Frame& F, const XcdBarrier& bar, const int lo, const int hi) {
    float* MOD = (float*)(F.ws + WS_MOD);
    float* XC = (float*)(F.ws + WS_XC);
    bf16* Hb = (bf16*)(F.ws + WS_H); bf16* Zb = (bf16*)(F.ws + WS_Z); bf16* ACT = (bf16*)(F.ws + WS_Z); float* ZS = (float*)(F.ws + WS_ZS);
    bf16* WFI = (bf16*)(F.ws + WS_WFI); bf16* WFO = (bf16*)(F.ws + WS_WFO); bf16* WZ = (bf16*)(F.ws + WS_WZ); bf16* WB = (bf16*)(F.ws + WS_WB); bf16* WO = (bf16*)(F.ws + WS_WO);
    bf16* Yb = (bf16*)(F.ws + WS_Y); float* PB = (float*)(F.ws + WS_MIX);
    const int vc = (F.G % 8 == 0) ? ((int)blockIdx.x % 8) * (F.G / 8) + (int)blockIdx.x / 8 : (int)blockIdx.x;
        constexpr int P = 1 + l * PH_PER_LAYER;
        constexpr bool last = (l == NLAYER - 1);
        const float* modl = MOD + (size_t)l * 9 * MODW;
        const float* xin_l = (l == 0) ? F.in[I_X] : F.out;
        const float* xin_c = (l == 0) ? F.in[I_CTX] : XC;
        constexpr int nPM = last ? 64 : 72;

        if (PHEN(0) && IN(P + 0)) { if (l == 0) { phase_mod(F); phase_rope(F); __syncthreads(); } conv_set(F, l, 0, nullptr); if (l == 0) conv_set(F, l, 2, nullptr); }
        SEAM(P + 0);
        if (PHEN(1) && IN(P + 1)) phase_norm<(l == 0), (l > 0), false>(F, xin_l, xin_c, F.in[I_F1N] + (size_t)l * D, modl + 0 * D, MT);
        SEAM(P + 1);
        if (PHEN(2) && IN(P + 2)) {
            pg8::Gemm g{Hb, WFI, MT, 2 * DFF, D, 1, 1}; pg8::TileOrder S; S.init(72, 44, 0, 0, 0, F.G, (int)blockIdx.x, 32);
            pg8::EpiSwiglu E{ACT, DFF};
            pg8::gemm_phase<pg8::EpiSwiglu, pg8::TileOrder, PG8_ALIGN, PG8_SP2>(F.lds + RING_OFF, g, S, E);
            if (DUPG & 2) { __syncthreads(); pg8::gemm_phase<pg8::EpiSwiglu, pg8::TileOrder, PG8_ALIGN, PG8_SP2>(F.lds + RING_OFF, g, S, E); }
        }
        SEAM(P + 2);
        if (PHEN(3) && IN(P + 3)) {
            pg8::Gemm g{ACT, WFO, MT, D, DFF, 1, 1};
            { pg8::TileOrder S; S.init(64, 8, 0, 0, 0, F.G, (int)blockIdx.x, DFF / 64); S.wgm = WGM_N8; pg8::EpiRes<false> E{F.out, XC, modl + 2 * D, 0.5f};
              pg8::gemm_phase<pg8::EpiRes<false>, pg8::TileOrder, PG8_ALIGN, PG8_SP2>(F.lds + RING_OFF, g, S, E); }
            { pg8::QuarterOrder S; S.init(8, 64, DFF / 256, F.G, (int)blockIdx.x); pg8::EpiRes<true> E{nullptr, PB, modl + 2 * D, 0.5f};
              pg8::gemm_phase<pg8::EpiRes<true>, pg8::QuarterOrder, PG8_ALIGN, PG8_SP2>(F.lds + RING_OFF, g, S, E); }
        }
        SEAM(P + 3);
        if (PHEN(4) && IN(P + 4)) phase_norm<false, true, !last>(F, F.out, XC, F.in[I_MIXN] + (size_t)l * D, modl + 3 * D, MT);
        SEAM(P + 4);
        if (PHEN(5) && IN(P + 5)) {
            pg8::Gemm g{Hb, WZ, MT, NZ, D, 1, 1}; pg8::TileOrder S;
            if (last) S.init(64, 57, 8, NKV_TILES, 64, F.G, (int)blockIdx.x, 32); else S.init(64, 57, 8, 56, 64, F.G, (int)blockIdx.x, 32, 10);
            pg8::EpiZ E{Zb, ZS, ZLD, (bf16*)(F.ws + WS_GT)};
            pg8::gemm_phase<pg8::EpiZ, pg8::TileOrder, PG8_ALIGN, PG8_SP2>(F.lds + RING_OFF, g, S, E);
            if (DUPG & 1) { __syncthreads(); pg8::gemm_phase<pg8::EpiZ, pg8::TileOrder, PG8_ALIGN, PG8_SP2>(F.lds + RING_OFF, g, S, E); }
            if (last) conv_set(F, l, 1, (unsigned*)(F.ctl + 2048 + 64 * 14));
        }
        SEAM(P + 5);
        if (PHEN(6) && IN(P + 6)) { if (l == 0) conv_set(F, l, 1, nullptr); MIX_PHASE_1 if (DUPMIX & 1) { __syncthreads(); MIX_PHASE_1 } }
        SEAM(P + 6);
        if (PHEN(7) && IN(P + 7)) { MIX_PHASE_2 if (DUPMIX & 2) { __syncthreads(); MIX_PHASE_2 } }
        SEAM(P + 7);
        if (PHEN(8) && IN(P + 8)) { MIX_PHASE_3 }
        SEAM(P + 8);
        if (PHEN(9) && IN(P + 9)) { MIX_PHASE_4 if (DUPMIX & 8) { __syncthreads(); MIX_PHASE_4 } }
        SEAM(P + 9);
        if (PHEN(10) && IN(P + 10)) {
            pg8::Gemm g{Yb, WB, 4 * MT, 4 * D, 512, 1}; pg8::BranchOrder S; S.init(nPM, 72, F.G, (int)blockIdx.x);
            pg8::EpiBranch E{(const bf16*)(F.ws + WS_GT), Hb, 72};
            pg8::gemm_phase<pg8::EpiBranch, pg8::BranchOrder, PG8_ALIGN, PG8_SP2>(F.lds + RING_OFF, g, S, E);
            if (DUPG & 4) { __syncthreads(); pg8::gemm_phase<pg8::EpiBranch, pg8::BranchOrder, PG8_ALIGN, PG8_SP2>(F.lds + RING_OFF, g, S, E); }
        }
        SEAM(P + 10);
        if (PHEN(11) && IN(P + 11)) {
            pg8::Gemm g{Hb, WO, MT, D, D, 1, 1};
            { pg8::TileOrder S; S.init(64, 8, 0, 0, 0, F.G, (int)blockIdx.x, D / 64); S.wgm = WGM_N8; pg8::EpiRes<false> E{F.out, XC, modl + 5 * D, 1.0f};
              pg8::gemm_phase<pg8::EpiRes<false>, pg8::TileOrder, PG8_ALIGN, PG8_SP2>(F.lds + RING_OFF, g, S, E); }
            if constexpr (nPM == 72) { pg8::QuarterOrder S; S.init(8, 64, D / 256, F.G, (int)blockIdx.x); pg8::EpiRes<true> E{nullptr, PB, modl + 5 * D, 1.0f};
              pg8::gemm_phase<pg8::EpiRes<true>, pg8::QuarterOrder, PG8_ALIGN, PG8_SP2>(F.lds + RING_OFF, g, S, E); }
        }
        SEAM(P + 11);
        if (PHEN(12) && IN(P + 12)) { phase_norm<false, (nPM == 72), false>(F, F.out, XC, F.in[I_F2N] + (size_t)l * D, modl + 6 * D, nPM * 256);
#ifdef DUPN
            if (nPM == 64) { phase_norm<false, false, false>(F, F.out, XC, F.in[I_F2N] + (size_t)l * D, modl + 6 * D, nPM * 256); phase_norm<false, false, false>(F, F.out, XC, F.in[I_F2N] + (size_t)l * D, modl + 6 * D, nPM * 256); }
#endif
        }
        SEAM(P + 12);
        if (PHEN(13) && IN(P + 13)) {
            pg8::Gemm g{Hb, WFI, MT, 2 * DFF, D, 1, 1}; pg8::TileOrder S; S.init(nPM, 44, 0, 0, 0, F.G, (int)blockIdx.x, 32);
            pg8::EpiSwiglu E{ACT, DFF};
            pg8::gemm_phase<pg8::EpiSwiglu, pg8::TileOrder, PG8_ALIGN, PG8_SP2>(F.lds + RING_OFF, g, S, E);
            if (!last) conv_set(F, l + 1, 2, (unsigned*)(F.ctl + 2048 + 64 * 15));
        }
        SEAM(P + 13);
        if (PHEN(14) && IN(P + 14)) {
            pg8::Gemm g{ACT, WFO, MT, D, DFF, 1, 1};
            { pg8::TileOrder S; S.init(64, 8, 0, 0, 0, F.G, (int)blockIdx.x, DFF / 64); S.wgm = WGM_N8; pg8::EpiRes<false> E{F.out, XC, modl + 8 * D, 0.5f};
              pg8::gemm_phase<pg8::EpiRes<false>, pg8::TileOrder, PG8_ALIGN, PG8_SP2>(F.lds + RING_OFF, g, S, E); }
            if constexpr (nPM == 72) { pg8::QuarterOrder S; S.init(8, 64, DFF / 256, F.G, (int)blockIdx.x); pg8::EpiRes<true> E{nullptr, PB, modl + 8 * D, 0.5f};
              pg8::gemm_phase<pg8::EpiRes<true>, pg8::QuarterOrder, PG8_ALIGN, PG8_SP2>(F.lds + RING_OFF, g, S, E); }
        }
        SEAM(P + 14);
    }
__global__ void __launch_bounds__(NWAVES * 64, 2) mk_fwd(Args args) {
    extern __shared__ __attribute__((aligned(16))) unsigned char lds[];
    Frame F;
    F.lds = (LAS unsigned char*)lds;
    F.MISC = (volatile LAS unsigned*)(F.lds + MISC_OFF);
    F.tid = threadIdx.x; F.lane = F.tid & 63; F.wave = __builtin_amdgcn_readfirstlane(F.tid >> 6);
    F.G = gridDim.x;
    F.ws = args.ws; F.ctl = (gu32*)(args.ws + WS_CTL); F.out = args.out;
    F.in = args.in;
    for (int u = F.tid; u < (LDS_BYTES - LDSCTL_OFF) / 4; u += NWAVES * 64) ((LAS unsigned*)(F.lds + LDSCTL_OFF))[u] = 0u;
    __syncthreads();
    const int lo = args.ph_lo, hi = args.ph_hi;
#if TPROBE
    if (blockIdx.x == 0 && F.tid == 0) ((unsigned long long*)(F.ws + WS_CTL + 524288))[0] = wall_clock64();
#endif
    XcdBarrier bar; bar.bar = (unsigned*)(F.ctl + CW_BAR) + args.li * XCD_BAR_WORDS; bar.x = 0; bar.st = nullptr;
    if (hi - lo > 1) bar = xcd_barrier_post((unsigned*)(F.ctl + CW_BAR) + args.li * XCD_BAR_WORDS, F.MISC + 8);


    layer_body<0>(F, bar, lo, hi);
#if !PROBE
    layer_body<1>(F, bar, lo, hi);
#endif
#if TPROBE
    if (IN(31)) {
        const unsigned long long* TS = (const unsigned long long*)(F.ws + WS_CTL + 524288);
        const float tot = (float)(TS[31] - TS[0]);
        const float fa = (float)(TS[TP_A2] - TS[TP_A1]) / tot, fb = (float)(TS[TP_B2] - TS[TP_B1]) / tot;
        const size_t n = (size_t)ML * D; float* o = F.out;
        for (size_t i = (size_t)blockIdx.x * 512 + F.tid; i < n; i += (size_t)F.G * 512) { float v = o[i] * (1.0f + fa); if (i == 0) v += 10000.0f * fb; o[i] = v; }
    }
#endif
#if PROBE
    if (IN(16)) {
        const size_t n = (size_t)ML * D; float* o = F.out;
        for (size_t i = (size_t)blockIdx.x * 512 + F.tid; i < n; i += (size_t)F.G * 512) { const size_t r = i / D, c = i % D;
#if PROBE == 1
            o[i] = bf1(((const bf16*)(F.ws + WS_Y))[(size_t)MT * 512 + r * 512 + (c & 511)]);
#elif PROBE == 2
            o[i] = bf1(((const bf16*)(F.ws + WS_MIX + MX_CP))[(i % ((size_t)1152 * 16384))]);
#elif PROBE == 3
            o[i] = bf1(((const bf16*)(F.ws + WS_MIX + MX_CL))[(i % ((size_t)1152 * 16384))]);
#elif PROBE == 4
            o[i] = ((const float*)(F.ws + WS_ZS))[(i % ((size_t)ML * 32))];
#endif
        }
    }
#endif
#undef IN
#undef SEAM
}

#ifndef MK_N_LAUNCHES
#define MK_N_LAUNCHES 1
#endif
extern "C" void kernel_launch(void* const* d_in, const int* in_sizes, int n_in, void* d_out, int out_size, void* d_ws, size_t ws_size, hipStream_t stream) {
    static int grid = 0;
    if (grid == 0) {
        if (n_in != 27 || in_sizes[0] != ML * D || out_size != ML * D || ws_size < WS_END) { fprintf(stderr, "kernel_launch: shape mismatch n_in %d in0 %d out %d ws %zu (need %zu)\n", n_in, n_in > 0 ? in_sizes[0] : -1, out_size, ws_size, (size_t)WS_END); grid = -1; return; }
        int dev = 0, cus = 0, per_cu = 0;
        if (hipGetDevice(&dev) != hipSuccess || hipDeviceGetAttribute(&cus, hipDeviceAttributeMultiprocessorCount, dev) != hipSuccess) { grid = -1; return; }
        if (hipFuncSetAttribute((const void*)mk_fwd, hipFuncAttributeMaxDynamicSharedMemorySize, LDS_BYTES) != hipSuccess) { fprintf(stderr, "kernel_launch: hipFuncSetAttribute failed\n"); grid = -1; return; }
        if (hipOccupancyMaxActiveBlocksPerMultiprocessor(&per_cu, (const void*)mk_fwd, NWAVES * 64, LDS_BYTES) != hipSuccess || per_cu < 1)
            fprintf(stderr, "kernel_launch: note: occupancy query reports %d workgroups per CU\n", per_cu);
        (void)hipGetLastError();
        grid = cus;
    }
    if (grid < 0) return;
    if (hipMemsetAsync((char*)d_ws + WS_CTL, 0, CTL_ZERO_BYTES, stream) != hipSuccess) return;
    Args a{};
    for (int i = 0; i < 27; ++i) a.in[i] = (const float*)d_in[i];
    a.out = (float*)d_out; a.ws = (unsigned char*)d_ws; a.pad = 0;
#if MK_N_LAUNCHES == 1
    a.ph_lo = 0; a.ph_hi = N_PHASES; a.li = 0;
    hipLaunchKernelGGL(mk_fwd, dim3(grid), dim3(NWAVES * 64), LDS_BYTES, stream, a);
#else
    for (int p = 0; p < N_PHASES; ++p) { a.ph_lo = p; a.ph_hi = p + 1; a.li = 0;
        hipLaunchKernelGGL(mk_fwd, dim3(grid), dim3(NWAVES * 64), LDS_BYTES, stream, a); }
#endif
    const hipError_t le = hipPeekAtLastError();
    if (le != hipSuccess) fprintf(stderr, "kernel_launch: launch failed: %s\n", hipGetErrorName(le));
}
```

```cpp
#include <hip/hip_runtime.h>
#include <cstdio>
#include <cstdint>
namespace pg8 {
#define PG8_LAS __attribute__((address_space(3)))
typedef unsigned short bf16_t;
typedef short bf16x8 __attribute__((ext_vector_type(8)));
typedef float f32x4 __attribute__((ext_vector_type(4)));
typedef unsigned u32x4 __attribute__((ext_vector_type(4)));
constexpr int BM = 256, BK = 64, HALF = 128, HTB = HALF * BK * 2  , STAGE_BYTES = 8 * HTB, NXCD = 8, WGM = 8;

__host__ __device__ __forceinline__ int lds_byte(int r, int c) { const int st = (r >> 4) * 2 + (c >> 5), rr = r & 15, cc = c & 31, ob = rr * 64 + cc * 2; return st * 1024 + (ob ^ (((ob >> 9) & 1) << 5)); }
__host__ __device__ __forceinline__ void stage_rc(int b, int& R, int& C) { const int st = b / 1024, sb = b % 1024, swz = sb ^ (((sb >> 9) & 1) << 5); R = (st >> 1) * 16 + swz / 64; C = (st & 1) * 32 + (swz % 64) / 2; }
__host__ __device__ __forceinline__ int perm32(int rho) { const int n = rho >> 4, i = rho & 15; return 8 * (i >> 2) + 4 * n + (i & 3); }

__host__ __device__ __forceinline__ int perm32_inv(int x) { return 16 * ((x >> 2) & 1) + 4 * (x >> 3) + (x & 3); }
__host__ __device__ __forceinline__ size_t sw_off(int row, int k, int K, bool perm) {
    const int tile = row >> 8, h = (row >> 7) & 1, Rp = row & 127, R = perm ? ((Rp & ~31) + perm32_inv(Rp & 31)) : Rp;
    return ((size_t)(tile * 2 + h) * (K >> 6) + (k >> 6)) * 8192 + (size_t)(lds_byte(R, k & 63) >> 1);
}
struct Unit { int pm, pn, k0, nt; };
struct Gemm { const bf16_t* A; const bf16_t* Bt; int M, N, K; int swb = 0, swa = 0; };

struct StaticOrder {
    int nM, nN, nwg, G, c;
    __host__ __device__ void init(int M, int N, int G_, int c_) { nM = M / BM; nN = N / BM; nwg = nM * nN; G = G_; c = c_; }
    __host__ __device__ bool next(int i, Unit& u) const {
        const long L = (long)i * G + c; if (L >= nwg) return false;
        int wgid = (int)L; { const int q = nwg / NXCD, r = nwg % NXCD, xcd = wgid % NXCD, off = wgid / NXCD; wgid = (xcd < r ? xcd * (q + 1) : r * (q + 1) + (xcd - r) * q) + off; }
        const int nig = WGM * nN, gid = wgid / nig, fm = gid * WGM, gsz = (nM - fm) < WGM ? (nM - fm) : WGM;
        u.pm = fm + ((wgid % nig) % gsz); u.pn = (wgid % nig) / gsz; u.k0 = 0; u.nt = 0; return true;
    }
    __device__ __forceinline__ void a_ready(const Unit&) const {}
    __device__ __forceinline__ void done(const Unit&) const {}
};

typedef float f32x2c_t __attribute__((ext_vector_type(2)));
typedef __bf16 bf16x2c_t __attribute__((ext_vector_type(2)));
__device__ __forceinline__ unsigned cvt_pk_bf16(float lo, float hi) { const f32x2c_t v = {lo, hi}; const bf16x2c_t b = __builtin_convertvector(v, bf16x2c_t); return __builtin_bit_cast(unsigned, b); }
typedef float f32x2 __attribute__((ext_vector_type(2)));
#ifndef WGM_DEF
#define WGM_DEF 4
#endif
#ifndef WGM_BR
#define WGM_BR 4
#endif
#ifndef WGM_N8
#define WGM_N8 4
#endif
__device__ __forceinline__ void tile_map(int nM, int nN, int wgid, int& pm, int& pn, int wgm = WGM_DEF) {
    const int nwg = nM * nN;
    { const int q = nwg / NXCD, r = nwg % NXCD, xcd = wgid % NXCD, off = wgid / NXCD; wgid = (xcd < r ? xcd * (q + 1) : r * (q + 1) + (xcd - r) * q) + off; }
    const int nig = wgm * nN, gid = wgid / nig, fm = gid * wgm, gsz = (nM - fm) < wgm ? (nM - fm) : wgm;
    pm = fm + ((wgid % nig) % gsz); pn = (wgid % nig) / gsz;
}
struct TileOrder {
    int nM0, nN0, n0, nM1, nN1, n1, pm1, G, c, ntK, skip1, wgm = WGM_DEF;
    __device__ __forceinline__ void init(int nM0_, int nN0_, int nM1_, int nN1_, int pm1_, int G_, int c_, int ntK_, int skip1_ = -1) { skip1 = skip1_; ntK = ntK_; nM0 = nM0_; nN0 = nN0_; n0 = nM0_ * nN0_; nM1 = nM1_; nN1 = nN1_; n1 = nM1_ * nN1_; pm1 = pm1_; G = G_; c = c_; }
    __device__ __forceinline__ bool next(int i, Unit& u) const {
        long L = (long)i * G + c; u.k0 = 0; u.nt = ntK;
        if (L < n0) { tile_map(nM0, nN0, (int)L, u.pm, u.pn, wgm); return true; }
        L -= n0;
        if (L < n1) { tile_map(nM1, nN1, (int)L, u.pm, u.pn, wgm); u.pm += pm1; if (skip1 >= 0 && u.pn >= skip1) ++u.pn; return true; }
        return false;
    }
    __device__ __forceinline__ void a_ready(const Unit&) const {}
    __device__ __forceinline__ void done(const Unit&) const {}
};
struct QuarterOrder {
    int n, pm0, G, c, ntK;
    __device__ __forceinline__ void init(int nM, int pm0_, int ntq, int G_, int c_) { n = nM * 8 * 4; pm0 = pm0_; ntK = ntq; G = G_; c = c_; }
    __device__ __forceinline__ bool next(int i, Unit& u) const {
        const long L = (long)i * G + c; if (L >= n) return false;
        const int t = (int)L >> 2, qq = (int)L & 3; u.pm = pm0 + (t >> 3); u.pn = t & 7; u.k0 = qq * ntK; u.nt = ntK; return true;
    }
    __device__ __forceinline__ void a_ready(const Unit&) const {}
    __device__ __forceinline__ void done(const Unit&) const {}
};
struct BranchOrder {
    int nM, NPM, G, c; static constexpr int ntK = 8;
    __device__ __forceinline__ void init(int nM_, int NPM_, int G_, int c_) { nM = nM_; NPM = NPM_; G = G_; c = c_; }
    __device__ __forceinline__ bool next(int i, Unit& u) const {
        const long L = (long)(i >> 2) * G + c; if (L >= nM * 8) return false;
        int pm, pn; tile_map(nM, 8, (int)L, pm, pn, WGM_BR); const int n = i & 3;
        u.pm = n * NPM + pm; u.pn = n * 8 + pn; u.k0 = 0; u.nt = 8; return true;
    }
    __device__ __forceinline__ void a_ready(const Unit&) const {}
    __device__ __forceinline__ void done(const Unit&) const {}
};

__device__ __forceinline__ float silu_f(float a) { return a * __builtin_amdgcn_rcpf(1.0f + __expf(-a)); }
__device__ __forceinline__ float sigmoid_f(float a) { return __builtin_amdgcn_rcpf(1.0f + __expf(-a)); }
struct EpiSwiglu {
    static constexpr bool PERM = true, AFTER_DRAIN = false, CHAIN = false;
    bf16_t* O; int ldc;
    __device__ __forceinline__ void operator()(const f32x4 (&acc)[2][2][4][2], const Unit& u, int wr, int wc, int fr, int fq) const {
        const int row0 = u.pm * BM + wr * 64 + fr, col0 = u.pn * HALF + wc * 32 + 8 * fq;
#pragma unroll
        for (int ai = 0; ai < 2; ++ai)
#pragma unroll
            for (int m = 0; m < 4; ++m) { bf16_t* rowp = O + sw_off(row0 + ai * HALF + m * 16, col0, ldc, false);
                const f32x4 a0 = acc[ai][0][m][0], a1 = acc[ai][0][m][1], b0 = acc[ai][1][m][0], b1 = acc[ai][1][m][1];
                f32x4 v0, v1;
#pragma unroll
                for (int j = 0; j < 4; ++j) { v0[j] = silu_f(a0[j]) * b0[j]; v1[j] = silu_f(a1[j]) * b1[j]; }
                u32x4 w; w.x = cvt_pk_bf16(v0[0], v0[1]); w.y = cvt_pk_bf16(v0[2], v0[3]); w.z = cvt_pk_bf16(v1[0], v1[1]); w.w = cvt_pk_bf16(v1[2], v1[3]);
                *(u32x4*)rowp = w; }
    }
};
template <bool ATOMIC  > struct EpiRes {
    static constexpr bool PERM = false, AFTER_DRAIN = false, CHAIN = false;
    float* out_l; float* out_c; const float* gate; float coef;
    __device__ __forceinline__ void operator()(const f32x4 (&acc)[2][2][4][2], const Unit& u, int wr, int wc, int fr, int fq) const {
        const bool isc = u.pm >= 64; const int b9 = isc ? 8 : (u.pm >> 3);
        const int prow = (isc ? (u.pm - 64) : u.pm) * BM + wr * 64 + fr, col0 = u.pn * BM + wc * 32 + 4 * fq;
        float* op = isc ? out_c : out_l;
        const float* gp = gate + (size_t)b9 * 18432 + col0;
        f32x4 gv[2][2];
#pragma unroll
        for (int bj = 0; bj < 2; ++bj)
#pragma unroll
            for (int n = 0; n < 2; ++n) gv[bj][n] = *(const f32x4*)(gp + bj * HALF + n * 16) * coef;
        if constexpr (!ATOMIC) {
#pragma unroll
            for (int ai = 0; ai < 2; ++ai) {
                f32x4 bs[4][2][2];
#pragma unroll
                for (int m = 0; m < 4; ++m)
#pragma unroll
                    for (int bj = 0; bj < 2; ++bj)
#pragma unroll
                        for (int n = 0; n < 2; ++n) bs[m][bj][n] = *(const f32x4*)(op + (size_t)(prow + ai * HALF + m * 16) * 2048 + col0 + bj * HALF + n * 16);
#pragma unroll
                for (int m = 0; m < 4; ++m)
#pragma unroll
                    for (int bj = 0; bj < 2; ++bj)
#pragma unroll
                        for (int n = 0; n < 2; ++n) *(f32x4*)(op + (size_t)(prow + ai * HALF + m * 16) * 2048 + col0 + bj * HALF + n * 16) = bs[m][bj][n] + gv[bj][n] * acc[ai][bj][m][n];
                asm volatile("" ::: "memory");
            }
        } else {
            float* pp = op + (size_t)(u.k0 / u.nt) * ((size_t)2048 * 2048);
#pragma unroll
            for (int ai = 0; ai < 2; ++ai)
#pragma unroll
                for (int m = 0; m < 4; ++m) { const size_t off = (size_t)(prow + ai * HALF + m * 16) * 2048 + col0;
#pragma unroll
                    for (int bj = 0; bj < 2; ++bj)
#pragma unroll
                        for (int n = 0; n < 2; ++n) *(f32x4*)(pp + off + bj * HALF + n * 16) = gv[bj][n] * acc[ai][bj][m][n]; }
        }
    }
};
struct EpiZ {
    static constexpr bool PERM = true, AFTER_DRAIN = false, CHAIN = false;
    bf16_t* Z; float* ZS; int ldz; bf16_t* GT;
    __device__ __forceinline__ void operator()(const f32x4 (&acc)[2][2][4][2], const Unit& u, int wr, int wc, int fr, int fq) const {
        const int row0 = u.pm * BM + wr * 64 + fr, col0 = u.pn * BM + wc * 32 + 8 * fq;
        if (u.pn >= 25) {
            bf16_t* tb = GT + ((size_t)u.pm * 32 + (u.pn - 25)) * 65536 + (size_t)threadIdx.x * 8;
#pragma unroll
            for (int ai = 0; ai < 2; ++ai)
#pragma unroll
                for (int m = 0; m < 4; ++m)
#pragma unroll
                    for (int bj = 0; bj < 2; ++bj) { f32x4 v0 = acc[ai][bj][m][0], v1 = acc[ai][bj][m][1];
#pragma unroll
                        for (int j = 0; j < 4; ++j) { v0[j] = 1.0f + __expf(-fminf(fmaxf(v0[j], -40.f), 40.f)); v1[j] = 1.0f + __expf(-fminf(fmaxf(v1[j], -40.f), 40.f)); }
                        u32x4 w; w.x = cvt_pk_bf16(v0[0], v0[1]); w.y = cvt_pk_bf16(v0[2], v0[3]); w.z = cvt_pk_bf16(v1[0], v1[1]); w.w = cvt_pk_bf16(v1[2], v1[3]);
                        *(u32x4*)(tb + ((ai * 4 + m) * 2 + bj) * 4096) = w; }
            return;
        }
        if (u.pn == 10) {
            if (wc == 0) {
#pragma unroll
                for (int ai = 0; ai < 2; ++ai)
#pragma unroll
                    for (int m = 0; m < 4; ++m) { float* zp = ZS + (size_t)(row0 + ai * HALF + m * 16) * 32 + 8 * fq;
                        *(f32x4*)zp = acc[ai][0][m][0]; *(f32x4*)(zp + 4) = acc[ai][0][m][1]; }
            }
            return;
        }
#pragma unroll
        for (int ai = 0; ai < 2; ++ai)
#pragma unroll
            for (int m = 0; m < 4; ++m) { bf16_t* rowp = Z + (size_t)(row0 + ai * HALF + m * 16) * ldz + col0;
#pragma unroll
                for (int bj = 0; bj < 2; ++bj) { const f32x4 v0 = acc[ai][bj][m][0], v1 = acc[ai][bj][m][1];
                    u32x4 w; w.x = cvt_pk_bf16(v0[0], v0[1]); w.y = cvt_pk_bf16(v0[2], v0[3]); w.z = cvt_pk_bf16(v1[0], v1[1]); w.w = cvt_pk_bf16(v1[2], v1[3]);
                    *(u32x4*)(rowp + bj * HALF) = w; } }
    }
};
struct EpiBranch {
    static constexpr bool PERM = true, AFTER_DRAIN = false, CHAIN = true;
    const bf16_t* GT; bf16_t* Hout; int NPM;
    static __device__ __forceinline__ float epos(float g) { return __expf(-fminf(fmaxf(g, -40.f), 40.f)); }
    __device__ __forceinline__ void chain(f32x4 (&acc)[2][2][4][2], const Unit& u, int wr, int wc, int fr, int fq) const {
        const int n = u.pn >> 3, pn = u.pn & 7, pm = u.pm - n * NPM;
        const int row0 = pm * BM + wr * 64 + fr, col0 = pn * BM + wc * 32 + 8 * fq;
#pragma unroll
        for (int ai = 0; ai < 2; ++ai) {
            u32x4 gaa[4][2], gbb[4][2];
#pragma unroll
            for (int m = 0; m < 4; ++m)
#pragma unroll
                for (int bj = 0; bj < 2; ++bj) { const bf16_t* gp = GT + ((size_t)pm * 32 + n * 8 + pn) * 65536 + ((ai * 4 + m) * 2 + bj) * 4096 + (size_t)threadIdx.x * 8; gaa[m][bj] = *(const u32x4*)gp; gbb[m][bj] = (n < 3) ? *(const u32x4*)(gp + 8 * 65536) : gaa[m][bj]; }
#pragma unroll
            for (int m = 0; m < 4; ++m) { const size_t r = (size_t)(row0 + ai * HALF + m * 16);
#pragma unroll
                for (int bj = 0; bj < 2; ++bj) {
                    const unsigned wa[4] = {gaa[m][bj].x, gaa[m][bj].y, gaa[m][bj].z, gaa[m][bj].w}, wb[4] = {gbb[m][bj].x, gbb[m][bj].y, gbb[m][bj].z, gbb[m][bj].w};
                    f32x4 f0, f1;
#pragma unroll
                    for (int j = 0; j < 4; ++j) { const float ea = (j & 1) ? __uint_as_float(wa[j >> 1] & 0xffff0000u) : __uint_as_float(wa[j >> 1] << 16);
                        const float eb = (j & 1) ? __uint_as_float(wb[j >> 1] & 0xffff0000u) : __uint_as_float(wb[j >> 1] << 16);
                        f0[j] = ((n < 3) ? eb : 1.0f) * __builtin_amdgcn_rcpf(ea); }
#pragma unroll
                    for (int j = 0; j < 4; ++j) { const float ea = (j & 1) ? __uint_as_float(wa[2 + (j >> 1)] & 0xffff0000u) : __uint_as_float(wa[2 + (j >> 1)] << 16);
                        const float eb = (j & 1) ? __uint_as_float(wb[2 + (j >> 1)] & 0xffff0000u) : __uint_as_float(wb[2 + (j >> 1)] << 16);
                        f1[j] = ((n < 3) ? eb : 1.0f) * __builtin_amdgcn_rcpf(ea); }
                    const f32x4 s0 = acc[ai][bj][m][0] * f0, s1 = acc[ai][bj][m][1] * f1;
                    if (n < 3) { acc[ai][bj][m][0] = s0; acc[ai][bj][m][1] = s1; }
                    else { u32x4 w; w.x = cvt_pk_bf16(s0[0], s0[1]); w.y = cvt_pk_bf16(s0[2], s0[3]); w.z = cvt_pk_bf16(s1[0], s1[1]); w.w = cvt_pk_bf16(s1[2], s1[3]);
                        *(u32x4*)(Hout + sw_off((int)r, col0 + bj * HALF, 2048, false)) = w;
                        acc[ai][bj][m][0] = (f32x4){0.f, 0.f, 0.f, 0.f}; acc[ai][bj][m][1] = (f32x4){0.f, 0.f, 0.f, 0.f}; } } }
        }
    }
};
template <class Epi, class Sched, bool ALIGN_EPI = false, bool SP2 = false>
__device__ __forceinline__ void gemm_phase(PG8_LAS unsigned char* lds, const Gemm g, const Sched& S, const Epi& E) {
    const int tid = threadIdx.x, wid = __builtin_amdgcn_readfirstlane(tid >> 6), lane = tid & 63, wr = wid >> 2, wc = wid & 3, fr = lane & 15, fq = lane >> 4;
    const int K = g.K, nt = S.ntK;
    unsigned voffA[2], voffB[2];
#pragma unroll
    for (int i = 0; i < 2; ++i) { int R, C; stage_rc(tid * 16 + i * 8192, R, C); const int Rb = Epi::PERM ? ((R & ~31) + perm32(R & 31)) : R;
        voffA[i] = g.swa ? (unsigned)(tid * 16 + i * 8192) : (unsigned)(R * K + C) * 2u; voffB[i] = g.swb ? (unsigned)(tid * 16 + i * 8192) : (unsigned)(Rb * K + C) * 2u; }
    const size_t kstep = (size_t)(BK * 2);
    const size_t hstep = (size_t)HALF * K * 2;
    const size_t tstep = 2 * hstep;
    const size_t kstepA = g.swa ? (size_t)HTB : kstep, hstepA = g.swa ? (size_t)(K / BK) * HTB : hstep, tstepA = 2 * hstepA;
    const size_t kstepB = g.swb ? (size_t)HTB : kstep, hstepB = g.swb ? (size_t)(K / BK) * HTB : hstep, tstepB = 2 * hstepB;
    const unsigned ldsw = (unsigned)wid * 1024u;
    const int aoff = lds_byte(wr * 64 + fr, fq * 8), boff = lds_byte(wc * 32 + fr, fq * 8);
#define PG8_SA(b, h) (((b) * 2 + (h)) * HTB)
#define PG8_SB(b, h) ((4 + (b) * 2 + (h)) * HTB)
#define PG8_STAGE(bufoff, gbase, voff) do { _Pragma("unroll") for (int _i = 0; _i < 2; ++_i) \
        __builtin_amdgcn_global_load_lds((const unsigned*)((const char*)(gbase) + (voff)[_i]), (PG8_LAS unsigned*)(lds + (bufoff) + ldsw + _i * 8192), 16, 0, 0); } while (0)
#define PG8_LDA(dst, b, h) do { _Pragma("unroll") for (int m = 0; m < 4; ++m) _Pragma("unroll") for (int k = 0; k < 2; ++k) dst[m][k] = *(const PG8_LAS bf16x8*)(lds + PG8_SA(b, h) + aoff + m * 2048 + k * 1024); } while (0)
#define PG8_LDB(dst, b, h) do { _Pragma("unroll") for (int n = 0; n < 2; ++n) _Pragma("unroll") for (int k = 0; k < 2; ++k) dst[n][k] = *(const PG8_LAS bf16x8*)(lds + PG8_SB(b, h) + boff + n * 2048 + k * 1024); } while (0)
#define PG8_MMA(ai, bj, At, Bt) do { __builtin_amdgcn_s_setprio(1); _Pragma("unroll") for (int m = 0; m < 4; ++m) _Pragma("unroll") for (int n = 0; n < 2; ++n) _Pragma("unroll") for (int k = 0; k < 2; ++k) \
        acc[ai][bj][m][n] = __builtin_amdgcn_mfma_f32_16x16x32_bf16(Bt[n][k], At[m][k], acc[ai][bj][m][n], 0, 0, 0); __builtin_amdgcn_s_setprio(0); } while (0)
#define PG8_WAIT_V(n) asm volatile("s_waitcnt vmcnt(" #n ")" ::: "memory")
#define PG8_WAIT_L(n) asm volatile("s_waitcnt lgkmcnt(" #n ")" ::: "memory")
#define PG8_BAR __builtin_amdgcn_s_barrier()
#define PG8_SCHED __builtin_amdgcn_sched_barrier(0)
    Unit cur, nxt; int ui = 0;
    if (!S.next(0, cur)) return;
    f32x4 acc[2][2][4][2];
#pragma unroll
    for (int a = 0; a < 2; ++a)
#pragma unroll
        for (int b = 0; b < 2; ++b)
#pragma unroll
            for (int m = 0; m < 4; ++m)
#pragma unroll
                for (int n = 0; n < 2; ++n) acc[a][b][m][n] = (f32x4){0.f, 0.f, 0.f, 0.f};
    bf16x8 At[4][2], B0[2][2], B1[2][2];
    const char* cA = (const char*)g.A + (size_t)cur.pm * tstepA + (size_t)cur.k0 * kstepA; const char* cB = (const char*)g.Bt + (size_t)cur.pn * tstepB + (size_t)cur.k0 * kstepB;
    S.a_ready(cur);
    if constexpr (SP2) {
        PG8_STAGE(PG8_SB(0, 0), cB, voffB); PG8_STAGE(PG8_SB(0, 1), cB + hstepB, voffB); PG8_STAGE(PG8_SA(0, 0), cA, voffA); PG8_STAGE(PG8_SA(0, 1), cA + hstepA, voffA);
        if (wr == 1) PG8_BAR;
        PG8_WAIT_V(2); PG8_BAR;
        PG8_STAGE(PG8_SB(1, 0), cB + kstepB, voffB); PG8_STAGE(PG8_SA(1, 0), cA + kstepA, voffA); PG8_STAGE(PG8_SB(1, 1), cB + hstepB + kstepB, voffB);
        PG8_WAIT_V(6); PG8_BAR;
    } else {
        PG8_STAGE(PG8_SB(0, 0), cB, voffB); PG8_STAGE(PG8_SA(0, 0), cA, voffA); PG8_STAGE(PG8_SB(0, 1), cB + hstepB, voffB); PG8_STAGE(PG8_SA(0, 1), cA + hstepA, voffA);
        if (wr == 1) PG8_BAR;
        PG8_WAIT_V(4); PG8_BAR;
        PG8_STAGE(PG8_SB(1, 0), cB + kstepB, voffB); PG8_STAGE(PG8_SA(1, 0), cA + kstepA, voffA); PG8_STAGE(PG8_SB(1, 1), cB + hstepB + kstepB, voffB);
        PG8_WAIT_V(6); PG8_BAR;
    }
    for (;;) {
        const bool has_next = S.next(ui + 1, nxt);
        const char* nA = has_next ? (const char*)g.A + (size_t)nxt.pm * tstepA + (size_t)nxt.k0 * kstepA : cA; const char* nB = has_next ? (const char*)g.Bt + (size_t)nxt.pn * tstepB + (size_t)nxt.k0 * kstepB : cB;
        for (int t = 0; t < nt; t += 2) {
            const bool last = (t == nt - 2);
            const char* a1 = cA + (size_t)(t + 1) * kstepA;
            const char* a2 = last ? nA : cA + (size_t)(t + 2) * kstepA; const char* b2 = last ? nB : cB + (size_t)(t + 2) * kstepB;
            const char* a3 = a2 + kstepA; const char* b3 = b2 + kstepB;
            if (last && has_next) S.a_ready(nxt);
            if constexpr (SP2) {
            PG8_LDB(B0, 0, 0); PG8_LDB(B1, 0, 1); PG8_SCHED; PG8_LDA(At, 0, 0); PG8_STAGE(PG8_SA(1, 1), a1 + hstepA, voffA);
            PG8_WAIT_V(8); PG8_WAIT_L(0); PG8_BAR; PG8_MMA(0, 0, At, B0); PG8_MMA(0, 1, At, B1); PG8_BAR; PG8_SCHED;
            PG8_LDA(At, 0, 1); PG8_STAGE(PG8_SB(0, 0), b2, voffB); PG8_STAGE(PG8_SB(0, 1), b2 + hstepB, voffB); PG8_STAGE(PG8_SA(0, 0), a2, voffA);
            PG8_WAIT_V(8); PG8_WAIT_L(0); PG8_BAR; PG8_MMA(1, 0, At, B0); PG8_MMA(1, 1, At, B1); PG8_BAR; PG8_SCHED;
            PG8_LDB(B0, 1, 0); PG8_LDB(B1, 1, 1); PG8_SCHED; PG8_LDA(At, 1, 0); PG8_STAGE(PG8_SA(0, 1), a2 + hstepA, voffA);
            PG8_WAIT_V(8); PG8_WAIT_L(0); PG8_BAR; PG8_MMA(0, 0, At, B0); PG8_MMA(0, 1, At, B1); PG8_BAR; PG8_SCHED;
            PG8_LDA(At, 1, 1); PG8_STAGE(PG8_SB(1, 0), b3, voffB); PG8_STAGE(PG8_SB(1, 1), b3 + hstepB, voffB); PG8_STAGE(PG8_SA(1, 0), a3, voffA);
            PG8_WAIT_V(8); PG8_WAIT_L(0); PG8_BAR; PG8_MMA(1, 0, At, B0); PG8_MMA(1, 1, At, B1); PG8_BAR; PG8_SCHED;
            } else {
            PG8_LDB(B0, 0, 0); PG8_SCHED; PG8_LDA(At, 0, 0); PG8_STAGE(PG8_SA(1, 1), a1 + hstepA, voffA);
            PG8_WAIT_L(8); PG8_BAR; PG8_WAIT_L(0); PG8_MMA(0, 0, At, B0); PG8_BAR; PG8_SCHED;
            PG8_LDB(B1, 0, 1); PG8_STAGE(PG8_SB(0, 0), b2, voffB);
            PG8_BAR; PG8_WAIT_L(0); PG8_MMA(0, 1, At, B1); PG8_BAR;
            PG8_LDA(At, 0, 1); PG8_STAGE(PG8_SA(0, 0), a2, voffA);
            PG8_BAR; PG8_WAIT_L(0); PG8_MMA(1, 0, At, B0); PG8_BAR; PG8_SCHED;
            PG8_STAGE(PG8_SB(0, 1), b2 + hstepB, voffB);
            PG8_WAIT_V(6); PG8_BAR; PG8_MMA(1, 1, At, B1); PG8_BAR;
            PG8_LDB(B0, 1, 0); PG8_SCHED; PG8_LDA(At, 1, 0); PG8_STAGE(PG8_SA(0, 1), a2 + hstepA, voffA);
            PG8_WAIT_L(8); PG8_BAR; PG8_WAIT_L(0); PG8_MMA(0, 0, At, B0); PG8_BAR; PG8_SCHED;
            PG8_LDB(B1, 1, 1); PG8_STAGE(PG8_SB(1, 0), b3, voffB);
            PG8_BAR; PG8_WAIT_L(0); PG8_MMA(0, 1, At, B1); PG8_BAR;
            PG8_LDA(At, 1, 1); PG8_STAGE(PG8_SA(1, 0), a3, voffA);
            PG8_BAR; PG8_WAIT_L(0); PG8_MMA(1, 0, At, B0); PG8_BAR; PG8_SCHED;
            PG8_STAGE(PG8_SB(1, 1), b3 + hstepB, voffB);
            PG8_WAIT_V(6); PG8_BAR; PG8_MMA(1, 1, At, B1); PG8_BAR;
            }
        }
        if constexpr (ALIGN_EPI) { if (wr == 0) PG8_BAR; }
        if constexpr (Epi::CHAIN) { E.chain(acc, cur, wr, wc, fr, fq); S.done(cur); }
        else if constexpr (!Epi::AFTER_DRAIN) { E(acc, cur, wr, wc, fr, fq); S.done(cur); }
        if (!has_next) break;
        if constexpr (!Epi::CHAIN) {
#pragma unroll
        for (int a = 0; a < 2; ++a)
#pragma unroll
            for (int b = 0; b < 2; ++b)
#pragma unroll
                for (int m = 0; m < 4; ++m)
#pragma unroll
                    for (int n = 0; n < 2; ++n) acc[a][b][m][n] = (f32x4){0.f, 0.f, 0.f, 0.f};
        }
        cur = nxt; cA = nA; cB = nB; ++ui;
        if constexpr (ALIGN_EPI) { if (wr == 1) PG8_BAR; }
    }
    PG8_WAIT_V(0);
    if constexpr (!ALIGN_EPI) { if (wr == 0) PG8_BAR; }
    PG8_BAR;
    if constexpr (Epi::AFTER_DRAIN) { E.fused(acc, cur, wr, wc, fr, fq, lds, wid, lane); S.done(cur); }
#undef PG8_SA
#undef PG8_SB
#undef PG8_STAGE
#undef PG8_LDA
#undef PG8_LDB
#undef PG8_MMA
#undef PG8_WAIT_V
#undef PG8_WAIT_L
#undef PG8_BAR
#undef PG8_SCHED
}
}
#ifndef PG8_SP2
#define PG8_SP2 true
#endif
#ifndef PG8_ALIGN
#define PG8_ALIGN true
#endif
constexpr int NWAVES = 8;
constexpr int D = 2048, BATCH = 8, SEQ = 2048, CTXL = 256, DFF = 5632, NLAYER = 2;
constexpr int ML = BATCH * SEQ, MC = BATCH * CTXL, MT = ML + MC;
constexpr int ZLD = 6400;
constexpr int NZ = 14592;
constexpr int MODW = 9 * D;
constexpr int INC = 14368;
constexpr float EPS = 1e-6f;
constexpr int ZC_MLK = 0, ZC_MLV = 512, ZC_GDK = 1024, ZC_GDV = 1536, ZC_ATK = 2048, ZC_ATV = 2304, ZC_SMALL = 2560, ZC_SGU = 2816, ZC_SGV = 3328,
              ZC_MLQ = 3840, ZC_MLO = 4352, ZC_GDQ = 4864, ZC_GDZ = 5376, ZC_ATQ = 5888, ZC_GATE = 6400;
constexpr int NKV_TILES = 11;

constexpr size_t MiB = 1u << 20;
constexpr size_t WS_CTL = 0, CTL_ZERO_BYTES = 1 * MiB;
constexpr size_t WS_MOD = 1 * MiB;
constexpr size_t WS_ROPE = 3 * MiB;
constexpr size_t WS_XC = 4 * MiB;
constexpr size_t WS_WFI = 20 * MiB;
constexpr size_t WS_WFO = 64 * MiB;
constexpr size_t WS_WZ = 86 * MiB;
constexpr size_t WS_WB = 143 * MiB;
constexpr size_t WS_WO = 151 * MiB;
constexpr size_t WS_H = 159 * MiB;
constexpr size_t WS_Z = 231 * MiB;
constexpr size_t WS_GT = WS_Z + (size_t)18432 * 6400 * 2;
constexpr size_t WS_ZS = 744 * MiB;
constexpr size_t WS_Y = 747 * MiB;
constexpr size_t WS_QA = 819 * MiB;
constexpr size_t WS_KC = 837 * MiB;
constexpr size_t WS_VC = 846 * MiB;
constexpr size_t WS_MIX = 855 * MiB;
constexpr size_t WS_END = 1150 * MiB;
static_assert(WS_GT + (size_t)72 * 32 * 131072 <= WS_ZS && WS_Z + (size_t)MT * NZ * 2 <= WS_ZS && WS_H + (size_t)MT * D * 2 <= WS_Z && WS_Y + (size_t)4 * MT * 512 * 2 <= WS_QA, "d_ws map");
static_assert(WS_WFI + (size_t)2 * DFF * D * 2 <= WS_WFO && WS_WFO + (size_t)D * DFF * 2 <= WS_WZ && WS_WZ + (size_t)NZ * D * 2 <= WS_WB, "d_ws map (weights)");
constexpr int CW_TMO = 0, CW_CODE = 1, CW_BAR = 4096;

constexpr int RING_OFF = 0, RING_BYTES = 131072;
constexpr int LDSCTL_OFF = RING_BYTES, MISC_OFF = LDSCTL_OFF + 320;
constexpr int LDS_BYTES = 147456;

#define GAS __attribute__((address_space(1)))
#define LAS __attribute__((address_space(3)))
typedef unsigned short bf16;
typedef unsigned v4u __attribute__((ext_vector_type(4)));
typedef unsigned v2u __attribute__((ext_vector_type(2)));
typedef float f32x4 __attribute__((ext_vector_type(4)));
typedef short bf16x8 __attribute__((ext_vector_type(8)));
typedef GAS unsigned gu32;
#define RLX_AGENT __ATOMIC_RELAXED, __HIP_MEMORY_SCOPE_AGENT
#define LDS_WAIT() asm volatile("s_waitcnt lgkmcnt(0)" ::: "memory")
#define VM_WAIT() asm volatile("s_waitcnt vmcnt(0)" ::: "memory")
typedef float f32x2_t __attribute__((ext_vector_type(2)));
typedef __bf16 bf16x2_t __attribute__((ext_vector_type(2)));
__device__ __forceinline__ unsigned pk2(float lo, float hi) { const f32x2_t v = {lo, hi}; const bf16x2_t b = __builtin_convertvector(v, bf16x2_t); return __builtin_bit_cast(unsigned, b); }
__device__ __forceinline__ float bflo(unsigned w) { return __uint_as_float(w << 16); }
__device__ __forceinline__ float bfhi(unsigned w) { return __uint_as_float(w & 0xffff0000u); }
__device__ __forceinline__ float bf1(bf16 b) { return __uint_as_float(((unsigned)b) << 16); }
__device__ __forceinline__ bf16 f2bf1(float f) { return (bf16)(pk2(f, 0.f) & 0xffffu); }
__device__ __forceinline__ float silu1(float a) { return a / (1.0f + __expf(-a)); }
__device__ __forceinline__ float sigm1(float a) { return 1.0f / (1.0f + __expf(-a)); }
__device__ __forceinline__ float wave_sum(float v) {
#pragma unroll
    for (int o = 1; o < 64; o <<= 1) v += __shfl_xor(v, o);
    return v;
}
#define XB_TMO      128
#define XB_XCNT(j)  (256  + 64 * (j))
#define XB_XSUB(j)  (1280 + 64 * (j))
#define XB_XGEN(j)  (2304 + 64 * (j))
#define XB_TOP      3328
#define XB_TOPGEN   3392
#define XCD_BAR_WORDS 3456
#define XB_SPIN_CAP (1u << 18)

__device__ __forceinline__ unsigned xb_ld(unsigned* p)              { return __hip_atomic_load(p, __ATOMIC_RELAXED, __HIP_MEMORY_SCOPE_AGENT); }
__device__ __forceinline__ unsigned xb_add(unsigned* p, unsigned v) { return __hip_atomic_fetch_add(p, v, __ATOMIC_RELAXED, __HIP_MEMORY_SCOPE_AGENT); }
__device__ __forceinline__ unsigned xb_xcc_id() { return (unsigned)__builtin_amdgcn_s_getreg((3 << 11) | 20) & 0xFu; }
#define XB_SPIN(cond, bar) do { unsigned _sp = 0; while (cond) { __builtin_amdgcn_s_sleep(1); \
    if ((++_sp & 255u) == 0u) { if (xb_ld(&(bar)[XB_TMO])) break; if (_sp > XB_SPIN_CAP) { atomicAdd(&(bar)[XB_TMO], 1u); break; } } } } while (0)

struct XcdBarrier {
    unsigned* bar; unsigned x;
    volatile LAS unsigned* st;
};

__device__ __forceinline__ XcdBarrier xcd_barrier_post(unsigned* bar, volatile LAS unsigned* st) {
    XcdBarrier b; b.bar = bar; b.x = xb_xcc_id(); b.st = st;
    if (threadIdx.x == 0) (void)xb_add(&bar[XB_XCNT(b.x)], 1u);
    return b;
}
__device__ __forceinline__ void xcd_barrier_complete(unsigned* bar, unsigned x, unsigned& nloc, unsigned& nx) {
    const unsigned G = gridDim.x * gridDim.y * gridDim.z;
    unsigned sum, cnt, mine, sp = 0u;
    for (;;) {
        sum = 0u; cnt = 0u; mine = 0u;
#pragma unroll
        for (unsigned j = 0; j < 16; ++j) { const unsigned c = xb_ld(&bar[XB_XCNT(j)]); sum += c; cnt += (c > 0u) ? 1u : 0u; mine = (j == x) ? c : mine; }
        if (sum == G) break;
        __builtin_amdgcn_s_sleep(1);
        if ((++sp & 255u) == 0u) { if (xb_ld(&bar[XB_TMO])) break; if (sp > XB_SPIN_CAP) { atomicAdd(&bar[XB_TMO], 1u); break; } }
    }
    nloc = mine > 0u ? mine : 1u; nx = cnt > 0u ? cnt : 1u;
}

__device__ __forceinline__ void xcd_barrier(const XcdBarrier& b) {
    asm volatile("s_waitcnt vmcnt(0)" ::: "memory");
    __syncthreads();
    if (threadIdx.x == 0) {
        unsigned* bar = b.bar;
        __builtin_amdgcn_s_waitcnt(0);
        unsigned nloc = b.st[0], nx = b.st[1];
        if (nloc == 0u) { xcd_barrier_complete(bar, b.x, nloc, nx); b.st[0] = nloc; b.st[1] = nx; }
        const unsigned old = xb_add(&bar[XB_XSUB(b.x)], 1u);
        const unsigned gen = old / nloc;
        if (old + 1u == (gen + 1u) * nloc) {
            __builtin_amdgcn_fence(__ATOMIC_RELEASE, "agent");
            asm volatile("s_waitcnt vmcnt(0)" ::: "memory");
            const unsigned og = xb_add(&bar[XB_TOP], 1u);
            const unsigned tg = og / nx;
            if (og + 1u == (tg + 1u) * nx) xb_add(&bar[XB_TOPGEN], 1u);
            else XB_SPIN(xb_ld(&bar[XB_TOPGEN]) == tg, bar);
            __builtin_amdgcn_fence(__ATOMIC_ACQUIRE, "agent");
            xb_add(&bar[XB_XGEN(b.x)], 1u);
            asm volatile("s_waitcnt vmcnt(0)" ::: "memory");
        } else {
            XB_SPIN(xb_ld(&bar[XB_XGEN(b.x)]) == gen, bar);
            __builtin_amdgcn_fence(__ATOMIC_ACQUIRE, "agent");
            asm volatile("s_waitcnt vmcnt(0)" ::: "memory");
        }
    }
    __syncthreads();
}
struct Frame {
    LAS unsigned char* lds;
    volatile LAS unsigned* MISC;
    gu32* ctl;
    int tid, lane, wave, G;
    unsigned char* ws;
    const float* const* in;
    float* out;
};
enum { I_X = 0, I_C, I_CTX, I_CCTX, I_MODW, I_MODB, I_F1N, I_F1WI, I_F1WO, I_MIXN, I_WIN, I_SGN, I_SGW, I_SGB, I_MLIFB, I_MLN, I_GDCONV, I_GDALOG, I_GDDTB, I_GDN,
       I_ATQN, I_ATKN, I_WBR, I_WOUT, I_F2N, I_F2WI, I_F2WO };

__device__ __forceinline__ void phase_mod(Frame& F) {
    LAS float* tab = (LAS float*)(F.lds + RING_OFF);
    LAS float* red = (LAS float*)(F.lds + RING_OFF + 98304);
    const float* c = F.in[I_C]; const float* cc = F.in[I_CCTX];
    for (int i = F.tid; i < 9 * D; i += NWAVES * 64) { const int b = i / D, k = i % D; const float x = b < 8 ? c[b * D + k] : cc[k]; tab[k * 12 + b] = silu1(x); }
    __syncthreads();
    float* MOD = (float*)(F.ws + WS_MOD);
    for (int item = blockIdx.x; item < 2 * 288; item += F.G) {
        const int l = item / 288, n0 = (item % 288) * 64;
        const float* W = F.in[I_MODW] + (size_t)l * D * MODW + n0 + F.lane;
        float acc[9];
#pragma unroll
        for (int b = 0; b < 9; ++b) acc[b] = 0.f;
        const int k0 = F.wave * 256;
        for (int k = k0; k < k0 + 256; k += 8) {
            float w[8];
#pragma unroll
            for (int j = 0; j < 8; ++j) w[j] = W[(size_t)(k + j) * MODW];
#pragma unroll
            for (int j = 0; j < 8; ++j) { const LAS f32x4* tp = (const LAS f32x4*)(tab + (k + j) * 12); const f32x4 s0 = tp[0], s1 = tp[1], s2 = tp[2];
                acc[0] += s0[0] * w[j]; acc[1] += s0[1] * w[j]; acc[2] += s0[2] * w[j]; acc[3] += s0[3] * w[j];
                acc[4] += s1[0] * w[j]; acc[5] += s1[1] * w[j]; acc[6] += s1[2] * w[j]; acc[7] += s1[3] * w[j]; acc[8] += s2[0] * w[j]; }
        }
#pragma unroll
        for (int b = 0; b < 9; ++b) red[(F.wave * 9 + b) * 64 + F.lane] = acc[b];
        __syncthreads();
        for (int i = F.tid; i < 576; i += NWAVES * 64) { const int b = i / 64, cc2 = i % 64; float s = 0.f;
#pragma unroll
            for (int w = 0; w < 8; ++w) s += red[(w * 9 + b) * 64 + cc2];
            MOD[(size_t)(l * 9 + b) * MODW + n0 + cc2] = s + F.in[I_MODB][(size_t)l * MODW + n0 + cc2]; }
        __syncthreads();
    }
}
__device__ __forceinline__ void phase_rope(Frame& F) {
    float* RC = (float*)(F.ws + WS_ROPE); float* RS = RC + 96 * 32;
    const int idx = blockIdx.x * (NWAVES * 64) + F.tid;
    if (idx < 96 * 32) {
        const int pos = idx >> 5, i = idx & 31; const float p = (float)(pos < 32 ? pos : pos - 32);
        const float inv = exp2f(-(float)i * (13.287712379549449f / 32.0f));
        const float x = p * inv;
        const float kf = rintf(x * 0.6366197723675814f);
        float r = fmaf(-kf, 1.5707963705062866f, x); r = fmaf(-kf, -4.371138828673793e-8f, r);
        const float r2 = r * r;
        const float sn = r + r * r2 * (-1.6666667163e-1f + r2 * (8.3333337680e-3f + r2 * (-1.9841270114e-4f + r2 * 2.7557314297e-6f)));
        const float cs = 1.0f + r2 * (-0.5f + r2 * (4.1666667908e-2f + r2 * (-1.3888889225e-3f + r2 * (2.4801587642e-5f + r2 * -2.7557314297e-7f))));
        const int q = ((int)kf) & 3;
        const float sv = (q == 0) ? sn : (q == 1) ? cs : (q == 2) ? -sn : -cs;
        const float cv = (q == 0) ? cs : (q == 1) ? -sn : (q == 2) ? -cs : sn;
        RC[idx] = cv; RS[idx] = sv;
    }
}
template <int MAP> __device__ __forceinline__ int dst_row(int n) {
    if (MAP == 0) return n;
    if (MAP == 1) { const int half = n >= DFF ? 1 : 0, j = n - half * DFF; return (j >> 7) * 256 + half * 128 + (j & 127); }
    if (n < 1024) return n;
    if (n < 1040) return ZC_SMALL + (n - 1024);
    if (n < 2064) return 1024 + (n - 1040);
    if (n < 2080) return ZC_SMALL + 16 + (n - 2064);
    if (n < 2592) return 2048 + (n - 2080);
    return n + 224;
}
template <int MAP, bool PERMB> __device__ __forceinline__ void conv_item(const float* W, int K, int N, bf16* WT, LAS float* scr, int item, int lane) {
    const int nblk = N / 32, kb = item / nblk, nb = item % nblk, k0 = 64 * kb, n0 = 32 * nb;
#pragma unroll 8
    for (int i = 0; i < 32; ++i) { const int kk = 2 * i + (lane >> 5); scr[kk * 33 + (lane & 31)] = W[(size_t)(k0 + kk) * N + n0 + (lane & 31)]; }
    LDS_WAIT(); asm volatile("" ::: "memory");
    const int c = lane & 7;
#pragma unroll
    for (int j = 0; j < 4; ++j) { const int n = (lane >> 3) + 8 * j; const LAS float* s = scr + (8 * c) * 33 + n;
        v4u o; o.x = pk2(s[0 * 33], s[1 * 33]); o.y = pk2(s[2 * 33], s[3 * 33]); o.z = pk2(s[4 * 33], s[5 * 33]); o.w = pk2(s[6 * 33], s[7 * 33]);
        *(GAS v4u*)(WT + pg8::sw_off(dst_row<MAP>(n0 + n), k0 + 8 * c, K, PERMB)) = o; }
    LDS_WAIT(); asm volatile("" ::: "memory");
}
__device__ __forceinline__ void conv_set(Frame& F, int l, int set, unsigned* queue) {
    LAS float* scr = (LAS float*)(F.lds + RING_OFF + F.wave * 16384);
    const int gw = blockIdx.x * NWAVES + F.wave, NGW = F.G * NWAVES;
    constexpr int I_FI = (D / 64) * (2 * DFF / 32), I_FO = (DFF / 64) * (D / 32), I_Z = (D / 64) * (INC / 32), I_B = (512 / 64) * (D / 32), I_O = (D / 64) * (D / 32);
    bf16* WFI = (bf16*)(F.ws + WS_WFI); bf16* WFO = (bf16*)(F.ws + WS_WFO); bf16* WZ = (bf16*)(F.ws + WS_WZ); bf16* WB = (bf16*)(F.ws + WS_WB); bf16* WO = (bf16*)(F.ws + WS_WO);
    const float* fwi = F.in[set == 1 ? I_F2WI : I_F1WI] + (size_t)l * D * 2 * DFF; const float* fwo = F.in[set == 1 ? I_F2WO : I_F1WO] + (size_t)l * DFF * D;
    const int NIT = set < 2 ? (I_FI + I_FO) : (I_Z + 4 * I_B + I_O);
    int it = gw, lim = NIT, step = NGW;
    for (;;) {
        if (queue) { int base = 0; if (F.lane == 0) base = (int)__hip_atomic_fetch_add(queue, 16u, __ATOMIC_RELAXED, __HIP_MEMORY_SCOPE_AGENT);
            base = __builtin_amdgcn_readfirstlane(base); if (base >= NIT) break; it = base; lim = base + 16 < NIT ? base + 16 : NIT; step = 1; }
        for (; it < lim; it += step) {
            int r = it;
            if (set < 2) {
                if (r < I_FI) { conv_item<1, true>(fwi, D, 2 * DFF, WFI, scr, r, F.lane); continue; } r -= I_FI;
                conv_item<0, false>(fwo, DFF, D, WFO, scr, r, F.lane);
            } else {
                if (r < I_Z) { conv_item<2, true>(F.in[I_WIN] + (size_t)l * D * INC, D, INC, WZ, scr, r, F.lane); continue; } r -= I_Z;
                if (r < 4 * I_B) { const int n = r / I_B; conv_item<0, true>(F.in[I_WBR] + ((size_t)l * 4 + n) * 512 * D, 512, D, WB + (size_t)n * D * 512, scr, r % I_B, F.lane); continue; } r -= 4 * I_B;
                conv_item<0, false>(F.in[I_WOUT] + (size_t)l * D * D, D, D, WO, scr, r, F.lane);
            }
        }
        if (!queue) break;
    }
    if (set == 2 && (!queue || blockIdx.x < 32)) {
        GAS v4u* z = (GAS v4u*)(WZ + (size_t)(10 * 2) * (D / 64) * 8192); const int npc = 2 * (D / 64) * 1024; const int nb = queue ? 32 : F.G;
        for (int i = blockIdx.x * (NWAVES * 64) + F.tid; i < npc; i += nb * NWAVES * 64) { int R, C; pg8::stage_rc((i & 1023) * 16, R, C); const int h = i / (1024 * (D / 64));
            const int rowt = 128 * h + ((R & ~31) + pg8::perm32(R & 31)); if (rowt >= 32) z[i] = (v4u){0u, 0u, 0u, 0u}; }
    }
}
template <bool COPY, bool ADDP, bool ZSM> __device__ __forceinline__ void phase_norm(Frame& F, const float* xl, const float* xc, const float* gain, const float* mod  , int nrows) {
    bf16* H = (bf16*)(F.ws + WS_H);
    const int gw = blockIdx.x * NWAVES + F.wave, NGW = F.G * NWAVES;
    if (ZSM) {
        const bf16* wz = (const bf16*)(F.ws + WS_WZ);
        for (int i = F.tid; i < 32 * D * 2 / 16; i += NWAVES * 64) { const int c = i / (D / 8), k8 = (i % (D / 8)) * 8;
            *(LAS v4u*)(F.lds + RING_OFF + i * 16) = *(const GAS v4u*)(wz + pg8::sw_off(ZC_SMALL + c, k8, D, true)); }
        __syncthreads();
    }
    for (int row = gw; row < nrows; row += NGW) {
        const bool isc = row >= ML; const int b9 = isc ? 8 : row / SEQ;
        const GAS f32x4* xr = (const GAS f32x4*)(isc ? xc + (size_t)(row - ML) * D : xl + (size_t)row * D) + F.lane;
        f32x4 v[8]; float s = 0.f;
#pragma unroll
        for (int j = 0; j < 8; ++j) v[j] = xr[64 * j];
        if (ADDP && isc) {
            const GAS f32x4* pr = (const GAS f32x4*)((const float*)(F.ws + WS_MIX) + (size_t)(row - ML) * D) + F.lane;
#pragma unroll
            for (int q = 0; q < 4; ++q)
#pragma unroll
                for (int j = 0; j < 8; ++j) v[j] = v[j] + pr[(size_t)q * (2048 * 2048 / 4) + 64 * j];
            GAS f32x4* xw = (GAS f32x4*)((float*)(F.ws + WS_XC) + (size_t)(row - ML) * D) + F.lane;
#pragma unroll
            for (int j = 0; j < 8; ++j) xw[64 * j] = v[j];
        }
#pragma unroll
        for (int j = 0; j < 8; ++j) s += (v[j].x * v[j].x + v[j].y * v[j].y) + (v[j].z * v[j].z + v[j].w * v[j].w);
        if (COPY) { GAS f32x4* cp = (GAS f32x4*)(isc ? (float*)(F.ws + WS_XC) + (size_t)(row - ML) * D : F.out + (size_t)row * D) + F.lane;
#pragma unroll
            for (int j = 0; j < 8; ++j) cp[64 * j] = v[j]; }
        const float rstd = 1.0f / sqrtf(wave_sum(s) * (1.0f / D) + EPS);
        const float* sh = mod + (size_t)b9 * MODW; const float* sc = sh + D;
#pragma unroll
        for (int j = 0; j < 8; ++j) { const int c = 4 * F.lane + 256 * j;
            const f32x4 g = *(const f32x4*)(gain + c), a = *(const f32x4*)(sc + c), b = *(const f32x4*)(sh + c);
            const f32x4 y = (v[j] * rstd * g) * (a + 1.0f) + b;
            if (ZSM) v[j] = y;
            v2u w; w.x = pk2(y.x, y.y); w.y = pk2(y.z, y.w); *(GAS v2u*)(H + pg8::sw_off(row, c & ~7, D, false) + (c & 7)) = w; }
        if (ZSM && isc) {
            float res = 0.f;
            for (int c = 0; c < 32; ++c) { const LAS v2u* wr = (const LAS v2u*)(F.lds + RING_OFF + c * (D * 2)) + F.lane; float s = 0.f;
#pragma unroll
                for (int j = 0; j < 8; ++j) { const v2u w = wr[64 * j]; s += v[j].x * bflo(w.x) + v[j].y * bfhi(w.x) + v[j].z * bflo(w.y) + v[j].w * bfhi(w.y); }
                s = wave_sum(s); res = (F.lane == c) ? s : res; }
            if (F.lane < 32) ((float*)(F.ws + WS_ZS))[(size_t)row * 32 + F.lane] = res;
        }
    }
}
#include <hip/hip_bf16.h>
namespace attn {
using bf16 = __hip_bfloat16;
constexpr int   D = 128, NW = 8, QBLK = 32, KVBLK = 64;
constexpr float SCALE = 0.088388347648318440f;
constexpr float THR = 8.f;
constexpr int SDEPTH = 2;
constexpr int LDQ = 512, LDK = 256, LDO = 512;
constexpr size_t SHM_V = KVBLK * D * 2, SHM_K = KVBLK * D * 2, SHM_ATTN = 2 * SHM_V + 2 * SHM_K + NW * 64 * 4;
using bf16x8 = __attribute__((ext_vector_type(8))) short;
using s16x4  = __attribute__((ext_vector_type(4))) short;
using f32x16 = __attribute__((ext_vector_type(16))) float;
using f32x8  = __attribute__((ext_vector_type(8))) float;
using u32x4  = __attribute__((ext_vector_type(4))) unsigned;
#define KSWZ(row, colB) ((row) * 256 + ((colB) ^ (((row) & 7) << 4)))
#define SBAR() __builtin_amdgcn_sched_barrier(0)
__device__ __forceinline__ int crow(int r, int hi) { return (r & 3) + 8 * (r >> 2) + 4 * hi; }
__device__ __forceinline__ unsigned cvtpk(float lo, float hi) {
  unsigned r; asm volatile("v_cvt_pk_bf16_f32 %0, %1, %2" : "=v"(r) : "v"(lo), "v"(hi)); return r;
}
template <typename TIn> struct Stage;
template <> struct Stage<bf16>  { using T = bf16x8;
  __device__ static __forceinline__ T ld8(const bf16* p) { return *reinterpret_cast<const bf16x8*>(p); }
  __device__ static __forceinline__ bf16x8 tobf(T x) { return x; } };
template <> struct Stage<float> { using T = f32x8;
  __device__ static __forceinline__ T ld8(const float* p) { return *reinterpret_cast<const f32x8*>(p); }
  __device__ static __forceinline__ bf16x8 tobf(T x) {
    u32x4 w = {cvtpk(x[0], x[1]), cvtpk(x[2], x[3]), cvtpk(x[4], x[5]), cvtpk(x[6], x[7])}; return *reinterpret_cast<bf16x8*>(&w); } };

__device__ __forceinline__ void partialSM(f32x16& p0, f32x16& p1, float& m_reg, float& mn, float& alpha) {
  constexpr float C = SCALE * 1.4426950408889634f;
  float pmax = p0[0]; for (int r = 1; r < 16; ++r) pmax = fmaxf(pmax, p0[r]); for (int r = 0; r < 16; ++r) pmax = fmaxf(pmax, p1[r]);
  { auto rr = __builtin_amdgcn_permlane32_swap(__float_as_uint(pmax), __float_as_uint(pmax), false, false);
    pmax = fmaxf(__uint_as_float(rr[0]), __uint_as_float(rr[1])); }
  if (__builtin_expect(__all(pmax - m_reg <= THR / SCALE), 1)) { mn = m_reg; alpha = 1.f; }
  else { mn = fmaxf(m_reg, pmax); alpha = __builtin_amdgcn_exp2f((m_reg - mn) * C); m_reg = mn; }
  float mnC = -mn * C;
  for (int r = 0; r < 16; ++r) p0[r] = fmaf(p0[r], C, mnC); for (int r = 0; r < 16; ++r) p1[r] = fmaf(p1[r], C, mnC);
  for (int r = 0; r < 16; ++r) p0[r] = __builtin_amdgcn_exp2f(p0[r]);
}
__device__ __forceinline__ void finishSM(f32x16& p0, f32x16& p1, float alpha, float& l_reg, bf16x8& pa0, bf16x8& pa1, bf16x8& pa2, bf16x8& pa3) {
  for (int r = 0; r < 16; ++r) p1[r] = __builtin_amdgcn_exp2f(p1[r]);
  float ps = 0; for (int r = 0; r < 16; ++r) ps += p0[r]; for (int r = 0; r < 16; ++r) ps += p1[r];
  { auto rr = __builtin_amdgcn_permlane32_swap(__float_as_uint(ps), __float_as_uint(ps), false, false);
    ps = __uint_as_float(rr[0]) + __uint_as_float(rr[1]); }
  l_reg = l_reg * alpha + ps;
#define PK4(P, BASE, OUT) do { unsigned a0 = cvtpk(P[BASE + 0], P[BASE + 1]), a1 = cvtpk(P[BASE + 2], P[BASE + 3]);   \
    unsigned b0 = cvtpk(P[BASE + 4], P[BASE + 5]), b1 = cvtpk(P[BASE + 6], P[BASE + 7]);                              \
    auto r0 = __builtin_amdgcn_permlane32_swap(a0, b0, false, false); auto r1 = __builtin_amdgcn_permlane32_swap(a1, b1, false, false); \
    u32x4 w = {r0[0], r1[0], r0[1], r1[1]}; OUT = *reinterpret_cast<bf16x8*>(&w); } while (0)
  PK4(p0, 0, pa0); PK4(p0, 8, pa1); PK4(p1, 0, pa2); PK4(p1, 8, pa3);
#undef PK4
}
__device__ __forceinline__ void qkt(f32x16& p0, f32x16& p1, const bf16* Ks, const bf16x8* qr, int r32, int hi) {
  p0 = f32x16{}; p1 = f32x16{};
  for (int d0 = 0; d0 < 8; ++d0) { int cb = (d0 * 16 + hi * 8) * 2;
    bf16x8 b0 = *reinterpret_cast<const bf16x8*>((const char*)Ks + KSWZ(r32, cb));
    bf16x8 b1 = *reinterpret_cast<const bf16x8*>((const char*)Ks + KSWZ(32 + r32, cb));
    p0 = __builtin_amdgcn_mfma_f32_32x32x16_bf16(b0, qr[d0], p0, 0, 0, 0);
    p1 = __builtin_amdgcn_mfma_f32_32x32x16_bf16(b1, qr[d0], p1, 0, 0, 0); }
}
__device__ __forceinline__ int v_st(int k, int c) { const int kk = (k & ~0xC) | ((k & 4) << 1) | ((k & 8) >> 1); return ((kk >> 3) * 4 + (c >> 5)) * 512 + ((kk & 7) * 32 + (c & 31)) * 2; }
__device__ __forceinline__ int v_rd_base(int lane) { return ((lane & 3) << 3) | (((lane >> 2) & 3) << 6) | (((lane >> 4) & 1) << 5) | (((lane >> 5) & 1) << 8); }
constexpr int v_rd_off(int d0, int ks, int half) { return d0 * 512 + ks * 4096 + half * 2048; }
template <int OFF> __device__ __forceinline__ s16x4 tr_read(int vb) {
  s16x4 r; asm volatile("ds_read_b64_tr_b16 %0, %1 offset:%2" : "=&v"(r) : "v"(vb), "i"(OFF) : "memory"); return r;
}
template <int D0> __device__ __forceinline__ void pv_one(f32x16& od, int vb, bf16x8 pa0, bf16x8 pa1, bf16x8 pa2, bf16x8 pa3) {
  const s16x4 l0 = tr_read<v_rd_off(D0, 0, 0)>(vb), h0 = tr_read<v_rd_off(D0, 0, 1)>(vb), l1 = tr_read<v_rd_off(D0, 1, 0)>(vb), h1 = tr_read<v_rd_off(D0, 1, 1)>(vb);
  const s16x4 l2 = tr_read<v_rd_off(D0, 2, 0)>(vb), h2 = tr_read<v_rd_off(D0, 2, 1)>(vb), l3 = tr_read<v_rd_off(D0, 3, 0)>(vb), h3 = tr_read<v_rd_off(D0, 3, 1)>(vb);
  asm volatile("s_waitcnt lgkmcnt(0)" ::: "memory"); SBAR();
#define PK(L, H) (bf16x8){L[0], L[1], L[2], L[3], H[0], H[1], H[2], H[3]}
  od = __builtin_amdgcn_mfma_f32_32x32x16_bf16(pa0, PK(l0, h0), od, 0, 0, 0);
  od = __builtin_amdgcn_mfma_f32_32x32x16_bf16(pa1, PK(l1, h1), od, 0, 0, 0);
  od = __builtin_amdgcn_mfma_f32_32x32x16_bf16(pa2, PK(l2, h2), od, 0, 0, 0);
  od = __builtin_amdgcn_mfma_f32_32x32x16_bf16(pa3, PK(l3, h3), od, 0, 0, 0);
#undef PK
}
__device__ __forceinline__ void pv_d0(f32x16* o, int vb, bf16x8 pa0, bf16x8 pa1, bf16x8 pa2, bf16x8 pa3) {
  pv_one<0>(o[0], vb, pa0, pa1, pa2, pa3); pv_one<1>(o[1], vb, pa0, pa1, pa2, pa3); pv_one<2>(o[2], vb, pa0, pa1, pa2, pa3); pv_one<3>(o[3], vb, pa0, pa1, pa2, pa3);
}

template <typename TQ>
__device__ __forceinline__ void attn_dense_body(const TQ* __restrict__ Qb, const bf16* __restrict__ Kh, const bf16* __restrict__ Vh,
                                                bf16* __restrict__ Ob, int seq, char* lds) {
  using St = Stage<bf16>; using SQ = Stage<TQ>;
  const int tid = threadIdx.x, wid = tid >> 6, lane = tid & 63, r32 = lane & 31, hi = lane >> 5;
  bf16* V_lds = (bf16*)lds; bf16* K_lds = (bf16*)(lds + 2 * SHM_V);
  float* ws = (float*)(lds + 2 * SHM_V + 2 * SHM_K) + wid * 64; float* li_l = ws; float* al_l = ws + 32;
  float m_reg = -1e30f, l_reg = 0; f32x16 o[4] = {}; bf16x8 qr[8];
  const TQ* Qw = Qb + (long)(wid * QBLK + r32) * LDQ + hi * 8;
#pragma unroll
  for (int d0 = 0; d0 < 8; ++d0) qr[d0] = SQ::tobf(SQ::ld8(Qw + d0 * 16));
  const int sr = tid >> 4, sc = (tid & 15) * 8, vst0 = v_st(sr, sc), vst1 = v_st(32 + sr, sc);
  const int vb0 = (int)(uintptr_t)V_lds + v_rd_base(lane);
  struct { typename St::T vs0, vs1, ks0, ks1; } sr_[SDEPTH];
#define SLOAD(i, k0) do { sr_[i].vs0 = St::ld8(&Vh[(long)((k0) + sr) * LDK + sc]); sr_[i].vs1 = St::ld8(&Vh[(long)((k0) + 32 + sr) * LDK + sc]); \
    sr_[i].ks0 = St::ld8(&Kh[(long)((k0) + sr) * LDK + sc]); sr_[i].ks1 = St::ld8(&Kh[(long)((k0) + 32 + sr) * LDK + sc]); } while (0)
#define SWRITE(b, i) do { *(bf16x8*)((char*)V_lds + (b) * SHM_V + vst0) = St::tobf(sr_[i].vs0);          \
    *(bf16x8*)((char*)V_lds + (b) * SHM_V + vst1) = St::tobf(sr_[i].vs1); int kc = sc * 2;               \
    *(bf16x8*)((char*)K_lds + (b) * SHM_K + KSWZ(sr, kc)) = St::tobf(sr_[i].ks0);                       \
    *(bf16x8*)((char*)K_lds + (b) * SHM_K + KSWZ(32 + sr, kc)) = St::tobf(sr_[i].ks1); } while (0)
#define SWAIT() do { if constexpr (SDEPTH == 2) asm volatile("s_waitcnt vmcnt(4)" ::: "memory"); else asm volatile("s_waitcnt vmcnt(0)" ::: "memory"); } while (0)
#define RESC(a) do { if (__any((a) < 1.f)) { if (hi == 0) al_l[r32] = (a); asm volatile("s_waitcnt lgkmcnt(0)" ::: "memory"); \
    for (int d = 0; d < 4; ++d) for (int r = 0; r < 16; ++r) o[d][r] *= al_l[crow(r, hi)]; } } while (0)
  f32x16 pA0, pA1, pB0, pB1; float mnA, mnB, alA, alB; bf16x8 pa0, pa1, pa2, pa3; const int NT = seq / KVBLK;
  constexpr int SE = 0, SO = SDEPTH - 1;
  SLOAD(SE, 0); asm volatile("s_waitcnt vmcnt(0)" ::: "memory"); SWRITE(0, SE); __syncthreads();
  qkt(pA0, pA1, K_lds, qr, r32, hi); partialSM(pA0, pA1, m_reg, mnA, alA);
  SLOAD(SO, KVBLK); if constexpr (SDEPTH == 2) { if (2 < NT) SLOAD(SE, 2 * KVBLK); }
  SWAIT(); SWRITE(1, SO); __syncthreads();
  for (int j = 1; j + 1 < NT; j += 2) {
    SBAR(); qkt(pB0, pB1, (bf16*)((char*)K_lds + SHM_K), qr, r32, hi);
    finishSM(pA0, pA1, alA, l_reg, pa0, pa1, pa2, pa3); SBAR();
    SLOAD(SO, (j + SDEPTH) * KVBLK); SBAR();
    pv_d0(o, vb0, pa0, pa1, pa2, pa3); partialSM(pB0, pB1, m_reg, mnB, alB);
    __syncthreads(); SWAIT(); SWRITE(0, SE);
    RESC(alB); __syncthreads();
    SBAR(); qkt(pA0, pA1, K_lds, qr, r32, hi);
    finishSM(pB0, pB1, alB, l_reg, pa0, pa1, pa2, pa3); SBAR();
    if (SDEPTH == 1 || j + 3 < NT) SLOAD(SE, (j + 1 + SDEPTH) * KVBLK); SBAR();
    pv_d0(o, vb0 + (int)SHM_V, pa0, pa1, pa2, pa3); partialSM(pA0, pA1, m_reg, mnA, alA);
    __syncthreads(); SWAIT(); SWRITE(1, SO);
    RESC(alA); __syncthreads();
  }
  SBAR(); qkt(pB0, pB1, (bf16*)((char*)K_lds + SHM_K), qr, r32, hi);
  finishSM(pA0, pA1, alA, l_reg, pa0, pa1, pa2, pa3); SBAR();
  pv_d0(o, vb0, pa0, pa1, pa2, pa3); partialSM(pB0, pB1, m_reg, mnB, alB);
  __syncthreads(); RESC(alB);
  finishSM(pB0, pB1, alB, l_reg, pa0, pa1, pa2, pa3); SBAR();
  pv_d0(o, vb0 + (int)SHM_V, pa0, pa1, pa2, pa3);
  if (hi == 0) li_l[r32] = l_reg; asm volatile("s_waitcnt lgkmcnt(0)" ::: "memory");
  float rli[16];
#pragma unroll
  for (int r = 0; r < 16; ++r) rli[r] = __builtin_amdgcn_rcpf(li_l[crow(r, hi)]);
  bf16* Ow = Ob + (long)(wid * QBLK) * LDO;
#pragma unroll
  for (int r = 0; r < 16; ++r) { int orow = crow(r, hi);
    for (int d0 = 0; d0 < 4; ++d0) Ow[(long)orow * LDO + d0 * 32 + r32] = __float2bfloat16(o[d0][r] * rli[r]); }
#undef SLOAD
#undef SWRITE
#undef SWAIT
#undef RESC
}

#undef KSWZ
#undef SBAR
}
constexpr size_t MX_CL = 0;
constexpr size_t MX_CP = 36 * MiB;
constexpr size_t MX_NL = 72 * MiB;
constexpr size_t MX_NP = 73 * MiB;
constexpr size_t MX_ST = 74 * MiB;
constexpr size_t MX_SP = 75 * MiB;
constexpr size_t MX_GQ = 76 * MiB, MX_GK = 94 * MiB, MX_GV = 112 * MiB;
constexpr size_t MX_GG = 130 * MiB, MX_GB = 131 * MiB;
constexpr size_t MX_GD1 = 132 * MiB;
constexpr size_t GD1_ITEM = 73728;
constexpr size_t MX_GE = 294 * MiB;
static_assert(MX_GD1 + (size_t)2304 * GD1_ITEM <= MX_GE && WS_MIX + MX_GE + 2304 * 128 <= WS_END, "mixer scratch map");

typedef float f32x4m __attribute__((ext_vector_type(4)));
#define MFMA16(a, b, c) __builtin_amdgcn_mfma_f32_16x16x32_bf16((a), (b), (c), 0, 0, 0)
__device__ __forceinline__ bf16x8 lds_frag(const LAS unsigned char* base, int stride, int row0, int kb, int lane) {
    return *(const LAS bf16x8*)(base + (row0 + (lane & 15)) * stride + kb + (lane >> 4) * 16);
}
__device__ __forceinline__ float gelu_tanh(float x) { const float y = 0.7978845608028654f * (x + 0.044715f * x * x * x); const float t = 1.0f - 2.0f / (1.0f + __expf(2.0f * y)); return 0.5f * x * (1.0f + t); }
__device__ __forceinline__ float logsigmoid1(float x) { return fminf(x, 0.f) - log1pf(__expf(-fabsf(x))); }
__device__ __forceinline__ float softplus1(float x) { return fmaxf(x, 0.f) + log1pf(__expf(-fabsf(x))); }
__device__ __forceinline__ int perm32p(int jl) { return 8 * ((jl & 15) >> 2) + 4 * (jl >> 4) + (jl & 3); }

__device__ __forceinline__ float wscan_sum_f(float v, int lane) {
#pragma unroll
    for (int o = 1; o < 64; o <<= 1) { const float t = __shfl_up(v, o); if (lane >= o) v += t; }
    return v;
}
__device__ __forceinline__ float wscan_sum_b(float v, int lane) {
#pragma unroll
    for (int o = 1; o < 64; o <<= 1) { const float t = __shfl_down(v, o); if (lane + o < 64) v += t; }
    return v;
}
__device__ __forceinline__ float wscan_max_f(float v, int lane) {
#pragma unroll
    for (int o = 1; o < 64; o <<= 1) { const float t = __shfl_up(v, o); if (lane >= o) v = fmaxf(v, t); }
    return v;
}
__device__ __forceinline__ float wscan_max_b(float v, int lane) {
#pragma unroll
    for (int o = 1; o < 64; o <<= 1) { const float t = __shfl_down(v, o); if (lane + o < 64) v = fmaxf(v, t); }
    return v;
}
__device__ __forceinline__ void phase_attn_prep(Frame& F, int l, bool last) {
    const bf16* Z = (const bf16*)(F.ws + WS_Z); bf16* QA = (bf16*)(F.ws + WS_QA); bf16* KC = (bf16*)(F.ws + WS_KC); bf16* VC = (bf16*)(F.ws + WS_VC);
    const float* RC = (const float*)(F.ws + WS_ROPE); const float* RS = RC + 96 * 32;
    const float* gq = F.in[I_ATQN] + l * 128; const float* gk = F.in[I_ATKN] + l * 128;
    const int gw = blockIdx.x * NWAVES + F.wave, NGW = F.G * NWAVES;
    const int half = F.lane >> 5, i = F.lane & 31, da = 64 * half + i, db = da + 32;
    const float gqa = gq[da], gqb = gq[db], gka = gk[da], gkb = gk[db];
    for (int row = gw; row < MT; row += NGW) {
        const bool isc = row >= ML; const int b = isc ? (row - ML) / CTXL : row / SEQ, t = isc ? (row - ML) % CTXL : row % SEQ;
        const bf16* zr = Z + (size_t)row * ZLD;
        float cs = 1.f, sn = 0.f;
        if (!isc) { const int pos = half ? 32 + (t & 63) : (t >> 6); cs = RC[pos * 32 + i]; sn = RS[pos * 32 + i]; }
        if (!(isc && last)) {
#pragma unroll
            for (int h = 0; h < 4; ++h) {
                const float a = bf1(zr[ZC_ATQ + h * 128 + da]), bb = bf1(zr[ZC_ATQ + h * 128 + db]);
                const float rs = 1.0f / sqrtf(wave_sum(a * a + bb * bb) * (1.0f / 128.0f) + EPS);
                const float ya = a * rs * gqa, yb = bb * rs * gqb;
                QA[(size_t)row * 512 + h * 128 + da] = f2bf1(ya * cs - yb * sn); QA[(size_t)row * 512 + h * 128 + db] = f2bf1(yb * cs + ya * sn);
            }
        }
        const size_t krow = (size_t)b * 2304 + (isc ? t : 256 + t);
#pragma unroll
        for (int h = 0; h < 2; ++h) {
            const float a = bf1(zr[ZC_ATK + h * 128 + da]), bb = bf1(zr[ZC_ATK + h * 128 + db]);
            const float rs = 1.0f / sqrtf(wave_sum(a * a + bb * bb) * (1.0f / 128.0f) + EPS);
            const float ya = a * rs * gka, yb = bb * rs * gkb;
            KC[krow * 256 + h * 128 + da] = f2bf1(ya * cs - yb * sn); KC[krow * 256 + h * 128 + db] = f2bf1(yb * cs + ya * sn);
        }
        *(GAS v2u*)(VC + krow * 256 + 4 * F.lane) = *(const GAS v2u*)(zr + ZC_ATV + 4 * F.lane);
        if (!(isc && last)) {
            const v4u w = *(const GAS v4u*)(zr + ZC_SGV + 8 * F.lane);
            const float e0 = gelu_tanh(bflo(w.x)), e1 = gelu_tanh(bfhi(w.x)), e2 = gelu_tanh(bflo(w.y)), e3 = gelu_tanh(bfhi(w.y)), e4 = gelu_tanh(bflo(w.z)), e5 = gelu_tanh(bfhi(w.z)), e6 = gelu_tanh(bflo(w.w)), e7 = gelu_tanh(bfhi(w.w));
            const float ss = wave_sum((e0 * e0 + e1 * e1) + (e2 * e2 + e3 * e3) + (e4 * e4 + e5 * e5) + (e6 * e6 + e7 * e7));
            if (F.lane == 0) ((float*)(F.ws + WS_ROPE + 65536))[(row >> 3) * 32 + (row & 7)] = 1.0f / sqrtf(ss * (1.0f / 512.0f) + EPS);
        }
    }
}
__device__ __forceinline__ void attn_item(Frame& F, int it) {
    const attn::bf16* QA = (const attn::bf16*)(F.ws + WS_QA); const attn::bf16* KC = (const attn::bf16*)(F.ws + WS_KC); const attn::bf16* VC = (const attn::bf16*)(F.ws + WS_VC);
    attn::bf16* Y3 = (attn::bf16*)(F.ws + WS_Y) + (size_t)3 * MT * 512;
    int h, b, seq; size_t r0;
    if (it < 256) { const int qb = it & 7; h = (it >> 3) & 3; b = it >> 5; r0 = (size_t)b * SEQ + qb * 256; seq = 2304; }
    else { const int j = it - 256; h = j & 3; b = j >> 2; r0 = (size_t)ML + b * CTXL; seq = 256; }
    attn::attn_dense_body<attn::bf16>(QA + r0 * 512 + h * 128, KC + (size_t)b * 2304 * 256 + (h >> 1) * 128, VC + (size_t)b * 2304 * 256 + (h >> 1) * 128, Y3 + r0 * 512 + h * 128, seq, (char*)F.lds + RING_OFF);
    __syncthreads();
}
__device__ __forceinline__ void phase_spatial(Frame& F, int l, bool last) {
    const bf16* Z = (const bf16*)(F.ws + WS_Z); bf16* Y0 = (bf16*)(F.ws + WS_Y);
    LAS unsigned char* Wl = F.lds + RING_OFF; LAS unsigned char* Vt = Wl + 34816;
    const int nchunk = last ? ML / 128 : MT / 128;
    const int tid = F.tid, r = tid >> 2, q = tid & 3;
    for (int it = F.G - 1 - (int)blockIdx.x; it < nchunk * 4; it += F.G) {
        const int ch = it >> 2, g = it & 3; const size_t row0 = (size_t)ch * 128;
        const bf16* zv = Z + (row0 + r) * ZLD + ZC_SGV;
        const float rstd = ((const float*)(F.ws + WS_ROPE + 65536))[((row0 + r) >> 3) * 32 + ((row0 + r) & 7)];
        const float* gn = F.in[I_SGN] + l * 512 + g * 128 + q * 32;
#pragma unroll
        for (int j = 0; j < 4; ++j) { const v4u w = *(const GAS v4u*)(zv + g * 128 + q * 32 + j * 8);
            const float e[8] = {gelu_tanh(bflo(w.x)), gelu_tanh(bfhi(w.x)), gelu_tanh(bflo(w.y)), gelu_tanh(bfhi(w.y)), gelu_tanh(bflo(w.z)), gelu_tanh(bfhi(w.z)), gelu_tanh(bflo(w.w)), gelu_tanh(bfhi(w.w))};
#pragma unroll
            for (int k = 0; k < 8; ++k) { const int c = q * 32 + j * 8 + k; *(LAS bf16*)(Vt + c * 272 + r * 2) = f2bf1(e[k] * rstd * gn[j * 8 + k]); } }
        const float* wg = F.in[I_SGW] + ((size_t)(l * 4 + g) * 128 + r) * 128 + q * 32;
#pragma unroll
        for (int j = 0; j < 4; ++j) { const f32x4 a = *(const f32x4*)(wg + j * 8), b = *(const f32x4*)(wg + j * 8 + 4);
            v4u o; o.x = pk2(a.x, a.y); o.y = pk2(a.z, a.w); o.z = pk2(b.x, b.y); o.w = pk2(b.z, b.w);
            *(LAS v4u*)(Wl + r * 272 + (q * 32 + j * 8) * 2) = o; }
        __syncthreads();
        const int wr = F.wave >> 1, wc = F.wave & 1;
        f32x4 acc[2][4];
#pragma unroll
        for (int mi = 0; mi < 2; ++mi)
#pragma unroll
            for (int ni = 0; ni < 4; ++ni) acc[mi][ni] = (f32x4){0.f, 0.f, 0.f, 0.f};
#pragma unroll
        for (int ks = 0; ks < 4; ++ks) {
            bf16x8 a[2], b[4];
#pragma unroll
            for (int mi = 0; mi < 2; ++mi) a[mi] = lds_frag(Wl, 272, 32 * wr + 16 * mi, ks * 64, F.lane);
#pragma unroll
            for (int ni = 0; ni < 4; ++ni) b[ni] = lds_frag(Vt, 272, 64 * wc + 16 * ni, ks * 64, F.lane);
#pragma unroll
            for (int mi = 0; mi < 2; ++mi)
#pragma unroll
                for (int ni = 0; ni < 4; ++ni) acc[mi][ni] = MFMA16(a[mi], b[ni], acc[mi][ni]);
        }
        const float* bs = F.in[I_SGB] + (l * 4 + g) * 128;
#pragma unroll
        for (int mi = 0; mi < 2; ++mi)
#pragma unroll
            for (int rr = 0; rr < 4; ++rr) { const int t = 32 * wr + 16 * mi + 4 * (F.lane >> 4) + rr; const float bias = bs[t];
#pragma unroll
                for (int ni = 0; ni < 4; ++ni) { const int c = g * 128 + 64 * wc + 16 * ni + (F.lane & 15);
                    const float u = gelu_tanh(bf1(Z[(row0 + t) * ZLD + ZC_SGU + c]));
                    Y0[(row0 + t) * 512 + c] = f2bf1(u * (acc[mi][ni][rr] + bias)); } }
        __syncthreads();
    }
}
__device__ __forceinline__ void ml_slot(int chain, int k, int& rowbase, int& h, int& dir) {
    const int b = chain >> 3; h = (chain >> 1) & 3; dir = chain & 1;
    if (k < 2) { const int j = dir ? 1 - k : k; rowbase = ML + b * CTXL + 128 * j; }
    else { const int n = k - 2, j = dir ? 15 - n : n; rowbase = b * SEQ + 128 * j; }
}
__device__ __forceinline__ void ml_gates(Frame& F, int l, int rowbase, int h, int dir, LAS float* li, LAS float* lf, LAS float* bc) {
    const float* ZS = (const float*)(F.ws + WS_ZS); const float* bias = F.in[I_MLIFB] + l * 16;
    float s = 0.f;
    if (F.tid < 128) { const float* zr = ZS + (size_t)(rowbase + F.tid) * 32;
        li[F.tid] = zr[dir * 4 + h] + bias[dir * 4 + h];
        const float f = logsigmoid1(zr[(2 + dir) * 4 + h] + bias[(2 + dir) * 4 + h]);
        s = dir ? wscan_sum_b(f, F.lane) : wscan_sum_f(f, F.lane);
        if (dir == 0 && F.tid == 63) lf[0] = s;
        if (dir == 1 && F.tid == 64) lf[0] = s; }
    __syncthreads();
    if (F.tid < 128) { if ((dir == 0 && F.tid >= 64) || (dir == 1 && F.tid < 64)) s += lf[0]; bc[F.tid] = s; }
    __syncthreads();
}
__device__ __forceinline__ void phase_ml1(Frame& F, int l) {
    const bf16* Z = (const bf16*)(F.ws + WS_Z);
    bf16* CL = (bf16*)(F.ws + WS_MIX + MX_CL); float* NL = (float*)(F.ws + WS_MIX + MX_NL); float* ST = (float*)(F.ws + WS_MIX + MX_ST);
    LAS unsigned char* kT = F.lds + RING_OFF; LAS unsigned char* vT = kT + 34816;
    LAS float* li = (LAS float*)(F.lds + RING_OFF + 69632); LAS float* lf = li + 128; LAS float* bc = lf + 128; LAS float* wg = bc + 128; LAS float* red = wg + 128;
    const int tid = F.tid, tau = tid >> 2, q = tid & 3;
    for (int it = blockIdx.x; it < 64 * 18; it += F.G) {
        const int chain = it / 18, k = it % 18; int rowbase, h, dir; ml_slot(chain, k, rowbase, h, dir);
        ml_gates(F, l, rowbase, h, dir, li, lf, bc);
        const float bend = dir ? bc[0] : bc[127];
        if (tid < 128) wg[tid] = bend - bc[tid] + li[tid];
        __syncthreads();
        if (tid < 64) { float m = fmaxf(wg[tid], wg[tid + 64]);
#pragma unroll
            for (int o = 1; o < 64; o <<= 1) m = fmaxf(m, __shfl_xor(m, o));
            if (tid == 0) red[0] = m; }
        __syncthreads();
        const float mloc = red[0];
        __syncthreads();
        if (tid < 128) wg[tid] = __expf(wg[tid] - mloc);
        __syncthreads();
        { const bf16* zk = Z + (size_t)(rowbase + tau) * ZLD + ZC_MLK + h * 128 + q * 32; const bf16* zv = Z + (size_t)(rowbase + tau) * ZLD + ZC_MLV + h * 128 + q * 32; const float w = wg[tau];
#pragma unroll
          for (int j = 0; j < 4; ++j) { const v4u a = *(const GAS v4u*)(zk + j * 8), b = *(const GAS v4u*)(zv + j * 8);
              const float ka[8] = {bflo(a.x), bfhi(a.x), bflo(a.y), bfhi(a.y), bflo(a.z), bfhi(a.z), bflo(a.w), bfhi(a.w)};
              const float va[8] = {bflo(b.x), bfhi(b.x), bflo(b.y), bfhi(b.y), bflo(b.z), bfhi(b.z), bflo(b.w), bfhi(b.w)};
#pragma unroll
              for (int c = 0; c < 8; ++c) { const int col = q * 32 + j * 8 + c;
                  *(LAS bf16*)(kT + col * 272 + tau * 2) = f2bf1(ka[c] * 0.08838834764831845f);
                  *(LAS bf16*)(vT + col * 272 + tau * 2) = f2bf1(va[c] * w); } } }
        __syncthreads();
        const int wr = F.wave >> 1, wc = F.wave & 1;
        f32x4 acc[2][4];
#pragma unroll
        for (int mi = 0; mi < 2; ++mi)
#pragma unroll
            for (int ni = 0; ni < 4; ++ni) acc[mi][ni] = (f32x4){0.f, 0.f, 0.f, 0.f};
#pragma unroll
        for (int ks = 0; ks < 4; ++ks) {
            bf16x8 a[2], b[4];
#pragma unroll
            for (int mi = 0; mi < 2; ++mi) a[mi] = lds_frag(vT, 272, 32 * wr + 16 * mi, ks * 64, F.lane);
#pragma unroll
            for (int ni = 0; ni < 4; ++ni) b[ni] = lds_frag(kT, 272, 64 * wc + 16 * ni, ks * 64, F.lane);
#pragma unroll
            for (int mi = 0; mi < 2; ++mi)
#pragma unroll
                for (int ni = 0; ni < 4; ++ni) acc[mi][ni] = MFMA16(a[mi], b[ni], acc[mi][ni]);
        }
        bf16* cl = CL + (size_t)it * 16384;
#pragma unroll
        for (int mi = 0; mi < 2; ++mi)
#pragma unroll
            for (int rr = 0; rr < 4; ++rr) { const int e = 32 * wr + 16 * mi + 4 * (F.lane >> 4) + rr;
#pragma unroll
                for (int ni = 0; ni < 4; ++ni) cl[e * 128 + 64 * wc + 16 * ni + (F.lane & 15)] = f2bf1(acc[mi][ni][rr]); }
        { float s = 0.f; const LAS bf16* kr = (const LAS bf16*)(kT + tau * 272) + q * 32;
#pragma unroll 8
          for (int t = 0; t < 32; ++t) s += wg[q * 32 + t] * bf1(kr[t]);
          s += __shfl_xor(s, 1); s += __shfl_xor(s, 2);
          if (q == 0) NL[(size_t)it * 128 + tau] = s; }
        if (tid == 0) { ST[it * 32 + 0] = mloc; ST[it * 32 + 1] = bend; }
        __syncthreads();
    }
}
__device__ __forceinline__ void phase_ml2(Frame& F, int wg0) {
    const bf16* CL = (const bf16*)(F.ws + WS_MIX + MX_CL); const float* NL = (const float*)(F.ws + WS_MIX + MX_NL); const float* ST = (const float*)(F.ws + WS_MIX + MX_ST);
    bf16* CP = (bf16*)(F.ws + WS_MIX + MX_CP); float* NP = (float*)(F.ws + WS_MIX + MX_NP); float* SP = (float*)(F.ws + WS_MIX + MX_SP);
    if ((int)blockIdx.x < wg0) return;
    const int gt = ((int)blockIdx.x - wg0) * (NWAVES * 64) + F.tid, NT = (F.G - wg0) * NWAVES * 64;
    for (int task = gt; task < 64 * 4096; task += NT) {
        const int chain = task >> 12, e4 = (task & 4095) * 4;
        v2u w[18]; float ml[18], be[18];
#pragma unroll
        for (int k = 0; k < 18; ++k) { const int it = chain * 18 + k; w[k] = *(const GAS v2u*)(CL + (size_t)it * 16384 + e4); ml[k] = ST[it * 32 + 0]; be[k] = ST[it * 32 + 1]; }
        float c0 = 0.f, c1 = 0.f, c2 = 0.f, c3 = 0.f, m = 0.f;
#pragma unroll
        for (int k = 0; k < 18; ++k) { const int it = chain * 18 + k;
            v2u o; o.x = pk2(c0, c1); o.y = pk2(c2, c3); *(GAS v2u*)(CP + (size_t)it * 16384 + e4) = o;
            const float mn = fmaxf(be[k] + m, ml[k]), sp = __expf(be[k] + m - mn), sl = __expf(ml[k] - mn);
            c0 = sp * c0 + sl * bflo(w[k].x); c1 = sp * c1 + sl * bfhi(w[k].x); c2 = sp * c2 + sl * bflo(w[k].y); c3 = sp * c3 + sl * bfhi(w[k].y); m = mn; }
    }
    for (int task = gt; task < 64 * 128; task += NT) {
        const int chain = task >> 7, d = task & 127; float n = 0.f, m = 0.f;
        float nl[18], ml[18], be[18];
#pragma unroll
        for (int k = 0; k < 18; ++k) { const int it = chain * 18 + k; nl[k] = NL[(size_t)it * 128 + d]; ml[k] = ST[it * 32 + 0]; be[k] = ST[it * 32 + 1]; }
#pragma unroll
        for (int k = 0; k < 18; ++k) { const int it = chain * 18 + k;
            NP[(size_t)it * 128 + d] = n;
            if (d == 0) SP[it * 32] = m;
            const float mn = fmaxf(be[k] + m, ml[k]), sp = __expf(be[k] + m - mn), sl = __expf(ml[k] - mn);
            n = sp * n + sl * nl[k]; m = mn; }
    }
}
__device__ __forceinline__ void ml3_item(Frame& F, int l, int it) {
    const bf16* Z = (const bf16*)(F.ws + WS_Z); bf16* Y1 = (bf16*)(F.ws + WS_Y) + (size_t)MT * 512;
    const bf16* CL = (const bf16*)(F.ws + WS_MIX + MX_CP); const float* NL = (const float*)(F.ws + WS_MIX + MX_NP); const float* ST = (const float*)(F.ws + WS_MIX + MX_SP);
    LAS unsigned char* qs = F.lds + RING_OFF; LAS unsigned char* ks = qs + 34816; LAS unsigned char* vT = ks + 34816;
    LAS float* li = (LAS float*)(F.lds + RING_OFF + 104448); LAS float* lf = li + 128; LAS float* bc = lf + 128; LAS float* cv = bc + 128; LAS float* Mt = cv + 128;
    LAS float* inter = Mt + 128; LAS float* rden = inter + 128; LAS float* emt = rden + 128; LAS float* rowss = emt + 128; LAS float* npv = rowss + 256;
    const int tid = F.tid, tau = tid >> 2, q = tid & 3, lane = F.lane, g4 = lane >> 4, l15 = lane & 15;
    {
        int b, h, j, rowbase, nch;
        if (it < 512) { b = it >> 6; h = (it >> 4) & 3; j = it & 15; rowbase = b * SEQ + 128 * j; nch = 16; }
        else { const int r = it - 512; b = r >> 3; h = (r >> 1) & 3; j = r & 1; rowbase = ML + b * CTXL + 128 * j; nch = 2; }
        { const bf16* zq = Z + (size_t)(rowbase + tau) * ZLD + ZC_MLQ + h * 128 + q * 32; const bf16* zk = Z + (size_t)(rowbase + tau) * ZLD + ZC_MLK + h * 128 + q * 32;
          const bf16* zv = Z + (size_t)(rowbase + tau) * ZLD + ZC_MLV + h * 128 + q * 32;
#pragma unroll
          for (int jj = 0; jj < 4; ++jj) { const v4u a = *(const GAS v4u*)(zq + jj * 8), kk = *(const GAS v4u*)(zk + jj * 8), vv = *(const GAS v4u*)(zv + jj * 8);
              *(LAS v4u*)(qs + tau * 272 + (q * 32 + jj * 8) * 2) = a;
              v4u ko; const float s = 0.08838834764831845f;
              ko.x = pk2(bflo(kk.x) * s, bfhi(kk.x) * s); ko.y = pk2(bflo(kk.y) * s, bfhi(kk.y) * s); ko.z = pk2(bflo(kk.z) * s, bfhi(kk.z) * s); ko.w = pk2(bflo(kk.w) * s, bfhi(kk.w) * s);
              *(LAS v4u*)(ks + tau * 272 + (q * 32 + jj * 8) * 2) = ko;
              const unsigned vw[4] = {vv.x, vv.y, vv.z, vv.w};
#pragma unroll
              for (int c = 0; c < 4; ++c) { const int col = q * 32 + jj * 8 + 2 * c;
                  *(LAS bf16*)(vT + col * 272 + tau * 2) = (bf16)(vw[c] & 0xffffu); *(LAS bf16*)(vT + (col + 1) * 272 + tau * 2) = (bf16)(vw[c] >> 16); } } }
        __syncthreads();
        const int wr = F.wave >> 1, wc = F.wave & 1;
        f32x4 accS[2][4];
#pragma unroll
        for (int mi = 0; mi < 2; ++mi)
#pragma unroll
            for (int ni = 0; ni < 4; ++ni) accS[mi][ni] = (f32x4){0.f, 0.f, 0.f, 0.f};
#pragma unroll
        for (int kk = 0; kk < 4; ++kk) {
            bf16x8 a[2], bq[4];
#pragma unroll
            for (int mi = 0; mi < 2; ++mi) a[mi] = lds_frag(ks, 272, 32 * wr + 16 * mi, kk * 64, lane);
#pragma unroll
            for (int ni = 0; ni < 4; ++ni) bq[ni] = lds_frag(qs, 272, 64 * wc + 16 * ni, kk * 64, lane);
#pragma unroll
            for (int mi = 0; mi < 2; ++mi)
#pragma unroll
                for (int ni = 0; ni < 4; ++ni) accS[mi][ni] = MFMA16(a[mi], bq[ni], accS[mi][ni]);
        }
        f32x4 hsum[2][4];
#pragma unroll
        for (int mi = 0; mi < 2; ++mi)
#pragma unroll
            for (int ni = 0; ni < 4; ++ni) hsum[mi][ni] = (f32x4){0.f, 0.f, 0.f, 0.f};
        for (int dir = 0; dir < 2; ++dir) {
            const int n = dir ? nch - 1 - j : j, slot = (it < 512) ? 2 + n : n, chain = (b * 4 + h) * 2 + dir, sit = chain * 18 + slot;
            __syncthreads();
            const bf16* cp = CL + (size_t)sit * 16384;
            bf16x8 cb[2][4];
#pragma unroll
            for (int kk = 0; kk < 2; ++kk)
#pragma unroll
                for (int ni = 0; ni < 4; ++ni) cb[kk][ni] = *(const GAS bf16x8*)(cp + (64 * wc + 16 * ni + l15) * 128 + kk * 32 + g4 * 8);
            ml_gates(F, l, rowbase, h, dir, li, lf, bc);
            const float mprev = ST[sit * 32];
            if (tid < 128) { cv[tid] = li[tid] - bc[tid]; npv[tid] = NL[(size_t)sit * 128 + tid]; }
            __syncthreads();
            float mx = -3.0e38f;
            if (tid < 128) { mx = dir ? wscan_max_b(cv[tid], lane) : wscan_max_f(cv[tid], lane);
                if (dir == 0 && tid == 63) lf[1] = mx; if (dir == 1 && tid == 64) lf[1] = mx; }
            __syncthreads();
            if (tid < 128) { if ((dir == 0 && tid >= 64) || (dir == 1 && tid < 64)) mx = fmaxf(mx, lf[1]);
                const float M = fmaxf(mx, mprev); Mt[tid] = M; inter[tid] = __expf(mprev - M); emt[tid] = __expf(-(bc[tid] + M)); }
            __syncthreads();
#pragma unroll
            for (int mi = 0; mi < 2; ++mi)
#pragma unroll
                for (int ni = 0; ni < 4; ++ni) { const int t = 64 * wc + 16 * ni + l15, s0 = 32 * wr + 16 * mi + 4 * g4; const float M = Mt[t];
                    float p[4];
#pragma unroll
                    for (int rr = 0; rr < 4; ++rr) { const int s = s0 + rr; const bool ok = dir ? (s >= t) : (s <= t); p[rr] = ok ? __expf(cv[s] - M) * accS[mi][ni][rr] : 0.f; }
                    v2u o; o.x = pk2(p[0], p[1]); o.y = pk2(p[2], p[3]); *(LAS v2u*)(ks + t * 272 + s0 * 2) = o; }
            __syncthreads();
            { float sp = 0.f, sn = 0.f; const LAS bf16* pr = (const LAS bf16*)(ks + tau * 272) + q * 32; const LAS bf16* qr = (const LAS bf16*)(qs + tau * 272) + q * 32;
#pragma unroll 8
              for (int c = 0; c < 32; ++c) { sp += bf1(pr[c]); sn += npv[q * 32 + c] * bf1(qr[c]); }
              sp += __shfl_xor(sp, 1); sp += __shfl_xor(sp, 2); sn += __shfl_xor(sn, 1); sn += __shfl_xor(sn, 2);
              if (q == 0) { const float den = sp + inter[tau] * sn; rden[tau] = 1.0f / fmaxf(fabsf(den), emt[tau]); } }
            f32x4 acc[2][4];
#pragma unroll
            for (int mi = 0; mi < 2; ++mi)
#pragma unroll
                for (int ni = 0; ni < 4; ++ni) acc[mi][ni] = (f32x4){0.f, 0.f, 0.f, 0.f};
            bf16x8 cb2[2][4];
#pragma unroll
            for (int kk = 0; kk < 2; ++kk)
#pragma unroll
                for (int ni = 0; ni < 4; ++ni) cb2[kk][ni] = *(const GAS bf16x8*)(cp + (64 * wc + 16 * ni + l15) * 128 + (kk + 2) * 32 + g4 * 8);
#pragma unroll
            for (int kk = 0; kk < 4; ++kk) {
                bf16x8 a[2];
#pragma unroll
                for (int mi = 0; mi < 2; ++mi) a[mi] = lds_frag(qs, 272, 32 * wr + 16 * mi, kk * 64, lane);
#pragma unroll
                for (int mi = 0; mi < 2; ++mi)
#pragma unroll
                    for (int ni = 0; ni < 4; ++ni) acc[mi][ni] = MFMA16(a[mi], kk < 2 ? cb[kk][ni] : cb2[kk - 2][ni], acc[mi][ni]);
            }
#pragma unroll
            for (int mi = 0; mi < 2; ++mi)
#pragma unroll
                for (int rr = 0; rr < 4; ++rr) { const float sc = inter[32 * wr + 16 * mi + 4 * g4 + rr];
#pragma unroll
                    for (int ni = 0; ni < 4; ++ni) acc[mi][ni][rr] *= sc; }
#pragma unroll
            for (int kk = 0; kk < 4; ++kk) {
                bf16x8 a[2], bb[4];
#pragma unroll
                for (int mi = 0; mi < 2; ++mi) a[mi] = lds_frag(ks, 272, 32 * wr + 16 * mi, kk * 64, lane);
#pragma unroll
                for (int ni = 0; ni < 4; ++ni) bb[ni] = lds_frag(vT, 272, 64 * wc + 16 * ni, kk * 64, lane);
#pragma unroll
                for (int mi = 0; mi < 2; ++mi)
#pragma unroll
                    for (int ni = 0; ni < 4; ++ni) acc[mi][ni] = MFMA16(a[mi], bb[ni], acc[mi][ni]);
            }
            __syncthreads();
#pragma unroll
            for (int mi = 0; mi < 2; ++mi)
#pragma unroll
                for (int rr = 0; rr < 4; ++rr) { const float sc = rden[32 * wr + 16 * mi + 4 * g4 + rr];
#pragma unroll
                    for (int ni = 0; ni < 4; ++ni) hsum[mi][ni][rr] += acc[mi][ni][rr] * sc; }
        }
        __syncthreads();
#pragma unroll
        for (int mi = 0; mi < 2; ++mi)
#pragma unroll
            for (int rr = 0; rr < 4; ++rr) { float s = 0.f;
#pragma unroll
                for (int ni = 0; ni < 4; ++ni) s += hsum[mi][ni][rr] * hsum[mi][ni][rr];
                s += __shfl_xor(s, 1); s += __shfl_xor(s, 2); s += __shfl_xor(s, 4); s += __shfl_xor(s, 8);
                if (l15 == 0) rowss[wc * 128 + 32 * wr + 16 * mi + 4 * g4 + rr] = s; }
        __syncthreads();
        const float* gn = F.in[I_MLN] + l * 512 + h * 128;
#pragma unroll
        for (int mi = 0; mi < 2; ++mi)
#pragma unroll
            for (int rr = 0; rr < 4; ++rr) { const int t = 32 * wr + 16 * mi + 4 * g4 + rr; const float rs = 1.0f / sqrtf((rowss[t] + rowss[128 + t]) * (1.0f / 128.0f) + EPS);
#pragma unroll
                for (int ni = 0; ni < 4; ++ni) { const int e = 64 * wc + 16 * ni + l15;
                    const float og = sigm1(bf1(Z[(size_t)(rowbase + t) * ZLD + ZC_MLO + h * 128 + e]));
                    Y1[(size_t)(rowbase + t) * 512 + h * 128 + e] = f2bf1(og * hsum[mi][ni][rr] * rs * gn[e]); } }
        __syncthreads();
    }
}
__device__ __forceinline__ void gd_slot(int chain, int k, int& seqbase, int& T, int& n, int& h, int& dir) {
    const int b = chain >> 3; h = (chain >> 1) & 3; dir = chain & 1;
    if (k < 4) { seqbase = ML + b * CTXL; T = CTXL; n = k; } else { seqbase = b * SEQ; T = SEQ; n = k - 4; }
}
__device__ __forceinline__ void phase_gd0(Frame& F, int l, bool last) {
    const bf16* Z = (const bf16*)(F.ws + WS_Z); const float* ZS = (const float*)(F.ws + WS_ZS);
    bf16* GQ = (bf16*)(F.ws + WS_MIX + MX_GQ); bf16* GK = (bf16*)(F.ws + WS_MIX + MX_GK); bf16* GV = (bf16*)(F.ws + WS_MIX + MX_GV);
    float* GG = (float*)(F.ws + WS_MIX + MX_GG); float* GB = (float*)(F.ws + WS_MIX + MX_GB);
    const float* cw = F.in[I_GDCONV] + (size_t)l * 3 * 1536;
    const int gw = blockIdx.x * NWAVES + F.wave, NGW = F.G * NWAVES, c8 = F.lane * 8;
    for (int row = gw; row < MT; row += NGW) {
        const bool isc = row >= ML; const int t = isc ? (row - ML) % CTXL : row % SEQ, T = isc ? CTXL : SEQ;
        const bool hp = t > 0, hn = t < T - 1;
#pragma unroll
        for (int seg = 0; seg < 3; ++seg) {
            if (seg == 0 && isc && last) continue;
            const int zc = (seg == 0 ? ZC_GDQ : seg == 1 ? ZC_GDK : ZC_GDV) + c8;
            const bf16* zr = Z + (size_t)row * ZLD + zc;
            const v4u x1 = *(const GAS v4u*)zr;
            v4u x0 = (v4u){0u, 0u, 0u, 0u}, x2 = (v4u){0u, 0u, 0u, 0u};
            if (hp) x0 = *(const GAS v4u*)(zr - ZLD);
            if (hn) x2 = *(const GAS v4u*)(zr + ZLD);
            const float* w0 = cw + seg * 512 + c8; const float* w1 = w0 + 1536; const float* w2 = w1 + 1536;
            const unsigned a0[4] = {x0.x, x0.y, x0.z, x0.w}, a1[4] = {x1.x, x1.y, x1.z, x1.w}, a2[4] = {x2.x, x2.y, x2.z, x2.w};
            float y[8]; float ss = 0.f;
#pragma unroll
            for (int j = 0; j < 4; ++j) {
                const float lo = bflo(a0[j]) * w0[2 * j] + bflo(a1[j]) * w1[2 * j] + bflo(a2[j]) * w2[2 * j];
                const float hi = bfhi(a0[j]) * w0[2 * j + 1] + bfhi(a1[j]) * w1[2 * j + 1] + bfhi(a2[j]) * w2[2 * j + 1];
                y[2 * j] = silu1(lo); y[2 * j + 1] = silu1(hi); ss += y[2 * j] * y[2 * j] + y[2 * j + 1] * y[2 * j + 1]; }
            float sc = 1.f;
            if (seg < 2) { ss += __shfl_xor(ss, 1); ss += __shfl_xor(ss, 2); ss += __shfl_xor(ss, 4); ss += __shfl_xor(ss, 8);
                sc = 1.0f / sqrtf(ss + EPS); if (seg == 0) sc *= 0.08838834764831845f; }
            v4u o; o.x = pk2(y[0] * sc, y[1] * sc); o.y = pk2(y[2] * sc, y[3] * sc); o.z = pk2(y[4] * sc, y[5] * sc); o.w = pk2(y[6] * sc, y[7] * sc);
            bf16* dst = (seg == 0 ? GQ : seg == 1 ? GK : GV) + (size_t)row * 512 + c8;
            *(GAS v4u*)dst = o;
        }
        if (F.lane < 8) {
            const int dir = F.lane >> 2, h = F.lane & 3; const float* zs = ZS + (size_t)row * 32 + 16;
            const float beta = sigm1(zs[dir * 4 + h]);
            const float g = -__expf(F.in[I_GDALOG][l * 8 + dir * 4 + h]) * softplus1(zs[(2 + dir) * 4 + h] + F.in[I_GDDTB][l * 8 + dir * 4 + h]);
            GG[((size_t)dir * MT + row) * 4 + h] = g; GB[((size_t)dir * MT + row) * 4 + h] = beta;
        }
    }
}
__device__ __forceinline__ void phase_gd1(Frame& F) {
    const bf16* GQ = (const bf16*)(F.ws + WS_MIX + MX_GQ); const bf16* GK = (const bf16*)(F.ws + WS_MIX + MX_GK); const bf16* GV = (const bf16*)(F.ws + WS_MIX + MX_GV);
    const float* GG = (const float*)(F.ws + WS_MIX + MX_GG); const float* GB = (const float*)(F.ws + WS_MIX + MX_GB);
    unsigned char* G1 = F.ws + WS_MIX + MX_GD1; float* GE = (float*)(F.ws + WS_MIX + MX_GE);
    LAS unsigned char* kl = F.lds + RING_OFF; LAS unsigned char* ql = kl + 17408; LAS unsigned char* vl = ql + 17408;
    LAS float* Mf = (LAS float*)(F.lds + RING_OFF + 52224);
    LAS unsigned char* Tl = F.lds + RING_OFF + 69632;
    LAS unsigned char* vsT = F.lds + RING_OFF + 78848; LAS unsigned char* ksT = F.lds + RING_OFF + 97280;
    LAS float* gc = (LAS float*)(F.lds + RING_OFF + 115712); LAS float* bt = gc + 64;
    const int tid = F.tid, lane = F.lane, g4 = lane >> 4, l15 = lane & 15;
    for (int it = blockIdx.x; it < 64 * 36; it += F.G) {
        const int chain = it / 36, k = it % 36; int seqbase, T, n, h, dir; gd_slot(chain, k, seqbase, T, n, h, dir);
        unsigned char* out = G1 + (size_t)it * GD1_ITEM;
        bf16* WN = (bf16*)out; bf16* QD = (bf16*)(out + 16384); bf16* KT = (bf16*)(out + 32768); bf16* UT = (bf16*)(out + 49152); bf16* QKM = (bf16*)(out + 65536);
        const int sp = tid >> 3, sc0 = (tid & 7) * 16;
        { const int tok = dir ? T - 1 - (64 * n + sp) : 64 * n + sp; const size_t off = (size_t)(seqbase + tok) * 512 + h * 128 + sc0;
          *(LAS v4u*)(kl + sp * 272 + sc0 * 2) = *(const GAS v4u*)(GK + off); *(LAS v4u*)(kl + sp * 272 + sc0 * 2 + 16) = *(const GAS v4u*)(GK + off + 8);
          *(LAS v4u*)(ql + sp * 272 + sc0 * 2) = *(const GAS v4u*)(GQ + off); *(LAS v4u*)(ql + sp * 272 + sc0 * 2 + 16) = *(const GAS v4u*)(GQ + off + 8);
          *(LAS v4u*)(vl + sp * 272 + sc0 * 2) = *(const GAS v4u*)(GV + off); *(LAS v4u*)(vl + sp * 272 + sc0 * 2 + 16) = *(const GAS v4u*)(GV + off + 8); }
        if (tid < 64) { const int tok = dir ? T - 1 - (64 * n + tid) : 64 * n + tid; const size_t gi = ((size_t)dir * MT + seqbase + tok) * 4 + h;
            gc[tid] = wscan_sum_f(GG[gi], lane); bt[tid] = GB[gi]; }
        __syncthreads();
        const float gcend = gc[63];
        { const float bj = bt[sp], bk = bj * __expf(gc[sp]);
#pragma unroll
          for (int hh = 0; hh < 2; ++hh) { const v4u vv = *(const LAS v4u*)(vl + sp * 272 + sc0 * 2 + 16 * hh), kk = *(const LAS v4u*)(kl + sp * 272 + sc0 * 2 + 16 * hh);
              const unsigned vw[4] = {vv.x, vv.y, vv.z, vv.w}, kw[4] = {kk.x, kk.y, kk.z, kk.w};
#pragma unroll
              for (int c = 0; c < 4; ++c) { const int col = sc0 + 8 * hh + 2 * c;
                  *(LAS bf16*)(vsT + col * 144 + sp * 2) = f2bf1(bflo(vw[c]) * bj); *(LAS bf16*)(vsT + (col + 1) * 144 + sp * 2) = f2bf1(bfhi(vw[c]) * bj);
                  *(LAS bf16*)(ksT + col * 144 + sp * 2) = f2bf1(bflo(kw[c]) * bk); *(LAS bf16*)(ksT + (col + 1) * 144 + sp * 2) = f2bf1(bfhi(kw[c]) * bk); } } }
        if (F.wave < 4) {
            const int i0 = 16 * F.wave; f32x4 acc[4];
#pragma unroll
            for (int ni = 0; ni < 4; ++ni) acc[ni] = (f32x4){0.f, 0.f, 0.f, 0.f};
#pragma unroll
            for (int ks = 0; ks < 4; ++ks) { const bf16x8 a = lds_frag(kl, 272, i0, ks * 64, lane);
#pragma unroll
                for (int ni = 0; ni < 4; ++ni) acc[ni] = MFMA16(a, lds_frag(kl, 272, 16 * ni, ks * 64, lane), acc[ni]); }
#pragma unroll
            for (int ni = 0; ni < 4; ++ni)
#pragma unroll
                for (int rr = 0; rr < 4; ++rr) { const int i = i0 + 4 * g4 + rr, j = 16 * ni + l15;
                    Mf[i * 65 + j] = (j < i) ? bt[i] * acc[ni][rr] * __expf(gc[i] - gc[j]) : 0.f; }
        } else {
            const int j0 = 16 * (F.wave - 4); f32x4 acc[4];
#pragma unroll
            for (int ni = 0; ni < 4; ++ni) acc[ni] = (f32x4){0.f, 0.f, 0.f, 0.f};
#pragma unroll
            for (int ks = 0; ks < 4; ++ks) { const bf16x8 a = lds_frag(kl, 272, j0, ks * 64, lane);
#pragma unroll
                for (int ni = 0; ni < 4; ++ni) acc[ni] = MFMA16(a, lds_frag(ql, 272, 16 * ni, ks * 64, lane), acc[ni]); }
            const int jt = F.wave - 4;
#pragma unroll
            for (int ni = 0; ni < 4; ++ni) { const int i = 16 * ni + l15; float v[4];
#pragma unroll
                for (int rr = 0; rr < 4; ++rr) { const int j = j0 + 4 * g4 + rr; v[rr] = (j <= i) ? acc[ni][rr] * __expf(gc[i] - gc[j]) : 0.f; }
                v2u o; o.x = pk2(v[0], v[1]); o.y = pk2(v[2], v[3]);
                *(GAS v2u*)(QKM + i * 64 + 32 * (jt >> 1) + 8 * g4 + 4 * (jt & 1)) = o; }
        }
        { const int d = tid & 127, lq = tid >> 7; float v[16];
#pragma unroll
          for (int ll = 0; ll < 16; ++ll) { const int lp = 16 * lq + ll; v[ll] = bf1(((const LAS bf16*)(kl + lp * 272))[d]) * __expf(gcend - gc[lp]); }
#pragma unroll
          for (int g = 0; g < 4; ++g) { v2u o; o.x = pk2(v[4 * g], v[4 * g + 1]); o.y = pk2(v[4 * g + 2], v[4 * g + 3]);
              *(GAS v2u*)(KT + d * 64 + 32 * (lq >> 1) + 8 * g + 4 * (lq & 1)) = o; } }
        { const int lq = tid & 63, db = tid >> 6; const float e = __expf(gc[lq]); const LAS bf16* qr = (const LAS bf16*)(ql + lq * 272) + 16 * db; float v[16];
#pragma unroll
          for (int dd = 0; dd < 16; ++dd) v[dd] = bf1(qr[dd]) * e;
#pragma unroll
          for (int g = 0; g < 4; ++g) { v2u o; o.x = pk2(v[4 * g], v[4 * g + 1]); o.y = pk2(v[4 * g + 2], v[4 * g + 3]);
              *(GAS v2u*)(QD + lq * 128 + 32 * (db >> 1) + 8 * g + 4 * (db & 1)) = o; } }
        if (tid == 0) GE[it * 32] = __expf(gcend);
        __syncthreads();
#ifndef DUPS
#define DUPS 0
#endif
        for (int rep = 0; rep < ((DUPS & 1) ? 2 : 1); ++rep) { const int cb = 8 * F.wave; float res[8];
#pragma unroll
          for (int cc = 0; cc < 8; ++cc) res[cc] = (lane == cb + cc) ? 1.0f : 0.0f;
          for (int j = cb; j < 63; ++j) { const float mj = Mf[lane * 65 + j];
#pragma unroll
              for (int cc = 0; cc < 8; ++cc) { const float xj = __builtin_bit_cast(float, __builtin_amdgcn_readlane(__builtin_bit_cast(int, res[cc]), j)); res[cc] -= mj * xj; } }
          v4u o; o.x = pk2(res[0], res[1]); o.y = pk2(res[2], res[3]); o.z = pk2(res[4], res[5]); o.w = pk2(res[6], res[7]);
          *(LAS v4u*)(Tl + lane * 144 + cb * 2) = o; }
        __syncthreads();
        if (F.wave < 4) {
            f32x4 acc[8];
#pragma unroll
            for (int ni = 0; ni < 8; ++ni) acc[ni] = (f32x4){0.f, 0.f, 0.f, 0.f};
#pragma unroll
            for (int ks = 0; ks < 2; ++ks) { const bf16x8 a = lds_frag(Tl, 144, 16 * F.wave, ks * 64, lane);
#pragma unroll
                for (int ni = 0; ni < 8; ++ni) acc[ni] = MFMA16(a, lds_frag(vsT, 144, 16 * ni, ks * 64, lane), acc[ni]); }
#pragma unroll
            for (int ni = 0; ni < 8; ++ni) { v2u o; o.x = pk2(acc[ni][0], acc[ni][1]); o.y = pk2(acc[ni][2], acc[ni][3]);
                *(GAS v2u*)(UT + (16 * ni + l15) * 64 + 16 * F.wave + 4 * g4) = o; }
        } else {
            const int it4 = F.wave - 4; f32x4 acc[8];
#pragma unroll
            for (int mi = 0; mi < 8; ++mi) acc[mi] = (f32x4){0.f, 0.f, 0.f, 0.f};
#pragma unroll
            for (int ks = 0; ks < 2; ++ks) { const bf16x8 bfr = lds_frag(Tl, 144, 16 * it4, ks * 64, lane);
#pragma unroll
                for (int mi = 0; mi < 8; ++mi) acc[mi] = MFMA16(lds_frag(ksT, 144, 16 * mi, ks * 64, lane), bfr, acc[mi]); }
#pragma unroll
            for (int mi = 0; mi < 8; ++mi) { v2u o; o.x = pk2(-acc[mi][0], -acc[mi][1]); o.y = pk2(-acc[mi][2], -acc[mi][3]);
                *(GAS v2u*)(WN + (16 * it4 + l15) * 128 + 32 * (mi >> 1) + 8 * g4 + 4 * (mi & 1)) = o; }
        }
        __syncthreads();
    }
}
constexpr int GD2_BUF = 62464;
__device__ __forceinline__ void gd2_load(const unsigned char* src, v4u (&r)[7], int tid) {
#pragma unroll
    for (int j = 0; j < 7; ++j) r[j] = *(const GAS v4u*)(src + (size_t)(tid + 512 * j) * 16);
}
__device__ __forceinline__ void gd2_store(LAS unsigned char* buf, const v4u (&r)[7], int tid) {
#pragma unroll
    for (int j = 0; j < 7; ++j) { const int pc = tid + 512 * j;
        int off;
        if (pc < 1024) off = (pc >> 4) * 272 + (pc & 15) * 16;
        else if (pc < 2048) off = 17408 + ((pc - 1024) >> 4) * 272 + (pc & 15) * 16;
        else if (pc < 3072) off = 44032 + ((pc - 2048) >> 3) * 144 + (pc & 7) * 16;
        else off = 34816 + ((pc - 3072) >> 3) * 144 + (pc & 7) * 16;
        *(LAS v4u*)(buf + off) = r[j]; }
}
__device__ __forceinline__ void phase_gd2(Frame& F, bool last) {
    const unsigned char* G1 = F.ws + WS_MIX + MX_GD1; const float* GE = (const float*)(F.ws + WS_MIX + MX_GE);
    float* GO = (float*)(F.ws + WS_H);
    const int tid = F.tid, lane = F.lane, g4 = lane >> 4, l15 = lane & 15, e0 = 16 * F.wave;
    for (int chain = blockIdx.x; chain < 64; chain += F.G) {
        const int h = (chain >> 1) & 3, dir = chain & 1, b = chain >> 3;
        f32x4 S[8];
#pragma unroll
        for (int db = 0; db < 8; ++db) S[db] = (f32x4){0.f, 0.f, 0.f, 0.f};
        v4u r[7];
        { const unsigned char* it0 = G1 + (size_t)(chain * 36) * GD1_ITEM;
#pragma unroll
          for (int j = 0; j < 7; ++j) { const int pc = tid + 512 * j; const int gp = pc < 3072 ? pc : pc + 1024; r[j] = *(const GAS v4u*)(it0 + (size_t)gp * 16); } }
        gd2_store(F.lds + RING_OFF, r, tid);
        v2u un[4]; float gn;
        { const unsigned char* it0 = G1 + (size_t)(chain * 36) * GD1_ITEM; const bf16* UT0 = (const bf16*)(it0 + 49152);
#pragma unroll
          for (int lb = 0; lb < 4; ++lb) un[lb] = *(const GAS v2u*)(UT0 + (e0 + l15) * 64 + 16 * lb + 4 * g4);
          gn = GE[(chain * 36) * 32]; }
        __syncthreads();
        for (int k = 0; k < 36; ++k) {
            LAS unsigned char* buf = F.lds + RING_OFF + (k & 1) * GD2_BUF;
            const unsigned char* item = G1 + (size_t)(chain * 36 + k) * GD1_ITEM;
            if (k + 1 < 36) { const unsigned char* nx = item + GD1_ITEM;
#pragma unroll
                for (int j = 0; j < 7; ++j) { const int pc = tid + 512 * j; const int gp = pc < 3072 ? pc : pc + 1024; r[j] = *(const GAS v4u*)(nx + (size_t)gp * 16); } }
            v2u uc[4];
#pragma unroll
            for (int lb = 0; lb < 4; ++lb) uc[lb] = un[lb];
            const float gend = gn;
            if (k + 1 < 36) { const bf16* UTn = (const bf16*)(item + GD1_ITEM + 49152);
#pragma unroll
                for (int lb = 0; lb < 4; ++lb) un[lb] = *(const GAS v2u*)(UTn + (e0 + l15) * 64 + 16 * lb + 4 * g4);
                gn = GE[(chain * 36 + k + 1) * 32]; }
            int seqbase, T, n; if (k < 4) { seqbase = ML + b * CTXL; T = CTXL; n = k; } else { seqbase = b * SEQ; T = SEQ; n = k - 4; }
            bf16x8 Sb[4];
#pragma unroll
            for (int ks = 0; ks < 4; ++ks) { v4u w; w.x = pk2(S[2 * ks][0], S[2 * ks][1]); w.y = pk2(S[2 * ks][2], S[2 * ks][3]); w.z = pk2(S[2 * ks + 1][0], S[2 * ks + 1][1]); w.w = pk2(S[2 * ks + 1][2], S[2 * ks + 1][3]);
                Sb[ks] = __builtin_bit_cast(bf16x8, w); }
            f32x4 vn[4];
#pragma unroll
            for (int lb = 0; lb < 4; ++lb) { const v2u uu = uc[lb];
                f32x4 acc = (f32x4){bflo(uu.x), bfhi(uu.x), bflo(uu.y), bfhi(uu.y)};
#pragma unroll
                for (int ks = 0; ks < 4; ++ks) acc = MFMA16(lds_frag(buf, 272, 16 * lb, ks * 64, lane), Sb[ks], acc);
                vn[lb] = acc; }
            bf16x8 Vb[2];
#pragma unroll
            for (int ks = 0; ks < 2; ++ks) { v4u w; w.x = pk2(vn[2 * ks][0], vn[2 * ks][1]); w.y = pk2(vn[2 * ks][2], vn[2 * ks][3]); w.z = pk2(vn[2 * ks + 1][0], vn[2 * ks + 1][1]); w.w = pk2(vn[2 * ks + 1][2], vn[2 * ks + 1][3]);
                Vb[ks] = __builtin_bit_cast(bf16x8, w); }
            const bool wr_o = !(last && k < 4);
#pragma unroll
            for (int lb = 0; lb < 4; ++lb) { f32x4 acc = (f32x4){0.f, 0.f, 0.f, 0.f};
#pragma unroll
                for (int ks = 0; ks < 4; ++ks) acc = MFMA16(lds_frag(buf + 17408, 272, 16 * lb, ks * 64, lane), Sb[ks], acc);
#pragma unroll
                for (int ks = 0; ks < 2; ++ks) acc = MFMA16(lds_frag(buf + 34816, 144, 16 * lb, ks * 64, lane), Vb[ks], acc);
                if (wr_o) {
#pragma unroll
                    for (int rr = 0; rr < 4; ++rr) { const int p = 16 * lb + 4 * g4 + rr; const int tok = dir ? T - 1 - (64 * n + p) : 64 * n + p;
                        GO[((size_t)dir * MT + seqbase + tok) * 512 + h * 128 + e0 + l15] = acc[rr]; } } }
#pragma unroll
            for (int db = 0; db < 8; ++db) { f32x4 acc = S[db] * gend;
#pragma unroll
                for (int ks = 0; ks < 2; ++ks) acc = MFMA16(lds_frag(buf + 44032, 144, 16 * db, ks * 64, lane), Vb[ks], acc);
                S[db] = acc; }
            if (k + 1 < 36) gd2_store(F.lds + RING_OFF + ((k + 1) & 1) * GD2_BUF, r, tid);
            __syncthreads();
        }
    }
}
__device__ __forceinline__ void phase_gd3(Frame& F, int l, bool last) {
    const float* GO = (const float*)(F.ws + WS_H); const bf16* Z = (const bf16*)(F.ws + WS_Z); bf16* Y2 = (bf16*)(F.ws + WS_Y) + (size_t)2 * MT * 512;
    const int gw = blockIdx.x * NWAVES + F.wave, NGW = F.G * NWAVES, c8 = F.lane * 8; const int nrows = last ? ML : MT;
    const float* gn = F.in[I_GDN] + l * 128 + (c8 & 127);
    for (int row = gw; row < nrows; row += NGW) {
        const f32x4 a0 = *(const f32x4*)(GO + (size_t)row * 512 + c8), a1 = *(const f32x4*)(GO + (size_t)row * 512 + c8 + 4);
        const f32x4 b0 = *(const f32x4*)(GO + ((size_t)MT + row) * 512 + c8), b1 = *(const f32x4*)(GO + ((size_t)MT + row) * 512 + c8 + 4);
        const f32x4 s0 = a0 + b0, s1 = a1 + b1;
        float ss = (s0.x * s0.x + s0.y * s0.y) + (s0.z * s0.z + s0.w * s0.w) + (s1.x * s1.x + s1.y * s1.y) + (s1.z * s1.z + s1.w * s1.w);
        ss += __shfl_xor(ss, 1); ss += __shfl_xor(ss, 2); ss += __shfl_xor(ss, 4); ss += __shfl_xor(ss, 8);
        const float rs = 1.0f / sqrtf(ss * (1.0f / 128.0f) + EPS);
        const v4u zz = *(const GAS v4u*)(Z + (size_t)row * ZLD + ZC_GDZ + c8);
        const float o[8] = {s0.x, s0.y, s0.z, s0.w, s1.x, s1.y, s1.z, s1.w}; const float zf[8] = {bflo(zz.x), bfhi(zz.x), bflo(zz.y), bfhi(zz.y), bflo(zz.z), bfhi(zz.z), bflo(zz.w), bfhi(zz.w)};
        float y[8];
#pragma unroll
        for (int j = 0; j < 8; ++j) y[j] = o[j] * rs * gn[j] * silu1(zf[j]);
        v4u w; w.x = pk2(y[0], y[1]); w.y = pk2(y[2], y[3]); w.z = pk2(y[4], y[5]); w.w = pk2(y[6], y[7]);
        *(GAS v4u*)(Y2 + (size_t)row * 512 + c8) = w;
    }
}
#ifndef DUPC
#define DUPC 0
#endif
constexpr int CW_Q = 2048;
__device__ __forceinline__ int q_pull(Frame& F, int qi) {
    volatile LAS unsigned* slot = F.MISC + 16;
    __syncthreads();
    if (F.tid == 0) *slot = __hip_atomic_fetch_add((unsigned*)(F.ctl + CW_Q + 64 * qi), 1u, __ATOMIC_RELAXED, __HIP_MEMORY_SCOPE_AGENT);
    __syncthreads();
    return (int)*slot;
}
__device__ __forceinline__ void phase_mixc(Frame& F, int l, bool last, int qo = 0) {
    for (int rep = 0; rep < ((DUPC & 4) ? 2 : 1); ++rep) if ((int)blockIdx.x < 64 || F.G < 128) phase_gd2(F, last);
    const int n_att = last ? 256 : 288, n_ml3 = last ? 512 : 576;
    for (int rep = 0; rep < ((DUPC & 1) ? 2 : 1); ++rep) for (;;) { const int idx = q_pull(F, 2 * l + 8 * rep); if (idx >= n_att) break; attn_item(F, idx); }
    for (int rep = 0; rep < ((DUPC & 2) ? 2 : 1); ++rep) for (;;) { const int idx = q_pull(F, 2 * l + 1 + 8 * rep); if (idx >= n_ml3) break; ml3_item(F, l, idx); }
}
#ifndef DUPA
#define DUPA 0
#endif
#define MIX_PHASE_1 for (int rep = 0; rep < ((DUPA & 1) ? 2 : 1); ++rep) phase_attn_prep(F, l, last); \
    for (int rep = 0; rep < ((DUPA & 4) ? 2 : 1); ++rep) phase_gd0(F, l, last); for (int rep = 0; rep < ((DUPA & 8) ? 2 : 1); ++rep) { __syncthreads(); phase_ml1(F, l); }
#define MIX_PHASE_2 for (int rep = 0; rep < ((DUPA & 2) ? 2 : 1); ++rep) { __syncthreads(); phase_spatial(F, l, last); } for (int rep = 0; rep < ((DUPA & 16) ? 2 : 1); ++rep) { __syncthreads(); phase_gd1(F); } for (int rep = 0; rep < ((DUPA & 32) ? 2 : 1); ++rep) phase_ml2(F, 0);
#define MIX_PHASE_3 phase_mixc(F, l, last);
#define MIX_PHASE_4 phase_gd3(F, l, last);
#ifndef PROBE
#define PROBE 0
#endif
#ifndef DUPMIX
#define DUPMIX 0
#endif
#ifndef DUPG
#define DUPG 0
#endif
#ifdef DUPAUX
#define DUP_AUX(x) x
#else
#define DUP_AUX(x)
#endif
#ifndef TPROBE
#define TPROBE 0
#endif
constexpr int PH_PER_LAYER = 15, N_PHASES = PROBE ? (1 + PH_PER_LAYER + 1) : (1 + NLAYER * PH_PER_LAYER + (TPROBE ? 1 : 0));
#ifndef PHMASK
#define PHMASK 0xffff
#endif
#define PHEN(k) ((PHMASK >> (k)) & 1)
#define IN(p) (lo <= (p) && (p) < hi)
#ifndef TPROBE
#define TPROBE 0
#endif
#if TPROBE
#define SEAM(p) do { if (lo <= (p) && (p) + 1 < hi) { xcd_barrier(bar); if (blockIdx.x == 0 && F.tid == 0) ((unsigned long long*)(F.ws + WS_CTL + 524288))[(p) + 1] = wall_clock64(); } } while (0)
#else
#ifdef DUPBAR
#define SEAM(p) do { if (lo <= (p) && (p) + 1 < hi) { xcd_barrier(bar); xcd_barrier(bar); } } while (0)
#else
#define SEAM(p) do { if (lo <= (p) && (p) + 1 < hi) xcd_barrier(bar); } while (0)
#endif
#endif
struct Args { const float* in[27]; float* out; unsigned char* ws; int ph_lo, ph_hi, li, pad; };
template <int l> __device__ __forceinline__ void layer_body(Frame& F, const XcdBarrier& bar, const int lo, const int hi) {
    float* MOD = (float*)(F.ws + WS_MOD);
    float* XC = (float*)(F.ws + WS_XC);
    bf16* Hb = (bf16*)(F.ws + WS_H); bf16* Zb = (bf16*)(F.ws + WS_Z); bf16* ACT = (bf16*)(F.ws + WS_Z); float* ZS = (float*)(F.ws + WS_ZS);
    bf16* WFI = (bf16*)(F.ws + WS_WFI); bf16* WFO = (bf16*)(F.ws + WS_WFO); bf16* WZ = (bf16*)(F.ws + WS_WZ); bf16* WB = (bf16*)(F.ws + WS_WB); bf16* WO = (bf16*)(F.ws + WS_WO);
    bf16* Yb = (bf16*)(F.ws + WS_Y); float* PB = (float*)(F.ws + WS_MIX);
    const int vc = (F.G % 8 == 0) ? ((int)blockIdx.x % 8) * (F.G / 8) + (int)blockIdx.x / 8 : (int)blockIdx.x;
        constexpr int P = 1 + l * PH_PER_LAYER;
        constexpr bool last = (l == NLAYER - 1);
        const float* modl = MOD + (size_t)l * 9 * MODW;
        const float* xin_l = (l == 0) ? F.in[I_X] : F.out;
        const float* xin_c = (l == 0) ? F.in[I_CTX] : XC;
        constexpr int nPM = last ? 64 : 72;

        if (PHEN(0) && IN(P + 0)) { if (l == 0) { phase_mod(F); phase_rope(F); __syncthreads(); } conv_set(F, l, 0, nullptr); if (l == 0) conv_set(F, l, 2, nullptr); }
        SEAM(P + 0);
        if (PHEN(1) && IN(P + 1)) phase_norm<(l == 0), (l > 0), false>(F, xin_l, xin_c, F.in[I_F1N] + (size_t)l * D, modl + 0 * D, MT);
        SEAM(P + 1);
        if (PHEN(2) && IN(P + 2)) {
            pg8::Gemm g{Hb, WFI, MT, 2 * DFF, D, 1, 1}; pg8::TileOrder S; S.init(72, 44, 0, 0, 0, F.G, (int)blockIdx.x, 32);
            pg8::EpiSwiglu E{ACT, DFF};
            pg8::gemm_phase<pg8::EpiSwiglu, pg8::TileOrder, PG8_ALIGN, PG8_SP2>(F.lds + RING_OFF, g, S, E);
            if (DUPG & 2) { __syncthreads(); pg8::gemm_phase<pg8::EpiSwiglu, pg8::TileOrder, PG8_ALIGN, PG8_SP2>(F.lds + RING_OFF, g, S, E); }
        }
        SEAM(P + 2);
        if (PHEN(3) && IN(P + 3)) {
            pg8::Gemm g{ACT, WFO, MT, D, DFF, 1, 1};
            { pg8::TileOrder S; S.init(64, 8, 0, 0, 0, F.G, (int)blockIdx.x, DFF / 64); S.wgm = WGM_N8; pg8::EpiRes<false> E{F.out, XC, modl + 2 * D, 0.5f};
              pg8::gemm_phase<pg8::EpiRes<false>, pg8::TileOrder, PG8_ALIGN, PG8_SP2>(F.lds + RING_OFF, g, S, E); }
            { pg8::QuarterOrder S; S.init(8, 64, DFF / 256, F.G, (int)blockIdx.x); pg8::EpiRes<true> E{nullptr, PB, modl + 2 * D, 0.5f};
              pg8::gemm_phase<pg8::EpiRes<true>, pg8::QuarterOrder, PG8_ALIGN, PG8_SP2>(F.lds + RING_OFF, g, S, E); }
        }
        SEAM(P + 3);
        if (PHEN(4) && IN(P + 4)) phase_norm<false, true, !last>(F, F.out, XC, F.in[I_MIXN] + (size_t)l * D, modl + 3 * D, MT);
        SEAM(P + 4);
        if (PHEN(5) && IN(P + 5)) {
            pg8::Gemm g{Hb, WZ, MT, NZ, D, 1, 1}; pg8::TileOrder S;
            if (last) S.init(64, 57, 8, NKV_TILES, 64, F.G, (int)blockIdx.x, 32); else S.init(64, 57, 8, 56, 64, F.G, (int)blockIdx.x, 32, 10);
            pg8::EpiZ E{Zb, ZS, ZLD, (bf16*)(F.ws + WS_GT)};
            pg8::gemm_phase<pg8::EpiZ, pg8::TileOrder, PG8_ALIGN, PG8_SP2>(F.lds + RING_OFF, g, S, E);
            if (DUPG & 1) { __syncthreads(); pg8::gemm_phase<pg8::EpiZ, pg8::TileOrder, PG8_ALIGN, PG8_SP2>(F.lds + RING_OFF, g, S, E); }
            if (last) conv_set(F, l, 1, (unsigned*)(F.ctl + 2048 + 64 * 14));
        }
        SEAM(P + 5);
        if (PHEN(6) && IN(P + 6)) { if (l == 0) conv_set(F, l, 1, nullptr); MIX_PHASE_1 if (DUPMIX & 1) { __syncthreads(); MIX_PHASE_1 } }
        SEAM(P + 6);
        if (PHEN(7) && IN(P + 7)) { MIX_PHASE_2 if (DUPMIX & 2) { __syncthreads(); MIX_PHASE_2 } }
        SEAM(P + 7);
        if (PHEN(8) && IN(P + 8)) { MIX_PHASE_3 }
        SEAM(P + 8);
        if (PHEN(9) && IN(P + 9)) { MIX_PHASE_4 if (DUPMIX & 8) { __syncthreads(); MIX_PHASE_4 } }
        SEAM(P + 9);
        if (PHEN(10) && IN(P + 10)) {
            pg8::Gemm g{Yb, WB, 4 * MT, 4 * D, 512, 1}; pg8::BranchOrder S; S.init(nPM, 72, F.G, (int)blockIdx.x);
            pg8::EpiBranch E{(const bf16*)(F.ws + WS_GT), Hb, 72};
            pg8::gemm_phase<pg8::EpiBranch, pg8::BranchOrder, PG8_ALIGN, PG8_SP2>(F.lds + RING_OFF, g, S, E);
            if (DUPG & 4) { __syncthreads(); pg8::gemm_phase<pg8::EpiBranch, pg8::BranchOrder, PG8_ALIGN, PG8_SP2>(F.lds + RING_OFF, g, S, E); }
        }
        SEAM(P + 10);
        if (PHEN(11) && IN(P + 11)) {
            pg8::Gemm g{Hb, WO, MT, D, D, 1, 1};
            { pg8::TileOrder S; S.init(64, 8, 0, 0, 0, F.G, (int)blockIdx.x, D / 64); S.wgm = WGM_N8; pg8::EpiRes<false> E{F.out, XC, modl + 5 * D, 1.0f};
              pg8::gemm_phase<pg8::EpiRes<false>, pg8::TileOrder, PG8_ALIGN, PG8_SP2>(F.lds + RING_OFF, g, S, E); }
            if constexpr (nPM == 72) { pg8::QuarterOrder S; S.init(8, 64, D / 256, F.G, (int)blockIdx.x); pg8::EpiRes<true> E{nullptr, PB, modl + 5 * D, 1.0f};
              pg8::gemm_phase<pg8::EpiRes<true>, pg8::QuarterOrder, PG8_ALIGN, PG8_SP2>(F.lds + RING_OFF, g, S, E); }
        }
        SEAM(P + 11);
        if (PHEN(12) && IN(P + 12)) { phase_norm<false, (nPM == 72), false>(F, F.out, XC, F.in[I_F2N] + (size_t)l * D, modl + 6 * D, nPM * 256);
#ifdef DUPN
            if (nPM == 64) { phase_norm<false, false, false>(F, F.out, XC, F.in[I_F2N] + (size_t)l * D, modl + 6 * D, nPM * 256); phase_norm<false, false, false>(F, F.out, XC, F.in[I_F2N] + (size_t)l * D, modl + 6 * D, nPM * 256); }
#endif
        }
        SEAM(P + 12);
        if (PHEN(13) && IN(P + 13)) {
            pg8::Gemm g{Hb, WFI, MT, 2 * DFF, D, 1, 1}; pg8::TileOrder S; S.init(nPM, 44, 0, 0, 0, F.G, (int)blockIdx.x, 32);
            pg8::EpiSwiglu E{ACT, DFF};
            pg8::gemm_phase<pg8::EpiSwiglu, pg8::TileOrder, PG8_ALIGN, PG8_SP2>(F.lds + RING_OFF, g, S, E);
            if (!last) conv_set(F, l + 1, 2, (unsigned*)(F.ctl + 2048 + 64 * 15));
        }
        SEAM(P + 13);
        if (PHEN(14) && IN(P + 14)) {
            pg8::Gemm g{ACT, WFO, MT, D, DFF, 1, 1};
            { pg8::TileOrder S; S.init(64, 8, 0, 0, 0, F.G, (int)blockIdx.x, DFF / 64); S.wgm = WGM_N8; pg8::EpiRes<false> E{F.out, XC, modl + 8 * D, 0.5f};
              pg8::gemm_phase<pg8::EpiRes<false>, pg8::TileOrder, PG8_ALIGN, PG8_SP2>(F.lds + RING_OFF, g, S, E); }
            if constexpr (nPM == 72) { pg8::QuarterOrder S; S.init(8, 64, DFF / 256, F.G, (int)blockIdx.x); pg8::EpiRes<true> E{nullptr, PB, modl + 8 * D, 0.5f};
              pg8::gemm_phase<pg8::EpiRes<true>, pg8::QuarterOrder, PG8_ALIGN, PG8_SP2>(F.lds + RING_OFF, g, S, E); }
        }
        SEAM(P + 14);
    }
__global__ void __launch_bounds__(NWAVES * 64, 2) mk_fwd(Args args) {
    extern __shared__ __attribute__((aligned(16))) unsigned char lds[];
    Frame F;
    F.lds = (LAS unsigned char*)lds;
    F.MISC = (volatile LAS unsigned*)(F.lds + MISC_OFF);
    F.tid = threadIdx.x; F.lane = F.tid & 63; F.wave = __builtin_amdgcn_readfirstlane(F.tid >> 6);
    F.G = gridDim.x;
    F.ws = args.ws; F.ctl = (gu32*)(args.ws + WS_CTL); F.out = args.out;
    F.in = args.in;
    for (int u = F.tid; u < (LDS_BYTES - LDSCTL_OFF) / 4; u += NWAVES * 64) ((LAS unsigned*)(F.lds + LDSCTL_OFF))[u] = 0u;
    __syncthreads();
    const int lo = args.ph_lo, hi = args.ph_hi;
#if TPROBE
    if (blockIdx.x == 0 && F.tid == 0) ((unsigned long long*)(F.ws + WS_CTL + 524288))[0] = wall_clock64();
#endif
    XcdBarrier bar; bar.bar = (unsigned*)(F.ctl + CW_BAR) + args.li * XCD_BAR_WORDS; bar.x = 0; bar.st = nullptr;
    if (hi - lo > 1) bar = xcd_barrier_post((unsigned*)(F.ctl + CW_BAR) + args.li * XCD_BAR_WORDS, F.MISC + 8);


    layer_body<0>(F, bar, lo, hi);
#if !PROBE
    layer_body<1>(F, bar, lo, hi);
#endif
#if TPROBE
    if (IN(31)) {
        const unsigned long long* TS = (const unsigned long long*)(F.ws + WS_CTL + 524288);
        const float tot = (float)(TS[31] - TS[0]);
        const float fa = (float)(TS[TP_A2] - TS[TP_A1]) / tot, fb = (float)(TS[TP_B2] - TS[TP_B1]) / tot;
        const size_t n = (size_t)ML * D; float* o = F.out;
        for (size_t i = (size_t)blockIdx.x * 512 + F.tid; i < n; i += (size_t)F.G * 512) { float v = o[i] * (1.0f + fa); if (i == 0) v += 10000.0f * fb; o[i] = v; }
    }
#endif
#if PROBE
    if (IN(16)) {
        const size_t n = (size_t)ML * D; float* o = F.out;
        for (size_t i = (size_t)blockIdx.x * 512 + F.tid; i < n; i += (size_t)F.G * 512) { const size_t r = i / D, c = i % D;
#if PROBE == 1
            o[i] = bf1(((const bf16*)(F.ws + WS_Y))[(size_t)MT * 512 + r * 512 + (c & 511)]);
#elif PROBE == 2
            o[i] = bf1(((const bf16*)(F.ws + WS_MIX + MX_CP))[(i % ((size_t)1152 * 16384))]);
#elif PROBE == 3
            o[i] = bf1(((const bf16*)(F.ws + WS_MIX + MX_CL))[(i % ((size_t)1152 * 16384))]);
#elif PROBE == 4
            o[i] = ((const float*)(F.ws + WS_ZS))[(i % ((size_t)ML * 32))];
#endif
        }
    }
#endif
#undef IN
#undef SEAM
}

#ifndef MK_N_LAUNCHES
#define MK_N_LAUNCHES 1
#endif
extern "C" void kernel_launch(void* const* d_in, const int* in_sizes, int n_in, void* d_out, int out_size, void* d_ws, size_t ws_size, hipStream_t stream) {
    static int grid = 0;
    if (grid == 0) {
        if (n_in != 27 || in_sizes[0] != ML * D || out_size != ML * D || ws_size < WS_END) { fprintf(stderr, "kernel_launch: shape mismatch n_in %d in0 %d out %d ws %zu (need %zu)\n", n_in, n_in > 0 ? in_sizes[0] : -1, out_size, ws_size, (size_t)WS_END); grid = -1; return; }
        int dev = 0, cus = 0, per_cu = 0;
        if (hipGetDevice(&dev) != hipSuccess || hipDeviceGetAttribute(&cus, hipDeviceAttributeMultiprocessorCount, dev) != hipSuccess) { grid = -1; return; }
        if (hipFuncSetAttribute((const void*)mk_fwd, hipFuncAttributeMaxDynamicSharedMemorySize, LDS_BYTES) != hipSuccess) { fprintf(stderr, "kernel_launch: hipFuncSetAttribute failed\n"); grid = -1; return; }
        if (hipOccupancyMaxActiveBlocksPerMultiprocessor(&per_cu, (const void*)mk_fwd, NWAVES * 64, LDS_BYTES) != hipSuccess || per_cu < 1)
            fprintf(stderr, "kernel_launch: note: occupancy query reports %d workgroups per CU\n", per_cu);
        (void)hipGetLastError();
        grid = cus;
    }
    if (grid < 0) return;
    if (hipMemsetAsync((char*)d_ws + WS_CTL, 0, CTL_ZERO_BYTES, stream) != hipSuccess) return;
    Args a{};
    for (int i = 0; i < 27; ++i) a.in[i] = (const float*)d_in[i];
    a.out = (float*)d_out; a.ws = (unsigned char*)d_ws; a.pad = 0;
#if MK_N_LAUNCHES == 1
    a.ph_lo = 0; a.ph_hi = N_PHASES; a.li = 0;
    hipLaunchKernelGGL(mk_fwd, dim3(grid), dim3(NWAVES * 64), LDS_BYTES, stream, a);
#else
    for (int p = 0; p < N_PHASES; ++p) { a.ph_lo = p; a.ph_hi = p + 1; a.li = 0;
        hipLaunchKernelGGL(mk_fwd, dim3(grid), dim3(NWAVES * 64), LDS_BYTES, stream, a); }
#endif
    const hipError_t le = hipPeekAtLastError();
    if (le != hipSuccess) fprintf(stderr, "kernel_launch: launch failed: %s\n", hipGetErrorName(le));
}
```

```cpp
#include <hip/hip_runtime.h>
#include <cstdio>
#include <cstdint>
namespace pg8 {
#define PG8_LAS __attribute__((address_space(3)))
typedef unsigned short bf16_t;
typedef short bf16x8 __attribute__((ext_vector_type(8)));
typedef float f32x4 __attribute__((ext_vector_type(4)));
typedef unsigned u32x4 __attribute__((ext_vector_type(4)));
constexpr int BM = 256, BK = 64, HALF = 128, HTB = HALF * BK * 2  , STAGE_BYTES = 8 * HTB, NXCD = 8, WGM = 8;

__host__ __device__ __forceinline__ int lds_byte(int r, int c) { const int st = (r >> 4) * 2 + (c >> 5), rr = r & 15, cc = c & 31, ob = rr * 64 + cc * 2; return st * 1024 + (ob ^ (((ob >> 9) & 1) << 5)); }
__host__ __device__ __forceinline__ void stage_rc(int b, int& R, int& C) { const int st = b / 1024, sb = b % 1024, swz = sb ^ (((sb >> 9) & 1) << 5); R = (st >> 1) * 16 + swz / 64; C = (st & 1) * 32 + (swz % 64) / 2; }
__host__ __device__ __forceinline__ int perm32(int rho) { const int n = rho >> 4, i = rho & 15; return 8 * (i >> 2) + 4 * n + (i & 3); }

__host__ __device__ __forceinline__ int perm32_inv(int x) { return 16 * ((x >> 2) & 1) + 4 * (x >> 3) + (x & 3); }
__host__ __device__ __forceinline__ size_t sw_off(int row, int k, int K, bool perm) {
    const int tile = row >> 8, h = (row >> 7) & 1, Rp = row & 127, R = perm ? ((Rp & ~31) + perm32_inv(Rp & 31)) : Rp;
    return ((size_t)(tile * 2 + h) * (K >> 6) + (k >> 6)) * 8192 + (size_t)(lds_byte(R, k & 63) >> 1);
}
struct Unit { int pm, pn, k0, nt; };
struct Gemm { const bf16_t* A; const bf16_t* Bt; int M, N, K; int swb = 0, swa = 0; };

struct StaticOrder {
    int nM, nN, nwg, G, c;
    __host__ __device__ void init(int M, int N, int G_, int c_) { nM = M / BM; nN = N / BM; nwg = nM * nN; G = G_; c = c_; }
    __host__ __device__ bool next(int i, Unit& u) const {
        const long L = (long)i * G + c; if (L >= nwg) return false;
        int wgid = (int)L; { const int q = nwg / NXCD, r = nwg % NXCD, xcd = wgid % NXCD, off = wgid / NXCD; wgid = (xcd < r ? xcd * (q + 1) : r * (q + 1) + (xcd - r) * q) + off; }
        const int nig = WGM * nN, gid = wgid / nig, fm = gid * WGM, gsz = (nM - fm) < WGM ? (nM - fm) : WGM;
        u.pm = fm + ((wgid % nig) % gsz); u.pn = (wgid % nig) / gsz; u.k0 = 0; u.nt = 0; return true;
    }
    __device__ __forceinline__ void a_ready(const Unit&) const {}
    __device__ __forceinline__ void done(const Unit&) const {}
};

typedef float f32x2c_t __attribute__((ext_vector_type(2)));
typedef __bf16 bf16x2c_t __attribute__((ext_vector_type(2)));
__device__ __forceinline__ unsigned cvt_pk_bf16(float lo, float hi) { const f32x2c_t v = {lo, hi}; const bf16x2c_t b = __builtin_convertvector(v, bf16x2c_t); return __builtin_bit_cast(unsigned, b); }
typedef float f32x2 __attribute__((ext_vector_type(2)));
#ifndef WGM_DEF
#define WGM_DEF 4
#endif
#ifndef WGM_BR
#define WGM_BR 4
#endif
#ifndef WGM_N8
#define WGM_N8 4
#endif
__device__ __forceinline__ void tile_map(int nM, int nN, int wgid, int& pm, int& pn, int wgm = WGM_DEF) {
    const int nwg = nM * nN;
    { const int q = nwg / NXCD, r = nwg % NXCD, xcd = wgid % NXCD, off = wgid / NXCD; wgid = (xcd < r ? xcd * (q + 1) : r * (q + 1) + (xcd - r) * q) + off; }
    const int nig = wgm * nN, gid = wgid / nig, fm = gid * wgm, gsz = (nM - fm) < wgm ? (nM - fm) : wgm;
    pm = fm + ((wgid % nig) % gsz); pn = (wgid % nig) / gsz;
}
struct TileOrder {
    int nM0, nN0, n0, nM1, nN1, n1, pm1, G, c, ntK, skip1, wgm = WGM_DEF;
    __device__ __forceinline__ void init(int nM0_, int nN0_, int nM1_, int nN1_, int pm1_, int G_, int c_, int ntK_, int skip1_ = -1) { skip1 = skip1_; ntK = ntK_; nM0 = nM0_; nN0 = nN0_; n0 = nM0_ * nN0_; nM1 = nM1_; nN1 = nN1_; n1 = nM1_ * nN1_; pm1 = pm1_; G = G_; c = c_; }
    __device__ __forceinline__ bool next(int i, Unit& u) const {
        long L = (long)i * G + c; u.k0 = 0; u.nt = ntK;
        if (L < n0) { tile_map(nM0, nN0, (int)L, u.pm, u.pn, wgm); return true; }
        L -= n0;
        if (L < n1) { tile_map(nM1, nN1, (int)L, u.pm, u.pn, wgm); u.pm += pm1; if (skip1 >= 0 && u.pn >= skip1) ++u.pn; return true; }
        return false;
    }
    __device__ __forceinline__ void a_ready(const Unit&) const {}
    __device__ __forceinline__ void done(const Unit&) const {}
};
struct QuarterOrder {
    int n, pm0, G, c, ntK;
    __device__ __forceinline__ void init(int nM, int pm0_, int ntq, int G_, int c_) { n = nM * 8 * 4; pm0 = pm0_; ntK = ntq; G = G_; c = c_; }
    __device__ __forceinline__ bool next(int i, Unit& u) const {
        const long L = (long)i * G + c; if (L >= n) return false;
        const int t = (int)L >> 2, qq = (int)L & 3; u.pm = pm0 + (t >> 3); u.pn = t & 7; u.k0 = qq * ntK; u.nt = ntK; return true;
    }
    __device__ __forceinline__ void a_ready(const Unit&) const {}
    __device__ __forceinline__ void done(const Unit&) const {}
};
struct BranchOrder {
    int nM, NPM, G, c; static constexpr int ntK = 8;
    __device__ __forceinline__ void init(int nM_, int NPM_, int G_, int c_) { nM = nM_; NPM = NPM_; G = G_; c = c_; }
    __device__ __forceinline__ bool next(int i, Unit& u) const {
        const long L = (long)(i >> 2) * G + c; if (L >= nM * 8) return false;
        int pm, pn; tile_map(nM, 8, (int)L, pm, pn, WGM_BR); const int n = i & 3;
        u.pm = n * NPM + pm; u.pn = n * 8 + pn; u.k0 = 0; u.nt = 8; return true;
    }
    __device__ __forceinline__ void a_ready(const Unit&) const {}
    __device__ __forceinline__ void done(const Unit&) const {}
};

__device__ __forceinline__ float silu_f(float a) { return a * __builtin_amdgcn_rcpf(1.0f + __expf(-a)); }
__device__ __forceinline__ float sigmoid_f(float a) { return __builtin_amdgcn_rcpf(1.0f + __expf(-a)); }
struct EpiSwiglu {
    static constexpr bool PERM = true, AFTER_DRAIN = false, CHAIN = false;
    bf16_t* O; int ldc;
    __device__ __forceinline__ void operator()(const f32x4 (&acc)[2][2][4][2], const Unit& u, int wr, int wc, int fr, int fq) const {
        const int row0 = u.pm * BM + wr * 64 + fr, col0 = u.pn * HALF + wc * 32 + 8 * fq;
#pragma unroll
        for (int ai = 0; ai < 2; ++ai)
#pragma unroll
            for (int m = 0; m < 4; ++m) { bf16_t* rowp = O + sw_off(row0 + ai * HALF + m * 16, col0, ldc, false);
                const f32x4 a0 = acc[ai][0][m][0], a1 = acc[ai][0][m][1], b0 = acc[ai][1][m][0], b1 = acc[ai][1][m][1];
                f32x4 v0, v1;
#pragma unroll
                for (int j = 0; j < 4; ++j) { v0[j] = silu_f(a0[j]) * b0[j]; v1[j] = silu_f(a1[j]) * b1[j]; }
                u32x4 w; w.x = cvt_pk_bf16(v0[0], v0[1]); w.y = cvt_pk_bf16(v0[2], v0[3]); w.z = cvt_pk_bf16(v1[0], v1[1]); w.w = cvt_pk_bf16(v1[2], v1[3]);
                *(u32x4*)rowp = w; }
    }
};
template <bool ATOMIC  > struct EpiRes {
    static constexpr bool PERM = false, AFTER_DRAIN = false, CHAIN = false;
    float* out_l; float* out_c; const float* gate; float coef;
    __device__ __forceinline__ void operator()(const f32x4 (&acc)[2][2][4][2], const Unit& u, int wr, int wc, int fr, int fq) const {
        const bool isc = u.pm >= 64; const int b9 = isc ? 8 : (u.pm >> 3);
        const int prow = (isc ? (u.pm - 64) : u.pm) * BM + wr * 64 + fr, col0 = u.pn * BM + wc * 32 + 4 * fq;
        float* op = isc ? out_c : out_l;
        const float* gp = gate + (size_t)b9 * 18432 + col0;
        f32x4 gv[2][2];
#pragma unroll
        for (int bj = 0; bj < 2; ++bj)
#pragma unroll
            for (int n = 0; n < 2; ++n) gv[bj][n] = *(const f32x4*)(gp + bj * HALF + n * 16) * coef;
        if constexpr (!ATOMIC) {
#pragma unroll
            for (int ai = 0; ai < 2; ++ai) {
                f32x4 bs[4][2][2];
#pragma unroll
                for (int m = 0; m < 4; ++m)
#pragma unroll
                    for (int bj = 0; bj < 2; ++bj)
#pragma unroll
                        for (int n = 0; n < 2; ++n) bs[m][bj][n] = *(const f32x4*)(op + (size_t)(prow + ai * HALF + m * 16) * 2048 + col0 + bj * HALF + n * 16);
#pragma unroll
                for (int m = 0; m < 4; ++m)
#pragma unroll
                    for (int bj = 0; bj < 2; ++bj)
#pragma unroll
                        for (int n = 0; n < 2; ++n) *(f32x4*)(op + (size_t)(prow + ai * HALF + m * 16) * 2048 + col0 + bj * HALF + n * 16) = bs[m][bj][n] + gv[bj][n] * acc[ai][bj][m][n];
                asm volatile("" ::: "memory");
            }
        } else {
            float* pp = op + (size_t)(u.k0 / u.nt) * ((size_t)2048 * 2048);
#pragma unroll
            for (int ai = 0; ai < 2; ++ai)
#pragma unroll
                for (int m = 0; m < 4; ++m) { const size_t off = (size_t)(prow + ai * HALF + m * 16) * 2048 + col0;
#pragma unroll
                    for (int bj = 0; bj < 2; ++bj)
#pragma unroll
                        for (int n = 0; n < 2; ++n) *(f32x4*)(pp + off + bj * HALF + n * 16) = gv[bj][n] * acc[ai][bj][m][n]; }
        }
    }
};
struct EpiZ {
    static constexpr bool PERM = true, AFTER_DRAIN = false, CHAIN = false;
    bf16_t* Z; float* ZS; int ldz; bf16_t* GT;
    __device__ __forceinline__ void operator()(const f32x4 (&acc)[2][2][4][2], const Unit& u, int wr, int wc, int fr, int fq) const {
        const int row0 = u.pm * BM + wr * 64 + fr, col0 = u.pn * BM + wc * 32 + 8 * fq;
        if (u.pn >= 25) {
            bf16_t* tb = GT + ((size_t)u.pm * 32 + (u.pn - 25)) * 65536 + (size_t)threadIdx.x * 8;
#pragma unroll
            for (int ai = 0; ai < 2; ++ai)
#pragma unroll
                for (int m = 0; m < 4; ++m)
#pragma unroll
                    for (int bj = 0; bj < 2; ++bj) { f32x4 v0 = acc[ai][bj][m][0], v1 = acc[ai][bj][m][1];
#pragma unroll
                        for (int j = 0; j < 4; ++j) { v0[j] = 1.0f + __expf(-fminf(fmaxf(v0[j], -40.f), 40.f)); v1[j] = 1.0f + __expf(-fminf(fmaxf(v1[j], -40.f), 40.f)); }
                        u32x4 w; w.x = cvt_pk_bf16(v0[0], v0[1]); w.y = cvt_pk_bf16(v0[2], v0[3]); w.z = cvt_pk_bf16(v1[0], v1[1]); w.w = cvt_pk_bf16(v1[2], v1[3]);
                        *(u32x4*)(tb + ((ai * 4 + m) * 2 + bj) * 4096) = w; }
            return;
        }
        if (u.pn == 10) {
            if (wc == 0) {
#pragma unroll
                for (int ai = 0; ai < 2; ++ai)
#pragma unroll
                    for (int m = 0; m < 4; ++m) { float* zp = ZS + (size_t)(row0 + ai * HALF + m * 16) * 32 + 8 * fq;
                        *(f32x4*)zp = acc[ai][0][m][0]; *(f32x4*)(zp + 4) = acc[ai][0][m][1]; }
            }
            return;
        }
#pragma unroll
        for (int ai = 0; ai < 2; ++ai)
#pragma unroll
            for (int m = 0; m < 4; ++m) { bf16_t* rowp = Z + (size_t)(row0 + ai * HALF + m * 16) * ldz + col0;
#pragma unroll
                for (int bj = 0; bj < 2; ++bj) { const f32x4 v0 = acc[ai][bj][m][0], v1 = acc[ai][bj][m][1];
                    u32x4 w; w.x = cvt_pk_bf16(v0[0], v0[1]); w.y = cvt_pk_bf16(v0[2], v0[3]); w.z = cvt_pk_bf16(v1[0], v1[1]); w.w = cvt_pk_bf16(v1[2], v1[3]);
                    *(u32x4*)(rowp + bj * HALF) = w; } }
    }
};
struct EpiBranch {
    static constexpr bool PERM = true, AFTER_DRAIN = false, CHAIN = true;
    const bf16_t* GT; bf16_t* Hout; int NPM;
    static __device__ __forceinline__ float epos(float g) { return __expf(-fminf(fmaxf(g, -40.f), 40.f)); }
    __device__ __forceinline__ void chain(f32x4 (&acc)[2][2][4][2], const Unit& u, int wr, int wc, int fr, int fq) const {
        const int n = u.pn >> 3, pn = u.pn & 7, pm = u.pm - n * NPM;
        const int row0 = pm * BM + wr * 64 + fr, col0 = pn * BM + wc * 32 + 8 * fq;
#pragma unroll
        for (int ai = 0; ai < 2; ++ai) {
            u32x4 gaa[4][2], gbb[4][2];
#pragma unroll
            for (int m = 0; m < 4; ++m)
#pragma unroll
                for (int bj = 0; bj < 2; ++bj) { const bf16_t* gp = GT + ((size_t)pm * 32 + n * 8 + pn) * 65536 + ((ai * 4 + m) * 2 + bj) * 4096 + (size_t)threadIdx.x * 8; gaa[m][bj] = *(const u32x4*)gp; gbb[m][bj] = (n < 3) ? *(const u32x4*)(gp + 8 * 65536) : gaa[m][bj]; }
#pragma unroll
            for (int m = 0; m < 4; ++m) { const size_t r = (size_t)(row0 + ai * HALF + m * 16);
#pragma unroll
                for (int bj = 0; bj < 2; ++bj) {
                    const unsigned wa[4] = {gaa[m][bj].x, gaa[m][bj].y, gaa[m][bj].z, gaa[m][bj].w}, wb[4] = {gbb[m][bj].x, gbb[m][bj].y, gbb[m][bj].z, gbb[m][bj].w};
                    f32x4 f0, f1;
#pragma unroll
                    for (int j = 0; j < 4; ++j) { const float ea = (j & 1) ? __uint_as_float(wa[j >> 1] & 0xffff0000u) : __uint_as_float(wa[j >> 1] << 16);
                        const float eb = (j & 1) ? __uint_as_float(wb[j >> 1] & 0xffff0000u) : __uint_as_float(wb[j >> 1] << 16);
                        f0[j] = ((n < 3) ? eb : 1.0f) * __builtin_amdgcn_rcpf(ea); }
#pragma unroll
                    for (int j = 0; j < 4; ++j) { const float ea = (j & 1) ? __uint_as_float(wa[2 + (j >> 1)] & 0xffff0000u) : __uint_as_float(wa[2 + (j >> 1)] << 16);
                        const float eb = (j & 1) ? __uint_as_float(wb[2 + (j >> 1)] & 0xffff0000u) : __uint_as_float(wb[2 + (j >> 1)] << 16);
                        f1[j] = ((n < 3) ? eb : 1.0f) * __builtin_amdgcn_rcpf(ea); }
                    const f32x4 s0 = acc[ai][bj][m][0] * f0, s1 = acc[ai][bj][m][1] * f1;
                    if (n < 3) { acc[ai][bj][m][0] = s0; acc[ai][bj][m][1] = s1; }
                    else { u32x4 w; w.x = cvt_pk_bf16(s0[0], s0[1]); w.y = cvt_pk_bf16(s0[2], s0[3]); w.z = cvt_pk_bf16(s1[0], s1[1]); w.w = cvt_pk_bf16(s1[2], s1[3]);
                        *(u32x4*)(Hout + sw_off((int)r, col0 + bj * HALF, 2048, false)) = w;
                        acc[ai][bj][m][0] = (f32x4){0.f, 0.f, 0.f, 0.f}; acc[ai][bj][m][1] = (f32x4){0.f, 0.f, 0.f, 0.f}; } } }
        }
    }
};
template <class Epi, class Sched, bool ALIGN_EPI = false, bool SP2 = false>
__device__ __forceinline__ void gemm_phase(PG8_LAS unsigned char* lds, const Gemm g, const Sched& S, const Epi& E) {
    const int tid = threadIdx.x, wid = __builtin_amdgcn_readfirstlane(tid >> 6), lane = tid & 63, wr = wid >> 2, wc = wid & 3, fr = lane & 15, fq = lane >> 4;
    const int K = g.K, nt = S.ntK;
    unsigned voffA[2], voffB[2];
#pragma unroll
    for (int i = 0; i < 2; ++i) { int R, C; stage_rc(tid * 16 + i * 8192, R, C); const int Rb = Epi::PERM ? ((R & ~31) + perm32(R & 31)) : R;
        voffA[i] = g.swa ? (unsigned)(tid * 16 + i * 8192) : (unsigned)(R * K + C) * 2u; voffB[i] = g.swb ? (unsigned)(tid * 16 + i * 8192) : (unsigned)(Rb * K + C) * 2u; }
    const size_t kstep = (size_t)(BK * 2);
    const size_t hstep = (size_t)HALF * K * 2;
    const size_t tstep = 2 * hstep;
    const size_t kstepA = g.swa ? (size_t)HTB : kstep, hstepA = g.swa ? (size_t)(K / BK) * HTB : hstep, tstepA = 2 * hstepA;
    const size_t kstepB = g.swb ? (size_t)HTB : kstep, hstepB = g.swb ? (size_t)(K / BK) * HTB : hstep, tstepB = 2 * hstepB;
    const unsigned ldsw = (unsigned)wid * 1024u;
    const int aoff = lds_byte(wr * 64 + fr, fq * 8), boff = lds_byte(wc * 32 + fr, fq * 8);
#define PG8_SA(b, h) (((b) * 2 + (h)) * HTB)
#define PG8_SB(b, h) ((4 + (b) * 2 + (h)) * HTB)
#define PG8_STAGE(bufoff, gbase, voff) do { _Pragma("unroll") for (int _i = 0; _i < 2; ++_i) \
        __builtin_amdgcn_global_load_lds((const unsigned*)((const char*)(gbase) + (voff)[_i]), (PG8_LAS unsigned*)(lds + (bufoff) + ldsw + _i * 8192), 16, 0, 0); } while (0)
#define PG8_LDA(dst, b, h) do { _Pragma("unroll") for (int m = 0; m < 4; ++m) _Pragma("unroll") for (int k = 0; k < 2; ++k) dst[m][k] = *(const PG8_LAS bf16x8*)(lds + PG8_SA(b, h) + aoff + m * 2048 + k * 1024); } while (0)
#define PG8_LDB(dst, b, h) do { _Pragma("unroll") for (int n = 0; n < 2; ++n) _Pragma("unroll") for (int k = 0; k < 2; ++k) dst[n][k] = *(const PG8_LAS bf16x8*)(lds + PG8_SB(b, h) + boff + n * 2048 + k * 1024); } while (0)
#define PG8_MMA(ai, bj, At, Bt) do { __builtin_amdgcn_s_setprio(1); _Pragma("unroll") for (int m = 0; m < 4; ++m) _Pragma("unroll") for (int n = 0; n < 2; ++n) _Pragma("unroll") for (int k = 0; k < 2; ++k) \
        acc[ai][bj][m][n] = __builtin_amdgcn_mfma_f32_16x16x32_bf16(Bt[n][k], At[m][k], acc[ai][bj][m][n], 0, 0, 0); __builtin_amdgcn_s_setprio(0); } while (0)
#define PG8_WAIT_V(n) asm volatile("s_waitcnt vmcnt(" #n ")" ::: "memory")
#define PG8_WAIT_L(n) asm volatile("s_waitcnt lgkmcnt(" #n ")" ::: "memory")
#define PG8_BAR __builtin_amdgcn_s_barrier()
#define PG8_SCHED __builtin_amdgcn_sched_barrier(0)
    Unit cur, nxt; int ui = 0;
    if (!S.next(0, cur)) return;
    f32x4 acc[2][2][4][2];
#pragma unroll
    for (int a = 0; a < 2; ++a)
#pragma unroll
        for (int b = 0; b < 2; ++b)
#pragma unroll
            for (int m = 0; m < 4; ++m)
#pragma unroll
                for (int n = 0; n < 2; ++n) acc[a][b][m][n] = (f32x4){0.f, 0.f, 0.f, 0.f};
    bf16x8 At[4][2], B0[2][2], B1[2][2];
    const char* cA = (const char*)g.A + (size_t)cur.pm * tstepA + (size_t)cur.k0 * kstepA; const char* cB = (const char*)g.Bt + (size_t)cur.pn * tstepB + (size_t)cur.k0 * kstepB;
    S.a_ready(cur);
    if constexpr (SP2) {
        PG8_STAGE(PG8_SB(0, 0), cB, voffB); PG8_STAGE(PG8_SB(0, 1), cB + hstepB, voffB); PG8_STAGE(PG8_SA(0, 0), cA, voffA); PG8_STAGE(PG8_SA(0, 1), cA + hstepA, voffA);
        if (wr == 1) PG8_BAR;
        PG8_WAIT_V(2); PG8_BAR;
        PG8_STAGE(PG8_SB(1, 0), cB + kstepB, voffB); PG8_STAGE(PG8_SA(1, 0), cA + kstepA, voffA); PG8_STAGE(PG8_SB(1, 1), cB + hstepB + kstepB, voffB);
        PG8_WAIT_V(6); PG8_BAR;
    } else {
        PG8_STAGE(PG8_SB(0, 0), cB, voffB); PG8_STAGE(PG8_SA(0, 0), cA, voffA); PG8_STAGE(PG8_SB(0, 1), cB + hstepB, voffB); PG8_STAGE(PG8_SA(0, 1), cA + hstepA, voffA);
        if (wr == 1) PG8_BAR;
        PG8_WAIT_V(4); PG8_BAR;
        PG8_STAGE(PG8_SB(1, 0), cB + kstepB, voffB); PG8_STAGE(PG8_SA(1, 0), cA + kstepA, voffA); PG8_STAGE(PG8_SB(1, 1), cB + hstepB + kstepB, voffB);
        PG8_WAIT_V(6); PG8_BAR;
    }
    for (;;) {
        const bool has_next = S.next(ui + 1, nxt);
        const char* nA = has_next ? (const char*)g.A + (size_t)nxt.pm * tstepA + (size_t)nxt.k0 * kstepA : cA; const char* nB = has_next ? (const char*)g.Bt + (size_t)nxt.pn * tstepB + (size_t)nxt.k0 * kstepB : cB;
        for (int t = 0; t < nt; t += 2) {
            const bool last = (t == nt - 2);
            const char* a1 = cA + (size_t)(t + 1) * kstepA;
            const char* a2 = last ? nA : cA + (size_t)(t + 2) * kstepA; const char* b2 = last ? nB : cB + (size_t)(t + 2) * kstepB;
            const char* a3 = a2 + kstepA; const char* b3 = b2 + kstepB;
            if (last && has_next) S.a_ready(nxt);
            if constexpr (SP2) {
            PG8_LDB(B0, 0, 0); PG8_LDB(B1, 0, 1); PG8_SCHED; PG8_LDA(At, 0, 0); PG8_STAGE(PG8_SA(1, 1), a1 + hstepA, voffA);
            PG8_WAIT_V(8); PG8_WAIT_L(0); PG8_BAR; PG8_MMA(0, 0, At, B0); PG8_MMA(0, 1, At, B1); PG8_BAR; PG8_SCHED;
            PG8_LDA(At, 0, 1); PG8_STAGE(PG8_SB(0, 0), b2, voffB); PG8_STAGE(PG8_SB(0, 1), b2 + hstepB, voffB); PG8_STAGE(PG8_SA(0, 0), a2, voffA);
            PG8_WAIT_V(8); PG8_WAIT_L(0); PG8_BAR; PG8_MMA(1, 0, At, B0); PG8_MMA(1, 1, At, B1); PG8_BAR; PG8_SCHED;
            PG8_LDB(B0, 1, 0); PG8_LDB(B1, 1, 1); PG8_SCHED; PG8_LDA(At, 1, 0); PG8_STAGE(PG8_SA(0, 1), a2 + hstepA, voffA);
            PG8_WAIT_V(8); PG8_WAIT_L(0); PG8_BAR; PG8_MMA(0, 0, At, B0); PG8_MMA(0, 1, At, B1); PG8_BAR; PG8_SCHED;
            PG8_LDA(At, 1, 1); PG8_STAGE(PG8_SB(1, 0), b3, voffB); PG8_STAGE(PG8_SB(1, 1), b3 + hstepB, voffB); PG8_STAGE(PG8_SA(1, 0), a3, voffA);
            PG8_WAIT_V(8); PG8_WAIT_L(0); PG8_BAR; PG8_MMA(1, 0, At, B0); PG8_MMA(1, 1, At, B1); PG8_BAR; PG8_SCHED;
            } else {
            PG8_LDB(B0, 0, 0); PG8_SCHED; PG8_LDA(At, 0, 0); PG8_STAGE(PG8_SA(1, 1), a1 + hstepA, voffA);
            PG8_WAIT_L(8); PG8_BAR; PG8_WAIT_L(0); PG8_MMA(0, 0, At, B0); PG8_BAR; PG8_SCHED;
            PG8_LDB(B1, 0, 1); PG8_STAGE(PG8_SB(0, 0), b2, voffB);
            PG8_BAR; PG8_WAIT_L(0); PG8_MMA(0, 1, At, B1); PG8_BAR;
            PG8_LDA(At, 0, 1); PG8_STAGE(PG8_SA(0, 0), a2, voffA);
            PG8_BAR; PG8_WAIT_L(0); PG8_MMA(1, 0, At, B0); PG8_BAR; PG8_SCHED;
            PG8_STAGE(PG8_SB(0, 1), b2 + hstepB, voffB);
            PG8_WAIT_V(6); PG8_BAR; PG8_MMA(1, 1, At, B1); PG8_BAR;
            PG8_LDB(B0, 1, 0); PG8_SCHED; PG8_LDA(At, 1, 0); PG8_STAGE(PG8_SA(0, 1), a2 + hstepA, voffA);
            PG8_WAIT_L(8); PG8_BAR; PG8_WAIT_L(0); PG8_MMA(0, 0, At, B0); PG8_BAR; PG8_SCHED;
            PG8_LDB(B1, 1, 1); PG8_STAGE(PG8_SB(1, 0), b3, voffB);
            PG8_BAR; PG8_WAIT_L(0); PG8_MMA(0, 1, At, B1); PG8_BAR;
            PG8_LDA(At, 1, 1); PG8_STAGE(PG8_SA(1, 0), a3, voffA);
            PG8_BAR; PG8_WAIT_L(0); PG8_MMA(1, 0, At, B0); PG8_BAR; PG8_SCHED;
            PG8_STAGE(PG8_SB(1, 1), b3 + hstepB, voffB);
            PG8_WAIT_V(6); PG8_BAR; PG8_MMA(1, 1, At, B1); PG8_BAR;
            }
        }
        if constexpr (ALIGN_EPI) { if (wr == 0) PG8_BAR; }
        if constexpr (Epi::CHAIN) { E.chain(acc, cur, wr, wc, fr, fq); S.done(cur); }
        else if constexpr (!Epi::AFTER_DRAIN) { E(acc, cur, wr, wc, fr, fq); S.done(cur); }
        if (!has_next) break;
        if constexpr (!Epi::CHAIN) {
#pragma unroll
        for (int a = 0; a < 2; ++a)
#pragma unroll
            for (int b = 0; b < 2; ++b)
#pragma unroll
                for (int m = 0; m < 4; ++m)
#pragma unroll
                    for (int n = 0; n < 2; ++n) acc[a][b][m][n] = (f32x4){0.f, 0.f, 0.f, 0.f};
        }
        cur = nxt; cA = nA; cB = nB; ++ui;
        if constexpr (ALIGN_EPI) { if (wr == 1) PG8_BAR; }
    }
    PG8_WAIT_V(0);
    if constexpr (!ALIGN_EPI) { if (wr == 0) PG8_BAR; }
    PG8_BAR;
    if constexpr (Epi::AFTER_DRAIN) { E.fused(acc, cur, wr, wc, fr, fq, lds, wid, lane); S.done(cur); }
#undef PG8_SA
#undef PG8_SB
#undef PG8_STAGE
#undef PG8_LDA
#undef PG8_LDB
#undef PG8_MMA
#undef PG8_WAIT_V
#undef PG8_WAIT_L
#undef PG8_BAR
#undef PG8_SCHED
}
}
#ifndef PG8_SP2
#define PG8_SP2 true
#endif
#ifndef PG8_ALIGN
#define PG8_ALIGN true
#endif
constexpr int NWAVES = 8;
constexpr int D = 2048, BATCH = 8, SEQ = 2048, CTXL = 256, DFF = 5632, NLAYER = 2;
constexpr int ML = BATCH * SEQ, MC = BATCH * CTXL, MT = ML + MC;
constexpr int ZLD = 6400;
constexpr int NZ = 14592;
constexpr int MODW = 9 * D;
constexpr int INC = 14368;
constexpr float EPS = 1e-6f;
constexpr int ZC_MLK = 0, ZC_MLV = 512, ZC_GDK = 1024, ZC_GDV = 1536, ZC_ATK = 2048, ZC_ATV = 2304, ZC_SMALL = 2560, ZC_SGU = 2816, ZC_SGV = 3328,
              ZC_MLQ = 3840, ZC_MLO = 4352, ZC_GDQ = 4864, ZC_GDZ = 5376, ZC_ATQ = 5888, ZC_GATE = 6400;
constexpr int NKV_TILES = 11;

constexpr size_t MiB = 1u << 20;
constexpr size_t WS_CTL = 0, CTL_ZERO_BYTES = 1 * MiB;
constexpr size_t WS_MOD = 1 * MiB;
constexpr size_t WS_ROPE = 3 * MiB;
constexpr size_t WS_XC = 4 * MiB;
constexpr size_t WS_WFI = 20 * MiB;
constexpr size_t WS_WFO = 64 * MiB;
constexpr size_t WS_WZ = 86 * MiB;
constexpr size_t WS_WB = 143 * MiB;
constexpr size_t WS_WO = 151 * MiB;
constexpr size_t WS_H = 159 * MiB;
constexpr size_t WS_Z = 231 * MiB;
constexpr size_t WS_GT = WS_Z + (size_t)18432 * 6400 * 2;
constexpr size_t WS_ZS = 744 * MiB;
constexpr size_t WS_Y = 747 * MiB;
constexpr size_t WS_QA = 819 * MiB;
constexpr size_t WS_KC = 837 * MiB;
constexpr size_t WS_VC = 846 * MiB;
constexpr size_t WS_MIX = 855 * MiB;
constexpr size_t WS_END = 1150 * MiB;
static_assert(WS_GT + (size_t)72 * 32 * 131072 <= WS_ZS && WS_Z + (size_t)MT * NZ * 2 <= WS_ZS && WS_H + (size_t)MT * D * 2 <= WS_Z && WS_Y + (size_t)4 * MT * 512 * 2 <= WS_QA, "d_ws map");
static_assert(WS_WFI + (size_t)2 * DFF * D * 2 <= WS_WFO && WS_WFO + (size_t)D * DFF * 2 <= WS_WZ && WS_WZ + (size_t)NZ * D * 2 <= WS_WB, "d_ws map (weights)");
constexpr int CW_TMO = 0, CW_CODE = 1, CW_BAR = 4096;

constexpr int RING_OFF = 0, RING_BYTES = 131072;
constexpr int LDSCTL_OFF = RING_BYTES, MISC_OFF = LDSCTL_OFF + 320;
constexpr int NORM_P_OFF = RING_BYTES + 1024;
constexpr int LDS_BYTES = 163840;

#define GAS __attribute__((address_space(1)))
#define LAS __attribute__((address_space(3)))
typedef unsigned short bf16;
typedef unsigned v4u __attribute__((ext_vector_type(4)));
typedef unsigned v2u __attribute__((ext_vector_type(2)));
typedef float f32x4 __attribute__((ext_vector_type(4)));
typedef short bf16x8 __attribute__((ext_vector_type(8)));
typedef GAS unsigned gu32;
#define RLX_AGENT __ATOMIC_RELAXED, __HIP_MEMORY_SCOPE_AGENT
#define LDS_WAIT() asm volatile("s_waitcnt lgkmcnt(0)" ::: "memory")
#define VM_WAIT() asm volatile("s_waitcnt vmcnt(0)" ::: "memory")
typedef float f32x2_t __attribute__((ext_vector_type(2)));
typedef __bf16 bf16x2_t __attribute__((ext_vector_type(2)));
__device__ __forceinline__ unsigned pk2(float lo, float hi) { const f32x2_t v = {lo, hi}; const bf16x2_t b = __builtin_convertvector(v, bf16x2_t); return __builtin_bit_cast(unsigned, b); }
__device__ __forceinline__ float bflo(unsigned w) { return __uint_as_float(w << 16); }
__device__ __forceinline__ float bfhi(unsigned w) { return __uint_as_float(w & 0xffff0000u); }
__device__ __forceinline__ float bf1(bf16 b) { return __uint_as_float(((unsigned)b) << 16); }
__device__ __forceinline__ bf16 f2bf1(float f) { return (bf16)(pk2(f, 0.f) & 0xffffu); }
__device__ __forceinline__ float silu1(float a) { return a / (1.0f + __expf(-a)); }
__device__ __forceinline__ float sigm1(float a) { return 1.0f / (1.0f + __expf(-a)); }
__device__ __forceinline__ float wave_sum(float v) {
#pragma unroll
    for (int o = 1; o < 64; o <<= 1) v += __shfl_xor(v, o);
    return v;
}

#ifndef TPROBE
#define TPROBE 0
#endif
#if TPROBE == 2
#define TSTAMP(i) do { if (blockIdx.x == 0 && F.tid == 0) ((unsigned long long*)(F.ws + WS_CTL + 524288))[40 + (i)] = wall_clock64(); } while (0)
#else
#define TSTAMP(i) do {} while (0)
#endif
#define XB_TMO      128
#define XB_XCNT(j)  (256  + 64 * (j))
#define XB_XSUB(j)  (1280 + 64 * (j))
#define XB_XGEN(j)  (2304 + 64 * (j))
#define XB_TOP      3328
#define XB_TOPGEN   3392
#define XCD_BAR_WORDS 3456
#define XB_SPIN_CAP (1u << 18)

__device__ __forceinline__ unsigned xb_ld(unsigned* p)              { return __hip_atomic_load(p, __ATOMIC_RELAXED, __HIP_MEMORY_SCOPE_AGENT); }
__device__ __forceinline__ unsigned xb_add(unsigned* p, unsigned v) { return __hip_atomic_fetch_add(p, v, __ATOMIC_RELAXED, __HIP_MEMORY_SCOPE_AGENT); }
__device__ __forceinline__ unsigned xb_xcc_id() { return (unsigned)__builtin_amdgcn_s_getreg((3 << 11) | 20) & 0xFu; }
#define XB_SPIN(cond, bar) do { unsigned _sp = 0; while (cond) { __builtin_amdgcn_s_sleep(1); \
    if ((++_sp & 255u) == 0u) { if (xb_ld(&(bar)[XB_TMO])) break; if (_sp > XB_SPIN_CAP) { atomicAdd(&(bar)[XB_TMO], 1u); break; } } } } while (0)

struct XcdBarrier {
    unsigned* bar; unsigned x;
    volatile LAS unsigned* st;
};

__device__ __forceinline__ XcdBarrier xcd_barrier_post(unsigned* bar, volatile LAS unsigned* st) {
    XcdBarrier b; b.bar = bar; b.x = xb_xcc_id(); b.st = st;
    if (threadIdx.x == 0) (void)xb_add(&bar[XB_XCNT(b.x)], 1u);
    return b;
}
__device__ __forceinline__ void xcd_barrier_complete(unsigned* bar, unsigned x, unsigned& nloc, unsigned& nx) {
    const unsigned G = gridDim.x * gridDim.y * gridDim.z;
    unsigned sum, cnt, mine, sp = 0u;
    for (;;) {
        sum = 0u; cnt = 0u; mine = 0u;
#pragma unroll
        for (unsigned j = 0; j < 16; ++j) { const unsigned c = xb_ld(&bar[XB_XCNT(j)]); sum += c; cnt += (c > 0u) ? 1u : 0u; mine = (j == x) ? c : mine; }
        if (sum == G) break;
        __builtin_amdgcn_s_sleep(1);
        if ((++sp & 255u) == 0u) { if (xb_ld(&bar[XB_TMO])) break; if (sp > XB_SPIN_CAP) { atomicAdd(&bar[XB_TMO], 1u); break; } }
    }
    nloc = mine > 0u ? mine : 1u; nx = cnt > 0u ? cnt : 1u;
}

__device__ __forceinline__ void xcd_barrier(const XcdBarrier& b) {
    asm volatile("s_waitcnt vmcnt(0)" ::: "memory");
    __syncthreads();
    if (threadIdx.x == 0) {
        unsigned* bar = b.bar;
        __builtin_amdgcn_s_waitcnt(0);
        unsigned nloc = b.st[0], nx = b.st[1];
        if (nloc == 0u) { xcd_barrier_complete(bar, b.x, nloc, nx); b.st[0] = nloc; b.st[1] = nx; }
        const unsigned old = xb_add(&bar[XB_XSUB(b.x)], 1u);
        const unsigned gen = old / nloc;
        if (old + 1u == (gen + 1u) * nloc) {
            __builtin_amdgcn_fence(__ATOMIC_RELEASE, "agent");
            asm volatile("s_waitcnt vmcnt(0)" ::: "memory");
            const unsigned og = xb_add(&bar[XB_TOP], 1u);
            const unsigned tg = og / nx;
            if (og + 1u == (tg + 1u) * nx) xb_add(&bar[XB_TOPGEN], 1u);
            else XB_SPIN(xb_ld(&bar[XB_TOPGEN]) == tg, bar);
            __builtin_amdgcn_fence(__ATOMIC_ACQUIRE, "agent");
            xb_add(&bar[XB_XGEN(b.x)], 1u);
            asm volatile("s_waitcnt vmcnt(0)" ::: "memory");
        } else {
            XB_SPIN(xb_ld(&bar[XB_XGEN(b.x)]) == gen, bar);
            __builtin_amdgcn_fence(__ATOMIC_ACQUIRE, "agent");
            asm volatile("s_waitcnt vmcnt(0)" ::: "memory");
        }
    }
    __syncthreads();
}
struct Frame {
    LAS unsigned char* lds;
    volatile LAS unsigned* MISC;
    gu32* ctl;
    int tid, lane, wave, G;
    unsigned char* ws;
    const float* const* in;
    float* out;
};
enum { I_X = 0, I_C, I_CTX, I_CCTX, I_MODW, I_MODB, I_F1N, I_F1WI, I_F1WO, I_MIXN, I_WIN, I_SGN, I_SGW, I_SGB, I_MLIFB, I_MLN, I_GDCONV, I_GDALOG, I_GDDTB, I_GDN,
       I_ATQN, I_ATKN, I_WBR, I_WOUT, I_F2N, I_F2WI, I_F2WO };

__device__ __forceinline__ void phase_mod(Frame& F) {
    LAS float* tab = (LAS float*)(F.lds + RING_OFF);
    LAS float* red = (LAS float*)(F.lds + RING_OFF);
    const float* c = F.in[I_C]; const float* cc = F.in[I_CCTX];
    float* MOD = (float*)(F.ws + WS_MOD);
    const int ntot = 2 * MODW, per = (ntot / 4 + F.G - 1) / F.G * 4;
    for (int n0 = blockIdx.x * per; n0 < ntot; n0 += F.G * per) {
        const int ncol = (ntot - n0) < per ? (ntot - n0) : per;
        for (int cb = 0; cb < ncol; cb += 256) {
            for (int i = F.tid; i < 9 * D; i += NWAVES * 64) { const int b = i / D, k = i % D; const float x = b < 8 ? c[b * D + k] : cc[k]; tab[k * 12 + b] = silu1(x); }
            __syncthreads();
            const int cl = cb + 4 * F.lane; const bool act = cl < ncol; const int gcol = n0 + cl, l = gcol / MODW, nn = gcol % MODW;
            f32x4 acc[9];
#pragma unroll
            for (int b = 0; b < 9; ++b) acc[b] = (f32x4){0.f, 0.f, 0.f, 0.f};
            if (act) { const float* W = F.in[I_MODW] + (size_t)l * D * MODW + nn; const int k0 = F.wave * 256;
                for (int k = k0; k < k0 + 256; k += 8) {
                    f32x4 w[8];
#pragma unroll
                    for (int j = 0; j < 8; ++j) w[j] = *(const f32x4*)(W + (size_t)(k + j) * MODW);
#pragma unroll
                    for (int j = 0; j < 8; ++j) { const LAS f32x4* tp = (const LAS f32x4*)(tab + (k + j) * 12); const f32x4 s0 = tp[0], s1 = tp[1], s2 = tp[2];
                        acc[0] += w[j] * s0[0]; acc[1] += w[j] * s0[1]; acc[2] += w[j] * s0[2]; acc[3] += w[j] * s0[3];
                        acc[4] += w[j] * s1[0]; acc[5] += w[j] * s1[1]; acc[6] += w[j] * s1[2]; acc[7] += w[j] * s1[3]; acc[8] += w[j] * s2[0]; } } }
            __syncthreads();
            if (act) {
#pragma unroll
                for (int b = 0; b < 9; ++b) *(LAS f32x4*)(red + ((F.wave * 9 + b) * 64 + F.lane) * 4) = acc[b]; }
            __syncthreads();
            for (int i = F.tid; i < 9 * 64; i += NWAVES * 64) { const int b = i / 64, ln = i % 64; const int cl2 = cb + 4 * ln;
                if (cl2 < ncol) { f32x4 s = (f32x4){0.f, 0.f, 0.f, 0.f};
#pragma unroll
                    for (int w = 0; w < 8; ++w) s += *(const LAS f32x4*)(red + ((w * 9 + b) * 64 + ln) * 4);
                    const int gcol2 = n0 + cl2, l2 = gcol2 / MODW, nn2 = gcol2 % MODW;
                    *(f32x4*)(MOD + (size_t)(l2 * 9 + b) * MODW + nn2) = s + *(const f32x4*)(F.in[I_MODB] + (size_t)l2 * MODW + nn2); } }
            __syncthreads();
        }
    }
}
__device__ __forceinline__ void phase_rope(Frame& F) {
    float* RC = (float*)(F.ws + WS_ROPE); float* RS = RC + 96 * 32;
    const int idx = blockIdx.x * (NWAVES * 64) + F.tid;
    if (idx < 96 * 32) {
        const int pos = idx >> 5, i = idx & 31; const float p = (float)(pos < 32 ? pos : pos - 32);
        const float inv = exp2f(-(float)i * (13.287712379549449f / 32.0f));
        const float x = p * inv;
        const float kf = rintf(x * 0.6366197723675814f);
        float r = fmaf(-kf, 1.5707963705062866f, x); r = fmaf(-kf, -4.371138828673793e-8f, r);
        const float r2 = r * r;
        const float sn = r + r * r2 * (-1.6666667163e-1f + r2 * (8.3333337680e-3f + r2 * (-1.9841270114e-4f + r2 * 2.7557314297e-6f)));
        const float cs = 1.0f + r2 * (-0.5f + r2 * (4.1666667908e-2f + r2 * (-1.3888889225e-3f + r2 * (2.4801587642e-5f + r2 * -2.7557314297e-7f))));
        const int q = ((int)kf) & 3;
        const float sv = (q == 0) ? sn : (q == 1) ? cs : (q == 2) ? -sn : -cs;
        const float cv = (q == 0) ? cs : (q == 1) ? -sn : (q == 2) ? -cs : sn;
        RC[idx] = cv; RS[idx] = sv;
    }
}
template <int MAP> __device__ __forceinline__ int dst_row(int n) {
    if (MAP == 0) return n;
    if (MAP == 1) { const int half = n >= DFF ? 1 : 0, j = n - half * DFF; return (j >> 7) * 256 + half * 128 + (j & 127); }
    if (n < 1024) return n;
    if (n < 1040) return ZC_SMALL + (n - 1024);
    if (n < 2064) return 1024 + (n - 1040);
    if (n < 2080) return ZC_SMALL + 16 + (n - 2064);
    if (n < 2592) return 2048 + (n - 2080);
    return n + 224;
}
__device__ __forceinline__ int dst_row_rt(int map, int n) { return map == 0 ? dst_row<0>(n) : (map == 1 ? dst_row<1>(n) : dst_row<2>(n)); }
struct ConvSrc { const float* W; bf16* WT; int K, N, map, perm, item; };
__device__ __forceinline__ ConvSrc conv_decode(Frame& F, int l, int set, int it) {
    constexpr int I_FI = (D / 64) * (2 * DFF / 32), I_FO = (DFF / 64) * (D / 32), I_Z = (D / 64) * (INC / 32), I_B = (512 / 64) * (D / 32);
    ConvSrc c; int r = it;
    if (set < 2) {
        if (r < I_FI) { c.W = F.in[set == 1 ? I_F2WI : I_F1WI] + (size_t)l * D * 2 * DFF; c.WT = (bf16*)(F.ws + WS_WFI); c.K = D; c.N = 2 * DFF; c.map = 1; c.perm = 1; c.item = r; return c; }
        r -= I_FI; c.W = F.in[set == 1 ? I_F2WO : I_F1WO] + (size_t)l * DFF * D; c.WT = (bf16*)(F.ws + WS_WFO); c.K = DFF; c.N = D; c.map = 0; c.perm = 0; c.item = r; return c;
    }
    if (r < I_Z) { c.W = F.in[I_WIN] + (size_t)l * D * INC; c.WT = (bf16*)(F.ws + WS_WZ); c.K = D; c.N = INC; c.map = 2; c.perm = 1; c.item = r; return c; }
    r -= I_Z;
    if (r < 4 * I_B) { const int n = r / I_B; c.W = F.in[I_WBR] + ((size_t)l * 4 + n) * 512 * D; c.WT = (bf16*)(F.ws + WS_WB) + (size_t)n * D * 512; c.K = 512; c.N = D; c.map = 0; c.perm = 1; c.item = r % I_B; return c; }
    r -= 4 * I_B; c.W = F.in[I_WOUT] + (size_t)l * D * D; c.WT = (bf16*)(F.ws + WS_WO); c.K = D; c.N = D; c.map = 0; c.perm = 0; c.item = r; return c;
}
__device__ __forceinline__ void conv_load(const ConvSrc& c, float (&r)[32], int lane) {
    const int nblk = c.N / 32, k0 = 64 * (c.item / nblk), n0 = 32 * (c.item % nblk);
    const float* p = c.W + (size_t)(k0 + (lane >> 5)) * c.N + n0 + (lane & 31);
#pragma unroll
    for (int i = 0; i < 32; ++i) r[i] = p[(size_t)(2 * i) * c.N];
}
__device__ __forceinline__ void conv_set(Frame& F, int l, int set) {
    LAS float* scr = (LAS float*)(F.lds + RING_OFF + F.wave * 16384);
    const int gw = blockIdx.x * NWAVES + F.wave, NGW = F.G * NWAVES, lane = F.lane;
    constexpr int I_FI = (D / 64) * (2 * DFF / 32), I_FO = (DFF / 64) * (D / 32), I_Z = (D / 64) * (INC / 32), I_B = (512 / 64) * (D / 32), I_O = (D / 64) * (D / 32);
    const int NIT = set < 2 ? (I_FI + I_FO) : (I_Z + 4 * I_B + I_O);
    float r[32]; ConvSrc cur, nxt;
    int it = gw;
    if (it < NIT) { cur = conv_decode(F, l, set, it); conv_load(cur, r, lane); }
    while (it < NIT) {
#pragma unroll
        for (int i = 0; i < 32; ++i) scr[(2 * i + (lane >> 5)) * 33 + (lane & 31)] = r[i];
        const int nit = it + NGW;
        if (nit < NIT) { nxt = conv_decode(F, l, set, nit); conv_load(nxt, r, lane); }
        LDS_WAIT(); asm volatile("" ::: "memory");
        { const int nblk = cur.N / 32, k0 = 64 * (cur.item / nblk), n0 = 32 * (cur.item % nblk), c = lane & 7;
#pragma unroll
          for (int j = 0; j < 4; ++j) { const int n = (lane >> 3) + 8 * j; const LAS float* s = scr + (8 * c) * 33 + n;
              v4u o; o.x = pk2(s[0 * 33], s[1 * 33]); o.y = pk2(s[2 * 33], s[3 * 33]); o.z = pk2(s[4 * 33], s[5 * 33]); o.w = pk2(s[6 * 33], s[7 * 33]);
              *(GAS v4u*)(cur.WT + pg8::sw_off(dst_row_rt(cur.map, n0 + n), k0 + 8 * c, cur.K, cur.perm != 0)) = o; } }
        LDS_WAIT(); asm volatile("" ::: "memory");
        cur = nxt; it = nit;
    }
    if (set == 2) {
        bf16* WZ = (bf16*)(F.ws + WS_WZ);
        GAS v4u* z = (GAS v4u*)(WZ + (size_t)(10 * 2) * (D / 64) * 8192); const int npc = 2 * (D / 64) * 1024;
        for (int i = blockIdx.x * (NWAVES * 64) + F.tid; i < npc; i += F.G * NWAVES * 64) { int R, C; pg8::stage_rc((i & 1023) * 16, R, C); const int h = i / (1024 * (D / 64));
            const int rowt = 128 * h + ((R & ~31) + pg8::perm32(R & 31)); if (rowt >= 32) z[i] = (v4u){0u, 0u, 0u, 0u}; }
    }
}
template <bool COPY, bool ADDP, bool ZSM> __device__ __forceinline__ void phase_norm(Frame& F, const float* xl, const float* xc, const float* gain, const float* mod  , int nrows) {
    bf16* H = (bf16*)(F.ws + WS_H);
    const int gw = blockIdx.x * NWAVES + F.wave, NGW = F.G * NWAVES;
    LAS f32x4* PA = (LAS f32x4*)(F.lds + NORM_P_OFF); LAS f32x4* PB = PA + D / 4;
    const bool uni = (NGW == SEQ);
    if (ZSM) {
        const bf16* wz = (const bf16*)(F.ws + WS_WZ);
        for (int i = F.tid; i < 32 * D * 2 / 16; i += NWAVES * 64) { const int c = i / (D / 8), k8 = (i % (D / 8)) * 8;
            *(LAS v4u*)(F.lds + RING_OFF + i * 16) = *(const GAS v4u*)(wz + pg8::sw_off(ZC_SMALL + c, k8, D, true)); }
    }
    f32x4 vn[8];
    if (gw < nrows) { const bool isc0 = gw >= ML; const GAS f32x4* xr0 = (const GAS f32x4*)(isc0 ? xc + (size_t)(gw - ML) * D : xl + (size_t)gw * D) + F.lane;
#pragma unroll
        for (int j = 0; j < 8; ++j) vn[j] = xr0[64 * j]; }
    for (int row = gw; row < nrows; row += NGW) {
        const bool isc = row >= ML; const int b9 = isc ? 8 : row / SEQ;
        __syncthreads();
        if (uni) { const float* sh = mod + (size_t)b9 * MODW; const float* sc = sh + D; const int c = 4 * F.tid;
            const f32x4 g = *(const f32x4*)(gain + c), a = *(const f32x4*)(sc + c), b = *(const f32x4*)(sh + c);
            PA[F.tid] = g * (a + 1.0f); PB[F.tid] = b; }
        __syncthreads();
        f32x4 v[8]; float s = 0.f;
#pragma unroll
        for (int j = 0; j < 8; ++j) v[j] = vn[j];
        { const int nr = row + NGW; if (nr < nrows) { const bool iscn = nr >= ML; const GAS f32x4* xrn = (const GAS f32x4*)(iscn ? xc + (size_t)(nr - ML) * D : xl + (size_t)nr * D) + F.lane;
#pragma unroll
            for (int j = 0; j < 8; ++j) vn[j] = xrn[64 * j]; } }
        if (ADDP && isc) {
            const GAS f32x4* pr = (const GAS f32x4*)((const float*)(F.ws + WS_MIX) + (size_t)(row - ML) * D) + F.lane;
#pragma unroll
            for (int q = 0; q < 4; ++q)
#pragma unroll
                for (int j = 0; j < 8; ++j) v[j] = v[j] + pr[(size_t)q * (2048 * 2048 / 4) + 64 * j];
            GAS f32x4* xw = (GAS f32x4*)((float*)(F.ws + WS_XC) + (size_t)(row - ML) * D) + F.lane;
#pragma unroll
            for (int j = 0; j < 8; ++j) xw[64 * j] = v[j];
        }
#pragma unroll
        for (int j = 0; j < 8; ++j) s += (v[j].x * v[j].x + v[j].y * v[j].y) + (v[j].z * v[j].z + v[j].w * v[j].w);
        if (COPY) { GAS f32x4* cp = (GAS f32x4*)(isc ? (float*)(F.ws + WS_XC) + (size_t)(row - ML) * D : F.out + (size_t)row * D) + F.lane;
#pragma unroll
            for (int j = 0; j < 8; ++j) cp[64 * j] = v[j]; }
        const float rstd = 1.0f / sqrtf(wave_sum(s) * (1.0f / D) + EPS);
        const float* sh = mod + (size_t)b9 * MODW; const float* sc = sh + D;
#pragma unroll
        for (int j = 0; j < 8; ++j) { const int c = 4 * F.lane + 256 * j;
            f32x4 pa, pb;
            if (uni) { pa = PA[F.lane + 64 * j]; pb = PB[F.lane + 64 * j]; }
            else { const f32x4 g = *(const f32x4*)(gain + c), a = *(const f32x4*)(sc + c); pa = g * (a + 1.0f); pb = *(const f32x4*)(sh + c); }
            const f32x4 y = (v[j] * rstd) * pa + pb;
            if (ZSM) v[j] = y;
            v2u w; w.x = pk2(y.x, y.y); w.y = pk2(y.z, y.w); *(GAS v2u*)(H + pg8::sw_off(row, c & ~7, D, false) + (c & 7)) = w; }
        if (ZSM && isc) {
            float res = 0.f;
            for (int c = 0; c < 32; ++c) { const LAS v2u* wr = (const LAS v2u*)(F.lds + RING_OFF + c * (D * 2)) + F.lane; float s2 = 0.f;
#pragma unroll
                for (int j = 0; j < 8; ++j) { const v2u w = wr[64 * j]; s2 += v[j].x * bflo(w.x) + v[j].y * bfhi(w.x) + v[j].z * bflo(w.y) + v[j].w * bfhi(w.y); }
                s2 = wave_sum(s2); res = (F.lane == c) ? s2 : res; }
            if (F.lane < 32) ((float*)(F.ws + WS_ZS))[(size_t)row * 32 + F.lane] = res;
        }
    }
}
#include <hip/hip_bf16.h>
namespace attn {
using bf16 = __hip_bfloat16;
constexpr int   D = 128, NW = 8, QBLK = 32, KVBLK = 64;
constexpr float SCALE = 0.088388347648318440f;
constexpr float THR = 8.f;
constexpr int SDEPTH = 2;
constexpr int LDQ = 512, LDK = 256, LDO = 512;
constexpr size_t SHM_V = KVBLK * D * 2, SHM_K = KVBLK * D * 2, SHM_ATTN = 2 * SHM_V + 2 * SHM_K + NW * 64 * 4;
using bf16x8 = __attribute__((ext_vector_type(8))) short;
using s16x4  = __attribute__((ext_vector_type(4))) short;
using f32x16 = __attribute__((ext_vector_type(16))) float;
using f32x8  = __attribute__((ext_vector_type(8))) float;
using u32x4  = __attribute__((ext_vector_type(4))) unsigned;
#define KSWZ(row, colB) ((row) * 256 + ((colB) ^ (((row) & 7) << 4)))
#define SBAR() __builtin_amdgcn_sched_barrier(0)
__device__ __forceinline__ int crow(int r, int hi) { return (r & 3) + 8 * (r >> 2) + 4 * hi; }
__device__ __forceinline__ unsigned cvtpk(float lo, float hi) {
  unsigned r; asm volatile("v_cvt_pk_bf16_f32 %0, %1, %2" : "=v"(r) : "v"(lo), "v"(hi)); return r;
}
template <typename TIn> struct Stage;
template <> struct Stage<bf16>  { using T = bf16x8;
  __device__ static __forceinline__ T ld8(const bf16* p) { return *reinterpret_cast<const bf16x8*>(p); }
  __device__ static __forceinline__ bf16x8 tobf(T x) { return x; } };
template <> struct Stage<float> { using T = f32x8;
  __device__ static __forceinline__ T ld8(const float* p) { return *reinterpret_cast<const f32x8*>(p); }
  __device__ static __forceinline__ bf16x8 tobf(T x) {
    u32x4 w = {cvtpk(x[0], x[1]), cvtpk(x[2], x[3]), cvtpk(x[4], x[5]), cvtpk(x[6], x[7])}; return *reinterpret_cast<bf16x8*>(&w); } };

__device__ __forceinline__ void partialSM(f32x16& p0, f32x16& p1, float& m_reg, float& mn, float& alpha) {
  constexpr float C = SCALE * 1.4426950408889634f;
  float pmax = p0[0]; for (int r = 1; r < 16; ++r) pmax = fmaxf(pmax, p0[r]); for (int r = 0; r < 16; ++r) pmax = fmaxf(pmax, p1[r]);
  { auto rr = __builtin_amdgcn_permlane32_swap(__float_as_uint(pmax), __float_as_uint(pmax), false, false);
    pmax = fmaxf(__uint_as_float(rr[0]), __uint_as_float(rr[1])); }
  if (__builtin_expect(__all(pmax - m_reg <= THR / SCALE), 1)) { mn = m_reg; alpha = 1.f; }
  else { mn = fmaxf(m_reg, pmax); alpha = __builtin_amdgcn_exp2f((m_reg - mn) * C); m_reg = mn; }
  float mnC = -mn * C;
  for (int r = 0; r < 16; ++r) p0[r] = fmaf(p0[r], C, mnC); for (int r = 0; r < 16; ++r) p1[r] = fmaf(p1[r], C, mnC);
  for (int r = 0; r < 16; ++r) p0[r] = __builtin_amdgcn_exp2f(p0[r]);
}
__device__ __forceinline__ void finishSM(f32x16& p0, f32x16& p1, float alpha, float& l_reg, bf16x8& pa0, bf16x8& pa1, bf16x8& pa2, bf16x8& pa3) {
  for (int r = 0; r < 16; ++r) p1[r] = __builtin_amdgcn_exp2f(p1[r]);
  float ps = 0; for (int r = 0; r < 16; ++r) ps += p0[r]; for (int r = 0; r < 16; ++r) ps += p1[r];
  { auto rr = __builtin_amdgcn_permlane32_swap(__float_as_uint(ps), __float_as_uint(ps), false, false);
    ps = __uint_as_float(rr[0]) + __uint_as_float(rr[1]); }
  l_reg = l_reg * alpha + ps;
#define PK4(P, BASE, OUT) do { unsigned a0 = cvtpk(P[BASE + 0], P[BASE + 1]), a1 = cvtpk(P[BASE + 2], P[BASE + 3]);   \
    unsigned b0 = cvtpk(P[BASE + 4], P[BASE + 5]), b1 = cvtpk(P[BASE + 6], P[BASE + 7]);                              \
    auto r0 = __builtin_amdgcn_permlane32_swap(a0, b0, false, false); auto r1 = __builtin_amdgcn_permlane32_swap(a1, b1, false, false); \
    u32x4 w = {r0[0], r1[0], r0[1], r1[1]}; OUT = *reinterpret_cast<bf16x8*>(&w); } while (0)
  PK4(p0, 0, pa0); PK4(p0, 8, pa1); PK4(p1, 0, pa2); PK4(p1, 8, pa3);
#undef PK4
}
__device__ __forceinline__ void qkt(f32x16& p0, f32x16& p1, const bf16* Ks, const bf16x8* qr, int r32, int hi) {
  p0 = f32x16{}; p1 = f32x16{};
  for (int d0 = 0; d0 < 8; ++d0) { int cb = (d0 * 16 + hi * 8) * 2;
    bf16x8 b0 = *reinterpret_cast<const bf16x8*>((const char*)Ks + KSWZ(r32, cb));
    bf16x8 b1 = *reinterpret_cast<const bf16x8*>((const char*)Ks + KSWZ(32 + r32, cb));
    p0 = __builtin_amdgcn_mfma_f32_32x32x16_bf16(b0, qr[d0], p0, 0, 0, 0);
    p1 = __builtin_amdgcn_mfma_f32_32x32x16_bf16(b1, qr[d0], p1, 0, 0, 0); }
}
__device__ __forceinline__ int v_st(int k, int c) { const int kk = (k & ~0xC) | ((k & 4) << 1) | ((k & 8) >> 1); return ((kk >> 3) * 4 + (c >> 5)) * 512 + ((kk & 7) * 32 + (c & 31)) * 2; }
__device__ __forceinline__ int v_rd_base(int lane) { return ((lane & 3) << 3) | (((lane >> 2) & 3) << 6) | (((lane >> 4) & 1) << 5) | (((lane >> 5) & 1) << 8); }
constexpr int v_rd_off(int d0, int ks, int half) { return d0 * 512 + ks * 4096 + half * 2048; }
template <int OFF> __device__ __forceinline__ s16x4 tr_read(int vb) {
  s16x4 r; asm volatile("ds_read_b64_tr_b16 %0, %1 offset:%2" : "=&v"(r) : "v"(vb), "i"(OFF) : "memory"); return r;
}
template <int D0> __device__ __forceinline__ void pv_one(f32x16& od, int vb, bf16x8 pa0, bf16x8 pa1, bf16x8 pa2, bf16x8 pa3) {
  const s16x4 l0 = tr_read<v_rd_off(D0, 0, 0)>(vb), h0 = tr_read<v_rd_off(D0, 0, 1)>(vb), l1 = tr_read<v_rd_off(D0, 1, 0)>(vb), h1 = tr_read<v_rd_off(D0, 1, 1)>(vb);
  const s16x4 l2 = tr_read<v_rd_off(D0, 2, 0)>(vb), h2 = tr_read<v_rd_off(D0, 2, 1)>(vb), l3 = tr_read<v_rd_off(D0, 3, 0)>(vb), h3 = tr_read<v_rd_off(D0, 3, 1)>(vb);
  asm volatile("s_waitcnt lgkmcnt(0)" ::: "memory"); SBAR();
#define PK(L, H) (bf16x8){L[0], L[1], L[2], L[3], H[0], H[1], H[2], H[3]}
  od = __builtin_amdgcn_mfma_f32_32x32x16_bf16(pa0, PK(l0, h0), od, 0, 0, 0);
  od = __builtin_amdgcn_mfma_f32_32x32x16_bf16(pa1, PK(l1, h1), od, 0, 0, 0);
  od = __builtin_amdgcn_mfma_f32_32x32x16_bf16(pa2, PK(l2, h2), od, 0, 0, 0);
  od = __builtin_amdgcn_mfma_f32_32x32x16_bf16(pa3, PK(l3, h3), od, 0, 0, 0);
#undef PK
}
__device__ __forceinline__ void pv_d0(f32x16* o, int vb, bf16x8 pa0, bf16x8 pa1, bf16x8 pa2, bf16x8 pa3) {
  pv_one<0>(o[0], vb, pa0, pa1, pa2, pa3); pv_one<1>(o[1], vb, pa0, pa1, pa2, pa3); pv_one<2>(o[2], vb, pa0, pa1, pa2, pa3); pv_one<3>(o[3], vb, pa0, pa1, pa2, pa3);
}

template <typename TQ>
__device__ __forceinline__ void attn_dense_body(const TQ* __restrict__ Qb, const bf16* __restrict__ Kh, const bf16* __restrict__ Vh,
                                                bf16* __restrict__ Ob, int seq, char* lds) {
  using St = Stage<bf16>; using SQ = Stage<TQ>;
  const int tid = threadIdx.x, wid = tid >> 6, lane = tid & 63, r32 = lane & 31, hi = lane >> 5;
  bf16* V_lds = (bf16*)lds; bf16* K_lds = (bf16*)(lds + 2 * SHM_V);
  float* ws = (float*)(lds + 2 * SHM_V + 2 * SHM_K) + wid * 64; float* li_l = ws; float* al_l = ws + 32;
  float m_reg = -1e30f, l_reg = 0; f32x16 o[4] = {}; bf16x8 qr[8];
  const TQ* Qw = Qb + (long)(wid * QBLK + r32) * LDQ + hi * 8;
#pragma unroll
  for (int d0 = 0; d0 < 8; ++d0) qr[d0] = SQ::tobf(SQ::ld8(Qw + d0 * 16));
  const int sr = tid >> 4, sc = (tid & 15) * 8, vst0 = v_st(sr, sc), vst1 = v_st(32 + sr, sc);
  const int vb0 = (int)(uintptr_t)V_lds + v_rd_base(lane);
  struct { typename St::T vs0, vs1, ks0, ks1; } sr_[SDEPTH];
#define SLOAD(i, k0) do { sr_[i].vs0 = St::ld8(&Vh[(long)((k0) + sr) * LDK + sc]); sr_[i].vs1 = St::ld8(&Vh[(long)((k0) + 32 + sr) * LDK + sc]); \
    sr_[i].ks0 = St::ld8(&Kh[(long)((k0) + sr) * LDK + sc]); sr_[i].ks1 = St::ld8(&Kh[(long)((k0) + 32 + sr) * LDK + sc]); } while (0)
#define SWRITE(b, i) do { *(bf16x8*)((char*)V_lds + (b) * SHM_V + vst0) = St::tobf(sr_[i].vs0);          \
    *(bf16x8*)((char*)V_lds + (b) * SHM_V + vst1) = St::tobf(sr_[i].vs1); int kc = sc * 2;               \
    *(bf16x8*)((char*)K_lds + (b) * SHM_K + KSWZ(sr, kc)) = St::tobf(sr_[i].ks0);                       \
    *(bf16x8*)((char*)K_lds + (b) * SHM_K + KSWZ(32 + sr, kc)) = St::tobf(sr_[i].ks1); } while (0)
#define SWAIT() do { if constexpr (SDEPTH == 2) asm volatile("s_waitcnt vmcnt(4)" ::: "memory"); else asm volatile("s_waitcnt vmcnt(0)" ::: "memory"); } while (0)
#define RESC(a) do { if (__any((a) < 1.f)) { if (hi == 0) al_l[r32] = (a); asm volatile("s_waitcnt lgkmcnt(0)" ::: "memory"); \
    for (int d = 0; d < 4; ++d) for (int r = 0; r < 16; ++r) o[d][r] *= al_l[crow(r, hi)]; } } while (0)
  f32x16 pA0, pA1, pB0, pB1; float mnA, mnB, alA, alB; bf16x8 pa0, pa1, pa2, pa3; const int NT = seq / KVBLK;
  constexpr int SE = 0, SO = SDEPTH - 1;
  SLOAD(SE, 0); asm volatile("s_waitcnt vmcnt(0)" ::: "memory"); SWRITE(0, SE); __syncthreads();
  qkt(pA0, pA1, K_lds, qr, r32, hi); partialSM(pA0, pA1, m_reg, mnA, alA);
  SLOAD(SO, KVBLK); if constexpr (SDEPTH == 2) { if (2 < NT) SLOAD(SE, 2 * KVBLK); }
  SWAIT(); SWRITE(1, SO); __syncthreads();
  for (int j = 1; j + 1 < NT; j += 2) {
    SBAR(); qkt(pB0, pB1, (bf16*)((char*)K_lds + SHM_K), qr, r32, hi);
    finishSM(pA0, pA1, alA, l_reg, pa0, pa1, pa2, pa3); SBAR();
    SLOAD(SO, (j + SDEPTH) * KVBLK); SBAR();
    pv_d0(o, vb0, pa0, pa1, pa2, pa3); partialSM(pB0, pB1, m_reg, mnB, alB);
    __syncthreads(); SWAIT(); SWRITE(0, SE);
    RESC(alB); __syncthreads();
    SBAR(); qkt(pA0, pA1, K_lds, qr, r32, hi);
    finishSM(pB0, pB1, alB, l_reg, pa0, pa1, pa2, pa3); SBAR();
    if (SDEPTH == 1 || j + 3 < NT) SLOAD(SE, (j + 1 + SDEPTH) * KVBLK); SBAR();
    pv_d0(o, vb0 + (int)SHM_V, pa0, pa1, pa2, pa3); partialSM(pA0, pA1, m_reg, mnA, alA);
    __syncthreads(); SWAIT(); SWRITE(1, SO);
    RESC(alA); __syncthreads();
  }
  SBAR(); qkt(pB0, pB1, (bf16*)((char*)K_lds + SHM_K), qr, r32, hi);
  finishSM(pA0, pA1, alA, l_reg, pa0, pa1, pa2, pa3); SBAR();
  pv_d0(o, vb0, pa0, pa1, pa2, pa3); partialSM(pB0, pB1, m_reg, mnB, alB);
  __syncthreads(); RESC(alB);
  finishSM(pB0, pB1, alB, l_reg, pa0, pa1, pa2, pa3); SBAR();
  pv_d0(o, vb0 + (int)SHM_V, pa0, pa1, pa2, pa3);
  if (hi == 0) li_l[r32] = l_reg; asm volatile("s_waitcnt lgkmcnt(0)" ::: "memory");
  float rli[16];
#pragma unroll
  for (int r = 0; r < 16; ++r) rli[r] = __builtin_amdgcn_rcpf(li_l[crow(r, hi)]);
  bf16* Ow = Ob + (long)(wid * QBLK) * LDO;
#pragma unroll
  for (int r = 0; r < 16; ++r) { int orow = crow(r, hi);
    for (int d0 = 0; d0 < 4; ++d0) Ow[(long)orow * LDO + d0 * 32 + r32] = __float2bfloat16(o[d0][r] * rli[r]); }
#undef SLOAD
#undef SWRITE
#undef SWAIT
#undef RESC
}

#undef KSWZ
#undef SBAR
}
constexpr size_t MX_CL = 0;
constexpr size_t MX_CP = 36 * MiB;
constexpr size_t MX_NL = 72 * MiB;
constexpr size_t MX_NP = 73 * MiB;
constexpr size_t MX_ST = 74 * MiB;
constexpr size_t MX_SP = 75 * MiB;
constexpr size_t MX_GQ = 76 * MiB, MX_GK = 94 * MiB, MX_GV = 112 * MiB;
constexpr size_t MX_GG = 130 * MiB, MX_GB = 131 * MiB;
constexpr size_t MX_GD1 = 132 * MiB;
constexpr size_t GD1_ITEM = 73728;
constexpr size_t MX_GE = 294 * MiB;
static_assert(MX_GD1 + (size_t)2304 * GD1_ITEM <= MX_GE && WS_MIX + MX_GE + 2304 * 128 <= WS_END, "mixer scratch map");

typedef float f32x4m __attribute__((ext_vector_type(4)));
#define MFMA16(a, b, c) __builtin_amdgcn_mfma_f32_16x16x32_bf16((a), (b), (c), 0, 0, 0)
__device__ __forceinline__ bf16x8 lds_frag(const LAS unsigned char* base, int stride, int row0, int kb, int lane) {
    return *(const LAS bf16x8*)(base + (row0 + (lane & 15)) * stride + kb + (lane >> 4) * 16);
}
__device__ __forceinline__ float gelu_tanh(float x) { const float y = 0.7978845608028654f * (x + 0.044715f * x * x * x); const float t = 1.0f - 2.0f / (1.0f + __expf(2.0f * y)); return 0.5f * x * (1.0f + t); }
__device__ __forceinline__ float logsigmoid1(float x) { return fminf(x, 0.f) - log1pf(__expf(-fabsf(x))); }
__device__ __forceinline__ float softplus1(float x) { return fmaxf(x, 0.f) + log1pf(__expf(-fabsf(x))); }
__device__ __forceinline__ int perm32p(int jl) { return 8 * ((jl & 15) >> 2) + 4 * (jl >> 4) + (jl & 3); }

__device__ __forceinline__ float wscan_sum_f(float v, int lane) {
#pragma unroll
    for (int o = 1; o < 64; o <<= 1) { const float t = __shfl_up(v, o); if (lane >= o) v += t; }
    return v;
}
__device__ __forceinline__ float wscan_sum_b(float v, int lane) {
#pragma unroll
    for (int o = 1; o < 64; o <<= 1) { const float t = __shfl_down(v, o); if (lane + o < 64) v += t; }
    return v;
}
__device__ __forceinline__ float wscan_max_f(float v, int lane) {
#pragma unroll
    for (int o = 1; o < 64; o <<= 1) { const float t = __shfl_up(v, o); if (lane >= o) v = fmaxf(v, t); }
    return v;
}
__device__ __forceinline__ float wscan_max_b(float v, int lane) {
#pragma unroll
    for (int o = 1; o < 64; o <<= 1) { const float t = __shfl_down(v, o); if (lane + o < 64) v = fmaxf(v, t); }
    return v;
}
struct AprepRow { bf16 qa[4], qb[4], ka[2], kb[2]; v2u vv; v4u sg; float cs, sn; };
__device__ __forceinline__ void aprep_load(AprepRow& R, const bf16* Z, const float* RC, const float* RS, int row, int da, int db, int half, int i, int lane, bool last) {
    const bool isc = row >= ML; const int t = isc ? (row - ML) % CTXL : row % SEQ;
    const bf16* zr = Z + (size_t)row * ZLD;
    R.cs = 1.f; R.sn = 0.f;
    if (!isc) { const int pos = half ? 32 + (t & 63) : (t >> 6); R.cs = RC[pos * 32 + i]; R.sn = RS[pos * 32 + i]; }
    if (!(isc && last)) {
#pragma unroll
        for (int h = 0; h < 4; ++h) { R.qa[h] = zr[ZC_ATQ + h * 128 + da]; R.qb[h] = zr[ZC_ATQ + h * 128 + db]; }
        R.sg = *(const GAS v4u*)(zr + ZC_SGV + 8 * lane);
    }
#pragma unroll
    for (int h = 0; h < 2; ++h) { R.ka[h] = zr[ZC_ATK + h * 128 + da]; R.kb[h] = zr[ZC_ATK + h * 128 + db]; }
    R.vv = *(const GAS v2u*)(zr + ZC_ATV + 4 * lane);
}
__device__ __forceinline__ void phase_attn_prep(Frame& F, int l, bool last) {
    const bf16* Z = (const bf16*)(F.ws + WS_Z); bf16* QA = (bf16*)(F.ws + WS_QA); bf16* KC = (bf16*)(F.ws + WS_KC); bf16* VC = (bf16*)(F.ws + WS_VC);
    const float* RC = (const float*)(F.ws + WS_ROPE); const float* RS = RC + 96 * 32;
    const float* gq = F.in[I_ATQN] + l * 128; const float* gk = F.in[I_ATKN] + l * 128;
    const int gw = blockIdx.x * NWAVES + F.wave, NGW = F.G * NWAVES;
    const int half = F.lane >> 5, i = F.lane & 31, da = 64 * half + i, db = da + 32;
    const float gqa = gq[da], gqb = gq[db], gka = gk[da], gkb = gk[db];
    AprepRow N;
    if (gw < MT) aprep_load(N, Z, RC, RS, gw, da, db, half, i, F.lane, last);
    for (int row = gw; row < MT; row += NGW) {
        const AprepRow R = N;
        if (row + NGW < MT) aprep_load(N, Z, RC, RS, row + NGW, da, db, half, i, F.lane, last);
        const bool isc = row >= ML; const int b = isc ? (row - ML) / CTXL : row / SEQ, t = isc ? (row - ML) % CTXL : row % SEQ;
        const bool doq = !(isc && last);
        float qa[4], qb[4], ka[2], kb[2], red[7];
#pragma unroll
        for (int h = 0; h < 4; ++h) { qa[h] = doq ? bf1(R.qa[h]) : 0.f; qb[h] = doq ? bf1(R.qb[h]) : 0.f; red[h] = qa[h] * qa[h] + qb[h] * qb[h]; }
#pragma unroll
        for (int h = 0; h < 2; ++h) { ka[h] = bf1(R.ka[h]); kb[h] = bf1(R.kb[h]); red[4 + h] = ka[h] * ka[h] + kb[h] * kb[h]; }
        { const v4u w = R.sg; float ss = 0.f;
          if (doq) { const float e0 = gelu_tanh(bflo(w.x)), e1 = gelu_tanh(bfhi(w.x)), e2 = gelu_tanh(bflo(w.y)), e3 = gelu_tanh(bfhi(w.y)), e4 = gelu_tanh(bflo(w.z)), e5 = gelu_tanh(bfhi(w.z)), e6 = gelu_tanh(bflo(w.w)), e7 = gelu_tanh(bfhi(w.w));
              ss = (e0 * e0 + e1 * e1) + (e2 * e2 + e3 * e3) + (e4 * e4 + e5 * e5) + (e6 * e6 + e7 * e7); }
          red[6] = ss; }
#pragma unroll
        for (int o = 1; o < 64; o <<= 1) { float tt[7];
#pragma unroll
            for (int k = 0; k < 7; ++k) tt[k] = __shfl_xor(red[k], o);
#pragma unroll
            for (int k = 0; k < 7; ++k) red[k] += tt[k]; }
        if (doq) {
#pragma unroll
            for (int h = 0; h < 4; ++h) { const float rs = 1.0f / sqrtf(red[h] * (1.0f / 128.0f) + EPS); const float ya = qa[h] * rs * gqa, yb = qb[h] * rs * gqb;
                QA[(size_t)row * 512 + h * 128 + da] = f2bf1(ya * R.cs - yb * R.sn); QA[(size_t)row * 512 + h * 128 + db] = f2bf1(yb * R.cs + ya * R.sn); }
            if (F.lane == 0) ((float*)(F.ws + WS_ROPE + 65536))[(row >> 3) * 32 + (row & 7)] = 1.0f / sqrtf(red[6] * (1.0f / 512.0f) + EPS);
        }
        const size_t krow = (size_t)b * 2304 + (isc ? t : 256 + t);
#pragma unroll
        for (int h = 0; h < 2; ++h) { const float rs = 1.0f / sqrtf(red[4 + h] * (1.0f / 128.0f) + EPS); const float ya = ka[h] * rs * gka, yb = kb[h] * rs * gkb;
            KC[krow * 256 + h * 128 + da] = f2bf1(ya * R.cs - yb * R.sn); KC[krow * 256 + h * 128 + db] = f2bf1(yb * R.cs + ya * R.sn); }
        *(GAS v2u*)(VC + krow * 256 + 4 * F.lane) = R.vv;
    }
}
__device__ __forceinline__ void attn_item(Frame& F, int it) {
    const attn::bf16* QA = (const attn::bf16*)(F.ws + WS_QA); const attn::bf16* KC = (const attn::bf16*)(F.ws + WS_KC); const attn::bf16* VC = (const attn::bf16*)(F.ws + WS_VC);
    attn::bf16* Y3 = (attn::bf16*)(F.ws + WS_Y) + (size_t)3 * MT * 512;
    int h, b, seq; size_t r0;
    if (it < 256) { const int qb = it & 7; h = (it >> 3) & 3; b = it >> 5; r0 = (size_t)b * SEQ + qb * 256; seq = 2304; }
    else { const int j = it - 256; h = j & 3; b = j >> 2; r0 = (size_t)ML + b * CTXL; seq = 256; }
    attn::attn_dense_body<attn::bf16>(QA + r0 * 512 + h * 128, KC + (size_t)b * 2304 * 256 + (h >> 1) * 128, VC + (size_t)b * 2304 * 256 + (h >> 1) * 128, Y3 + r0 * 512 + h * 128, seq, (char*)F.lds + RING_OFF);
    __syncthreads();
}
__device__ __forceinline__ void phase_spatial(Frame& F, int l, bool last) {
    const bf16* Z = (const bf16*)(F.ws + WS_Z); bf16* Y0 = (bf16*)(F.ws + WS_Y);
    LAS unsigned char* Wl = F.lds + RING_OFF; LAS unsigned char* Vt = Wl + 34816;
    const int nchunk = last ? ML / 128 : MT / 128;
    const int tid = F.tid, r = tid >> 2, q = tid & 3;
    for (int it = F.G - 1 - (int)blockIdx.x; it < nchunk * 4; it += F.G) {
        const int ch = it >> 2, g = it & 3; const size_t row0 = (size_t)ch * 128;
        const bf16* zv = Z + (row0 + r) * ZLD + ZC_SGV;
        const float rstd = ((const float*)(F.ws + WS_ROPE + 65536))[((row0 + r) >> 3) * 32 + ((row0 + r) & 7)];
        const float* gn = F.in[I_SGN] + l * 512 + g * 128 + q * 32;
#pragma unroll
        for (int j = 0; j < 4; ++j) { const v4u w = *(const GAS v4u*)(zv + g * 128 + q * 32 + j * 8);
            const float e[8] = {gelu_tanh(bflo(w.x)), gelu_tanh(bfhi(w.x)), gelu_tanh(bflo(w.y)), gelu_tanh(bfhi(w.y)), gelu_tanh(bflo(w.z)), gelu_tanh(bfhi(w.z)), gelu_tanh(bflo(w.w)), gelu_tanh(bfhi(w.w))};
#pragma unroll
            for (int k = 0; k < 8; ++k) { const int c = q * 32 + j * 8 + k; *(LAS bf16*)(Vt + c * 272 + r * 2) = f2bf1(e[k] * rstd * gn[j * 8 + k]); } }
        const float* wg = F.in[I_SGW] + ((size_t)(l * 4 + g) * 128 + r) * 128 + q * 32;
#pragma unroll
        for (int j = 0; j < 4; ++j) { const f32x4 a = *(const f32x4*)(wg + j * 8), b = *(const f32x4*)(wg + j * 8 + 4);
            v4u o; o.x = pk2(a.x, a.y); o.y = pk2(a.z, a.w); o.z = pk2(b.x, b.y); o.w = pk2(b.z, b.w);
            *(LAS v4u*)(Wl + r * 272 + (q * 32 + j * 8) * 2) = o; }
        __syncthreads();
        const int wr = F.wave >> 1, wc = F.wave & 1;
        f32x4 acc[2][4];
#pragma unroll
        for (int mi = 0; mi < 2; ++mi)
#pragma unroll
            for (int ni = 0; ni < 4; ++ni) acc[mi][ni] = (f32x4){0.f, 0.f, 0.f, 0.f};
#pragma unroll
        for (int ks = 0; ks < 4; ++ks) {
            bf16x8 a[2], b[4];
#pragma unroll
            for (int mi = 0; mi < 2; ++mi) a[mi] = lds_frag(Wl, 272, 32 * wr + 16 * mi, ks * 64, F.lane);
#pragma unroll
            for (int ni = 0; ni < 4; ++ni) b[ni] = lds_frag(Vt, 272, 64 * wc + 16 * ni, ks * 64, F.lane);
#pragma unroll
            for (int mi = 0; mi < 2; ++mi)
#pragma unroll
                for (int ni = 0; ni < 4; ++ni) acc[mi][ni] = MFMA16(a[mi], b[ni], acc[mi][ni]);
        }
        const float* bs = F.in[I_SGB] + (l * 4 + g) * 128;
#pragma unroll
        for (int mi = 0; mi < 2; ++mi)
#pragma unroll
            for (int rr = 0; rr < 4; ++rr) { const int t = 32 * wr + 16 * mi + 4 * (F.lane >> 4) + rr; const float bias = bs[t];
#pragma unroll
                for (int ni = 0; ni < 4; ++ni) { const int c = g * 128 + 64 * wc + 16 * ni + (F.lane & 15);
                    const float u = gelu_tanh(bf1(Z[(row0 + t) * ZLD + ZC_SGU + c]));
                    Y0[(row0 + t) * 512 + c] = f2bf1(u * (acc[mi][ni][rr] + bias)); } }
        __syncthreads();
    }
}
__device__ __forceinline__ void ml_slot(int chain, int k, int& rowbase, int& h, int& dir) {
    const int b = chain >> 3; h = (chain >> 1) & 3; dir = chain & 1;
    if (k < 2) { const int j = dir ? 1 - k : k; rowbase = ML + b * CTXL + 128 * j; }
    else { const int n = k - 2, j = dir ? 15 - n : n; rowbase = b * SEQ + 128 * j; }
}
__device__ __forceinline__ void ml_gates(Frame& F, int l, int rowbase, int h, int dir, LAS float* li, LAS float* lf, LAS float* bc) {
    const float* ZS = (const float*)(F.ws + WS_ZS); const float* bias = F.in[I_MLIFB] + l * 16;
    float s = 0.f;
    if (F.tid < 128) { const float* zr = ZS + (size_t)(rowbase + F.tid) * 32;
        li[F.tid] = zr[dir * 4 + h] + bias[dir * 4 + h];
        const float f = logsigmoid1(zr[(2 + dir) * 4 + h] + bias[(2 + dir) * 4 + h]);
        s = dir ? wscan_sum_b(f, F.lane) : wscan_sum_f(f, F.lane);
        if (dir == 0 && F.tid == 63) lf[0] = s;
        if (dir == 1 && F.tid == 64) lf[0] = s; }
    __syncthreads();
    if (F.tid < 128) { if ((dir == 0 && F.tid >= 64) || (dir == 1 && F.tid < 64)) s += lf[0]; bc[F.tid] = s; }
    __syncthreads();
}
__device__ __forceinline__ void phase_ml1(Frame& F, int l) {
    const bf16* Z = (const bf16*)(F.ws + WS_Z);
    bf16* CL = (bf16*)(F.ws + WS_MIX + MX_CL); float* NL = (float*)(F.ws + WS_MIX + MX_NL); float* ST = (float*)(F.ws + WS_MIX + MX_ST);
    LAS unsigned char* kT = F.lds + RING_OFF; LAS unsigned char* vT = kT + 34816;
    LAS float* li = (LAS float*)(F.lds + RING_OFF + 69632); LAS float* lf = li + 128; LAS float* bc = lf + 128; LAS float* wg = bc + 128; LAS float* red = wg + 128;
    const int tid = F.tid, tau = tid >> 2, q = tid & 3;
    for (int it = blockIdx.x; it < 64 * 18; it += F.G) {
        const int chain = it / 18, k = it % 18; int rowbase, h, dir; ml_slot(chain, k, rowbase, h, dir);
        ml_gates(F, l, rowbase, h, dir, li, lf, bc);
        const float bend = dir ? bc[0] : bc[127];
        if (tid < 128) wg[tid] = bend - bc[tid] + li[tid];
        __syncthreads();
        if (tid < 64) { float m = fmaxf(wg[tid], wg[tid + 64]);
#pragma unroll
            for (int o = 1; o < 64; o <<= 1) m = fmaxf(m, __shfl_xor(m, o));
            if (tid == 0) red[0] = m; }
        __syncthreads();
        const float mloc = red[0];
        __syncthreads();
        if (tid < 128) wg[tid] = __expf(wg[tid] - mloc);
        __syncthreads();
        { const bf16* zk = Z + (size_t)(rowbase + tau) * ZLD + ZC_MLK + h * 128 + q * 32; const bf16* zv = Z + (size_t)(rowbase + tau) * ZLD + ZC_MLV + h * 128 + q * 32; const float w = wg[tau];
#pragma unroll
          for (int j = 0; j < 4; ++j) { const v4u a = *(const GAS v4u*)(zk + j * 8), b = *(const GAS v4u*)(zv + j * 8);
              const float ka[8] = {bflo(a.x), bfhi(a.x), bflo(a.y), bfhi(a.y), bflo(a.z), bfhi(a.z), bflo(a.w), bfhi(a.w)};
              const float va[8] = {bflo(b.x), bfhi(b.x), bflo(b.y), bfhi(b.y), bflo(b.z), bfhi(b.z), bflo(b.w), bfhi(b.w)};
#pragma unroll
              for (int c = 0; c < 8; ++c) { const int col = q * 32 + j * 8 + c;
                  *(LAS bf16*)(kT + col * 272 + tau * 2) = f2bf1(ka[c] * 0.08838834764831845f);
                  *(LAS bf16*)(vT + col * 272 + tau * 2) = f2bf1(va[c] * w); } } }
        __syncthreads();
        const int wr = F.wave >> 1, wc = F.wave & 1;
        f32x4 acc[2][4];
#pragma unroll
        for (int mi = 0; mi < 2; ++mi)
#pragma unroll
            for (int ni = 0; ni < 4; ++ni) acc[mi][ni] = (f32x4){0.f, 0.f, 0.f, 0.f};
#pragma unroll
        for (int ks = 0; ks < 4; ++ks) {
            bf16x8 a[2], b[4];
#pragma unroll
            for (int mi = 0; mi < 2; ++mi) a[mi] = lds_frag(vT, 272, 32 * wr + 16 * mi, ks * 64, F.lane);
#pragma unroll
            for (int ni = 0; ni < 4; ++ni) b[ni] = lds_frag(kT, 272, 64 * wc + 16 * ni, ks * 64, F.lane);
#pragma unroll
            for (int mi = 0; mi < 2; ++mi)
#pragma unroll
                for (int ni = 0; ni < 4; ++ni) acc[mi][ni] = MFMA16(a[mi], b[ni], acc[mi][ni]);
        }
        bf16* cl = CL + (size_t)it * 16384;
#pragma unroll
        for (int mi = 0; mi < 2; ++mi)
#pragma unroll
            for (int rr = 0; rr < 4; ++rr) { const int e = 32 * wr + 16 * mi + 4 * (F.lane >> 4) + rr;
#pragma unroll
                for (int ni = 0; ni < 4; ++ni) cl[e * 128 + 64 * wc + 16 * ni + (F.lane & 15)] = f2bf1(acc[mi][ni][rr]); }
        { float s = 0.f; const LAS bf16* kr = (const LAS bf16*)(kT + tau * 272) + q * 32;
#pragma unroll 8
          for (int t = 0; t < 32; ++t) s += wg[q * 32 + t] * bf1(kr[t]);
          s += __shfl_xor(s, 1); s += __shfl_xor(s, 2);
          if (q == 0) NL[(size_t)it * 128 + tau] = s; }
        if (tid == 0) { ST[it * 32 + 0] = mloc; ST[it * 32 + 1] = bend; }
        __syncthreads();
    }
}
__device__ __forceinline__ void phase_ml2(Frame& F, int wg0) {
    const bf16* CL = (const bf16*)(F.ws + WS_MIX + MX_CL); const float* NL = (const float*)(F.ws + WS_MIX + MX_NL); const float* ST = (const float*)(F.ws + WS_MIX + MX_ST);
    bf16* CP = (bf16*)(F.ws + WS_MIX + MX_CP); float* NP = (float*)(F.ws + WS_MIX + MX_NP); float* SP = (float*)(F.ws + WS_MIX + MX_SP);
    if ((int)blockIdx.x < wg0) return;
    const int gt = ((int)blockIdx.x - wg0) * (NWAVES * 64) + F.tid, NT = (F.G - wg0) * NWAVES * 64;
    for (int task = gt; task < 64 * 4096; task += NT) {
        const int chain = task >> 12, e4 = (task & 4095) * 4;
        v2u w[18]; float ml[18], be[18];
#pragma unroll
        for (int k = 0; k < 18; ++k) { const int it = chain * 18 + k; w[k] = *(const GAS v2u*)(CL + (size_t)it * 16384 + e4); ml[k] = ST[it * 32 + 0]; be[k] = ST[it * 32 + 1]; }
        float c0 = 0.f, c1 = 0.f, c2 = 0.f, c3 = 0.f, m = 0.f;
#pragma unroll
        for (int k = 0; k < 18; ++k) { const int it = chain * 18 + k;
            v2u o; o.x = pk2(c0, c1); o.y = pk2(c2, c3); *(GAS v2u*)(CP + (size_t)it * 16384 + e4) = o;
            const float mn = fmaxf(be[k] + m, ml[k]), sp = __expf(be[k] + m - mn), sl = __expf(ml[k] - mn);
            c0 = sp * c0 + sl * bflo(w[k].x); c1 = sp * c1 + sl * bfhi(w[k].x); c2 = sp * c2 + sl * bflo(w[k].y); c3 = sp * c3 + sl * bfhi(w[k].y); m = mn; }
    }
    for (int task = gt; task < 64 * 128; task += NT) {
        const int chain = task >> 7, d = task & 127; float n = 0.f, m = 0.f;
        float nl[18], ml[18], be[18];
#pragma unroll
        for (int k = 0; k < 18; ++k) { const int it = chain * 18 + k; nl[k] = NL[(size_t)it * 128 + d]; ml[k] = ST[it * 32 + 0]; be[k] = ST[it * 32 + 1]; }
#pragma unroll
        for (int k = 0; k < 18; ++k) { const int it = chain * 18 + k;
            NP[(size_t)it * 128 + d] = n;
            if (d == 0) SP[it * 32] = m;
            const float mn = fmaxf(be[k] + m, ml[k]), sp = __expf(be[k] + m - mn), sl = __expf(ml[k] - mn);
            n = sp * n + sl * nl[k]; m = mn; }
    }
}
__device__ __forceinline__ void ml3_item(Frame& F, int l, int it) {
    const bf16* Z = (const bf16*)(F.ws + WS_Z); bf16* Y1 = (bf16*)(F.ws + WS_Y) + (size_t)MT * 512;
    const bf16* CL = (const bf16*)(F.ws + WS_MIX + MX_CP); const float* NL = (const float*)(F.ws + WS_MIX + MX_NP); const float* ST = (const float*)(F.ws + WS_MIX + MX_SP);
    LAS unsigned char* qs = F.lds + RING_OFF; LAS unsigned char* ks = qs + 34816; LAS unsigned char* vT = ks + 34816;
    LAS float* li = (LAS float*)(F.lds + RING_OFF + 104448); LAS float* lf = li + 128; LAS float* bc = lf + 128; LAS float* cv = bc + 128; LAS float* Mt = cv + 128;
    LAS float* inter = Mt + 128; LAS float* rden = inter + 128; LAS float* emt = rden + 128; LAS float* rowss = emt + 128; LAS float* npv = rowss + 256;
    const int tid = F.tid, tau = tid >> 2, q = tid & 3, lane = F.lane, g4 = lane >> 4, l15 = lane & 15;
    {
        int b, h, j, rowbase, nch;
        if (it < 512) { b = it >> 6; h = (it >> 4) & 3; j = it & 15; rowbase = b * SEQ + 128 * j; nch = 16; }
        else { const int r = it - 512; b = r >> 3; h = (r >> 1) & 3; j = r & 1; rowbase = ML + b * CTXL + 128 * j; nch = 2; }
        { const bf16* zq = Z + (size_t)(rowbase + tau) * ZLD + ZC_MLQ + h * 128 + q * 32; const bf16* zk = Z + (size_t)(rowbase + tau) * ZLD + ZC_MLK + h * 128 + q * 32;
          const bf16* zv = Z + (size_t)(rowbase + tau) * ZLD + ZC_MLV + h * 128 + q * 32;
#pragma unroll
          for (int jj = 0; jj < 4; ++jj) { const v4u a = *(const GAS v4u*)(zq + jj * 8), kk = *(const GAS v4u*)(zk + jj * 8), vv = *(const GAS v4u*)(zv + jj * 8);
              *(LAS v4u*)(qs + tau * 272 + (q * 32 + jj * 8) * 2) = a;
              v4u ko; const float s = 0.08838834764831845f;
              ko.x = pk2(bflo(kk.x) * s, bfhi(kk.x) * s); ko.y = pk2(bflo(kk.y) * s, bfhi(kk.y) * s); ko.z = pk2(bflo(kk.z) * s, bfhi(kk.z) * s); ko.w = pk2(bflo(kk.w) * s, bfhi(kk.w) * s);
              *(LAS v4u*)(ks + tau * 272 + (q * 32 + jj * 8) * 2) = ko;
              const unsigned vw[4] = {vv.x, vv.y, vv.z, vv.w};
#pragma unroll
              for (int c = 0; c < 4; ++c) { const int col = q * 32 + jj * 8 + 2 * c;
                  *(LAS bf16*)(vT + col * 272 + tau * 2) = (bf16)(vw[c] & 0xffffu); *(LAS bf16*)(vT + (col + 1) * 272 + tau * 2) = (bf16)(vw[c] >> 16); } } }
        __syncthreads();
        const int wr = F.wave >> 1, wc = F.wave & 1;
        f32x4 accS[2][4];
#pragma unroll
        for (int mi = 0; mi < 2; ++mi)
#pragma unroll
            for (int ni = 0; ni < 4; ++ni) accS[mi][ni] = (f32x4){0.f, 0.f, 0.f, 0.f};
#pragma unroll
        for (int kk = 0; kk < 4; ++kk) {
            bf16x8 a[2], bq[4];
#pragma unroll
            for (int mi = 0; mi < 2; ++mi) a[mi] = lds_frag(ks, 272, 32 * wr + 16 * mi, kk * 64, lane);
#pragma unroll
            for (int ni = 0; ni < 4; ++ni) bq[ni] = lds_frag(qs, 272, 64 * wc + 16 * ni, kk * 64, lane);
#pragma unroll
            for (int mi = 0; mi < 2; ++mi)
#pragma unroll
                for (int ni = 0; ni < 4; ++ni) accS[mi][ni] = MFMA16(a[mi], bq[ni], accS[mi][ni]);
        }
        f32x4 hsum[2][4];
#pragma unroll
        for (int mi = 0; mi < 2; ++mi)
#pragma unroll
            for (int ni = 0; ni < 4; ++ni) hsum[mi][ni] = (f32x4){0.f, 0.f, 0.f, 0.f};
        for (int dir = 0; dir < 2; ++dir) {
            const int n = dir ? nch - 1 - j : j, slot = (it < 512) ? 2 + n : n, chain = (b * 4 + h) * 2 + dir, sit = chain * 18 + slot;
            __syncthreads();
            const bf16* cp = CL + (size_t)sit * 16384;
            bf16x8 cb[2][4];
#pragma unroll
            for (int kk = 0; kk < 2; ++kk)
#pragma unroll
                for (int ni = 0; ni < 4; ++ni) cb[kk][ni] = *(const GAS bf16x8*)(cp + (64 * wc + 16 * ni + l15) * 128 + kk * 32 + g4 * 8);
            ml_gates(F, l, rowbase, h, dir, li, lf, bc);
            const float mprev = ST[sit * 32];
            if (tid < 128) { cv[tid] = li[tid] - bc[tid]; npv[tid] = NL[(size_t)sit * 128 + tid]; }
            __syncthreads();
            float mx = -3.0e38f;
            if (tid < 128) { mx = dir ? wscan_max_b(cv[tid], lane) : wscan_max_f(cv[tid], lane);
                if (dir == 0 && tid == 63) lf[1] = mx; if (dir == 1 && tid == 64) lf[1] = mx; }
            __syncthreads();
            if (tid < 128) { if ((dir == 0 && tid >= 64) || (dir == 1 && tid < 64)) mx = fmaxf(mx, lf[1]);
                const float M = fmaxf(mx, mprev); Mt[tid] = M; inter[tid] = __expf(mprev - M); emt[tid] = __expf(-(bc[tid] + M)); }
            __syncthreads();
#pragma unroll
            for (int mi = 0; mi < 2; ++mi)
#pragma unroll
                for (int ni = 0; ni < 4; ++ni) { const int t = 64 * wc + 16 * ni + l15, s0 = 32 * wr + 16 * mi + 4 * g4; const float M = Mt[t];
                    float p[4];
#pragma unroll
                    for (int rr = 0; rr < 4; ++rr) { const int s = s0 + rr; const bool ok = dir ? (s >= t) : (s <= t); p[rr] = ok ? __expf(cv[s] - M) * accS[mi][ni][rr] : 0.f; }
                    v2u o; o.x = pk2(p[0], p[1]); o.y = pk2(p[2], p[3]); *(LAS v2u*)(ks + t * 272 + s0 * 2) = o; }
            __syncthreads();
            { float sp = 0.f, sn = 0.f; const LAS bf16* pr = (const LAS bf16*)(ks + tau * 272) + q * 32; const LAS bf16* qr = (const LAS bf16*)(qs + tau * 272) + q * 32;
#pragma unroll 8
              for (int c = 0; c < 32; ++c) { sp += bf1(pr[c]); sn += npv[q * 32 + c] * bf1(qr[c]); }
              sp += __shfl_xor(sp, 1); sp += __shfl_xor(sp, 2); sn += __shfl_xor(sn, 1); sn += __shfl_xor(sn, 2);
              if (q == 0) { const float den = sp + inter[tau] * sn; rden[tau] = 1.0f / fmaxf(fabsf(den), emt[tau]); } }
            f32x4 acc[2][4];
#pragma unroll
            for (int mi = 0; mi < 2; ++mi)
#pragma unroll
                for (int ni = 0; ni < 4; ++ni) acc[mi][ni] = (f32x4){0.f, 0.f, 0.f, 0.f};
            bf16x8 cb2[2][4];
#pragma unroll
            for (int kk = 0; kk < 2; ++kk)
#pragma unroll
                for (int ni = 0; ni < 4; ++ni) cb2[kk][ni] = *(const GAS bf16x8*)(cp + (64 * wc + 16 * ni + l15) * 128 + (kk + 2) * 32 + g4 * 8);
#pragma unroll
            for (int kk = 0; kk < 4; ++kk) {
                bf16x8 a[2];
#pragma unroll
                for (int mi = 0; mi < 2; ++mi) a[mi] = lds_frag(qs, 272, 32 * wr + 16 * mi, kk * 64, lane);
#pragma unroll
                for (int mi = 0; mi < 2; ++mi)
#pragma unroll
                    for (int ni = 0; ni < 4; ++ni) acc[mi][ni] = MFMA16(a[mi], kk < 2 ? cb[kk][ni] : cb2[kk - 2][ni], acc[mi][ni]);
            }
#pragma unroll
            for (int mi = 0; mi < 2; ++mi)
#pragma unroll
                for (int rr = 0; rr < 4; ++rr) { const float sc = inter[32 * wr + 16 * mi + 4 * g4 + rr];
#pragma unroll
                    for (int ni = 0; ni < 4; ++ni) acc[mi][ni][rr] *= sc; }
#pragma unroll
            for (int kk = 0; kk < 4; ++kk) {
                bf16x8 a[2], bb[4];
#pragma unroll
                for (int mi = 0; mi < 2; ++mi) a[mi] = lds_frag(ks, 272, 32 * wr + 16 * mi, kk * 64, lane);
#pragma unroll
                for (int ni = 0; ni < 4; ++ni) bb[ni] = lds_frag(vT, 272, 64 * wc + 16 * ni, kk * 64, lane);
#pragma unroll
                for (int mi = 0; mi < 2; ++mi)
#pragma unroll
                    for (int ni = 0; ni < 4; ++ni) acc[mi][ni] = MFMA16(a[mi], bb[ni], acc[mi][ni]);
            }
            __syncthreads();
#pragma unroll
            for (int mi = 0; mi < 2; ++mi)
#pragma unroll
                for (int rr = 0; rr < 4; ++rr) { const float sc = rden[32 * wr + 16 * mi + 4 * g4 + rr];
#pragma unroll
                    for (int ni = 0; ni < 4; ++ni) hsum[mi][ni][rr] += acc[mi][ni][rr] * sc; }
        }
        __syncthreads();
#pragma unroll
        for (int mi = 0; mi < 2; ++mi)
#pragma unroll
            for (int rr = 0; rr < 4; ++rr) { float s = 0.f;
#pragma unroll
                for (int ni = 0; ni < 4; ++ni) s += hsum[mi][ni][rr] * hsum[mi][ni][rr];
                s += __shfl_xor(s, 1); s += __shfl_xor(s, 2); s += __shfl_xor(s, 4); s += __shfl_xor(s, 8);
                if (l15 == 0) rowss[wc * 128 + 32 * wr + 16 * mi + 4 * g4 + rr] = s; }
        __syncthreads();
        const float* gn = F.in[I_MLN] + l * 512 + h * 128;
#pragma unroll
        for (int mi = 0; mi < 2; ++mi)
#pragma unroll
            for (int rr = 0; rr < 4; ++rr) { const int t = 32 * wr + 16 * mi + 4 * g4 + rr; const float rs = 1.0f / sqrtf((rowss[t] + rowss[128 + t]) * (1.0f / 128.0f) + EPS);
#pragma unroll
                for (int ni = 0; ni < 4; ++ni) { const int e = 64 * wc + 16 * ni + l15;
                    const float og = sigm1(bf1(Z[(size_t)(rowbase + t) * ZLD + ZC_MLO + h * 128 + e]));
                    Y1[(size_t)(rowbase + t) * 512 + h * 128 + e] = f2bf1(og * hsum[mi][ni][rr] * rs * gn[e]); } }
        __syncthreads();
    }
}
#ifndef DUPS
#define DUPS 0
#endif
__device__ __forceinline__ void gd_slot(int chain, int k, int& seqbase, int& T, int& n, int& h, int& dir) {
    const int b = chain >> 3; h = (chain >> 1) & 3; dir = chain & 1;
    if (k < 4) { seqbase = ML + b * CTXL; T = CTXL; n = k; } else { seqbase = b * SEQ; T = SEQ; n = k - 4; }
}
__device__ __forceinline__ void phase_gd0(Frame& F, int l, bool last) {
    const bf16* Z = (const bf16*)(F.ws + WS_Z); const float* ZS = (const float*)(F.ws + WS_ZS);
    bf16* GQ = (bf16*)(F.ws + WS_MIX + MX_GQ); bf16* GK = (bf16*)(F.ws + WS_MIX + MX_GK); bf16* GV = (bf16*)(F.ws + WS_MIX + MX_GV);
    float* GG = (float*)(F.ws + WS_MIX + MX_GG); float* GB = (float*)(F.ws + WS_MIX + MX_GB);
    const float* cw = F.in[I_GDCONV] + (size_t)l * 3 * 1536;
    const int gw = blockIdx.x * NWAVES + F.wave, NGW = F.G * NWAVES, c8 = F.lane * 8;
    for (int row = gw; row < MT; row += NGW) {
        const bool isc = row >= ML; const int t = isc ? (row - ML) % CTXL : row % SEQ, T = isc ? CTXL : SEQ;
        const bool hp = t > 0, hn = t < T - 1;
#pragma unroll
        for (int seg = 0; seg < 3; ++seg) {
            if (seg == 0 && isc && last) continue;
            const int zc = (seg == 0 ? ZC_GDQ : seg == 1 ? ZC_GDK : ZC_GDV) + c8;
            const bf16* zr = Z + (size_t)row * ZLD + zc;
            const v4u x1 = *(const GAS v4u*)zr;
            v4u x0 = (v4u){0u, 0u, 0u, 0u}, x2 = (v4u){0u, 0u, 0u, 0u};
            if (hp) x0 = *(const GAS v4u*)(zr - ZLD);
            if (hn) x2 = *(const GAS v4u*)(zr + ZLD);
            const float* w0 = cw + seg * 512 + c8; const float* w1 = w0 + 1536; const float* w2 = w1 + 1536;
            const unsigned a0[4] = {x0.x, x0.y, x0.z, x0.w}, a1[4] = {x1.x, x1.y, x1.z, x1.w}, a2[4] = {x2.x, x2.y, x2.z, x2.w};
            float y[8]; float ss = 0.f;
#pragma unroll
            for (int j = 0; j < 4; ++j) {
                const float lo = bflo(a0[j]) * w0[2 * j] + bflo(a1[j]) * w1[2 * j] + bflo(a2[j]) * w2[2 * j];
                const float hi = bfhi(a0[j]) * w0[2 * j + 1] + bfhi(a1[j]) * w1[2 * j + 1] + bfhi(a2[j]) * w2[2 * j + 1];
                y[2 * j] = silu1(lo); y[2 * j + 1] = silu1(hi); ss += y[2 * j] * y[2 * j] + y[2 * j + 1] * y[2 * j + 1]; }
            float sc = 1.f;
            if (seg < 2) { ss += __shfl_xor(ss, 1); ss += __shfl_xor(ss, 2); ss += __shfl_xor(ss, 4); ss += __shfl_xor(ss, 8);
                sc = 1.0f / sqrtf(ss + EPS); if (seg == 0) sc *= 0.08838834764831845f; }
            v4u o; o.x = pk2(y[0] * sc, y[1] * sc); o.y = pk2(y[2] * sc, y[3] * sc); o.z = pk2(y[4] * sc, y[5] * sc); o.w = pk2(y[6] * sc, y[7] * sc);
            bf16* dst = (seg == 0 ? GQ : seg == 1 ? GK : GV) + (size_t)row * 512 + c8;
            *(GAS v4u*)dst = o;
        }
        if (F.lane < 8) {
            const int dir = F.lane >> 2, h = F.lane & 3; const float* zs = ZS + (size_t)row * 32 + 16;
            const float beta = sigm1(zs[dir * 4 + h]);
            const float g = -__expf(F.in[I_GDALOG][l * 8 + dir * 4 + h]) * softplus1(zs[(2 + dir) * 4 + h] + F.in[I_GDDTB][l * 8 + dir * 4 + h]);
            GG[((size_t)dir * MT + row) * 4 + h] = g; GB[((size_t)dir * MT + row) * 4 + h] = beta;
        }
    }
}
__device__ __forceinline__ void phase_gd1(Frame& F) {
    const bf16* GQ = (const bf16*)(F.ws + WS_MIX + MX_GQ); const bf16* GK = (const bf16*)(F.ws + WS_MIX + MX_GK); const bf16* GV = (const bf16*)(F.ws + WS_MIX + MX_GV);
    const float* GG = (const float*)(F.ws + WS_MIX + MX_GG); const float* GB = (const float*)(F.ws + WS_MIX + MX_GB);
    unsigned char* G1 = F.ws + WS_MIX + MX_GD1; float* GE = (float*)(F.ws + WS_MIX + MX_GE);
    LAS unsigned char* kl = F.lds + RING_OFF; LAS unsigned char* ql = kl + 17408; LAS unsigned char* vl = ql + 17408;
    LAS float* Mf = (LAS float*)(F.lds + RING_OFF + 52224);
    LAS unsigned char* Tl = F.lds + RING_OFF + 69632;
    LAS unsigned char* vsT = F.lds + RING_OFF + 78848; LAS unsigned char* ksT = F.lds + RING_OFF + 97280;
    LAS float* gc = (LAS float*)(F.lds + RING_OFF + 115712); LAS float* bt = gc + 64;
    const int tid = F.tid, lane = F.lane, g4 = lane >> 4, l15 = lane & 15;
    for (int it = blockIdx.x; it < 64 * 36; it += F.G) {
        TSTAMP(15); const int chain = it / 36, k = it % 36; int seqbase, T, n, h, dir; gd_slot(chain, k, seqbase, T, n, h, dir);
        unsigned char* out = G1 + (size_t)it * GD1_ITEM;
        bf16* WN = (bf16*)out; bf16* QD = (bf16*)(out + 16384); bf16* KT = (bf16*)(out + 32768); bf16* UT = (bf16*)(out + 49152); bf16* QKM = (bf16*)(out + 65536);
        const int sp = tid >> 3, sc0 = (tid & 7) * 16;
        { const int tok = dir ? T - 1 - (64 * n + sp) : 64 * n + sp; const size_t off = (size_t)(seqbase + tok) * 512 + h * 128 + sc0;
          *(LAS v4u*)(kl + sp * 272 + sc0 * 2) = *(const GAS v4u*)(GK + off); *(LAS v4u*)(kl + sp * 272 + sc0 * 2 + 16) = *(const GAS v4u*)(GK + off + 8);
          *(LAS v4u*)(ql + sp * 272 + sc0 * 2) = *(const GAS v4u*)(GQ + off); *(LAS v4u*)(ql + sp * 272 + sc0 * 2 + 16) = *(const GAS v4u*)(GQ + off + 8);
          *(LAS v4u*)(vl + sp * 272 + sc0 * 2) = *(const GAS v4u*)(GV + off); *(LAS v4u*)(vl + sp * 272 + sc0 * 2 + 16) = *(const GAS v4u*)(GV + off + 8); }
        if (tid < 64) { const int tok = dir ? T - 1 - (64 * n + tid) : 64 * n + tid; const size_t gi = ((size_t)dir * MT + seqbase + tok) * 4 + h;
            gc[tid] = wscan_sum_f(GG[gi], lane); bt[tid] = GB[gi]; }
        __syncthreads(); TSTAMP(8);
        const float gcend = gc[63];
        for (int rep2 = 0; rep2 < ((DUPS & 2) ? 2 : 1); ++rep2) { const float bj = bt[sp], bk = bj * __expf(gc[sp]);
#pragma unroll
          for (int hh = 0; hh < 2; ++hh) { const v4u vv = *(const LAS v4u*)(vl + sp * 272 + sc0 * 2 + 16 * hh), kk = *(const LAS v4u*)(kl + sp * 272 + sc0 * 2 + 16 * hh);
              const unsigned vw[4] = {vv.x, vv.y, vv.z, vv.w}, kw[4] = {kk.x, kk.y, kk.z, kk.w};
#pragma unroll
              for (int c = 0; c < 4; ++c) { const int col = sc0 + 8 * hh + 2 * c;
                  *(LAS bf16*)(vsT + col * 144 + sp * 2) = f2bf1(bflo(vw[c]) * bj); *(LAS bf16*)(vsT + (col + 1) * 144 + sp * 2) = f2bf1(bfhi(vw[c]) * bj);
                  *(LAS bf16*)(ksT + col * 144 + sp * 2) = f2bf1(bflo(kw[c]) * bk); *(LAS bf16*)(ksT + (col + 1) * 144 + sp * 2) = f2bf1(bfhi(kw[c]) * bk); } } }
        if (F.wave < 4) {
            const int i0 = 16 * F.wave; f32x4 acc[4];
#pragma unroll
            for (int ni = 0; ni < 4; ++ni) acc[ni] = (f32x4){0.f, 0.f, 0.f, 0.f};
#pragma unroll
            for (int ks = 0; ks < 4; ++ks) { const bf16x8 a = lds_frag(kl, 272, i0, ks * 64, lane);
#pragma unroll
                for (int ni = 0; ni < 4; ++ni) acc[ni] = MFMA16(a, lds_frag(kl, 272, 16 * ni, ks * 64, lane), acc[ni]); }
#pragma unroll
            for (int ni = 0; ni < 4; ++ni)
#pragma unroll
                for (int rr = 0; rr < 4; ++rr) { const int i = i0 + 4 * g4 + rr, j = 16 * ni + l15;
                    Mf[i * 68 + j] = (j < i) ? bt[i] * acc[ni][rr] * __expf(gc[i] - gc[j]) : 0.f; }
        } else {
            const int j0 = 16 * (F.wave - 4); f32x4 acc[4];
#pragma unroll
            for (int ni = 0; ni < 4; ++ni) acc[ni] = (f32x4){0.f, 0.f, 0.f, 0.f};
#pragma unroll
            for (int ks = 0; ks < 4; ++ks) { const bf16x8 a = lds_frag(kl, 272, j0, ks * 64, lane);
#pragma unroll
                for (int ni = 0; ni < 4; ++ni) acc[ni] = MFMA16(a, lds_frag(ql, 272, 16 * ni, ks * 64, lane), acc[ni]); }
            const int jt = F.wave - 4;
#pragma unroll
            for (int ni = 0; ni < 4; ++ni) { const int i = 16 * ni + l15; float v[4];
#pragma unroll
                for (int rr = 0; rr < 4; ++rr) { const int j = j0 + 4 * g4 + rr; v[rr] = (j <= i) ? acc[ni][rr] * __expf(gc[i] - gc[j]) : 0.f; }
                v2u o; o.x = pk2(v[0], v[1]); o.y = pk2(v[2], v[3]);
                *(GAS v2u*)(QKM + i * 64 + 32 * (jt >> 1) + 8 * g4 + 4 * (jt & 1)) = o; }
        }
        for (int rep4 = 0; rep4 < ((DUPS & 4) ? 2 : 1); ++rep4) { const int d = tid & 127, lq = tid >> 7; float v[16];
#pragma unroll
          for (int ll = 0; ll < 16; ++ll) { const int lp = 16 * lq + ll; v[ll] = bf1(((const LAS bf16*)(kl + lp * 272))[d]) * __expf(gcend - gc[lp]); }
#pragma unroll
          for (int g = 0; g < 4; ++g) { v2u o; o.x = pk2(v[4 * g], v[4 * g + 1]); o.y = pk2(v[4 * g + 2], v[4 * g + 3]);
              *(GAS v2u*)(KT + d * 64 + 32 * (lq >> 1) + 8 * g + 4 * (lq & 1)) = o; } }
        for (int rep8 = 0; rep8 < ((DUPS & 8) ? 2 : 1); ++rep8) { const int lq = tid & 63, db = tid >> 6; const float e = __expf(gc[lq]); const LAS bf16* qr = (const LAS bf16*)(ql + lq * 272) + 16 * db; float v[16];
#pragma unroll
          for (int dd = 0; dd < 16; ++dd) v[dd] = bf1(qr[dd]) * e;
#pragma unroll
          for (int g = 0; g < 4; ++g) { v2u o; o.x = pk2(v[4 * g], v[4 * g + 1]); o.y = pk2(v[4 * g + 2], v[4 * g + 3]);
              *(GAS v2u*)(QD + lq * 128 + 32 * (db >> 1) + 8 * g + 4 * (db & 1)) = o; } }
        if (tid == 0) GE[it * 32] = __expf(gcend);
        __syncthreads(); TSTAMP(9);
        for (int rep = 0; rep < ((DUPS & 1) ? 2 : 1); ++rep) { const int cb = 8 * F.wave; float res[8];
#pragma unroll
          for (int cc = 0; cc < 8; ++cc) res[cc] = (lane == cb + cc) ? 1.0f : 0.0f;
          f32x4 m4 = *(const LAS f32x4*)(Mf + lane * 68 + cb);
          for (int j = cb; j < 64; j += 4) { const f32x4 mc = m4; if (j + 4 < 64) m4 = *(const LAS f32x4*)(Mf + lane * 68 + j + 4);
#pragma unroll
              for (int q = 0; q < 4; ++q) { const float mj = mc[q];
#pragma unroll
                  for (int cc = 0; cc < 8; ++cc) { const float xj = __builtin_bit_cast(float, __builtin_amdgcn_readlane(__builtin_bit_cast(int, res[cc]), j + q)); res[cc] -= mj * xj; } } }
          v4u o; o.x = pk2(res[0], res[1]); o.y = pk2(res[2], res[3]); o.z = pk2(res[4], res[5]); o.w = pk2(res[6], res[7]);
          *(LAS v4u*)(Tl + lane * 144 + cb * 2) = o; }
        __syncthreads(); TSTAMP(10);
        if (F.wave < 4) {
            f32x4 acc[8];
#pragma unroll
            for (int ni = 0; ni < 8; ++ni) acc[ni] = (f32x4){0.f, 0.f, 0.f, 0.f};
#pragma unroll
            for (int ks = 0; ks < 2; ++ks) { const bf16x8 a = lds_frag(Tl, 144, 16 * F.wave, ks * 64, lane);
#pragma unroll
                for (int ni = 0; ni < 8; ++ni) acc[ni] = MFMA16(a, lds_frag(vsT, 144, 16 * ni, ks * 64, lane), acc[ni]); }
#pragma unroll
            for (int ni = 0; ni < 8; ++ni) { v2u o; o.x = pk2(acc[ni][0], acc[ni][1]); o.y = pk2(acc[ni][2], acc[ni][3]);
                *(GAS v2u*)(UT + (16 * ni + l15) * 64 + 16 * F.wave + 4 * g4) = o; }
        } else {
            const int it4 = F.wave - 4; f32x4 acc[8];
#pragma unroll
            for (int mi = 0; mi < 8; ++mi) acc[mi] = (f32x4){0.f, 0.f, 0.f, 0.f};
#pragma unroll
            for (int ks = 0; ks < 2; ++ks) { const bf16x8 bfr = lds_frag(Tl, 144, 16 * it4, ks * 64, lane);
#pragma unroll
                for (int mi = 0; mi < 8; ++mi) acc[mi] = MFMA16(lds_frag(ksT, 144, 16 * mi, ks * 64, lane), bfr, acc[mi]); }
#pragma unroll
            for (int mi = 0; mi < 8; ++mi) { v2u o; o.x = pk2(-acc[mi][0], -acc[mi][1]); o.y = pk2(-acc[mi][2], -acc[mi][3]);
                *(GAS v2u*)(WN + (16 * it4 + l15) * 128 + 32 * (mi >> 1) + 8 * g4 + 4 * (mi & 1)) = o; }
        }
        __syncthreads(); TSTAMP(11);
    }
}
constexpr int GD2_BUF = 62464;
__device__ __forceinline__ void gd2_load(const unsigned char* src, v4u (&r)[7], int tid) {
#pragma unroll
    for (int j = 0; j < 7; ++j) r[j] = *(const GAS v4u*)(src + (size_t)(tid + 512 * j) * 16);
}
__device__ __forceinline__ void gd2_store(LAS unsigned char* buf, const v4u (&r)[7], int tid) {
#pragma unroll
    for (int j = 0; j < 7; ++j) { const int pc = tid + 512 * j;
        int off;
        if (pc < 1024) off = (pc >> 4) * 272 + (pc & 15) * 16;
        else if (pc < 2048) off = 17408 + ((pc - 1024) >> 4) * 272 + (pc & 15) * 16;
        else if (pc < 3072) off = 44032 + ((pc - 2048) >> 3) * 144 + (pc & 7) * 16;
        else off = 34816 + ((pc - 3072) >> 3) * 144 + (pc & 7) * 16;
        *(LAS v4u*)(buf + off) = r[j]; }
}
__device__ __forceinline__ void phase_gd2(Frame& F, bool last) {
    const unsigned char* G1 = F.ws + WS_MIX + MX_GD1; const float* GE = (const float*)(F.ws + WS_MIX + MX_GE);
    float* GO = (float*)(F.ws + WS_H);
    const int tid = F.tid, lane = F.lane, g4 = lane >> 4, l15 = lane & 15, e0 = 16 * F.wave;
    for (int chain = blockIdx.x; chain < 64; chain += F.G) {
        const int h = (chain >> 1) & 3, dir = chain & 1, b = chain >> 3;
        f32x4 S[8];
#pragma unroll
        for (int db = 0; db < 8; ++db) S[db] = (f32x4){0.f, 0.f, 0.f, 0.f};
        v4u r[7];
        { const unsigned char* it0 = G1 + (size_t)(chain * 36) * GD1_ITEM;
#pragma unroll
          for (int j = 0; j < 7; ++j) { const int pc = tid + 512 * j; const int gp = pc < 3072 ? pc : pc + 1024; r[j] = *(const GAS v4u*)(it0 + (size_t)gp * 16); } }
        gd2_store(F.lds + RING_OFF, r, tid);
        v2u un[4]; float gn;
        { const unsigned char* it0 = G1 + (size_t)(chain * 36) * GD1_ITEM; const bf16* UT0 = (const bf16*)(it0 + 49152);
#pragma unroll
          for (int lb = 0; lb < 4; ++lb) un[lb] = *(const GAS v2u*)(UT0 + (e0 + l15) * 64 + 16 * lb + 4 * g4);
          gn = GE[(chain * 36) * 32]; }
        __syncthreads();
        for (int k = 0; k < 36; ++k) {
            LAS unsigned char* buf = F.lds + RING_OFF + (k & 1) * GD2_BUF;
            const unsigned char* item = G1 + (size_t)(chain * 36 + k) * GD1_ITEM;
            if (k + 1 < 36) { const unsigned char* nx = item + GD1_ITEM;
#pragma unroll
                for (int j = 0; j < 7; ++j) { const int pc = tid + 512 * j; const int gp = pc < 3072 ? pc : pc + 1024; r[j] = *(const GAS v4u*)(nx + (size_t)gp * 16); } }
            v2u uc[4];
#pragma unroll
            for (int lb = 0; lb < 4; ++lb) uc[lb] = un[lb];
            const float gend = gn;
            if (k + 1 < 36) { const bf16* UTn = (const bf16*)(item + GD1_ITEM + 49152);
#pragma unroll
                for (int lb = 0; lb < 4; ++lb) un[lb] = *(const GAS v2u*)(UTn + (e0 + l15) * 64 + 16 * lb + 4 * g4);
                gn = GE[(chain * 36 + k + 1) * 32]; }
            int seqbase, T, n; if (k < 4) { seqbase = ML + b * CTXL; T = CTXL; n = k; } else { seqbase = b * SEQ; T = SEQ; n = k - 4; }
            bf16x8 Sb[4];
#pragma unroll
            for (int ks = 0; ks < 4; ++ks) { v4u w; w.x = pk2(S[2 * ks][0], S[2 * ks][1]); w.y = pk2(S[2 * ks][2], S[2 * ks][3]); w.z = pk2(S[2 * ks + 1][0], S[2 * ks + 1][1]); w.w = pk2(S[2 * ks + 1][2], S[2 * ks + 1][3]);
                Sb[ks] = __builtin_bit_cast(bf16x8, w); }
            f32x4 vn[4];
#pragma unroll
            for (int lb = 0; lb < 4; ++lb) { const v2u uu = uc[lb];
                f32x4 acc = (f32x4){bflo(uu.x), bfhi(uu.x), bflo(uu.y), bfhi(uu.y)};
#pragma unroll
                for (int ks = 0; ks < 4; ++ks) acc = MFMA16(lds_frag(buf, 272, 16 * lb, ks * 64, lane), Sb[ks], acc);
                vn[lb] = acc; }
            bf16x8 Vb[2];
#pragma unroll
            for (int ks = 0; ks < 2; ++ks) { v4u w; w.x = pk2(vn[2 * ks][0], vn[2 * ks][1]); w.y = pk2(vn[2 * ks][2], vn[2 * ks][3]); w.z = pk2(vn[2 * ks + 1][0], vn[2 * ks + 1][1]); w.w = pk2(vn[2 * ks + 1][2], vn[2 * ks + 1][3]);
                Vb[ks] = __builtin_bit_cast(bf16x8, w); }
            const bool wr_o = !(last && k < 4);
#pragma unroll
            for (int lb = 0; lb < 4; ++lb) { f32x4 acc = (f32x4){0.f, 0.f, 0.f, 0.f};
#pragma unroll
                for (int ks = 0; ks < 4; ++ks) acc = MFMA16(lds_frag(buf + 17408, 272, 16 * lb, ks * 64, lane), Sb[ks], acc);
#pragma unroll
                for (int ks = 0; ks < 2; ++ks) acc = MFMA16(lds_frag(buf + 34816, 144, 16 * lb, ks * 64, lane), Vb[ks], acc);
                if (wr_o) {
#pragma unroll
                    for (int rr = 0; rr < 4; ++rr) { const int p = 16 * lb + 4 * g4 + rr; const int tok = dir ? T - 1 - (64 * n + p) : 64 * n + p;
                        GO[((size_t)dir * MT + seqbase + tok) * 512 + h * 128 + e0 + l15] = acc[rr]; } } }
#pragma unroll
            for (int db = 0; db < 8; ++db) { f32x4 acc = S[db] * gend;
#pragma unroll
                for (int ks = 0; ks < 2; ++ks) acc = MFMA16(lds_frag(buf + 44032, 144, 16 * db, ks * 64, lane), Vb[ks], acc);
                S[db] = acc; }
            if (k + 1 < 36) gd2_store(F.lds + RING_OFF + ((k + 1) & 1) * GD2_BUF, r, tid);
            __syncthreads();
        }
    }
}
__device__ __forceinline__ void phase_gd3(Frame& F, int l, bool last) {
    const float* GO = (const float*)(F.ws + WS_H); const bf16* Z = (const bf16*)(F.ws + WS_Z); bf16* Y2 = (bf16*)(F.ws + WS_Y) + (size_t)2 * MT * 512;
    const int gw = blockIdx.x * NWAVES + F.wave, NGW = F.G * NWAVES, c8 = F.lane * 8; const int nrows = last ? ML : MT;
    const float* gn = F.in[I_GDN] + l * 128 + (c8 & 127);
    for (int row = gw; row < nrows; row += NGW) {
        const f32x4 a0 = *(const f32x4*)(GO + (size_t)row * 512 + c8), a1 = *(const f32x4*)(GO + (size_t)row * 512 + c8 + 4);
        const f32x4 b0 = *(const f32x4*)(GO + ((size_t)MT + row) * 512 + c8), b1 = *(const f32x4*)(GO + ((size_t)MT + row) * 512 + c8 + 4);
        const f32x4 s0 = a0 + b0, s1 = a1 + b1;
        float ss = (s0.x * s0.x + s0.y * s0.y) + (s0.z * s0.z + s0.w * s0.w) + (s1.x * s1.x + s1.y * s1.y) + (s1.z * s1.z + s1.w * s1.w);
        ss += __shfl_xor(ss, 1); ss += __shfl_xor(ss, 2); ss += __shfl_xor(ss, 4); ss += __shfl_xor(ss, 8);
        const float rs = 1.0f / sqrtf(ss * (1.0f / 128.0f) + EPS);
        const v4u zz = *(const GAS v4u*)(Z + (size_t)row * ZLD + ZC_GDZ + c8);
        const float o[8] = {s0.x, s0.y, s0.z, s0.w, s1.x, s1.y, s1.z, s1.w}; const float zf[8] = {bflo(zz.x), bfhi(zz.x), bflo(zz.y), bfhi(zz.y), bflo(zz.z), bfhi(zz.z), bflo(zz.w), bfhi(zz.w)};
        float y[8];
#pragma unroll
        for (int j = 0; j < 8; ++j) y[j] = o[j] * rs * gn[j] * silu1(zf[j]);
        v4u w; w.x = pk2(y[0], y[1]); w.y = pk2(y[2], y[3]); w.z = pk2(y[4], y[5]); w.w = pk2(y[6], y[7]);
        *(GAS v4u*)(Y2 + (size_t)row * 512 + c8) = w;
    }
}
#ifndef DUPC
#define DUPC 0
#endif
constexpr int CW_Q = 2048;
__device__ __forceinline__ int q_pull(Frame& F, int qi) {
    volatile LAS unsigned* slot = F.MISC + 16;
    __syncthreads();
    if (F.tid == 0) *slot = __hip_atomic_fetch_add((unsigned*)(F.ctl + CW_Q + 64 * qi), 1u, __ATOMIC_RELAXED, __HIP_MEMORY_SCOPE_AGENT);
    __syncthreads();
    return (int)*slot;
}
__device__ __forceinline__ void phase_mixc(Frame& F, int l, bool last, int qo = 0) {
    for (int rep = 0; rep < ((DUPC & 4) ? 2 : 1); ++rep) if ((int)blockIdx.x < 64 || F.G < 128) phase_gd2(F, last);
    const int n_att = last ? 256 : 288, n_ml3 = last ? 512 : 576;
    for (int rep = 0; rep < ((DUPC & 1) ? 2 : 1); ++rep) for (;;) { const int idx = q_pull(F, 2 * l + 8 * rep); if (idx >= n_att) break; attn_item(F, idx); }
    for (int rep = 0; rep < ((DUPC & 2) ? 2 : 1); ++rep) for (;;) { const int idx = q_pull(F, 2 * l + 1 + 8 * rep); if (idx >= n_ml3) break; ml3_item(F, l, idx); }
}
#ifndef DUPA
#define DUPA 0
#endif
#define MIX_PHASE_1 TSTAMP(0); phase_attn_prep(F, l, last); TSTAMP(1); phase_gd0(F, l, last); TSTAMP(2); __syncthreads(); phase_ml1(F, l); TSTAMP(3);
#define MIX_PHASE_2 TSTAMP(4); __syncthreads(); phase_spatial(F, l, last); TSTAMP(5); __syncthreads(); phase_gd1(F); TSTAMP(6); phase_ml2(F, 0); TSTAMP(7);
#define MIX_PHASE_3 phase_mixc(F, l, last);
#define MIX_PHASE_4 phase_gd3(F, l, last);
#ifndef PROBE
#define PROBE 0
#endif
#ifndef DUPMIX
#define DUPMIX 0
#endif
#ifndef DUPG
#define DUPG 0
#endif
#ifdef DUPAUX
#define DUP_AUX(x) x
#else
#define DUP_AUX(x)
#endif
#ifndef TPROBE
#define TPROBE 0
#endif
constexpr int PH_PER_LAYER = 15, N_PHASES = PROBE ? (1 + PH_PER_LAYER + 1) : (1 + NLAYER * PH_PER_LAYER + (TPROBE ? 1 : 0));
#ifndef PHMASK
#define PHMASK 0xffff
#endif
#define PHEN(k) ((PHMASK >> (k)) & 1)
#define IN(p) (lo <= (p) && (p) < hi)
#ifndef TPROBE
#define TPROBE 0
#endif
#if TPROBE
#define SEAM(p) do { if (lo <= (p) && (p) + 1 < hi) { xcd_barrier(bar); if (blockIdx.x == 0 && F.tid == 0) ((unsigned long long*)(F.ws + WS_CTL + 524288))[(p) + 1] = wall_clock64(); } } while (0)
#else
#ifdef DUPBAR
#define SEAM(p) do { if (lo <= (p) && (p) + 1 < hi) { xcd_barrier(bar); xcd_barrier(bar); } } while (0)
#else
#define SEAM(p) do { if (lo <= (p) && (p) + 1 < hi) xcd_barrier(bar); } while (0)
#endif
#endif
struct Args { const float* in[27]; float* out; unsigned char* ws; int ph_lo, ph_hi, li, pad; };
template <int l> __device__ __forceinline__ void layer_body(Frame& F, const XcdBarrier& bar, const int lo, const int hi) {
    float* MOD = (float*)(F.ws + WS_MOD);
    float* XC = (float*)(F.ws + WS_XC);
    bf16* Hb = (bf16*)(F.ws + WS_H); bf16* Zb = (bf16*)(F.ws + WS_Z); bf16* ACT = (bf16*)(F.ws + WS_Z); float* ZS = (float*)(F.ws + WS_ZS);
    bf16* WFI = (bf16*)(F.ws + WS_WFI); bf16* WFO = (bf16*)(F.ws + WS_WFO); bf16* WZ = (bf16*)(F.ws + WS_WZ); bf16* WB = (bf16*)(F.ws + WS_WB); bf16* WO = (bf16*)(F.ws + WS_WO);
    bf16* Yb = (bf16*)(F.ws + WS_Y); float* PB = (float*)(F.ws + WS_MIX);
    const int vc = (F.G % 8 == 0) ? ((int)blockIdx.x % 8) * (F.G / 8) + (int)blockIdx.x / 8 : (int)blockIdx.x;
        constexpr int P = 1 + l * PH_PER_LAYER;
        constexpr bool last = (l == NLAYER - 1);
        const float* modl = MOD + (size_t)l * 9 * MODW;
        const float* xin_l = (l == 0) ? F.in[I_X] : F.out;
        const float* xin_c = (l == 0) ? F.in[I_CTX] : XC;
        constexpr int nPM = last ? 64 : 72;

        if (PHEN(0) && IN(P + 0)) { if (l == 0) { phase_mod(F); phase_rope(F); __syncthreads(); } conv_set(F, l, 0); conv_set(F, l, 2); }
        SEAM(P + 0);
        if (PHEN(1) && IN(P + 1)) phase_norm<(l == 0), (l > 0), false>(F, xin_l, xin_c, F.in[I_F1N] + (size_t)l * D, modl + 0 * D, MT);
        SEAM(P + 1);
        if (PHEN(2) && IN(P + 2)) {
            pg8::Gemm g{Hb, WFI, MT, 2 * DFF, D, 1, 1}; pg8::TileOrder S; S.init(72, 44, 0, 0, 0, F.G, (int)blockIdx.x, 32);
            pg8::EpiSwiglu E{ACT, DFF};
            pg8::gemm_phase<pg8::EpiSwiglu, pg8::TileOrder, PG8_ALIGN, PG8_SP2>(F.lds + RING_OFF, g, S, E);
            if (DUPG & 2) { __syncthreads(); pg8::gemm_phase<pg8::EpiSwiglu, pg8::TileOrder, PG8_ALIGN, PG8_SP2>(F.lds + RING_OFF, g, S, E); }
        }
        SEAM(P + 2);
        if (PHEN(3) && IN(P + 3)) {
            pg8::Gemm g{ACT, WFO, MT, D, DFF, 1, 1};
            { pg8::TileOrder S; S.init(64, 8, 0, 0, 0, F.G, (int)blockIdx.x, DFF / 64); S.wgm = WGM_N8; pg8::EpiRes<false> E{F.out, XC, modl + 2 * D, 0.5f};
              pg8::gemm_phase<pg8::EpiRes<false>, pg8::TileOrder, PG8_ALIGN, PG8_SP2>(F.lds + RING_OFF, g, S, E); }
            { pg8::QuarterOrder S; S.init(8, 64, DFF / 256, F.G, (int)blockIdx.x); pg8::EpiRes<true> E{nullptr, PB, modl + 2 * D, 0.5f};
              pg8::gemm_phase<pg8::EpiRes<true>, pg8::QuarterOrder, PG8_ALIGN, PG8_SP2>(F.lds + RING_OFF, g, S, E); }
        }
        SEAM(P + 3);
        if (PHEN(4) && IN(P + 4)) phase_norm<false, true, !last>(F, F.out, XC, F.in[I_MIXN] + (size_t)l * D, modl + 3 * D, MT);
        SEAM(P + 4);
        if (PHEN(5) && IN(P + 5)) {
            pg8::Gemm g{Hb, WZ, MT, NZ, D, 1, 1}; pg8::TileOrder S;
            if (last) S.init(64, 57, 8, NKV_TILES, 64, F.G, (int)blockIdx.x, 32); else S.init(64, 57, 8, 56, 64, F.G, (int)blockIdx.x, 32, 10);
            pg8::EpiZ E{Zb, ZS, ZLD, (bf16*)(F.ws + WS_GT)};
            pg8::gemm_phase<pg8::EpiZ, pg8::TileOrder, PG8_ALIGN, PG8_SP2>(F.lds + RING_OFF, g, S, E);
            if (DUPG & 1) { __syncthreads(); pg8::gemm_phase<pg8::EpiZ, pg8::TileOrder, PG8_ALIGN, PG8_SP2>(F.lds + RING_OFF, g, S, E); }
        }
        SEAM(P + 5);
        if (PHEN(6) && IN(P + 6)) { conv_set(F, l, 1); MIX_PHASE_1 if (DUPMIX & 1) { __syncthreads(); MIX_PHASE_1 } }
        SEAM(P + 6);
        if (PHEN(7) && IN(P + 7)) { MIX_PHASE_2 if (DUPMIX & 2) { __syncthreads(); MIX_PHASE_2 } }
        SEAM(P + 7);
        if (PHEN(8) && IN(P + 8)) { MIX_PHASE_3 }
        SEAM(P + 8);
        if (PHEN(9) && IN(P + 9)) { MIX_PHASE_4 if (DUPMIX & 8) { __syncthreads(); MIX_PHASE_4 } }
        SEAM(P + 9);
        if (PHEN(10) && IN(P + 10)) {
#ifdef STAGGER
            if ((blockIdx.x >> 3) & 1) { const unsigned long long t0 = wall_clock64(); while (wall_clock64() - t0 < (unsigned long long)STAGGER) __builtin_amdgcn_s_sleep(32); }
#endif
            pg8::Gemm g{Yb, WB, 4 * MT, 4 * D, 512, 1}; pg8::BranchOrder S; S.init(nPM, 72, F.G, (int)blockIdx.x);
            pg8::EpiBranch E{(const bf16*)(F.ws + WS_GT), Hb, 72};
            pg8::gemm_phase<pg8::EpiBranch, pg8::BranchOrder, PG8_ALIGN, PG8_SP2>(F.lds + RING_OFF, g, S, E);
            if (DUPG & 4) { __syncthreads(); pg8::gemm_phase<pg8::EpiBranch, pg8::BranchOrder, PG8_ALIGN, PG8_SP2>(F.lds + RING_OFF, g, S, E); }
        }
        SEAM(P + 10);
        if (PHEN(11) && IN(P + 11)) {
            pg8::Gemm g{Hb, WO, MT, D, D, 1, 1};
            { pg8::TileOrder S; S.init(64, 8, 0, 0, 0, F.G, (int)blockIdx.x, D / 64); S.wgm = WGM_N8; pg8::EpiRes<false> E{F.out, XC, modl + 5 * D, 1.0f};
              pg8::gemm_phase<pg8::EpiRes<false>, pg8::TileOrder, PG8_ALIGN, PG8_SP2>(F.lds + RING_OFF, g, S, E); }
            if constexpr (nPM == 72) { pg8::QuarterOrder S; S.init(8, 64, D / 256, F.G, (int)blockIdx.x); pg8::EpiRes<true> E{nullptr, PB, modl + 5 * D, 1.0f};
              pg8::gemm_phase<pg8::EpiRes<true>, pg8::QuarterOrder, PG8_ALIGN, PG8_SP2>(F.lds + RING_OFF, g, S, E); }
        }
        SEAM(P + 11);
        if (PHEN(12) && IN(P + 12)) { phase_norm<false, (nPM == 72), false>(F, F.out, XC, F.in[I_F2N] + (size_t)l * D, modl + 6 * D, nPM * 256);
#ifdef DUPN
            if (nPM == 64) { phase_norm<false, false, false>(F, F.out, XC, F.in[I_F2N] + (size_t)l * D, modl + 6 * D, nPM * 256); phase_norm<false, false, false>(F, F.out, XC, F.in[I_F2N] + (size_t)l * D, modl + 6 * D, nPM * 256); }
#endif
        }
        SEAM(P + 12);
        if (PHEN(13) && IN(P + 13)) {
            pg8::Gemm g{Hb, WFI, MT, 2 * DFF, D, 1, 1}; pg8::TileOrder S; S.init(nPM, 44, 0, 0, 0, F.G, (int)blockIdx.x, 32);
            pg8::EpiSwiglu E{ACT, DFF};
            pg8::gemm_phase<pg8::EpiSwiglu, pg8::TileOrder, PG8_ALIGN, PG8_SP2>(F.lds + RING_OFF, g, S, E);
        }
        SEAM(P + 13);
        if (PHEN(14) && IN(P + 14)) {
            pg8::Gemm g{ACT, WFO, MT, D, DFF, 1, 1};
            { pg8::TileOrder S; S.init(64, 8, 0, 0, 0, F.G, (int)blockIdx.x, DFF / 64); S.wgm = WGM_N8; pg8::EpiRes<false> E{F.out, XC, modl + 8 * D, 0.5f};
              pg8::gemm_phase<pg8::EpiRes<false>, pg8::TileOrder, PG8_ALIGN, PG8_SP2>(F.lds + RING_OFF, g, S, E); }
            if constexpr (nPM == 72) { pg8::QuarterOrder S; S.init(8, 64, DFF / 256, F.G, (int)blockIdx.x); pg8::EpiRes<true> E{nullptr, PB, modl + 8 * D, 0.5f};
              pg8::gemm_phase<pg8::EpiRes<true>, pg8::QuarterOrder, PG8_ALIGN, PG8_SP2>(F.lds + RING_OFF, g, S, E); }
        }
        SEAM(P + 14);
    }
__global__ void __launch_bounds__(NWAVES * 64, 2) mk_fwd(Args args) {
    extern __shared__ __attribute__((aligned(16))) unsigned char lds[];
    Frame F;
    F.lds = (LAS unsigned char*)lds;
    F.MISC = (volatile LAS unsigned*)(F.lds + MISC_OFF);
    F.tid = threadIdx.x; F.lane = F.tid & 63; F.wave = __builtin_amdgcn_readfirstlane(F.tid >> 6);
    F.G = gridDim.x;
    F.ws = args.ws; F.ctl = (gu32*)(args.ws + WS_CTL); F.out = args.out;
    F.in = args.in;
    for (int u = F.tid; u < (LDS_BYTES - LDSCTL_OFF) / 4; u += NWAVES * 64) ((LAS unsigned*)(F.lds + LDSCTL_OFF))[u] = 0u;
    __syncthreads();
    const int lo = args.ph_lo, hi = args.ph_hi;
#if TPROBE
    if (blockIdx.x == 0 && F.tid == 0) { const unsigned long long t0_ = wall_clock64(); ((unsigned long long*)(F.ws + WS_CTL + 524288))[0] = t0_; ((unsigned long long*)(F.ws + WS_CTL + 524288))[1] = t0_; }
#endif
    XcdBarrier bar; bar.bar = (unsigned*)(F.ctl + CW_BAR) + args.li * XCD_BAR_WORDS; bar.x = 0; bar.st = nullptr;
    if (hi - lo > 1) bar = xcd_barrier_post((unsigned*)(F.ctl + CW_BAR) + args.li * XCD_BAR_WORDS, F.MISC + 8);


    layer_body<0>(F, bar, lo, hi);
#if !PROBE
    layer_body<1>(F, bar, lo, hi);
#endif
#if TPROBE == 1
    if (IN(31)) {
        const unsigned long long* TS = (const unsigned long long*)(F.ws + WS_CTL + 524288);
        const float tot = (float)(TS[31] - TS[0]);
        const float fa = (float)(TS[TP_A2] - TS[TP_A1]) / tot, fb = (float)(TS[TP_B2] - TS[TP_B1]) / tot;
        const size_t n = (size_t)ML * D; float* o = F.out;
        for (size_t i = (size_t)blockIdx.x * 512 + F.tid; i < n; i += (size_t)F.G * 512) { float v = o[i] * (1.0f + fa); if (i == 0) v += 10000.0f * fb; o[i] = v; }
    }
#endif
#if TPROBE == 2
    if (blockIdx.x == 0 && F.tid == 0) {
        unsigned long long* TS = (unsigned long long*)(F.ws + WS_CTL + 524288);
        unsigned long long sum = 0ull;
#ifdef TSEG_A
        sum += __hip_atomic_load(TS + 40 + TSEG_B, __ATOMIC_RELAXED, __HIP_MEMORY_SCOPE_AGENT) - __hip_atomic_load(TS + 40 + TSEG_A, __ATOMIC_RELAXED, __HIP_MEMORY_SCOPE_AGENT);
#endif
        for (int p = 0; p < 31; ++p) if ((TMASK >> p) & 1ull) sum += __hip_atomic_load(TS + p + 1, __ATOMIC_RELAXED, __HIP_MEMORY_SCOPE_AGENT) - __hip_atomic_load(TS + p, __ATOMIC_RELAXED, __HIP_MEMORY_SCOPE_AGENT);
        const unsigned long long t0 = wall_clock64(), want = (unsigned long long)TAMP * sum;
        while (wall_clock64() - t0 < want) __builtin_amdgcn_s_sleep(16);
    }
#endif
#if PROBE
    if (IN(16)) {
        const size_t n = (size_t)ML * D; float* o = F.out;
        for (size_t i = (size_t)blockIdx.x * 512 + F.tid; i < n; i += (size_t)F.G * 512) { const size_t r = i / D, c = i % D;
#if PROBE == 1
            o[i] = bf1(((const bf16*)(F.ws + WS_Y))[(size_t)MT * 512 + r * 512 + (c & 511)]);
#elif PROBE == 2
            o[i] = bf1(((const bf16*)(F.ws + WS_MIX + MX_CP))[(i % ((size_t)1152 * 16384))]);
#elif PROBE == 3
            o[i] = bf1(((const bf16*)(F.ws + WS_MIX + MX_CL))[(i % ((size_t)1152 * 16384))]);
#elif PROBE == 4
            o[i] = ((const float*)(F.ws + WS_ZS))[(i % ((size_t)ML * 32))];
#endif
        }
    }
#endif
#undef IN
#undef SEAM
}

#ifndef MK_N_LAUNCHES
#define MK_N_LAUNCHES 1
#endif
extern "C" void kernel_launch(void* const* d_in, const int* in_sizes, int n_in, void* d_out, int out_size, void* d_ws, size_t ws_size, hipStream_t stream) {
    static int grid = 0;
    if (grid == 0) {
        if (n_in != 27 || in_sizes[0] != ML * D || out_size != ML * D || ws_size < WS_END) { fprintf(stderr, "kernel_launch: shape mismatch n_in %d in0 %d out %d ws %zu (need %zu)\n", n_in, n_in > 0 ? in_sizes[0] : -1, out_size, ws_size, (size_t)WS_END); grid = -1; return; }
        int dev = 0, cus = 0, per_cu = 0;
        if (hipGetDevice(&dev) != hipSuccess || hipDeviceGetAttribute(&cus, hipDeviceAttributeMultiprocessorCount, dev) != hipSuccess) { grid = -1; return; }
        if (hipFuncSetAttribute((const void*)mk_fwd, hipFuncAttributeMaxDynamicSharedMemorySize, LDS_BYTES) != hipSuccess) { fprintf(stderr, "kernel_launch: hipFuncSetAttribute failed\n"); grid = -1; return; }
        if (hipOccupancyMaxActiveBlocksPerMultiprocessor(&per_cu, (const void*)mk_fwd, NWAVES * 64, LDS_BYTES) != hipSuccess || per_cu < 1)
            fprintf(stderr, "kernel_launch: note: occupancy query reports %d workgroups per CU\n", per_cu);
        (void)hipGetLastError();
        grid = cus;
    }
    if (grid < 0) return;
    if (hipMemsetAsync((char*)d_ws + WS_CTL, 0, CTL_ZERO_BYTES, stream) != hipSuccess) return;
    Args a{};
    for (int i = 0; i < 27; ++i) a.in[i] = (const float*)d_in[i];
    a.out = (float*)d_out; a.ws = (unsigned char*)d_ws; a.pad = 0;
#if MK_N_LAUNCHES == 1
    a.ph_lo = 0; a.ph_hi = N_PHASES; a.li = 0;
    hipLaunchKernelGGL(mk_fwd, dim3(grid), dim3(NWAVES * 64), LDS_BYTES, stream, a);
#else
    for (int p = 0; p < N_PHASES; ++p) { a.ph_lo = p; a.ph_hi = p + 1; a.li = 0;
        hipLaunchKernelGGL(mk_fwd, dim3(grid), dim3(NWAVES * 64), LDS_BYTES, stream, a); }
#endif
    const hipError_t le = hipPeekAtLastError();
    if (le != hipSuccess) fprintf(stderr, "kernel_launch: launch failed: %s\n", hipGetErrorName(le));
}
```

```cpp
#include <hip/hip_runtime.h>
#include <cstdio>
#include <cstdint>
namespace pg8 {
#define PG8_LAS __attribute__((address_space(3)))
typedef unsigned short bf16_t;
typedef short bf16x8 __attribute__((ext_vector_type(8)));
typedef float f32x4 __attribute__((ext_vector_type(4)));
typedef unsigned u32x4 __attribute__((ext_vector_type(4)));
constexpr int BM = 256, BK = 64, HALF = 128, HTB = HALF * BK * 2  , STAGE_BYTES = 8 * HTB, NXCD = 8, WGM = 8;

__host__ __device__ __forceinline__ int lds_byte(int r, int c) { const int st = (r >> 4) * 2 + (c >> 5), rr = r & 15, cc = c & 31, ob = rr * 64 + cc * 2; return st * 1024 + (ob ^ (((ob >> 9) & 1) << 5)); }
__host__ __device__ __forceinline__ void stage_rc(int b, int& R, int& C) { const int st = b / 1024, sb = b % 1024, swz = sb ^ (((sb >> 9) & 1) << 5); R = (st >> 1) * 16 + swz / 64; C = (st & 1) * 32 + (swz % 64) / 2; }
__host__ __device__ __forceinline__ int perm32(int rho) { const int n = rho >> 4, i = rho & 15; return 8 * (i >> 2) + 4 * n + (i & 3); }

__host__ __device__ __forceinline__ int perm32_inv(int x) { return 16 * ((x >> 2) & 1) + 4 * (x >> 3) + (x & 3); }
__host__ __device__ __forceinline__ size_t sw_off(int row, int k, int K, bool perm) {
    const int tile = row >> 8, h = (row >> 7) & 1, Rp = row & 127, R = perm ? ((Rp & ~31) + perm32_inv(Rp & 31)) : Rp;
    return ((size_t)(tile * 2 + h) * (K >> 6) + (k >> 6)) * 8192 + (size_t)(lds_byte(R, k & 63) >> 1);
}
struct Unit { int pm, pn, k0, nt; };
struct Gemm { const bf16_t* A; const bf16_t* Bt; int M, N, K; int swb = 0, swa = 0; };

struct StaticOrder {
    int nM, nN, nwg, G, c;
    __host__ __device__ void init(int M, int N, int G_, int c_) { nM = M / BM; nN = N / BM; nwg = nM * nN; G = G_; c = c_; }
    __host__ __device__ bool next(int i, Unit& u) const {
        const long L = (long)i * G + c; if (L >= nwg) return false;
        int wgid = (int)L; { const int q = nwg / NXCD, r = nwg % NXCD, xcd = wgid % NXCD, off = wgid / NXCD; wgid = (xcd < r ? xcd * (q + 1) : r * (q + 1) + (xcd - r) * q) + off; }
        const int nig = WGM * nN, gid = wgid / nig, fm = gid * WGM, gsz = (nM - fm) < WGM ? (nM - fm) : WGM;
        u.pm = fm + ((wgid % nig) % gsz); u.pn = (wgid % nig) / gsz; u.k0 = 0; u.nt = 0; return true;
    }
    __device__ __forceinline__ void a_ready(const Unit&) const {}
    __device__ __forceinline__ void done(const Unit&) const {}
};

typedef float f32x2c_t __attribute__((ext_vector_type(2)));
typedef __bf16 bf16x2c_t __attribute__((ext_vector_type(2)));
__device__ __forceinline__ unsigned cvt_pk_bf16(float lo, float hi) { const f32x2c_t v = {lo, hi}; const bf16x2c_t b = __builtin_convertvector(v, bf16x2c_t); return __builtin_bit_cast(unsigned, b); }
typedef _Float16 f16x2c_t __attribute__((ext_vector_type(2)));
__device__ __forceinline__ unsigned cvt_pk_f16(float lo, float hi) { const f32x2c_t v = {lo, hi}; const f16x2c_t b = __builtin_convertvector(v, f16x2c_t); return __builtin_bit_cast(unsigned, b); }
__device__ __forceinline__ f32x2c_t cvt_up_f16(unsigned w) { return __builtin_convertvector(__builtin_bit_cast(f16x2c_t, w), f32x2c_t); }
typedef float f32x2 __attribute__((ext_vector_type(2)));
#ifndef WGM_DEF
#define WGM_DEF 4
#endif
#ifndef WGM_BR
#define WGM_BR 4
#endif
#ifndef WGM_N8
#define WGM_N8 4
#endif
__device__ __forceinline__ void tile_map(int nM, int nN, int wgid, int& pm, int& pn, int wgm = WGM_DEF) {
    const int nwg = nM * nN;
    { const int q = nwg / NXCD, r = nwg % NXCD, xcd = wgid % NXCD, off = wgid / NXCD; wgid = (xcd < r ? xcd * (q + 1) : r * (q + 1) + (xcd - r) * q) + off; }
    const int nig = wgm * nN, gid = wgid / nig, fm = gid * wgm, gsz = (nM - fm) < wgm ? (nM - fm) : wgm;
    pm = fm + ((wgid % nig) % gsz); pn = (wgid % nig) / gsz;
}
struct TileOrder {
    int nM0, nN0, n0, nM1, nN1, n1, pm1, G, c, ntK, skip1, wgm = WGM_DEF;
    __device__ __forceinline__ void init(int nM0_, int nN0_, int nM1_, int nN1_, int pm1_, int G_, int c_, int ntK_, int skip1_ = -1) { skip1 = skip1_; ntK = ntK_; nM0 = nM0_; nN0 = nN0_; n0 = nM0_ * nN0_; nM1 = nM1_; nN1 = nN1_; n1 = nM1_ * nN1_; pm1 = pm1_; G = G_; c = c_; }
    __device__ __forceinline__ bool next(int i, Unit& u) const {
        long L = (long)i * G + c; u.k0 = 0; u.nt = ntK;
        if (L < n0) { tile_map(nM0, nN0, (int)L, u.pm, u.pn, wgm); return true; }
        L -= n0;
        if (L < n1) { tile_map(nM1, nN1, (int)L, u.pm, u.pn, wgm); u.pm += pm1; if (skip1 >= 0 && u.pn >= skip1) ++u.pn; return true; }
        return false;
    }
    __device__ __forceinline__ void a_ready(const Unit&) const {}
    __device__ __forceinline__ void done(const Unit&) const {}
};
struct QuarterOrder {
    int n, pm0, G, c, ntK;
    __device__ __forceinline__ void init(int nM, int pm0_, int ntq, int G_, int c_) { n = nM * 8 * 4; pm0 = pm0_; ntK = ntq; G = G_; c = c_; }
    __device__ __forceinline__ bool next(int i, Unit& u) const {
        const long L = (long)i * G + c; if (L >= n) return false;
        const int t = (int)L >> 2, qq = (int)L & 3; u.pm = pm0 + (t >> 3); u.pn = t & 7; u.k0 = qq * ntK; u.nt = ntK; return true;
    }
    __device__ __forceinline__ void a_ready(const Unit&) const {}
    __device__ __forceinline__ void done(const Unit&) const {}
};
struct BranchOrder {
    int nM, NPM, G, c; static constexpr int ntK = 8;
    __device__ __forceinline__ void init(int nM_, int NPM_, int G_, int c_) { nM = nM_; NPM = NPM_; G = G_; c = c_; }
    __device__ __forceinline__ bool next(int i, Unit& u) const {
        const long L = (long)(i >> 2) * G + c; if (L >= nM * 8) return false;
        int pm, pn; tile_map(nM, 8, (int)L, pm, pn, WGM_BR); const int n = i & 3;
        u.pm = n * NPM + pm; u.pn = n * 8 + pn; u.k0 = 0; u.nt = 8; return true;
    }
    __device__ __forceinline__ void a_ready(const Unit&) const {}
    __device__ __forceinline__ void done(const Unit&) const {}
};

__device__ __forceinline__ float silu_f(float a) { return a * __builtin_amdgcn_rcpf(1.0f + __expf(-a)); }
__device__ __forceinline__ float sigmoid_f(float a) { return __builtin_amdgcn_rcpf(1.0f + __expf(-a)); }
struct EpiSwiglu {
    static constexpr bool PERM = true, AFTER_DRAIN = false, CHAIN = false;
    bf16_t* O; int ldc;
    __device__ __forceinline__ void operator()(const f32x4 (&acc)[2][2][4][2], const Unit& u, int wr, int wc, int fr, int fq) const {
        const int row0 = u.pm * BM + wr * 64 + fr, col0 = u.pn * HALF + wc * 32 + 8 * fq;
#pragma unroll
        for (int ai = 0; ai < 2; ++ai)
#pragma unroll
            for (int m = 0; m < 4; ++m) { bf16_t* rowp = O + sw_off(row0 + ai * HALF + m * 16, col0, ldc, false);
                const f32x4 a0 = acc[ai][0][m][0], a1 = acc[ai][0][m][1], b0 = acc[ai][1][m][0], b1 = acc[ai][1][m][1];
                f32x4 v0, v1;
#pragma unroll
                for (int j = 0; j < 4; ++j) { v0[j] = silu_f(a0[j]) * b0[j]; v1[j] = silu_f(a1[j]) * b1[j]; }
                u32x4 w; w.x = cvt_pk_bf16(v0[0], v0[1]); w.y = cvt_pk_bf16(v0[2], v0[3]); w.z = cvt_pk_bf16(v1[0], v1[1]); w.w = cvt_pk_bf16(v1[2], v1[3]);
                *(u32x4*)rowp = w; }
    }
};
typedef unsigned u32x2p __attribute__((ext_vector_type(2)));
template <bool ATOMIC  > struct EpiRes {
    static constexpr bool PERM = false, AFTER_DRAIN = false, CHAIN = false;
    float* out_l; float* out_c; const float* gate; float coef;
    __device__ __forceinline__ void operator()(const f32x4 (&acc)[2][2][4][2], const Unit& u, int wr, int wc, int fr, int fq) const {
        const bool isc = u.pm >= 64; const int b9 = isc ? 8 : (u.pm >> 3);
        const int prow = (isc ? (u.pm - 64) : u.pm) * BM + wr * 64 + fr, col0 = u.pn * BM + wc * 32 + 4 * fq;
        float* op = isc ? out_c : out_l;
        const float* gp = gate + (size_t)b9 * 18432 + col0;
        f32x4 gv[2][2];
#pragma unroll
        for (int bj = 0; bj < 2; ++bj)
#pragma unroll
            for (int n = 0; n < 2; ++n) gv[bj][n] = *(const f32x4*)(gp + bj * HALF + n * 16) * coef;
        if constexpr (!ATOMIC) {
#pragma unroll
            for (int ai = 0; ai < 2; ++ai) {
                f32x4 bs[4][2][2];
#pragma unroll
                for (int m = 0; m < 4; ++m)
#pragma unroll
                    for (int bj = 0; bj < 2; ++bj)
#pragma unroll
                        for (int n = 0; n < 2; ++n) bs[m][bj][n] = *(const f32x4*)(op + (size_t)(prow + ai * HALF + m * 16) * 2048 + col0 + bj * HALF + n * 16);
#pragma unroll
                for (int m = 0; m < 4; ++m)
#pragma unroll
                    for (int bj = 0; bj < 2; ++bj)
#pragma unroll
                        for (int n = 0; n < 2; ++n) *(f32x4*)(op + (size_t)(prow + ai * HALF + m * 16) * 2048 + col0 + bj * HALF + n * 16) = bs[m][bj][n] + gv[bj][n] * acc[ai][bj][m][n];
                asm volatile("" ::: "memory");
            }
        } else {
            bf16_t* pp = (bf16_t*)op + (size_t)(u.k0 / u.nt) * ((size_t)2048 * 2048);
#pragma unroll
            for (int ai = 0; ai < 2; ++ai)
#pragma unroll
                for (int m = 0; m < 4; ++m) { const size_t off = (size_t)(prow + ai * HALF + m * 16) * 2048 + col0;
#pragma unroll
                    for (int bj = 0; bj < 2; ++bj)
#pragma unroll
                        for (int n = 0; n < 2; ++n) { const f32x4 r = gv[bj][n] * acc[ai][bj][m][n]; u32x2p w; w.x = cvt_pk_f16(r[0], r[1]); w.y = cvt_pk_f16(r[2], r[3]); *(u32x2p*)(pp + off + bj * HALF + n * 16) = w; } }
        }
    }
};
typedef unsigned u32x2e __attribute__((ext_vector_type(2)));
template <bool FINAL> struct EpiResB {
    static constexpr bool PERM = false, AFTER_DRAIN = false, CHAIN = false;
    const bf16_t* src; bf16_t* dstb; float* dstf; const float* gate; float coef;
    __device__ __forceinline__ void operator()(const f32x4 (&acc)[2][2][4][2], const Unit& u, int wr, int wc, int fr, int fq) const {
        const int b9 = u.pm >> 3;
        const int prow = u.pm * BM + wr * 64 + fr, col0 = u.pn * BM + wc * 32 + 4 * fq;
        const float* gp = gate + (size_t)b9 * 18432 + col0;
        f32x4 gv[2][2];
#pragma unroll
        for (int bj = 0; bj < 2; ++bj)
#pragma unroll
            for (int n = 0; n < 2; ++n) gv[bj][n] = *(const f32x4*)(gp + bj * HALF + n * 16) * coef;
        u32x2e bs[2][4][2][2];
#pragma unroll
        for (int ai = 0; ai < 2; ++ai)
#pragma unroll
            for (int m = 0; m < 4; ++m)
#pragma unroll
                for (int bj = 0; bj < 2; ++bj)
#pragma unroll
                    for (int n = 0; n < 2; ++n) bs[ai][m][bj][n] = *(const u32x2e*)(src + (size_t)(prow + ai * HALF + m * 16) * 2048 + col0 + bj * HALF + n * 16);
#pragma unroll
        for (int ai = 0; ai < 2; ++ai) {
#pragma unroll
            for (int m = 0; m < 4; ++m)
#pragma unroll
                for (int bj = 0; bj < 2; ++bj)
#pragma unroll
                    for (int n = 0; n < 2; ++n) { const size_t off = (size_t)(prow + ai * HALF + m * 16) * 2048 + col0 + bj * HALF + n * 16; const u32x2e b = bs[ai][m][bj][n];
                        const f32x2c_t x01 = cvt_up_f16(b.x), x23 = cvt_up_f16(b.y); const f32x4 xo = {x01.x, x01.y, x23.x, x23.y};
                        const f32x4 r = xo + gv[bj][n] * acc[ai][bj][m][n];
                        if constexpr (FINAL) *(f32x4*)(dstf + off) = r;
                        else { u32x2e w; w.x = cvt_pk_f16(r[0], r[1]); w.y = cvt_pk_f16(r[2], r[3]); *(u32x2e*)(dstb + off) = w; } }
            asm volatile("" ::: "memory");
        }
    }
};
struct EpiZ {
    static constexpr bool PERM = true, AFTER_DRAIN = false, CHAIN = false;
    bf16_t* Z; float* ZS; int ldz; bf16_t* GT;
    __device__ __forceinline__ void operator()(const f32x4 (&acc)[2][2][4][2], const Unit& u, int wr, int wc, int fr, int fq) const {
        const int row0 = u.pm * BM + wr * 64 + fr, col0 = u.pn * BM + wc * 32 + 8 * fq;
        if (u.pn >= 25) {
            const int t = u.pn - 25, pnh = t >> 2, bjd = (t & 3) >> 1, wcd = 2 * (t & 1) + (wc >> 1), fqd = 2 * (wc & 1) + (fq >> 1), nd = fq & 1;
            bf16_t* tb = GT + ((size_t)u.pm * 32 + pnh) * 65536 + (size_t)(((wr * 4 + wcd) * 64 + fqd * 16 + fr) * 8 + nd * 4) + bjd * 4096;
#pragma unroll
            for (int ai = 0; ai < 2; ++ai)
#pragma unroll
                for (int m = 0; m < 4; ++m) { f32x4 e[4];
#pragma unroll
                    for (int br = 0; br < 4; ++br) { const f32x4 g = acc[ai][br >> 1][m][br & 1];
#pragma unroll
                        for (int j = 0; j < 4; ++j) e[br][j] = 1.0f + __expf(-fminf(fmaxf(g[j], -40.f), 40.f)); }
#pragma unroll
                    for (int br = 0; br < 4; ++br) { f32x4 r;
#pragma unroll
                        for (int j = 0; j < 4; ++j) r[j] = (br < 3 ? e[br + 1][j] : 1.0f) * __builtin_amdgcn_rcpf(e[br][j]);
                        u32x2p w; w.x = cvt_pk_bf16(r[0], r[1]); w.y = cvt_pk_bf16(r[2], r[3]);
                        *(u32x2p*)(tb + (size_t)br * 8 * 65536 + (ai * 4 + m) * 2 * 4096) = w; } }
            return;
        }
        if (u.pn == 10) {
            if (wc == 0) {
#pragma unroll
                for (int ai = 0; ai < 2; ++ai)
#pragma unroll
                    for (int m = 0; m < 4; ++m) { float* zp = ZS + (size_t)(row0 + ai * HALF + m * 16) * 32 + 8 * fq;
                        *(f32x4*)zp = acc[ai][0][m][0]; *(f32x4*)(zp + 4) = acc[ai][0][m][1]; }
            }
            return;
        }
#pragma unroll
        for (int ai = 0; ai < 2; ++ai)
#pragma unroll
            for (int m = 0; m < 4; ++m) { bf16_t* rowp = Z + (size_t)(row0 + ai * HALF + m * 16) * ldz + col0;
#pragma unroll
                for (int bj = 0; bj < 2; ++bj) { const f32x4 v0 = acc[ai][bj][m][0], v1 = acc[ai][bj][m][1];
                    u32x4 w; w.x = cvt_pk_bf16(v0[0], v0[1]); w.y = cvt_pk_bf16(v0[2], v0[3]); w.z = cvt_pk_bf16(v1[0], v1[1]); w.w = cvt_pk_bf16(v1[2], v1[3]);
                    *(u32x4*)(rowp + bj * HALF) = w; } }
    }
};
struct EpiBranch {
    static constexpr bool PERM = true, AFTER_DRAIN = false, CHAIN = true;
    const bf16_t* GT; bf16_t* Hout; int NPM;
    static __device__ __forceinline__ float epos(float g) { return __expf(-fminf(fmaxf(g, -40.f), 40.f)); }
    __device__ __forceinline__ void chain(f32x4 (&acc)[2][2][4][2], const Unit& u, int wr, int wc, int fr, int fq) const {
        const int n = u.pn >> 3, pn = u.pn & 7, pm = u.pm - n * NPM;
        const int row0 = pm * BM + wr * 64 + fr, col0 = pn * BM + wc * 32 + 8 * fq;
        u32x4 ga[2][4][2];
#pragma unroll
        for (int ai = 0; ai < 2; ++ai)
#pragma unroll
            for (int m = 0; m < 4; ++m)
#pragma unroll
                for (int bj = 0; bj < 2; ++bj) ga[ai][m][bj] = *(const u32x4*)(GT + ((size_t)pm * 32 + n * 8 + pn) * 65536 + ((ai * 4 + m) * 2 + bj) * 4096 + (size_t)threadIdx.x * 8);
#pragma unroll
        for (int ai = 0; ai < 2; ++ai) {
#pragma unroll
            for (int m = 0; m < 4; ++m) { const size_t r = (size_t)(row0 + ai * HALF + m * 16);
#pragma unroll
                for (int bj = 0; bj < 2; ++bj) { const u32x4 g = ga[ai][m][bj];
                    const f32x4 f0 = {__uint_as_float(g.x << 16), __uint_as_float(g.x & 0xffff0000u), __uint_as_float(g.y << 16), __uint_as_float(g.y & 0xffff0000u)};
                    const f32x4 f1 = {__uint_as_float(g.z << 16), __uint_as_float(g.z & 0xffff0000u), __uint_as_float(g.w << 16), __uint_as_float(g.w & 0xffff0000u)};
                    const f32x4 s0 = acc[ai][bj][m][0] * f0, s1 = acc[ai][bj][m][1] * f1;
                    if (n < 3) { acc[ai][bj][m][0] = s0; acc[ai][bj][m][1] = s1; }
                    else { u32x4 w; w.x = cvt_pk_bf16(s0[0], s0[1]); w.y = cvt_pk_bf16(s0[2], s0[3]); w.z = cvt_pk_bf16(s1[0], s1[1]); w.w = cvt_pk_bf16(s1[2], s1[3]);
                        *(u32x4*)(Hout + sw_off((int)r, col0 + bj * HALF, 2048, false)) = w;
                        acc[ai][bj][m][0] = (f32x4){0.f, 0.f, 0.f, 0.f}; acc[ai][bj][m][1] = (f32x4){0.f, 0.f, 0.f, 0.f}; } } }
        }
    }
};
template <class Epi, class Sched, bool ALIGN_EPI = false, bool SP2 = false>
__device__ __forceinline__ void gemm_phase(PG8_LAS unsigned char* lds, const Gemm g, const Sched& S, const Epi& E) {
    const int tid = threadIdx.x, wid = __builtin_amdgcn_readfirstlane(tid >> 6), lane = tid & 63, wr = wid >> 2, wc = wid & 3, fr = lane & 15, fq = lane >> 4;
    const int K = g.K, nt = S.ntK;
    unsigned voffA[2], voffB[2];
#pragma unroll
    for (int i = 0; i < 2; ++i) { int R, C; stage_rc(tid * 16 + i * 8192, R, C); const int Rb = Epi::PERM ? ((R & ~31) + perm32(R & 31)) : R;
        voffA[i] = g.swa ? (unsigned)(tid * 16 + i * 8192) : (unsigned)(R * K + C) * 2u; voffB[i] = g.swb ? (unsigned)(tid * 16 + i * 8192) : (unsigned)(Rb * K + C) * 2u; }
    const size_t kstep = (size_t)(BK * 2);
    const size_t hstep = (size_t)HALF * K * 2;
    const size_t tstep = 2 * hstep;
    const size_t kstepA = g.swa ? (size_t)HTB : kstep, hstepA = g.swa ? (size_t)(K / BK) * HTB : hstep, tstepA = 2 * hstepA;
    const size_t kstepB = g.swb ? (size_t)HTB : kstep, hstepB = g.swb ? (size_t)(K / BK) * HTB : hstep, tstepB = 2 * hstepB;
    const unsigned ldsw = (unsigned)wid * 1024u;
    const int aoff = lds_byte(wr * 64 + fr, fq * 8), boff = lds_byte(wc * 32 + fr, fq * 8);
#define PG8_SA(b, h) (((b) * 2 + (h)) * HTB)
#define PG8_SB(b, h) ((4 + (b) * 2 + (h)) * HTB)
#define PG8_STAGE(bufoff, gbase, voff) do { _Pragma("unroll") for (int _i = 0; _i < 2; ++_i) \
        __builtin_amdgcn_global_load_lds((const unsigned*)((const char*)(gbase) + (voff)[_i]), (PG8_LAS unsigned*)(lds + (bufoff) + ldsw + _i * 8192), 16, 0, 0); } while (0)
#define PG8_LDA(dst, b, h) do { _Pragma("unroll") for (int m = 0; m < 4; ++m) _Pragma("unroll") for (int k = 0; k < 2; ++k) dst[m][k] = *(const PG8_LAS bf16x8*)(lds + PG8_SA(b, h) + aoff + m * 2048 + k * 1024); } while (0)
#define PG8_LDB(dst, b, h) do { _Pragma("unroll") for (int n = 0; n < 2; ++n) _Pragma("unroll") for (int k = 0; k < 2; ++k) dst[n][k] = *(const PG8_LAS bf16x8*)(lds + PG8_SB(b, h) + boff + n * 2048 + k * 1024); } while (0)
#define PG8_MMA(ai, bj, At, Bt) do { __builtin_amdgcn_s_setprio(1); _Pragma("unroll") for (int m = 0; m < 4; ++m) _Pragma("unroll") for (int n = 0; n < 2; ++n) _Pragma("unroll") for (int k = 0; k < 2; ++k) \
        acc[ai][bj][m][n] = __builtin_amdgcn_mfma_f32_16x16x32_bf16(Bt[n][k], At[m][k], acc[ai][bj][m][n], 0, 0, 0); __builtin_amdgcn_s_setprio(0); } while (0)
#define PG8_WAIT_V(n) asm volatile("s_waitcnt vmcnt(" #n ")" ::: "memory")
#define PG8_WAIT_L(n) asm volatile("s_waitcnt lgkmcnt(" #n ")" ::: "memory")
#define PG8_BAR __builtin_amdgcn_s_barrier()
#define PG8_SCHED __builtin_amdgcn_sched_barrier(0)
    Unit cur, nxt; int ui = 0;
    if (!S.next(0, cur)) return;
    f32x4 acc[2][2][4][2];
#pragma unroll
    for (int a = 0; a < 2; ++a)
#pragma unroll
        for (int b = 0; b < 2; ++b)
#pragma unroll
            for (int m = 0; m < 4; ++m)
#pragma unroll
                for (int n = 0; n < 2; ++n) acc[a][b][m][n] = (f32x4){0.f, 0.f, 0.f, 0.f};
    bf16x8 At[4][2], B0[2][2], B1[2][2];
    const char* cA = (const char*)g.A + (size_t)cur.pm * tstepA + (size_t)cur.k0 * kstepA; const char* cB = (const char*)g.Bt + (size_t)cur.pn * tstepB + (size_t)cur.k0 * kstepB;
    S.a_ready(cur);
    if constexpr (SP2) {
        PG8_STAGE(PG8_SB(0, 0), cB, voffB); PG8_STAGE(PG8_SB(0, 1), cB + hstepB, voffB); PG8_STAGE(PG8_SA(0, 0), cA, voffA); PG8_STAGE(PG8_SA(0, 1), cA + hstepA, voffA);
        if (wr == 1) PG8_BAR;
        PG8_WAIT_V(2); PG8_BAR;
        PG8_STAGE(PG8_SB(1, 0), cB + kstepB, voffB); PG8_STAGE(PG8_SA(1, 0), cA + kstepA, voffA); PG8_STAGE(PG8_SB(1, 1), cB + hstepB + kstepB, voffB);
        PG8_WAIT_V(6); PG8_BAR;
    } else {
        PG8_STAGE(PG8_SB(0, 0), cB, voffB); PG8_STAGE(PG8_SA(0, 0), cA, voffA); PG8_STAGE(PG8_SB(0, 1), cB + hstepB, voffB); PG8_STAGE(PG8_SA(0, 1), cA + hstepA, voffA);
        if (wr == 1) PG8_BAR;
        PG8_WAIT_V(4); PG8_BAR;
        PG8_STAGE(PG8_SB(1, 0), cB + kstepB, voffB); PG8_STAGE(PG8_SA(1, 0), cA + kstepA, voffA); PG8_STAGE(PG8_SB(1, 1), cB + hstepB + kstepB, voffB);
        PG8_WAIT_V(6); PG8_BAR;
    }
    for (;;) {
        const bool has_next = S.next(ui + 1, nxt);
        const char* nA = has_next ? (const char*)g.A + (size_t)nxt.pm * tstepA + (size_t)nxt.k0 * kstepA : cA; const char* nB = has_next ? (const char*)g.Bt + (size_t)nxt.pn * tstepB + (size_t)nxt.k0 * kstepB : cB;
        for (int t = 0; t < nt; t += 2) {
            const bool last = (t == nt - 2);
            const char* a1 = cA + (size_t)(t + 1) * kstepA;
            const char* a2 = last ? nA : cA + (size_t)(t + 2) * kstepA; const char* b2 = last ? nB : cB + (size_t)(t + 2) * kstepB;
            const char* a3 = a2 + kstepA; const char* b3 = b2 + kstepB;
            if (last && has_next) S.a_ready(nxt);
            if constexpr (SP2) {
            PG8_LDB(B0, 0, 0); PG8_LDB(B1, 0, 1); PG8_SCHED; PG8_LDA(At, 0, 0); PG8_STAGE(PG8_SA(1, 1), a1 + hstepA, voffA);
            PG8_WAIT_V(8); PG8_WAIT_L(0); PG8_BAR; PG8_MMA(0, 0, At, B0); PG8_MMA(0, 1, At, B1); PG8_BAR; PG8_SCHED;
            PG8_LDA(At, 0, 1); PG8_STAGE(PG8_SB(0, 0), b2, voffB); PG8_STAGE(PG8_SB(0, 1), b2 + hstepB, voffB); PG8_STAGE(PG8_SA(0, 0), a2, voffA);
            PG8_WAIT_V(8); PG8_WAIT_L(0); PG8_BAR; PG8_MMA(1, 0, At, B0); PG8_MMA(1, 1, At, B1); PG8_BAR; PG8_SCHED;
            PG8_LDB(B0, 1, 0); PG8_LDB(B1, 1, 1); PG8_SCHED; PG8_LDA(At, 1, 0); PG8_STAGE(PG8_SA(0, 1), a2 + hstepA, voffA);
            PG8_WAIT_V(8); PG8_WAIT_L(0); PG8_BAR; PG8_MMA(0, 0, At, B0); PG8_MMA(0, 1, At, B1); PG8_BAR; PG8_SCHED;
            PG8_LDA(At, 1, 1); PG8_STAGE(PG8_SB(1, 0), b3, voffB); PG8_STAGE(PG8_SB(1, 1), b3 + hstepB, voffB); PG8_STAGE(PG8_SA(1, 0), a3, voffA);
            PG8_WAIT_V(8); PG8_WAIT_L(0); PG8_BAR; PG8_MMA(1, 0, At, B0); PG8_MMA(1, 1, At, B1); PG8_BAR; PG8_SCHED;
            } else {
            PG8_LDB(B0, 0, 0); PG8_SCHED; PG8_LDA(At, 0, 0); PG8_STAGE(PG8_SA(1, 1), a1 + hstepA, voffA);
            PG8_WAIT_L(8); PG8_BAR; PG8_WAIT_L(0); PG8_MMA(0, 0, At, B0); PG8_BAR; PG8_SCHED;
            PG8_LDB(B1, 0, 1); PG8_STAGE(PG8_SB(0, 0), b2, voffB);
            PG8_BAR; PG8_WAIT_L(0); PG8_MMA(0, 1, At, B1); PG8_BAR;
            PG8_LDA(At, 0, 1); PG8_STAGE(PG8_SA(0, 0), a2, voffA);
            PG8_BAR; PG8_WAIT_L(0); PG8_MMA(1, 0, At, B0); PG8_BAR; PG8_SCHED;
            PG8_STAGE(PG8_SB(0, 1), b2 + hstepB, voffB);
            PG8_WAIT_V(6); PG8_BAR; PG8_MMA(1, 1, At, B1); PG8_BAR;
            PG8_LDB(B0, 1, 0); PG8_SCHED; PG8_LDA(At, 1, 0); PG8_STAGE(PG8_SA(0, 1), a2 + hstepA, voffA);
            PG8_WAIT_L(8); PG8_BAR; PG8_WAIT_L(0); PG8_MMA(0, 0, At, B0); PG8_BAR; PG8_SCHED;
            PG8_LDB(B1, 1, 1); PG8_STAGE(PG8_SB(1, 0), b3, voffB);
            PG8_BAR; PG8_WAIT_L(0); PG8_MMA(0, 1, At, B1); PG8_BAR;
            PG8_LDA(At, 1, 1); PG8_STAGE(PG8_SA(1, 0), a3, voffA);
            PG8_BAR; PG8_WAIT_L(0); PG8_MMA(1, 0, At, B0); PG8_BAR; PG8_SCHED;
            PG8_STAGE(PG8_SB(1, 1), b3 + hstepB, voffB);
            PG8_WAIT_V(6); PG8_BAR; PG8_MMA(1, 1, At, B1); PG8_BAR;
            }
        }
        if constexpr (ALIGN_EPI) { if (wr == 0) PG8_BAR; }
        if constexpr (Epi::CHAIN) { E.chain(acc, cur, wr, wc, fr, fq); S.done(cur); }
        else if constexpr (!Epi::AFTER_DRAIN) { E(acc, cur, wr, wc, fr, fq); S.done(cur); }
        if (!has_next) break;
        if constexpr (!Epi::CHAIN) {
#pragma unroll
        for (int a = 0; a < 2; ++a)
#pragma unroll
            for (int b = 0; b < 2; ++b)
#pragma unroll
                for (int m = 0; m < 4; ++m)
#pragma unroll
                    for (int n = 0; n < 2; ++n) acc[a][b][m][n] = (f32x4){0.f, 0.f, 0.f, 0.f};
        }
        cur = nxt; cA = nA; cB = nB; ++ui;
        if constexpr (ALIGN_EPI) { if (wr == 1) PG8_BAR; }
    }
    PG8_WAIT_V(0);
    if constexpr (!ALIGN_EPI) { if (wr == 0) PG8_BAR; }
    PG8_BAR;
    if constexpr (Epi::AFTER_DRAIN) { E.fused(acc, cur, wr, wc, fr, fq, lds, wid, lane); S.done(cur); }
#undef PG8_SA
#undef PG8_SB
#undef PG8_STAGE
#undef PG8_LDA
#undef PG8_LDB
#undef PG8_MMA
#undef PG8_WAIT_V
#undef PG8_WAIT_L
#undef PG8_BAR
#undef PG8_SCHED
}
}
#ifndef PG8_SP2
#define PG8_SP2 true
#endif
#ifndef PG8_ALIGN
#define PG8_ALIGN true
#endif
constexpr int NWAVES = 8;
constexpr int D = 2048, BATCH = 8, SEQ = 2048, CTXL = 256, DFF = 5632, NLAYER = 2;
constexpr int ML = BATCH * SEQ, MC = BATCH * CTXL, MT = ML + MC;
constexpr int ZLD = 6400;
constexpr int NZ = 14592;
constexpr int MODW = 9 * D;
constexpr int INC = 14368;
constexpr float EPS = 1e-6f;
constexpr int ZC_MLK = 0, ZC_MLV = 512, ZC_GDK = 1024, ZC_GDV = 1536, ZC_ATK = 2048, ZC_ATV = 2304, ZC_SMALL = 2560, ZC_SGU = 2816, ZC_SGV = 3328,
              ZC_MLQ = 3840, ZC_MLO = 4352, ZC_GDQ = 4864, ZC_GDZ = 5376, ZC_ATQ = 5888, ZC_GATE = 6400;
constexpr int NKV_TILES = 11;

constexpr size_t MiB = 1u << 20;
constexpr size_t WS_CTL = 0, CTL_ZERO_BYTES = 1 * MiB;
constexpr size_t WS_MOD = 1 * MiB;
constexpr size_t WS_ROPE = 3 * MiB;
constexpr size_t WS_XC = 4 * MiB;
constexpr size_t WS_WFI = 20 * MiB;
constexpr size_t WS_WFO = 64 * MiB;
constexpr size_t WS_WZ = 86 * MiB;
constexpr size_t WS_WB = 143 * MiB;
constexpr size_t WS_WO = 151 * MiB;
constexpr size_t WS_H = 159 * MiB;
constexpr size_t WS_Z = 231 * MiB;
constexpr size_t WS_GT = WS_Z + (size_t)18432 * 6400 * 2;
constexpr size_t WS_ZS = 744 * MiB;
constexpr size_t WS_Y = 747 * MiB;
constexpr size_t WS_QA = 819 * MiB;
constexpr size_t WS_KC = 837 * MiB;
constexpr size_t WS_VC = 846 * MiB;
constexpr size_t WS_MIX = 855 * MiB;
constexpr size_t WS_END = 1150 * MiB;
static_assert(WS_GT + (size_t)72 * 32 * 131072 <= WS_ZS && WS_Z + (size_t)MT * NZ * 2 <= WS_ZS && WS_H + (size_t)MT * D * 2 <= WS_Z && WS_Y + (size_t)4 * MT * 512 * 2 <= WS_QA, "d_ws map");
static_assert(WS_WFI + (size_t)2 * DFF * D * 2 <= WS_WFO && WS_WFO + (size_t)D * DFF * 2 <= WS_WZ && WS_WZ + (size_t)NZ * D * 2 <= WS_WB, "d_ws map (weights)");
constexpr int CW_TMO = 0, CW_CODE = 1, CW_BAR = 4096;

constexpr int RING_OFF = 0, RING_BYTES = 131072;
constexpr int LDSCTL_OFF = RING_BYTES, MISC_OFF = LDSCTL_OFF + 320;
constexpr int NORM_P_OFF = RING_BYTES + 1024;
constexpr int LDS_BYTES = 163840;

#define GAS __attribute__((address_space(1)))
#define LAS __attribute__((address_space(3)))
typedef unsigned short bf16;
typedef unsigned v4u __attribute__((ext_vector_type(4)));
typedef unsigned v2u __attribute__((ext_vector_type(2)));
typedef float f32x4 __attribute__((ext_vector_type(4)));
typedef short bf16x8 __attribute__((ext_vector_type(8)));
typedef GAS unsigned gu32;
#define RLX_AGENT __ATOMIC_RELAXED, __HIP_MEMORY_SCOPE_AGENT
#define LDS_WAIT() asm volatile("s_waitcnt lgkmcnt(0)" ::: "memory")
#define VM_WAIT() asm volatile("s_waitcnt vmcnt(0)" ::: "memory")
typedef float f32x2_t __attribute__((ext_vector_type(2)));
typedef __bf16 bf16x2_t __attribute__((ext_vector_type(2)));
__device__ __forceinline__ unsigned pk2(float lo, float hi) { const f32x2_t v = {lo, hi}; const bf16x2_t b = __builtin_convertvector(v, bf16x2_t); return __builtin_bit_cast(unsigned, b); }
__device__ __forceinline__ float bflo(unsigned w) { return __uint_as_float(w << 16); }
__device__ __forceinline__ float bfhi(unsigned w) { return __uint_as_float(w & 0xffff0000u); }
__device__ __forceinline__ float bf1(bf16 b) { return __uint_as_float(((unsigned)b) << 16); }
__device__ __forceinline__ bf16 f2bf1(float f) { return (bf16)(pk2(f, 0.f) & 0xffffu); }
__device__ __forceinline__ float silu1(float a) { return a * __builtin_amdgcn_rcpf(1.0f + __expf(-a)); }
__device__ __forceinline__ float sigm1(float a) { return 1.0f / (1.0f + __expf(-a)); }
__device__ __forceinline__ float sigm1r(float a) { return __builtin_amdgcn_rcpf(1.0f + __expf(-a)); }
__device__ __forceinline__ float wave_sum(float v) {
#pragma unroll
    for (int o = 1; o < 64; o <<= 1) v += __shfl_xor(v, o);
    return v;
}

#ifndef TPROBE
#define TPROBE 0
#endif
#if TPROBE == 2
#define TSTAMP(i) do { if (blockIdx.x == 0 && F.tid == 0) ((unsigned long long*)(F.ws + WS_CTL + 524288))[40 + (i)] = wall_clock64(); } while (0)
#define TSTAMPL(i) do { if (blockIdx.x == gridDim.x - 1 && F.tid == 0) ((unsigned long long*)(F.ws + WS_CTL + 524288))[40 + (i)] = wall_clock64(); } while (0)
#else
#define TSTAMP(i) do {} while (0)
#define TSTAMPL(i) do {} while (0)
#endif
#define XB_TMO      128
#define XB_XCNT(j)  (256  + 64 * (j))
#define XB_XSUB(j)  (1280 + 64 * (j))
#define XB_XGEN(j)  (2304 + 64 * (j))
#define XB_TOP      3328
#define XB_TOPGEN   3392
#define XCD_BAR_WORDS 3456
#define XB_SPIN_CAP (1u << 18)

__device__ __forceinline__ unsigned xb_ld(unsigned* p)              { return __hip_atomic_load(p, __ATOMIC_RELAXED, __HIP_MEMORY_SCOPE_AGENT); }
__device__ __forceinline__ unsigned xb_add(unsigned* p, unsigned v) { return __hip_atomic_fetch_add(p, v, __ATOMIC_RELAXED, __HIP_MEMORY_SCOPE_AGENT); }
__device__ __forceinline__ unsigned xb_xcc_id() { return (unsigned)__builtin_amdgcn_s_getreg((3 << 11) | 20) & 0xFu; }
#define XB_SPIN(cond, bar) do { unsigned _sp = 0; while (cond) { __builtin_amdgcn_s_sleep(1); \
    if ((++_sp & 255u) == 0u) { if (xb_ld(&(bar)[XB_TMO])) break; if (_sp > XB_SPIN_CAP) { atomicAdd(&(bar)[XB_TMO], 1u); break; } } } } while (0)

struct XcdBarrier {
    unsigned* bar; unsigned x;
    volatile LAS unsigned* st;
};

__device__ __forceinline__ XcdBarrier xcd_barrier_post(unsigned* bar, volatile LAS unsigned* st) {
    XcdBarrier b; b.bar = bar; b.x = xb_xcc_id(); b.st = st;
    if (threadIdx.x == 0) (void)xb_add(&bar[XB_XCNT(b.x)], 1u);
    return b;
}
__device__ __forceinline__ void xcd_barrier_complete(unsigned* bar, unsigned x, unsigned& nloc, unsigned& nx) {
    const unsigned G = gridDim.x * gridDim.y * gridDim.z;
    unsigned sum, cnt, mine, sp = 0u;
    for (;;) {
        sum = 0u; cnt = 0u; mine = 0u;
#pragma unroll
        for (unsigned j = 0; j < 16; ++j) { const unsigned c = xb_ld(&bar[XB_XCNT(j)]); sum += c; cnt += (c > 0u) ? 1u : 0u; mine = (j == x) ? c : mine; }
        if (sum == G) break;
        __builtin_amdgcn_s_sleep(1);
        if ((++sp & 255u) == 0u) { if (xb_ld(&bar[XB_TMO])) break; if (sp > XB_SPIN_CAP) { atomicAdd(&bar[XB_TMO], 1u); break; } }
    }
    nloc = mine > 0u ? mine : 1u; nx = cnt > 0u ? cnt : 1u;
}

__device__ __forceinline__ void xcd_barrier(const XcdBarrier& b) {
    asm volatile("s_waitcnt vmcnt(0)" ::: "memory");
    __syncthreads();
    if (threadIdx.x == 0) {
        unsigned* bar = b.bar;
        __builtin_amdgcn_s_waitcnt(0);
        unsigned nloc = b.st[0], nx = b.st[1];
        if (nloc == 0u) { xcd_barrier_complete(bar, b.x, nloc, nx); b.st[0] = nloc; b.st[1] = nx; }
        const unsigned old = xb_add(&bar[XB_XSUB(b.x)], 1u);
        const unsigned gen = old / nloc;
        if (old + 1u == (gen + 1u) * nloc) {
            __builtin_amdgcn_fence(__ATOMIC_RELEASE, "agent");
            asm volatile("s_waitcnt vmcnt(0)" ::: "memory");
            const unsigned og = xb_add(&bar[XB_TOP], 1u);
            const unsigned tg = og / nx;
            if (og + 1u == (tg + 1u) * nx) xb_add(&bar[XB_TOPGEN], 1u);
            else XB_SPIN(xb_ld(&bar[XB_TOPGEN]) == tg, bar);
            __builtin_amdgcn_fence(__ATOMIC_ACQUIRE, "agent");
            xb_add(&bar[XB_XGEN(b.x)], 1u);
            asm volatile("s_waitcnt vmcnt(0)" ::: "memory");
        } else {
            XB_SPIN(xb_ld(&bar[XB_XGEN(b.x)]) == gen, bar);
            __builtin_amdgcn_fence(__ATOMIC_ACQUIRE, "agent");
            asm volatile("s_waitcnt vmcnt(0)" ::: "memory");
        }
    }
    __syncthreads();
}
struct Frame {
    LAS unsigned char* lds;
    volatile LAS unsigned* MISC;
    gu32* ctl;
    int tid, lane, wave, G;
    unsigned char* ws;
    const float* const* in;
    float* out;
};
enum { I_X = 0, I_C, I_CTX, I_CCTX, I_MODW, I_MODB, I_F1N, I_F1WI, I_F1WO, I_MIXN, I_WIN, I_SGN, I_SGW, I_SGB, I_MLIFB, I_MLN, I_GDCONV, I_GDALOG, I_GDDTB, I_GDN,
       I_ATQN, I_ATKN, I_WBR, I_WOUT, I_F2N, I_F2WI, I_F2WO };

__device__ __forceinline__ void phase_mod(Frame& F) {
    LAS float* tab = (LAS float*)(F.lds + RING_OFF);
    LAS float* red = (LAS float*)(F.lds + RING_OFF);
    const float* c = F.in[I_C]; const float* cc = F.in[I_CCTX];
    float* MOD = (float*)(F.ws + WS_MOD);
    const int ntot = 2 * MODW, per = (ntot / 4 + F.G - 1) / F.G * 4;
    for (int n0 = blockIdx.x * per; n0 < ntot; n0 += F.G * per) {
        const int ncol = (ntot - n0) < per ? (ntot - n0) : per;
        for (int cb = 0; cb < ncol; cb += 256) {
            for (int i = F.tid; i < 9 * D; i += NWAVES * 64) { const int b = i / D, k = i % D; const float x = b < 8 ? c[b * D + k] : cc[k]; tab[k * 12 + b] = silu1(x); }
            __syncthreads();
            const int cl = cb + 4 * F.lane; const bool act = cl < ncol; const int gcol = n0 + cl, l = gcol / MODW, nn = gcol % MODW;
            f32x4 acc[9];
#pragma unroll
            for (int b = 0; b < 9; ++b) acc[b] = (f32x4){0.f, 0.f, 0.f, 0.f};
            if (act) { const float* W = F.in[I_MODW] + (size_t)l * D * MODW + nn; const int k0 = F.wave * 256;
                for (int k = k0; k < k0 + 256; k += 8) {
                    f32x4 w[8];
#pragma unroll
                    for (int j = 0; j < 8; ++j) w[j] = *(const f32x4*)(W + (size_t)(k + j) * MODW);
#pragma unroll
                    for (int j = 0; j < 8; ++j) { const LAS f32x4* tp = (const LAS f32x4*)(tab + (k + j) * 12); const f32x4 s0 = tp[0], s1 = tp[1], s2 = tp[2];
                        acc[0] += w[j] * s0[0]; acc[1] += w[j] * s0[1]; acc[2] += w[j] * s0[2]; acc[3] += w[j] * s0[3];
                        acc[4] += w[j] * s1[0]; acc[5] += w[j] * s1[1]; acc[6] += w[j] * s1[2]; acc[7] += w[j] * s1[3]; acc[8] += w[j] * s2[0]; } } }
            __syncthreads();
            if (act) {
#pragma unroll
                for (int b = 0; b < 9; ++b) *(LAS f32x4*)(red + ((F.wave * 9 + b) * 64 + F.lane) * 4) = acc[b]; }
            __syncthreads();
            for (int i = F.tid; i < 9 * 64; i += NWAVES * 64) { const int b = i / 64, ln = i % 64; const int cl2 = cb + 4 * ln;
                if (cl2 < ncol) { f32x4 s = (f32x4){0.f, 0.f, 0.f, 0.f};
#pragma unroll
                    for (int w = 0; w < 8; ++w) s += *(const LAS f32x4*)(red + ((w * 9 + b) * 64 + ln) * 4);
                    const int gcol2 = n0 + cl2, l2 = gcol2 / MODW, nn2 = gcol2 % MODW;
                    *(f32x4*)(MOD + (size_t)(l2 * 9 + b) * MODW + nn2) = s + *(const f32x4*)(F.in[I_MODB] + (size_t)l2 * MODW + nn2); } }
            __syncthreads();
        }
    }
}
__device__ __forceinline__ void phase_rope(Frame& F) {
    float* RC = (float*)(F.ws + WS_ROPE); float* RS = RC + 96 * 32;
    const int idx = blockIdx.x * (NWAVES * 64) + F.tid;
    if (idx < 96 * 32) {
        const int pos = idx >> 5, i = idx & 31; const float p = (float)(pos < 32 ? pos : pos - 32);
        const float inv = exp2f(-(float)i * (13.287712379549449f / 32.0f));
        const float x = p * inv;
        const float kf = rintf(x * 0.6366197723675814f);
        float r = fmaf(-kf, 1.5707963705062866f, x); r = fmaf(-kf, -4.371138828673793e-8f, r);
        const float r2 = r * r;
        const float sn = r + r * r2 * (-1.6666667163e-1f + r2 * (8.3333337680e-3f + r2 * (-1.9841270114e-4f + r2 * 2.7557314297e-6f)));
        const float cs = 1.0f + r2 * (-0.5f + r2 * (4.1666667908e-2f + r2 * (-1.3888889225e-3f + r2 * (2.4801587642e-5f + r2 * -2.7557314297e-7f))));
        const int q = ((int)kf) & 3;
        const float sv = (q == 0) ? sn : (q == 1) ? cs : (q == 2) ? -sn : -cs;
        const float cv = (q == 0) ? cs : (q == 1) ? -sn : (q == 2) ? -cs : sn;
        RC[idx] = cv; RS[idx] = sv;
    }
}
template <int MAP> __device__ __forceinline__ int dst_row(int n) {
    if (MAP == 0) return n;
    if (MAP == 1) { const int half = n >= DFF ? 1 : 0, j = n - half * DFF; return (j >> 7) * 256 + half * 128 + (j & 127); }
    if (n < 1024) return n;
    if (n < 1040) return ZC_SMALL + (n - 1024);
    if (n < 2064) return 1024 + (n - 1040);
    if (n < 2080) return ZC_SMALL + 16 + (n - 2064);
    if (n < 2592) return 2048 + (n - 2080);
    if (n < 6176) return n + 224;
    { const int g = n - 6176, br = g >> 11, c = g & 2047;
      return ZC_GATE + 256 * (c >> 6) + 128 * (br >> 1) + 32 * ((c >> 4) & 3) + 8 * ((c >> 2) & 3) + 4 * (br & 1) + (c & 3); }
}
__device__ __forceinline__ int dst_row_rt(int map, int n) { return map == 0 ? dst_row<0>(n) : (map == 1 ? dst_row<1>(n) : dst_row<2>(n)); }
struct ConvSrc { const float* W; bf16* WT; int K, N, map, perm, item; };
__device__ __forceinline__ ConvSrc conv_decode(Frame& F, int l, int set, int it) {
    constexpr int I_FI = (D / 64) * (2 * DFF / 32), I_FO = (DFF / 64) * (D / 32), I_Z = (D / 64) * (INC / 32), I_B = (512 / 64) * (D / 32);
    ConvSrc c; int r = it;
    if (set < 2) {
        if (r < I_FI) { c.W = F.in[set == 1 ? I_F2WI : I_F1WI] + (size_t)l * D * 2 * DFF; c.WT = (bf16*)(F.ws + WS_WFI); c.K = D; c.N = 2 * DFF; c.map = 1; c.perm = 1; c.item = r; return c; }
        r -= I_FI; c.W = F.in[set == 1 ? I_F2WO : I_F1WO] + (size_t)l * DFF * D; c.WT = (bf16*)(F.ws + WS_WFO); c.K = DFF; c.N = D; c.map = 0; c.perm = 0; c.item = r; return c;
    }
    if (r < I_Z) { c.W = F.in[I_WIN] + (size_t)l * D * INC; c.WT = (bf16*)(F.ws + WS_WZ); c.K = D; c.N = INC; c.map = 2; c.perm = 1; c.item = r; return c; }
    r -= I_Z;
    if (r < 4 * I_B) { const int n = r / I_B; c.W = F.in[I_WBR] + ((size_t)l * 4 + n) * 512 * D; c.WT = (bf16*)(F.ws + WS_WB) + (size_t)n * D * 512; c.K = 512; c.N = D; c.map = 0; c.perm = 1; c.item = r % I_B; return c; }
    r -= 4 * I_B; c.W = F.in[I_WOUT] + (size_t)l * D * D; c.WT = (bf16*)(F.ws + WS_WO); c.K = D; c.N = D; c.map = 0; c.perm = 0; c.item = r; return c;
}
__device__ __forceinline__ void conv_load(const ConvSrc& c, float (&r)[32], int lane) {
    const int nblk = c.N / 32, k0 = 64 * (c.item / nblk), n0 = 32 * (c.item % nblk);
    const float* p = c.W + (size_t)(k0 + (lane >> 5)) * c.N + n0 + (lane & 31);
#pragma unroll
    for (int i = 0; i < 32; ++i) r[i] = p[(size_t)(2 * i) * c.N];
}
__device__ __forceinline__ void conv_set(Frame& F, int l, int set) {
    LAS float* scr = (LAS float*)(F.lds + RING_OFF + F.wave * 16384);
    const int gw = blockIdx.x * NWAVES + F.wave, NGW = F.G * NWAVES, lane = F.lane;
    constexpr int I_FI = (D / 64) * (2 * DFF / 32), I_FO = (DFF / 64) * (D / 32), I_Z = (D / 64) * (INC / 32), I_B = (512 / 64) * (D / 32), I_O = (D / 64) * (D / 32);
    const int NIT = set < 2 ? (I_FI + I_FO) : (I_Z + 4 * I_B + I_O);
    float r[32]; ConvSrc cur, nxt;
    int it = gw;
    if (it < NIT) { cur = conv_decode(F, l, set, it); conv_load(cur, r, lane); }
    while (it < NIT) {
#pragma unroll
        for (int i = 0; i < 32; ++i) scr[(2 * i + (lane >> 5)) * 33 + (lane & 31)] = r[i];
        const int nit = it + NGW;
        if (nit < NIT) { nxt = conv_decode(F, l, set, nit); conv_load(nxt, r, lane); }
        LDS_WAIT(); asm volatile("" ::: "memory");
        { const int nblk = cur.N / 32, k0 = 64 * (cur.item / nblk), n0 = 32 * (cur.item % nblk), c = lane & 7;
#pragma unroll
          for (int j = 0; j < 4; ++j) { const int n = (lane >> 3) + 8 * j; const LAS float* s = scr + (8 * c) * 33 + n;
              v4u o; o.x = pk2(s[0 * 33], s[1 * 33]); o.y = pk2(s[2 * 33], s[3 * 33]); o.z = pk2(s[4 * 33], s[5 * 33]); o.w = pk2(s[6 * 33], s[7 * 33]);
              *(GAS v4u*)(cur.WT + pg8::sw_off(dst_row_rt(cur.map, n0 + n), k0 + 8 * c, cur.K, cur.perm != 0)) = o; } }
        LDS_WAIT(); asm volatile("" ::: "memory");
        cur = nxt; it = nit;
    }
    if (set == 2) {
        bf16* WZ = (bf16*)(F.ws + WS_WZ);
        GAS v4u* z = (GAS v4u*)(WZ + (size_t)(10 * 2) * (D / 64) * 8192); const int npc = 2 * (D / 64) * 1024;
        for (int i = blockIdx.x * (NWAVES * 64) + F.tid; i < npc; i += F.G * NWAVES * 64) { int R, C; pg8::stage_rc((i & 1023) * 16, R, C); const int h = i / (1024 * (D / 64));
            const int rowt = 128 * h + ((R & ~31) + pg8::perm32(R & 31)); if (rowt >= 32) z[i] = (v4u){0u, 0u, 0u, 0u}; }
    }
}
template <bool COPY, bool ADDP, bool ZSM> __device__ __forceinline__ void phase_norm(Frame& F, const void* xlv  , const float* xc, const float* gain, const float* mod  , int nrows) {
    bf16* H = (bf16*)(F.ws + WS_H); const float* xl = (const float*)xlv; const bf16* xlb = (const bf16*)xlv;
    const int gw = blockIdx.x * NWAVES + F.wave, NGW = F.G * NWAVES;
    LAS f32x4* PA = (LAS f32x4*)(F.lds + NORM_P_OFF); LAS f32x4* PB = PA + D / 4;
    const bool uni = (NGW == SEQ);
    if (ZSM) {
        const bf16* wz = (const bf16*)(F.ws + WS_WZ);
        for (int i = F.tid; i < 32 * D * 2 / 16; i += NWAVES * 64) { const int c = i / (D / 8), k8 = (i % (D / 8)) * 8;
            *(LAS v4u*)(F.lds + RING_OFF + i * 16) = *(const GAS v4u*)(wz + pg8::sw_off(ZC_SMALL + c, k8, D, true)); }
    }
    f32x4 vn[8]; v2u vnb[8];
    if (gw < nrows) { const bool isc0 = gw >= ML;
        if (COPY || isc0) { const GAS f32x4* xr0 = (const GAS f32x4*)(isc0 ? xc + (size_t)(gw - ML) * D : xl + (size_t)gw * D) + F.lane;
#pragma unroll
            for (int j = 0; j < 8; ++j) vn[j] = xr0[64 * j]; }
        else { const GAS v2u* xr0 = (const GAS v2u*)(xlb + (size_t)gw * D) + F.lane;
#pragma unroll
            for (int j = 0; j < 8; ++j) vnb[j] = xr0[64 * j]; } }
    for (int row = gw; row < nrows; row += NGW) {
        const bool isc = row >= ML; const int b9 = isc ? 8 : row / SEQ;
        __syncthreads();
        if (uni) { const float* sh = mod + (size_t)b9 * MODW; const float* sc = sh + D; const int c = 4 * F.tid;
            const f32x4 g = *(const f32x4*)(gain + c), a = *(const f32x4*)(sc + c), b = *(const f32x4*)(sh + c);
            PA[F.tid] = g * (a + 1.0f); PB[F.tid] = b; }
        __syncthreads();
        f32x4 v[8]; float s = 0.f;
        if (COPY || isc) {
#pragma unroll
            for (int j = 0; j < 8; ++j) v[j] = vn[j]; }
        else {
#pragma unroll
            for (int j = 0; j < 8; ++j) { const pg8::f32x2c_t a = pg8::cvt_up_f16(vnb[j].x), b = pg8::cvt_up_f16(vnb[j].y); v[j] = (f32x4){a.x, a.y, b.x, b.y}; } }
        { const int nr = row + NGW; if (nr < nrows) { const bool iscn = nr >= ML;
            if (COPY || iscn) { const GAS f32x4* xrn = (const GAS f32x4*)(iscn ? xc + (size_t)(nr - ML) * D : xl + (size_t)nr * D) + F.lane;
#pragma unroll
                for (int j = 0; j < 8; ++j) vn[j] = xrn[64 * j]; }
            else { const GAS v2u* xrn = (const GAS v2u*)(xlb + (size_t)nr * D) + F.lane;
#pragma unroll
                for (int j = 0; j < 8; ++j) vnb[j] = xrn[64 * j]; } } }
        if (ADDP && isc) {
            const GAS v2u* pr = (const GAS v2u*)((const bf16*)(F.ws + WS_MIX) + (size_t)(row - ML) * D) + F.lane;
#pragma unroll
            for (int q = 0; q < 4; ++q)
#pragma unroll
                for (int j = 0; j < 8; ++j) { const v2u w = pr[(size_t)q * (2048 * 2048 / 4) + 64 * j]; const pg8::f32x2c_t a = pg8::cvt_up_f16(w.x), b = pg8::cvt_up_f16(w.y); v[j] = v[j] + (f32x4){a.x, a.y, b.x, b.y}; }
            GAS f32x4* xw = (GAS f32x4*)((float*)(F.ws + WS_XC) + (size_t)(row - ML) * D) + F.lane;
#pragma unroll
            for (int j = 0; j < 8; ++j) xw[64 * j] = v[j];
        }
#pragma unroll
        for (int j = 0; j < 8; ++j) s += (v[j].x * v[j].x + v[j].y * v[j].y) + (v[j].z * v[j].z + v[j].w * v[j].w);
        if (COPY) {
            if (isc) { GAS f32x4* cp = (GAS f32x4*)((float*)(F.ws + WS_XC) + (size_t)(row - ML) * D) + F.lane;
#pragma unroll
                for (int j = 0; j < 8; ++j) cp[64 * j] = v[j]; }
            else { GAS v2u* cp = (GAS v2u*)((bf16*)F.out + (size_t)row * D) + F.lane;
#pragma unroll
                for (int j = 0; j < 8; ++j) { v2u w; w.x = pg8::cvt_pk_f16(v[j].x, v[j].y); w.y = pg8::cvt_pk_f16(v[j].z, v[j].w); cp[64 * j] = w; } } }
        const float rstd = 1.0f / sqrtf(wave_sum(s) * (1.0f / D) + EPS);
        const float* sh = mod + (size_t)b9 * MODW; const float* sc = sh + D;
#pragma unroll
        for (int j = 0; j < 8; ++j) { const int c = 4 * F.lane + 256 * j;
            f32x4 pa, pb;
            if (uni) { pa = PA[F.lane + 64 * j]; pb = PB[F.lane + 64 * j]; }
            else { const f32x4 g = *(const f32x4*)(gain + c), a = *(const f32x4*)(sc + c); pa = g * (a + 1.0f); pb = *(const f32x4*)(sh + c); }
            const f32x4 y = (v[j] * rstd) * pa + pb;
            if (ZSM) v[j] = y;
            v2u w; w.x = pk2(y.x, y.y); w.y = pk2(y.z, y.w); *(GAS v2u*)(H + pg8::sw_off(row, c & ~7, D, false) + (c & 7)) = w; }
        if (ZSM && isc) {
            float res = 0.f;
            for (int c = 0; c < 32; ++c) { const LAS v2u* wr = (const LAS v2u*)(F.lds + RING_OFF + c * (D * 2)) + F.lane; float s2 = 0.f;
#pragma unroll
                for (int j = 0; j < 8; ++j) { const v2u w = wr[64 * j]; s2 += v[j].x * bflo(w.x) + v[j].y * bfhi(w.x) + v[j].z * bflo(w.y) + v[j].w * bfhi(w.y); }
                s2 = wave_sum(s2); res = (F.lane == c) ? s2 : res; }
            if (F.lane < 32) ((float*)(F.ws + WS_ZS))[(size_t)row * 32 + F.lane] = res;
        }
    }
}
#include <hip/hip_bf16.h>
namespace attn {
using bf16 = __hip_bfloat16;
constexpr int   D = 128, NW = 8, QBLK = 32, KVBLK = 64;
constexpr float SCALE = 0.088388347648318440f;
constexpr float THR = 8.f;
constexpr int SDEPTH = 2;
constexpr int LDQ = 512, LDK = 256, LDO = 512;
constexpr size_t SHM_V = KVBLK * D * 2, SHM_K = KVBLK * D * 2, SHM_ATTN = 2 * SHM_V + 2 * SHM_K + NW * 64 * 4;
using bf16x8 = __attribute__((ext_vector_type(8))) short;
using s16x4  = __attribute__((ext_vector_type(4))) short;
using f32x16 = __attribute__((ext_vector_type(16))) float;
using f32x8  = __attribute__((ext_vector_type(8))) float;
using u32x4  = __attribute__((ext_vector_type(4))) unsigned;
#define KSWZ(row, colB) ((row) * 256 + ((colB) ^ (((row) & 7) << 4)))
#define SBAR() __builtin_amdgcn_sched_barrier(0)
__device__ __forceinline__ int crow(int r, int hi) { return (r & 3) + 8 * (r >> 2) + 4 * hi; }
__device__ __forceinline__ unsigned cvtpk(float lo, float hi) {
  unsigned r; asm volatile("v_cvt_pk_bf16_f32 %0, %1, %2" : "=v"(r) : "v"(lo), "v"(hi)); return r;
}
template <typename TIn> struct Stage;
template <> struct Stage<bf16>  { using T = bf16x8;
  __device__ static __forceinline__ T ld8(const bf16* p) { return *reinterpret_cast<const bf16x8*>(p); }
  __device__ static __forceinline__ bf16x8 tobf(T x) { return x; } };
template <> struct Stage<float> { using T = f32x8;
  __device__ static __forceinline__ T ld8(const float* p) { return *reinterpret_cast<const f32x8*>(p); }
  __device__ static __forceinline__ bf16x8 tobf(T x) {
    u32x4 w = {cvtpk(x[0], x[1]), cvtpk(x[2], x[3]), cvtpk(x[4], x[5]), cvtpk(x[6], x[7])}; return *reinterpret_cast<bf16x8*>(&w); } };

__device__ __forceinline__ void partialSM(f32x16& p0, f32x16& p1, float& m_reg, float& mn, float& alpha) {
  constexpr float C = SCALE * 1.4426950408889634f;
  float pmax = p0[0]; for (int r = 1; r < 16; ++r) pmax = fmaxf(pmax, p0[r]); for (int r = 0; r < 16; ++r) pmax = fmaxf(pmax, p1[r]);
  { auto rr = __builtin_amdgcn_permlane32_swap(__float_as_uint(pmax), __float_as_uint(pmax), false, false);
    pmax = fmaxf(__uint_as_float(rr[0]), __uint_as_float(rr[1])); }
  if (__builtin_expect(__all(pmax - m_reg <= THR / SCALE), 1)) { mn = m_reg; alpha = 1.f; }
  else { mn = fmaxf(m_reg, pmax); alpha = __builtin_amdgcn_exp2f((m_reg - mn) * C); m_reg = mn; }
  float mnC = -mn * C;
  for (int r = 0; r < 16; ++r) p0[r] = fmaf(p0[r], C, mnC); for (int r = 0; r < 16; ++r) p1[r] = fmaf(p1[r], C, mnC);
  for (int r = 0; r < 16; ++r) p0[r] = __builtin_amdgcn_exp2f(p0[r]);
}
__device__ __forceinline__ void finishSM(f32x16& p0, f32x16& p1, float alpha, float& l_reg, bf16x8& pa0, bf16x8& pa1, bf16x8& pa2, bf16x8& pa3) {
  for (int r = 0; r < 16; ++r) p1[r] = __builtin_amdgcn_exp2f(p1[r]);
  float ps = 0; for (int r = 0; r < 16; ++r) ps += p0[r]; for (int r = 0; r < 16; ++r) ps += p1[r];
  { auto rr = __builtin_amdgcn_permlane32_swap(__float_as_uint(ps), __float_as_uint(ps), false, false);
    ps = __uint_as_float(rr[0]) + __uint_as_float(rr[1]); }
  l_reg = l_reg * alpha + ps;
#define PK4(P, BASE, OUT) do { unsigned a0 = cvtpk(P[BASE + 0], P[BASE + 1]), a1 = cvtpk(P[BASE + 2], P[BASE + 3]);   \
    unsigned b0 = cvtpk(P[BASE + 4], P[BASE + 5]), b1 = cvtpk(P[BASE + 6], P[BASE + 7]);                              \
    auto r0 = __builtin_amdgcn_permlane32_swap(a0, b0, false, false); auto r1 = __builtin_amdgcn_permlane32_swap(a1, b1, false, false); \
    u32x4 w = {r0[0], r1[0], r0[1], r1[1]}; OUT = *reinterpret_cast<bf16x8*>(&w); } while (0)
  PK4(p0, 0, pa0); PK4(p0, 8, pa1); PK4(p1, 0, pa2); PK4(p1, 8, pa3);
#undef PK4
}
__device__ __forceinline__ void qkt(f32x16& p0, f32x16& p1, const bf16* Ks, const bf16x8* qr, int r32, int hi) {
  p0 = f32x16{}; p1 = f32x16{};
  for (int d0 = 0; d0 < 8; ++d0) { int cb = (d0 * 16 + hi * 8) * 2;
    bf16x8 b0 = *reinterpret_cast<const bf16x8*>((const char*)Ks + KSWZ(r32, cb));
    bf16x8 b1 = *reinterpret_cast<const bf16x8*>((const char*)Ks + KSWZ(32 + r32, cb));
    p0 = __builtin_amdgcn_mfma_f32_32x32x16_bf16(b0, qr[d0], p0, 0, 0, 0);
    p1 = __builtin_amdgcn_mfma_f32_32x32x16_bf16(b1, qr[d0], p1, 0, 0, 0); }
}
__device__ __forceinline__ int v_st(int k, int c) { const int kk = (k & ~0xC) | ((k & 4) << 1) | ((k & 8) >> 1); return ((kk >> 3) * 4 + (c >> 5)) * 512 + ((kk & 7) * 32 + (c & 31)) * 2; }
__device__ __forceinline__ int v_rd_base(int lane) { return ((lane & 3) << 3) | (((lane >> 2) & 3) << 6) | (((lane >> 4) & 1) << 5) | (((lane >> 5) & 1) << 8); }
constexpr int v_rd_off(int d0, int ks, int half) { return d0 * 512 + ks * 4096 + half * 2048; }
template <int OFF> __device__ __forceinline__ s16x4 tr_read(int vb) {
  s16x4 r; asm volatile("ds_read_b64_tr_b16 %0, %1 offset:%2" : "=&v"(r) : "v"(vb), "i"(OFF) : "memory"); return r;
}
template <int D0> __device__ __forceinline__ void pv_one(f32x16& od, int vb, bf16x8 pa0, bf16x8 pa1, bf16x8 pa2, bf16x8 pa3) {
  const s16x4 l0 = tr_read<v_rd_off(D0, 0, 0)>(vb), h0 = tr_read<v_rd_off(D0, 0, 1)>(vb), l1 = tr_read<v_rd_off(D0, 1, 0)>(vb), h1 = tr_read<v_rd_off(D0, 1, 1)>(vb);
  const s16x4 l2 = tr_read<v_rd_off(D0, 2, 0)>(vb), h2 = tr_read<v_rd_off(D0, 2, 1)>(vb), l3 = tr_read<v_rd_off(D0, 3, 0)>(vb), h3 = tr_read<v_rd_off(D0, 3, 1)>(vb);
  asm volatile("s_waitcnt lgkmcnt(0)" ::: "memory"); SBAR();
#define PK(L, H) (bf16x8){L[0], L[1], L[2], L[3], H[0], H[1], H[2], H[3]}
  od = __builtin_amdgcn_mfma_f32_32x32x16_bf16(pa0, PK(l0, h0), od, 0, 0, 0);
  od = __builtin_amdgcn_mfma_f32_32x32x16_bf16(pa1, PK(l1, h1), od, 0, 0, 0);
  od = __builtin_amdgcn_mfma_f32_32x32x16_bf16(pa2, PK(l2, h2), od, 0, 0, 0);
  od = __builtin_amdgcn_mfma_f32_32x32x16_bf16(pa3, PK(l3, h3), od, 0, 0, 0);
#undef PK
}
__device__ __forceinline__ void pv_d0(f32x16* o, int vb, bf16x8 pa0, bf16x8 pa1, bf16x8 pa2, bf16x8 pa3) {
  pv_one<0>(o[0], vb, pa0, pa1, pa2, pa3); pv_one<1>(o[1], vb, pa0, pa1, pa2, pa3); pv_one<2>(o[2], vb, pa0, pa1, pa2, pa3); pv_one<3>(o[3], vb, pa0, pa1, pa2, pa3);
}

template <typename TQ>
__device__ __forceinline__ void attn_dense_body(const TQ* __restrict__ Qb, const bf16* __restrict__ Kh, const bf16* __restrict__ Vh,
                                                bf16* __restrict__ Ob, int seq, char* lds) {
  using St = Stage<bf16>; using SQ = Stage<TQ>;
  const int tid = threadIdx.x, wid = tid >> 6, lane = tid & 63, r32 = lane & 31, hi = lane >> 5;
  bf16* V_lds = (bf16*)lds; bf16* K_lds = (bf16*)(lds + 2 * SHM_V);
  float* ws = (float*)(lds + 2 * SHM_V + 2 * SHM_K) + wid * 64; float* li_l = ws; float* al_l = ws + 32;
  float m_reg = -1e30f, l_reg = 0; f32x16 o[4] = {}; bf16x8 qr[8];
  const TQ* Qw = Qb + (long)(wid * QBLK + r32) * LDQ + hi * 8;
#pragma unroll
  for (int d0 = 0; d0 < 8; ++d0) qr[d0] = SQ::tobf(SQ::ld8(Qw + d0 * 16));
  const int sr = tid >> 4, sc = (tid & 15) * 8, vst0 = v_st(sr, sc), vst1 = v_st(32 + sr, sc);
  const int vb0 = (int)(uintptr_t)V_lds + v_rd_base(lane);
  struct { typename St::T vs0, vs1, ks0, ks1; } sr_[SDEPTH];
#define SLOAD(i, k0) do { sr_[i].vs0 = St::ld8(&Vh[(long)((k0) + sr) * LDK + sc]); sr_[i].vs1 = St::ld8(&Vh[(long)((k0) + 32 + sr) * LDK + sc]); \
    sr_[i].ks0 = St::ld8(&Kh[(long)((k0) + sr) * LDK + sc]); sr_[i].ks1 = St::ld8(&Kh[(long)((k0) + 32 + sr) * LDK + sc]); } while (0)
#define SWRITE(b, i) do { *(bf16x8*)((char*)V_lds + (b) * SHM_V + vst0) = St::tobf(sr_[i].vs0);          \
    *(bf16x8*)((char*)V_lds + (b) * SHM_V + vst1) = St::tobf(sr_[i].vs1); int kc = sc * 2;               \
    *(bf16x8*)((char*)K_lds + (b) * SHM_K + KSWZ(sr, kc)) = St::tobf(sr_[i].ks0);                       \
    *(bf16x8*)((char*)K_lds + (b) * SHM_K + KSWZ(32 + sr, kc)) = St::tobf(sr_[i].ks1); } while (0)
#define SWAIT() do { if constexpr (SDEPTH == 2) asm volatile("s_waitcnt vmcnt(4)" ::: "memory"); else asm volatile("s_waitcnt vmcnt(0)" ::: "memory"); } while (0)
#define RESC(a) do { if (__any((a) < 1.f)) { if (hi == 0) al_l[r32] = (a); asm volatile("s_waitcnt lgkmcnt(0)" ::: "memory"); \
    for (int d = 0; d < 4; ++d) for (int r = 0; r < 16; ++r) o[d][r] *= al_l[crow(r, hi)]; } } while (0)
  f32x16 pA0, pA1, pB0, pB1; float mnA, mnB, alA, alB; bf16x8 pa0, pa1, pa2, pa3; const int NT = seq / KVBLK;
  constexpr int SE = 0, SO = SDEPTH - 1;
  SLOAD(SE, 0); asm volatile("s_waitcnt vmcnt(0)" ::: "memory"); SWRITE(0, SE); __syncthreads();
  qkt(pA0, pA1, K_lds, qr, r32, hi); partialSM(pA0, pA1, m_reg, mnA, alA);
  SLOAD(SO, KVBLK); if constexpr (SDEPTH == 2) { if (2 < NT) SLOAD(SE, 2 * KVBLK); }
  SWAIT(); SWRITE(1, SO); __syncthreads();
  for (int j = 1; j + 1 < NT; j += 2) {
    SBAR(); qkt(pB0, pB1, (bf16*)((char*)K_lds + SHM_K), qr, r32, hi);
    finishSM(pA0, pA1, alA, l_reg, pa0, pa1, pa2, pa3); SBAR();
    SLOAD(SO, (j + SDEPTH) * KVBLK); SBAR();
    pv_d0(o, vb0, pa0, pa1, pa2, pa3); partialSM(pB0, pB1, m_reg, mnB, alB);
    __syncthreads(); SWAIT(); SWRITE(0, SE);
    RESC(alB); __syncthreads();
    SBAR(); qkt(pA0, pA1, K_lds, qr, r32, hi);
    finishSM(pB0, pB1, alB, l_reg, pa0, pa1, pa2, pa3); SBAR();
    if (SDEPTH == 1 || j + 3 < NT) SLOAD(SE, (j + 1 + SDEPTH) * KVBLK); SBAR();
    pv_d0(o, vb0 + (int)SHM_V, pa0, pa1, pa2, pa3); partialSM(pA0, pA1, m_reg, mnA, alA);
    __syncthreads(); SWAIT(); SWRITE(1, SO);
    RESC(alA); __syncthreads();
  }
  SBAR(); qkt(pB0, pB1, (bf16*)((char*)K_lds + SHM_K), qr, r32, hi);
  finishSM(pA0, pA1, alA, l_reg, pa0, pa1, pa2, pa3); SBAR();
  pv_d0(o, vb0, pa0, pa1, pa2, pa3); partialSM(pB0, pB1, m_reg, mnB, alB);
  __syncthreads(); RESC(alB);
  finishSM(pB0, pB1, alB, l_reg, pa0, pa1, pa2, pa3); SBAR();
  pv_d0(o, vb0 + (int)SHM_V, pa0, pa1, pa2, pa3);
  if (hi == 0) li_l[r32] = l_reg; asm volatile("s_waitcnt lgkmcnt(0)" ::: "memory");
  float rli[16];
#pragma unroll
  for (int r = 0; r < 16; ++r) rli[r] = __builtin_amdgcn_rcpf(li_l[crow(r, hi)]);
  bf16* Ow = Ob + (long)(wid * QBLK) * LDO;
#pragma unroll
  for (int r = 0; r < 16; ++r) { int orow = crow(r, hi);
    for (int d0 = 0; d0 < 4; ++d0) Ow[(long)orow * LDO + d0 * 32 + r32] = __float2bfloat16(o[d0][r] * rli[r]); }
#undef SLOAD
#undef SWRITE
#undef SWAIT
#undef RESC
}

#undef KSWZ
#undef SBAR
}
constexpr size_t MX_CL = 0;
constexpr size_t MX_CP = 36 * MiB;
constexpr size_t MX_NL = 72 * MiB;
constexpr size_t MX_NP = 73 * MiB;
constexpr size_t MX_ST = 74 * MiB;
constexpr size_t MX_SP = 75 * MiB;
constexpr size_t MX_GQ = 76 * MiB, MX_GK = 94 * MiB, MX_GV = 112 * MiB;
constexpr size_t MX_GG = 130 * MiB, MX_GB = 131 * MiB;
constexpr size_t MX_GD1 = 132 * MiB;
constexpr size_t GD1_ITEM = 73728;
constexpr size_t MX_GE = 294 * MiB;
static_assert(MX_GD1 + (size_t)2304 * GD1_ITEM <= MX_GE && WS_MIX + MX_GE + 2304 * 128 <= WS_END, "mixer scratch map");

typedef float f32x4m __attribute__((ext_vector_type(4)));
#define MFMA16(a, b, c) __builtin_amdgcn_mfma_f32_16x16x32_bf16((a), (b), (c), 0, 0, 0)
__device__ __forceinline__ bf16x8 lds_frag(const LAS unsigned char* base, int stride, int row0, int kb, int lane) {
    return *(const LAS bf16x8*)(base + (row0 + (lane & 15)) * stride + kb + (lane >> 4) * 16);
}
__device__ __forceinline__ float gelu_tanh_r(float x) { const float y2 = 1.5957691216057308f * (x + 0.044715f * x * x * x); return x * __builtin_amdgcn_rcpf(1.0f + __expf(-y2)); }
__device__ __forceinline__ float gelu_tanh(float x) { const float y2 = 1.5957691216057308f * (x + 0.044715f * x * x * x); return x / (1.0f + __expf(-y2)); }
__device__ __forceinline__ float logsigmoid1(float x) { return fminf(x, 0.f) - log1pf(__expf(-fabsf(x))); }
__device__ __forceinline__ float softplus1(float x) { return fmaxf(x, 0.f) + log1pf(__expf(-fabsf(x))); }
__device__ __forceinline__ int perm32p(int jl) { return 8 * ((jl & 15) >> 2) + 4 * (jl >> 4) + (jl & 3); }

__device__ __forceinline__ float wscan_sum_f(float v, int lane) {
#pragma unroll
    for (int o = 1; o < 64; o <<= 1) { const float t = __shfl_up(v, o); if (lane >= o) v += t; }
    return v;
}
__device__ __forceinline__ float wscan_sum_b(float v, int lane) {
#pragma unroll
    for (int o = 1; o < 64; o <<= 1) { const float t = __shfl_down(v, o); if (lane + o < 64) v += t; }
    return v;
}
__device__ __forceinline__ float wscan_max_f(float v, int lane) {
#pragma unroll
    for (int o = 1; o < 64; o <<= 1) { const float t = __shfl_up(v, o); if (lane >= o) v = fmaxf(v, t); }
    return v;
}
__device__ __forceinline__ float wscan_max_b(float v, int lane) {
#pragma unroll
    for (int o = 1; o < 64; o <<= 1) { const float t = __shfl_down(v, o); if (lane + o < 64) v = fmaxf(v, t); }
    return v;
}
struct AprepRow { bf16 qa[4], qb[4], ka[2], kb[2]; v2u vv; v4u sg; float cs, sn; };
__device__ __forceinline__ void aprep_load(AprepRow& R, const bf16* Z, const float* RC, const float* RS, int row, int da, int db, int half, int i, int lane, bool last) {
    const bool isc = row >= ML; const int t = isc ? (row - ML) % CTXL : row % SEQ;
    const bf16* zr = Z + (size_t)row * ZLD;
    R.cs = 1.f; R.sn = 0.f;
    if (!isc) { const int pos = half ? 32 + (t & 63) : (t >> 6); R.cs = RC[pos * 32 + i]; R.sn = RS[pos * 32 + i]; }
    if (!(isc && last)) {
#pragma unroll
        for (int h = 0; h < 4; ++h) { R.qa[h] = zr[ZC_ATQ + h * 128 + da]; R.qb[h] = zr[ZC_ATQ + h * 128 + db]; }
        R.sg = *(const GAS v4u*)(zr + ZC_SGV + 8 * lane);
    }
#pragma unroll
    for (int h = 0; h < 2; ++h) { R.ka[h] = zr[ZC_ATK + h * 128 + da]; R.kb[h] = zr[ZC_ATK + h * 128 + db]; }
    R.vv = *(const GAS v2u*)(zr + ZC_ATV + 4 * lane);
}
__device__ __forceinline__ void phase_attn_prep(Frame& F, int l, bool last) {
    const bf16* Z = (const bf16*)(F.ws + WS_Z); bf16* QA = (bf16*)(F.ws + WS_QA); bf16* KC = (bf16*)(F.ws + WS_KC); bf16* VC = (bf16*)(F.ws + WS_VC);
    const float* RC = (const float*)(F.ws + WS_ROPE); const float* RS = RC + 96 * 32;
    const float* gq = F.in[I_ATQN] + l * 128; const float* gk = F.in[I_ATKN] + l * 128;
    const int gw = blockIdx.x * NWAVES + F.wave, NGW = F.G * NWAVES;
    const int half = F.lane >> 5, i = F.lane & 31, da = 64 * half + i, db = da + 32;
    const float gqa = gq[da], gqb = gq[db], gka = gk[da], gkb = gk[db];
    AprepRow N;
    if (gw < MT) aprep_load(N, Z, RC, RS, gw, da, db, half, i, F.lane, last);
    for (int row = gw; row < MT; row += NGW) {
        const AprepRow R = N;
        if (row + NGW < MT) aprep_load(N, Z, RC, RS, row + NGW, da, db, half, i, F.lane, last);
        const bool isc = row >= ML; const int b = isc ? (row - ML) / CTXL : row / SEQ, t = isc ? (row - ML) % CTXL : row % SEQ;
        const bool doq = !(isc && last);
        float qa[4], qb[4], ka[2], kb[2], red[7];
#pragma unroll
        for (int h = 0; h < 4; ++h) { qa[h] = doq ? bf1(R.qa[h]) : 0.f; qb[h] = doq ? bf1(R.qb[h]) : 0.f; red[h] = qa[h] * qa[h] + qb[h] * qb[h]; }
#pragma unroll
        for (int h = 0; h < 2; ++h) { ka[h] = bf1(R.ka[h]); kb[h] = bf1(R.kb[h]); red[4 + h] = ka[h] * ka[h] + kb[h] * kb[h]; }
        { const v4u w = R.sg; float ss = 0.f;
          if (doq) { const float e0 = gelu_tanh_r(bflo(w.x)), e1 = gelu_tanh_r(bfhi(w.x)), e2 = gelu_tanh_r(bflo(w.y)), e3 = gelu_tanh_r(bfhi(w.y)), e4 = gelu_tanh_r(bflo(w.z)), e5 = gelu_tanh_r(bfhi(w.z)), e6 = gelu_tanh_r(bflo(w.w)), e7 = gelu_tanh_r(bfhi(w.w));
              ss = (e0 * e0 + e1 * e1) + (e2 * e2 + e3 * e3) + (e4 * e4 + e5 * e5) + (e6 * e6 + e7 * e7); }
          red[6] = ss; }
#pragma unroll
        for (int o = 1; o < 64; o <<= 1) { float tt[7];
#pragma unroll
            for (int k = 0; k < 7; ++k) tt[k] = __shfl_xor(red[k], o);
#pragma unroll
            for (int k = 0; k < 7; ++k) red[k] += tt[k]; }
        if (doq) {
#pragma unroll
            for (int h = 0; h < 4; ++h) { const float rs = 1.0f / sqrtf(red[h] * (1.0f / 128.0f) + EPS); const float ya = qa[h] * rs * gqa, yb = qb[h] * rs * gqb;
                QA[(size_t)row * 512 + h * 128 + da] = f2bf1(ya * R.cs - yb * R.sn); QA[(size_t)row * 512 + h * 128 + db] = f2bf1(yb * R.cs + ya * R.sn); }
            if (F.lane == 0) ((float*)(F.ws + WS_ROPE + 65536))[(row >> 3) * 32 + (row & 7)] = 1.0f / sqrtf(red[6] * (1.0f / 512.0f) + EPS);
        }
        const size_t krow = (size_t)b * 2304 + (isc ? t : 256 + t);
#pragma unroll
        for (int h = 0; h < 2; ++h) { const float rs = 1.0f / sqrtf(red[4 + h] * (1.0f / 128.0f) + EPS); const float ya = ka[h] * rs * gka, yb = kb[h] * rs * gkb;
            KC[krow * 256 + h * 128 + da] = f2bf1(ya * R.cs - yb * R.sn); KC[krow * 256 + h * 128 + db] = f2bf1(yb * R.cs + ya * R.sn); }
        *(GAS v2u*)(VC + krow * 256 + 4 * F.lane) = R.vv;
    }
}
__device__ __forceinline__ void attn_item(Frame& F, int it) {
    const attn::bf16* QA = (const attn::bf16*)(F.ws + WS_QA); const attn::bf16* KC = (const attn::bf16*)(F.ws + WS_KC); const attn::bf16* VC = (const attn::bf16*)(F.ws + WS_VC);
    attn::bf16* Y3 = (attn::bf16*)(F.ws + WS_Y) + (size_t)3 * MT * 512;
    int h, b, seq; size_t r0;
    if (it < 256) { const int qb = it & 7; h = (it >> 3) & 3; b = it >> 5; r0 = (size_t)b * SEQ + qb * 256; seq = 2304; }
    else { const int j = it - 256; h = j & 3; b = j >> 2; r0 = (size_t)ML + b * CTXL; seq = 256; }
    attn::attn_dense_body<attn::bf16>(QA + r0 * 512 + h * 128, KC + (size_t)b * 2304 * 256 + (h >> 1) * 128, VC + (size_t)b * 2304 * 256 + (h >> 1) * 128, Y3 + r0 * 512 + h * 128, seq, (char*)F.lds + RING_OFF);
    __syncthreads();
}
__device__ __forceinline__ void phase_spatial(Frame& F, int l, bool last) {
    const bf16* Z = (const bf16*)(F.ws + WS_Z); bf16* Y0 = (bf16*)(F.ws + WS_Y);
    LAS unsigned char* Wl = F.lds + RING_OFF; LAS unsigned char* Vt = Wl + 34816;
    const int nchunk = last ? ML / 128 : MT / 128;
    const int tid = F.tid, r = tid >> 2, q = tid & 3;
    for (int it = F.G - 1 - (int)blockIdx.x; it < nchunk * 4; it += F.G) {
        const int ch = it >> 2, g = it & 3; const size_t row0 = (size_t)ch * 128;
        const bf16* zv = Z + (row0 + r) * ZLD + ZC_SGV;
        const float rstd = ((const float*)(F.ws + WS_ROPE + 65536))[((row0 + r) >> 3) * 32 + ((row0 + r) & 7)];
        const float* gn = F.in[I_SGN] + l * 512 + g * 128 + q * 32;
#pragma unroll
        for (int j = 0; j < 4; ++j) { const v4u w = *(const GAS v4u*)(zv + g * 128 + q * 32 + j * 8);
            const float e[8] = {gelu_tanh(bflo(w.x)), gelu_tanh(bfhi(w.x)), gelu_tanh(bflo(w.y)), gelu_tanh(bfhi(w.y)), gelu_tanh(bflo(w.z)), gelu_tanh(bfhi(w.z)), gelu_tanh(bflo(w.w)), gelu_tanh(bfhi(w.w))};
#pragma unroll
            for (int k = 0; k < 8; ++k) { const int c = q * 32 + j * 8 + k; *(LAS bf16*)(Vt + c * 272 + r * 2) = f2bf1(e[k] * rstd * gn[j * 8 + k]); } }
        const float* wg = F.in[I_SGW] + ((size_t)(l * 4 + g) * 128 + r) * 128 + q * 32;
#pragma unroll
        for (int j = 0; j < 4; ++j) { const f32x4 a = *(const f32x4*)(wg + j * 8), b = *(const f32x4*)(wg + j * 8 + 4);
            v4u o; o.x = pk2(a.x, a.y); o.y = pk2(a.z, a.w); o.z = pk2(b.x, b.y); o.w = pk2(b.z, b.w);
            *(LAS v4u*)(Wl + r * 272 + (q * 32 + j * 8) * 2) = o; }
        __syncthreads();
        const int wr = F.wave >> 1, wc = F.wave & 1;
        f32x4 acc[2][4];
#pragma unroll
        for (int mi = 0; mi < 2; ++mi)
#pragma unroll
            for (int ni = 0; ni < 4; ++ni) acc[mi][ni] = (f32x4){0.f, 0.f, 0.f, 0.f};
#pragma unroll
        for (int ks = 0; ks < 4; ++ks) {
            bf16x8 a[2], b[4];
#pragma unroll
            for (int mi = 0; mi < 2; ++mi) a[mi] = lds_frag(Wl, 272, 32 * wr + 16 * mi, ks * 64, F.lane);
#pragma unroll
            for (int ni = 0; ni < 4; ++ni) b[ni] = lds_frag(Vt, 272, 64 * wc + 16 * ni, ks * 64, F.lane);
#pragma unroll
            for (int mi = 0; mi < 2; ++mi)
#pragma unroll
                for (int ni = 0; ni < 4; ++ni) acc[mi][ni] = MFMA16(a[mi], b[ni], acc[mi][ni]);
        }
        const float* bs = F.in[I_SGB] + (l * 4 + g) * 128;
#pragma unroll
        for (int mi = 0; mi < 2; ++mi)
#pragma unroll
            for (int rr = 0; rr < 4; ++rr) { const int t = 32 * wr + 16 * mi + 4 * (F.lane >> 4) + rr; const float bias = bs[t];
#pragma unroll
                for (int ni = 0; ni < 4; ++ni) { const int c = g * 128 + 64 * wc + 16 * ni + (F.lane & 15);
                    const float u = gelu_tanh_r(bf1(Z[(row0 + t) * ZLD + ZC_SGU + c]));
                    Y0[(row0 + t) * 512 + c] = f2bf1(u * (acc[mi][ni][rr] + bias)); } }
        __syncthreads();
    }
}
__device__ __forceinline__ void ml_slot(int chain, int k, int& rowbase, int& h, int& dir) {
    const int b = chain >> 3; h = (chain >> 1) & 3; dir = chain & 1;
    if (k < 2) { const int j = dir ? 1 - k : k; rowbase = ML + b * CTXL + 128 * j; }
    else { const int n = k - 2, j = dir ? 15 - n : n; rowbase = b * SEQ + 128 * j; }
}
__device__ __forceinline__ void ml_gates(Frame& F, int l, int rowbase, int h, int dir, LAS float* li, LAS float* lf, LAS float* bc) {
    const float* ZS = (const float*)(F.ws + WS_ZS); const float* bias = F.in[I_MLIFB] + l * 16;
    float s = 0.f;
    if (F.tid < 128) { const float* zr = ZS + (size_t)(rowbase + F.tid) * 32;
        li[F.tid] = zr[dir * 4 + h] + bias[dir * 4 + h];
        const float f = logsigmoid1(zr[(2 + dir) * 4 + h] + bias[(2 + dir) * 4 + h]);
        s = dir ? wscan_sum_b(f, F.lane) : wscan_sum_f(f, F.lane);
        if (dir == 0 && F.tid == 63) lf[0] = s;
        if (dir == 1 && F.tid == 64) lf[0] = s; }
    __syncthreads();
    if (F.tid < 128) { if ((dir == 0 && F.tid >= 64) || (dir == 1 && F.tid < 64)) s += lf[0]; bc[F.tid] = s; }
    __syncthreads();
}
__device__ __forceinline__ void phase_ml1(Frame& F, int l) {
    const bf16* Z = (const bf16*)(F.ws + WS_Z); const float* ZS = (const float*)(F.ws + WS_ZS);
    bf16* CL = (bf16*)(F.ws + WS_MIX + MX_CL); float* NL = (float*)(F.ws + WS_MIX + MX_NL); float* ST = (float*)(F.ws + WS_MIX + MX_ST);
    LAS unsigned char* kT = F.lds + RING_OFF; LAS unsigned char* vT = kT + 34816;
    LAS float* wg = (LAS float*)(F.lds + RING_OFF + 69632);
    const int tid = F.tid, tau = tid >> 2, q = tid & 3, lane = F.lane;
    for (int it = blockIdx.x; it < 64 * 18; it += F.G) {
        const int chain = it / 18, k = it % 18; int rowbase, h, dir; ml_slot(chain, k, rowbase, h, dir);
        v4u ka[4], va[4];
        { const bf16* zk = Z + (size_t)(rowbase + tau) * ZLD + ZC_MLK + h * 128 + q * 32; const bf16* zv = Z + (size_t)(rowbase + tau) * ZLD + ZC_MLV + h * 128 + q * 32;
#pragma unroll
          for (int j = 0; j < 4; ++j) { ka[j] = *(const GAS v4u*)(zk + j * 8); va[j] = *(const GAS v4u*)(zv + j * 8); } }
        if (F.wave == 0) {
            const float* bias = F.in[I_MLIFB] + l * 16; const float* z0 = ZS + (size_t)(rowbase + 2 * lane) * 32;
            const float i0 = z0[dir * 4 + h] + bias[dir * 4 + h], i1 = z0[32 + dir * 4 + h] + bias[dir * 4 + h];
            const float f0 = logsigmoid1(z0[(2 + dir) * 4 + h] + bias[(2 + dir) * 4 + h]), f1 = logsigmoid1(z0[32 + (2 + dir) * 4 + h] + bias[(2 + dir) * 4 + h]);
            float b0, b1;
            if (dir == 0) { const float P = wscan_sum_f(f0 + f1, lane); b1 = P; b0 = P - f1; }
            else { const float P = wscan_sum_b(f0 + f1, lane); b0 = P; b1 = P - f0; }
            const float bend = dir ? __builtin_bit_cast(float, __builtin_amdgcn_readlane(__builtin_bit_cast(int, b0), 0)) : __builtin_bit_cast(float, __builtin_amdgcn_readlane(__builtin_bit_cast(int, b1), 63));
            const float w0 = bend - b0 + i0, w1 = bend - b1 + i1;
            float m = fmaxf(w0, w1);
#pragma unroll
            for (int o = 1; o < 64; o <<= 1) m = fmaxf(m, __shfl_xor(m, o));
            *(LAS f32x2_t*)(wg + 2 * lane) = (f32x2_t){__expf(w0 - m), __expf(w1 - m)};
            if (lane == 0) { ST[it * 32 + 0] = m; ST[it * 32 + 1] = bend; }
        }
        __syncthreads();
        { const float w = wg[tau];
#pragma unroll
          for (int j = 0; j < 4; ++j) { const v4u a = ka[j], b = va[j];
              const float kf[8] = {bflo(a.x), bfhi(a.x), bflo(a.y), bfhi(a.y), bflo(a.z), bfhi(a.z), bflo(a.w), bfhi(a.w)};
              const float vf[8] = {bflo(b.x), bfhi(b.x), bflo(b.y), bfhi(b.y), bflo(b.z), bfhi(b.z), bflo(b.w), bfhi(b.w)};
#pragma unroll
              for (int c = 0; c < 8; ++c) { const int col = q * 32 + j * 8 + c;
                  *(LAS bf16*)(kT + col * 272 + tau * 2) = f2bf1(kf[c] * 0.08838834764831845f);
                  *(LAS bf16*)(vT + col * 272 + tau * 2) = f2bf1(vf[c] * w); } } }
        __syncthreads();
        const int wr = F.wave >> 1, wc = F.wave & 1;
        f32x4 acc[2][4];
#pragma unroll
        for (int mi = 0; mi < 2; ++mi)
#pragma unroll
            for (int ni = 0; ni < 4; ++ni) acc[mi][ni] = (f32x4){0.f, 0.f, 0.f, 0.f};
#pragma unroll
        for (int ks = 0; ks < 4; ++ks) {
            bf16x8 a[2], b[4];
#pragma unroll
            for (int mi = 0; mi < 2; ++mi) a[mi] = lds_frag(vT, 272, 32 * wr + 16 * mi, ks * 64, F.lane);
#pragma unroll
            for (int ni = 0; ni < 4; ++ni) b[ni] = lds_frag(kT, 272, 64 * wc + 16 * ni, ks * 64, F.lane);
#pragma unroll
            for (int mi = 0; mi < 2; ++mi)
#pragma unroll
                for (int ni = 0; ni < 4; ++ni) acc[mi][ni] = MFMA16(a[mi], b[ni], acc[mi][ni]);
        }
        bf16* cl = CL + (size_t)it * 16384;
#pragma unroll
        for (int mi = 0; mi < 2; ++mi)
#pragma unroll
            for (int rr = 0; rr < 4; ++rr) { const int e = 32 * wr + 16 * mi + 4 * (F.lane >> 4) + rr;
#pragma unroll
                for (int ni = 0; ni < 4; ++ni) cl[e * 128 + 64 * wc + 16 * ni + (F.lane & 15)] = f2bf1(acc[mi][ni][rr]); }
        { float s = 0.f; const LAS bf16* kr = (const LAS bf16*)(kT + tau * 272) + q * 32;
#pragma unroll 8
          for (int t = 0; t < 32; ++t) s += wg[q * 32 + t] * bf1(kr[t]);
          s += __shfl_xor(s, 1); s += __shfl_xor(s, 2);
          if (q == 0) NL[(size_t)it * 128 + tau] = s; }
        __syncthreads();
    }
}
__device__ __forceinline__ void phase_ml2(Frame& F, int wg0) {
    const bf16* CL = (const bf16*)(F.ws + WS_MIX + MX_CL); const float* NL = (const float*)(F.ws + WS_MIX + MX_NL); const float* ST = (const float*)(F.ws + WS_MIX + MX_ST);
    bf16* CP = (bf16*)(F.ws + WS_MIX + MX_CP); float* NP = (float*)(F.ws + WS_MIX + MX_NP); float* SP = (float*)(F.ws + WS_MIX + MX_SP);
    if ((int)blockIdx.x < wg0) return;
    const int gt = ((int)blockIdx.x - wg0) * (NWAVES * 64) + F.tid, NT = (F.G - wg0) * NWAVES * 64;
    for (int task = gt; task < 64 * 4096; task += NT) {
        const int chain = task >> 12, e4 = (task & 4095) * 4;
        v2u w[18]; float ml[18], be[18];
#pragma unroll
        for (int k = 0; k < 18; ++k) { const int it = chain * 18 + k; w[k] = *(const GAS v2u*)(CL + (size_t)it * 16384 + e4); ml[k] = ST[it * 32 + 0]; be[k] = ST[it * 32 + 1]; }
        float c0 = 0.f, c1 = 0.f, c2 = 0.f, c3 = 0.f, m = 0.f;
#pragma unroll
        for (int k = 0; k < 18; ++k) { const int it = chain * 18 + k;
            v2u o; o.x = pk2(c0, c1); o.y = pk2(c2, c3); *(GAS v2u*)(CP + (size_t)it * 16384 + e4) = o;
            const float mn = fmaxf(be[k] + m, ml[k]), sp = __expf(be[k] + m - mn), sl = __expf(ml[k] - mn);
            c0 = sp * c0 + sl * bflo(w[k].x); c1 = sp * c1 + sl * bfhi(w[k].x); c2 = sp * c2 + sl * bflo(w[k].y); c3 = sp * c3 + sl * bfhi(w[k].y); m = mn; }
    }
    for (int task = gt; task < 64 * 128; task += NT) {
        const int chain = task >> 7, d = task & 127; float n = 0.f, m = 0.f;
        float nl[18], ml[18], be[18];
#pragma unroll
        for (int k = 0; k < 18; ++k) { const int it = chain * 18 + k; nl[k] = NL[(size_t)it * 128 + d]; ml[k] = ST[it * 32 + 0]; be[k] = ST[it * 32 + 1]; }
#pragma unroll
        for (int k = 0; k < 18; ++k) { const int it = chain * 18 + k;
            NP[(size_t)it * 128 + d] = n;
            if (d == 0) SP[it * 32] = m;
            const float mn = fmaxf(be[k] + m, ml[k]), sp = __expf(be[k] + m - mn), sl = __expf(ml[k] - mn);
            n = sp * n + sl * nl[k]; m = mn; }
    }
}
__device__ __forceinline__ float ml3_den(const LAS unsigned char* prow, const LAS unsigned char* qrow, const LAS float* nq, float inter_t, float emt_t) {
    float sp = 0.f, sn = 0.f;
#pragma unroll
    for (int c = 0; c < 4; ++c) { const v4u pv = *(const LAS v4u*)(prow + c * 16), qv = *(const LAS v4u*)(qrow + c * 16);
        const f32x4 n0 = *(const LAS f32x4*)(nq + c * 8), n1 = *(const LAS f32x4*)(nq + c * 8 + 4);
        sp += (bflo(pv.x) + bfhi(pv.x)) + (bflo(pv.y) + bfhi(pv.y)) + (bflo(pv.z) + bfhi(pv.z)) + (bflo(pv.w) + bfhi(pv.w));
        sn += n0.x * bflo(qv.x) + n0.y * bfhi(qv.x) + n0.z * bflo(qv.y) + n0.w * bfhi(qv.y) + n1.x * bflo(qv.z) + n1.y * bfhi(qv.z) + n1.z * bflo(qv.w) + n1.w * bfhi(qv.w); }
    sp += __shfl_xor(sp, 1); sp += __shfl_xor(sp, 2); sn += __shfl_xor(sn, 1); sn += __shfl_xor(sn, 2);
    const float den = sp + inter_t * sn; return 1.0f / fmaxf(fabsf(den), emt_t);
}
__device__ __forceinline__ void ml3_item(Frame& F, int l, int it) {
    const bf16* Z = (const bf16*)(F.ws + WS_Z); bf16* Y1 = (bf16*)(F.ws + WS_Y) + (size_t)MT * 512; const float* ZS = (const float*)(F.ws + WS_ZS);
    const bf16* CP = (const bf16*)(F.ws + WS_MIX + MX_CP); const float* NP = (const float*)(F.ws + WS_MIX + MX_NP); const float* SP = (const float*)(F.ws + WS_MIX + MX_SP);
    LAS unsigned char* qs = F.lds + RING_OFF; LAS unsigned char* ks = qs + 34816; LAS unsigned char* vT = ks + 34816;
    LAS unsigned char* p0lo = vT + 34816; LAS unsigned char* p0hi = F.lds + NORM_P_OFF - 64 * 272;
    LAS float* cv = (LAS float*)(F.lds + RING_OFF + 121856); LAS float* Mt = cv + 256; LAS float* inter = Mt + 256; LAS float* emt = inter + 256;
    LAS float* rden = emt + 256; LAS float* npv = rden + 256; LAS float* rowss = npv + 256;
    LAS float* tile = (LAS float*)(F.lds + RING_OFF);
    const int tid = F.tid, tau = tid >> 2, q = tid & 3, lane = F.lane, g4 = lane >> 4, l15 = lane & 15;
    int b, h, j, rowbase, nch;
    if (it < 512) { b = it >> 6; h = (it >> 4) & 3; j = it & 15; rowbase = b * SEQ + 128 * j; nch = 16; }
    else { const int r = it - 512; b = r >> 3; h = (r >> 1) & 3; j = r & 1; rowbase = ML + b * CTXL + 128 * j; nch = 2; }
    const int sit0 = ((b * 4 + h) * 2 + 0) * 18 + ((it < 512) ? 2 + j : j), sit1 = ((b * 4 + h) * 2 + 1) * 18 + ((it < 512) ? 2 + (nch - 1 - j) : (nch - 1 - j));
    const int wr = F.wave >> 1, wc = F.wave & 1;
    const bf16* cp0 = CP + (size_t)sit0 * 16384 + (64 * wc + l15) * 128 + g4 * 8; const bf16* cp1 = CP + (size_t)sit1 * 16384 + (64 * wc + l15) * 128 + g4 * 8;
    { const bf16* zq = Z + (size_t)(rowbase + tau) * ZLD + ZC_MLQ + h * 128 + q * 32; const bf16* zk = Z + (size_t)(rowbase + tau) * ZLD + ZC_MLK + h * 128 + q * 32;
      const bf16* zv = Z + (size_t)(rowbase + tau) * ZLD + ZC_MLV + h * 128 + q * 32;
#pragma unroll
      for (int jj = 0; jj < 4; ++jj) { const v4u a = *(const GAS v4u*)(zq + jj * 8), kk = *(const GAS v4u*)(zk + jj * 8), vv = *(const GAS v4u*)(zv + jj * 8);
          *(LAS v4u*)(qs + tau * 272 + (q * 32 + jj * 8) * 2) = a;
          v4u ko; const float s = 0.08838834764831845f;
          ko.x = pk2(bflo(kk.x) * s, bfhi(kk.x) * s); ko.y = pk2(bflo(kk.y) * s, bfhi(kk.y) * s); ko.z = pk2(bflo(kk.z) * s, bfhi(kk.z) * s); ko.w = pk2(bflo(kk.w) * s, bfhi(kk.w) * s);
          *(LAS v4u*)(ks + tau * 272 + (q * 32 + jj * 8) * 2) = ko;
          const unsigned vw[4] = {vv.x, vv.y, vv.z, vv.w};
#pragma unroll
          for (int c = 0; c < 4; ++c) { const int col = q * 32 + jj * 8 + 2 * c;
              *(LAS bf16*)(vT + col * 272 + tau * 2) = (bf16)(vw[c] & 0xffffu); *(LAS bf16*)(vT + (col + 1) * 272 + tau * 2) = (bf16)(vw[c] >> 16); } } }
    if (F.wave < 2) {
        const int dir = F.wave, sit = dir ? sit1 : sit0; const float* bias = F.in[I_MLIFB] + l * 16; const float* z0 = ZS + (size_t)(rowbase + 2 * lane) * 32;
        const float i0 = z0[dir * 4 + h] + bias[dir * 4 + h], i1 = z0[32 + dir * 4 + h] + bias[dir * 4 + h];
        const float f0 = logsigmoid1(z0[(2 + dir) * 4 + h] + bias[(2 + dir) * 4 + h]), f1 = logsigmoid1(z0[32 + (2 + dir) * 4 + h] + bias[(2 + dir) * 4 + h]);
        const float mprev = SP[sit * 32];
        float b0, b1, m0, m1;
        if (dir == 0) { const float P = wscan_sum_f(f0 + f1, lane); b1 = P; b0 = P - f1; }
        else { const float P = wscan_sum_b(f0 + f1, lane); b0 = P; b1 = P - f0; }
        const float c0 = i0 - b0, c1 = i1 - b1;
        if (dir == 0) { const float Pm = wscan_max_f(fmaxf(c0, c1), lane); float ex = __shfl_up(Pm, 1); if (lane == 0) ex = -3.0e38f; m1 = Pm; m0 = fmaxf(ex, c0); }
        else { const float Pm = wscan_max_b(fmaxf(c0, c1), lane); float ex = __shfl_down(Pm, 1); if (lane == 63) ex = -3.0e38f; m0 = Pm; m1 = fmaxf(ex, c1); }
        const float M0 = fmaxf(m0, mprev), M1 = fmaxf(m1, mprev); const int o = dir * 128 + 2 * lane;
        *(LAS f32x2_t*)(cv + o) = (f32x2_t){c0, c1}; *(LAS f32x2_t*)(Mt + o) = (f32x2_t){M0, M1};
        *(LAS f32x2_t*)(inter + o) = (f32x2_t){__expf(mprev - M0), __expf(mprev - M1)}; *(LAS f32x2_t*)(emt + o) = (f32x2_t){__expf(-(b0 + M0)), __expf(-(b1 + M1))};
    } else if (F.wave < 4) { const int dir = F.wave - 2; *(LAS f32x2_t*)(npv + dir * 128 + 2 * lane) = *(const GAS f32x2_t*)(NP + (size_t)(dir ? sit1 : sit0) * 128 + 2 * lane); }
    bf16x8 cb[4][4];
#pragma unroll
    for (int kk = 0; kk < 2; ++kk)
#pragma unroll
        for (int ni = 0; ni < 4; ++ni) cb[kk][ni] = *(const GAS bf16x8*)(cp0 + ni * 2048 + kk * 32);
    __syncthreads();
    f32x4 accS[2][4];
#pragma unroll
    for (int mi = 0; mi < 2; ++mi)
#pragma unroll
        for (int ni = 0; ni < 4; ++ni) accS[mi][ni] = (f32x4){0.f, 0.f, 0.f, 0.f};
#pragma unroll
    for (int kk = 0; kk < 4; ++kk) {
        bf16x8 a[2], bq[4];
#pragma unroll
        for (int mi = 0; mi < 2; ++mi) a[mi] = lds_frag(ks, 272, 32 * wr + 16 * mi, kk * 64, lane);
#pragma unroll
        for (int ni = 0; ni < 4; ++ni) bq[ni] = lds_frag(qs, 272, 64 * wc + 16 * ni, kk * 64, lane);
#pragma unroll
        for (int mi = 0; mi < 2; ++mi)
#pragma unroll
            for (int ni = 0; ni < 4; ++ni) accS[mi][ni] = MFMA16(a[mi], bq[ni], accS[mi][ni]);
    }
    LAS unsigned char* const p0w = wc ? p0hi : p0lo;
#pragma unroll
    for (int mi = 0; mi < 2; ++mi)
#pragma unroll
        for (int ni = 0; ni < 4; ++ni) { const int t = 64 * wc + 16 * ni + l15, s0 = 32 * wr + 16 * mi + 4 * g4; const float M = Mt[t];
            float p[4];
#pragma unroll
            for (int rr = 0; rr < 4; ++rr) { const int s = s0 + rr; p[rr] = (s <= t) ? __expf(cv[s] - M) * accS[mi][ni][rr] : 0.f; }
            v2u o; o.x = pk2(p[0], p[1]); o.y = pk2(p[2], p[3]); *(LAS v2u*)(p0w + t * 272 + s0 * 2) = o; }
    __syncthreads();
#pragma unroll
    for (int mi = 0; mi < 2; ++mi)
#pragma unroll
        for (int ni = 0; ni < 4; ++ni) { const int t = 64 * wc + 16 * ni + l15, s0 = 32 * wr + 16 * mi + 4 * g4; const float M = Mt[128 + t];
            float p[4];
#pragma unroll
            for (int rr = 0; rr < 4; ++rr) { const int s = s0 + rr; p[rr] = (s >= t) ? __expf(cv[128 + s] - M) * accS[mi][ni][rr] : 0.f; }
            v2u o; o.x = pk2(p[0], p[1]); o.y = pk2(p[2], p[3]); *(LAS v2u*)(ks + t * 272 + s0 * 2) = o; }
#pragma unroll
    for (int kk = 2; kk < 4; ++kk)
#pragma unroll
        for (int ni = 0; ni < 4; ++ni) cb[kk][ni] = *(const GAS bf16x8*)(cp0 + ni * 2048 + kk * 32);
    { const float r = ml3_den((tau < 64 ? p0lo : p0hi) + tau * 272 + q * 64, qs + tau * 272 + q * 64, npv + q * 32, inter[tau], emt[tau]); if (q == 0) rden[tau] = r; }
    const LAS unsigned char* const p0r = (wr < 2) ? p0lo : p0hi;
    f32x4 hsum[2][4];
#pragma unroll
    for (int dir = 0; dir < 2; ++dir) {
        f32x4 acc[2][4];
#pragma unroll
        for (int mi = 0; mi < 2; ++mi)
#pragma unroll
            for (int ni = 0; ni < 4; ++ni) acc[mi][ni] = (f32x4){0.f, 0.f, 0.f, 0.f};
#pragma unroll
        for (int kk = 0; kk < 4; ++kk) {
            bf16x8 a[2];
#pragma unroll
            for (int mi = 0; mi < 2; ++mi) a[mi] = lds_frag(qs, 272, 32 * wr + 16 * mi, kk * 64, lane);
#pragma unroll
            for (int mi = 0; mi < 2; ++mi)
#pragma unroll
                for (int ni = 0; ni < 4; ++ni) acc[mi][ni] = MFMA16(a[mi], cb[kk][ni], acc[mi][ni]);
        }
        if (dir == 0) {
#pragma unroll
            for (int kk = 0; kk < 4; ++kk)
#pragma unroll
                for (int ni = 0; ni < 4; ++ni) cb[kk][ni] = *(const GAS bf16x8*)(cp1 + ni * 2048 + kk * 32);
        }
#pragma unroll
        for (int mi = 0; mi < 2; ++mi)
#pragma unroll
            for (int rr = 0; rr < 4; ++rr) { const float sc = inter[dir * 128 + 32 * wr + 16 * mi + 4 * g4 + rr];
#pragma unroll
                for (int ni = 0; ni < 4; ++ni) acc[mi][ni][rr] *= sc; }
        const LAS unsigned char* const pr = dir ? (const LAS unsigned char*)ks : p0r;
#pragma unroll
        for (int kk = 0; kk < 4; ++kk) {
            bf16x8 a[2], bb[4];
#pragma unroll
            for (int mi = 0; mi < 2; ++mi) a[mi] = lds_frag(pr, 272, 32 * wr + 16 * mi, kk * 64, lane);
#pragma unroll
            for (int ni = 0; ni < 4; ++ni) bb[ni] = lds_frag(vT, 272, 64 * wc + 16 * ni, kk * 64, lane);
#pragma unroll
            for (int mi = 0; mi < 2; ++mi)
#pragma unroll
                for (int ni = 0; ni < 4; ++ni) acc[mi][ni] = MFMA16(a[mi], bb[ni], acc[mi][ni]);
        }
        __syncthreads();
#pragma unroll
        for (int mi = 0; mi < 2; ++mi)
#pragma unroll
            for (int rr = 0; rr < 4; ++rr) { const float sc = rden[dir * 128 + 32 * wr + 16 * mi + 4 * g4 + rr];
#pragma unroll
                for (int ni = 0; ni < 4; ++ni) hsum[mi][ni][rr] = dir ? hsum[mi][ni][rr] + acc[mi][ni][rr] * sc : acc[mi][ni][rr] * sc; }
        if (dir == 0) { const float r = ml3_den(ks + tau * 272 + q * 64, qs + tau * 272 + q * 64, npv + 128 + q * 32, inter[128 + tau], emt[128 + tau]); if (q == 0) rden[128 + tau] = r; }
    }
    v4u og[4];
    { const bf16* zo = Z + (size_t)(rowbase + tau) * ZLD + ZC_MLO + h * 128 + q * 32;
#pragma unroll
      for (int jj = 0; jj < 4; ++jj) og[jj] = *(const GAS v4u*)(zo + ((jj + 2 * (q >> 1)) & 3) * 8); }
#pragma unroll
    for (int mi = 0; mi < 2; ++mi)
#pragma unroll
        for (int rr = 0; rr < 4; ++rr) { float s = 0.f; const int t = 32 * wr + 16 * mi + 4 * g4 + rr;
#pragma unroll
            for (int ni = 0; ni < 4; ++ni) { s += hsum[mi][ni][rr] * hsum[mi][ni][rr]; tile[t * 132 + 64 * wc + 16 * ni + l15] = hsum[mi][ni][rr]; }
            s += __shfl_xor(s, 1); s += __shfl_xor(s, 2); s += __shfl_xor(s, 4); s += __shfl_xor(s, 8);
            if (l15 == 0) rowss[wc * 128 + t] = s; }
    __syncthreads();
    { const float* gn = F.in[I_MLN] + l * 512 + h * 128; const float rs = 1.0f / sqrtf((rowss[tau] + rowss[128 + tau]) * (1.0f / 128.0f) + EPS);
      bf16* yo = Y1 + (size_t)(rowbase + tau) * 512 + h * 128;
#pragma unroll
      for (int jj = 0; jj < 4; ++jj) { const int e0 = q * 32 + ((jj + 2 * (q >> 1)) & 3) * 8;
          const f32x4 x0 = *(const LAS f32x4*)(tile + tau * 132 + e0), x1 = *(const LAS f32x4*)(tile + tau * 132 + e0 + 4);
          const f32x4 g0 = *(const GAS f32x4*)(gn + e0), g1 = *(const GAS f32x4*)(gn + e0 + 4); const v4u gg = og[jj];
          v4u o; o.x = pk2(sigm1r(bflo(gg.x)) * x0.x * rs * g0.x, sigm1r(bfhi(gg.x)) * x0.y * rs * g0.y); o.y = pk2(sigm1r(bflo(gg.y)) * x0.z * rs * g0.z, sigm1r(bfhi(gg.y)) * x0.w * rs * g0.w);
          o.z = pk2(sigm1r(bflo(gg.z)) * x1.x * rs * g1.x, sigm1r(bfhi(gg.z)) * x1.y * rs * g1.y); o.w = pk2(sigm1r(bflo(gg.w)) * x1.z * rs * g1.z, sigm1r(bfhi(gg.w)) * x1.w * rs * g1.w);
          *(GAS v4u*)(yo + e0) = o; } }
    __syncthreads();
}
#ifndef DUPS
#define DUPS 0
#endif
__device__ __forceinline__ void gd_slot(int chain, int k, int& seqbase, int& T, int& n, int& h, int& dir) {
    const int b = chain >> 3; h = (chain >> 1) & 3; dir = chain & 1;
    if (k < 4) { seqbase = ML + b * CTXL; T = CTXL; n = k; } else { seqbase = b * SEQ; T = SEQ; n = k - 4; }
}
struct Gd0Row { v4u x[3][3]; };
__device__ __forceinline__ void gd0_load(Gd0Row& R, const bf16* Z, int row, int c8, bool last) {
    const bool isc = row >= ML; const int t = isc ? (row - ML) % CTXL : row % SEQ, T = isc ? CTXL : SEQ;
    const bool hp = t > 0, hn = t < T - 1;
#pragma unroll
    for (int seg = 0; seg < 3; ++seg) {
        const int zc = (seg == 0 ? ZC_GDQ : seg == 1 ? ZC_GDK : ZC_GDV) + c8; const bf16* zr = Z + (size_t)row * ZLD + zc;
        R.x[seg][0] = (v4u){0u, 0u, 0u, 0u}; R.x[seg][2] = (v4u){0u, 0u, 0u, 0u};
        if (seg == 0 && isc && last) { R.x[seg][1] = (v4u){0u, 0u, 0u, 0u}; continue; }
        R.x[seg][1] = *(const GAS v4u*)zr;
        if (hp) R.x[seg][0] = *(const GAS v4u*)(zr - ZLD);
        if (hn) R.x[seg][2] = *(const GAS v4u*)(zr + ZLD);
    }
}
__device__ __forceinline__ void phase_gd0(Frame& F, int l, bool last) {
    const bf16* Z = (const bf16*)(F.ws + WS_Z); const float* ZS = (const float*)(F.ws + WS_ZS);
    bf16* GQ = (bf16*)(F.ws + WS_MIX + MX_GQ); bf16* GK = (bf16*)(F.ws + WS_MIX + MX_GK); bf16* GV = (bf16*)(F.ws + WS_MIX + MX_GV);
    float* GG = (float*)(F.ws + WS_MIX + MX_GG); float* GB = (float*)(F.ws + WS_MIX + MX_GB);
    const float* cw = F.in[I_GDCONV] + (size_t)l * 3 * 1536;
    const int gw = blockIdx.x * NWAVES + F.wave, NGW = F.G * NWAVES, c8 = F.lane * 8;
    Gd0Row N;
    if (gw < MT) gd0_load(N, Z, gw, c8, last);
    for (int row = gw; row < MT; row += NGW) {
        const Gd0Row R = N;
        if (row + NGW < MT) gd0_load(N, Z, row + NGW, c8, last);
        const bool isc = row >= ML;
#pragma unroll
        for (int seg = 0; seg < 3; ++seg) {
            if (seg == 0 && isc && last) continue;
            const v4u x0 = R.x[seg][0], x1 = R.x[seg][1], x2 = R.x[seg][2];
            const float* w0 = cw + seg * 512 + c8; const float* w1 = w0 + 1536; const float* w2 = w1 + 1536;
            const unsigned a0[4] = {x0.x, x0.y, x0.z, x0.w}, a1[4] = {x1.x, x1.y, x1.z, x1.w}, a2[4] = {x2.x, x2.y, x2.z, x2.w};
            float y[8]; float ss = 0.f;
#pragma unroll
            for (int j = 0; j < 4; ++j) {
                const float lo = bflo(a0[j]) * w0[2 * j] + bflo(a1[j]) * w1[2 * j] + bflo(a2[j]) * w2[2 * j];
                const float hi = bfhi(a0[j]) * w0[2 * j + 1] + bfhi(a1[j]) * w1[2 * j + 1] + bfhi(a2[j]) * w2[2 * j + 1];
                y[2 * j] = silu1(lo); y[2 * j + 1] = silu1(hi); ss += y[2 * j] * y[2 * j] + y[2 * j + 1] * y[2 * j + 1]; }
            float sc = 1.f;
            if (seg < 2) { ss += __shfl_xor(ss, 1); ss += __shfl_xor(ss, 2); ss += __shfl_xor(ss, 4); ss += __shfl_xor(ss, 8);
                sc = 1.0f / sqrtf(ss + EPS); if (seg == 0) sc *= 0.08838834764831845f; }
            v4u o; o.x = pk2(y[0] * sc, y[1] * sc); o.y = pk2(y[2] * sc, y[3] * sc); o.z = pk2(y[4] * sc, y[5] * sc); o.w = pk2(y[6] * sc, y[7] * sc);
            bf16* dst = (seg == 0 ? GQ : seg == 1 ? GK : GV) + (size_t)row * 512 + c8;
            *(GAS v4u*)dst = o;
        }
        if (F.lane < 8) {
            const int dir = F.lane >> 2, h = F.lane & 3; const float* zs = ZS + (size_t)row * 32 + 16;
            const float beta = sigm1(zs[dir * 4 + h]);
            const float g = -__expf(F.in[I_GDALOG][l * 8 + dir * 4 + h]) * softplus1(zs[(2 + dir) * 4 + h] + F.in[I_GDDTB][l * 8 + dir * 4 + h]);
            GG[((size_t)dir * MT + row) * 4 + h] = g; GB[((size_t)dir * MT + row) * 4 + h] = beta;
        }
    }
}
__device__ __forceinline__ void phase_gd1(Frame& F) {
    const bf16* GQ = (const bf16*)(F.ws + WS_MIX + MX_GQ); const bf16* GK = (const bf16*)(F.ws + WS_MIX + MX_GK); const bf16* GV = (const bf16*)(F.ws + WS_MIX + MX_GV);
    const float* GG = (const float*)(F.ws + WS_MIX + MX_GG); const float* GB = (const float*)(F.ws + WS_MIX + MX_GB);
    unsigned char* G1 = F.ws + WS_MIX + MX_GD1; float* GE = (float*)(F.ws + WS_MIX + MX_GE);
    LAS unsigned char* kl = F.lds + RING_OFF; LAS unsigned char* ql = kl + 17408; LAS unsigned char* vl = ql + 17408;
    LAS float* Mf = (LAS float*)(F.lds + RING_OFF + 52224);
    LAS unsigned char* Tl = F.lds + RING_OFF + 69632;
    LAS unsigned char* vsT = F.lds + RING_OFF + 78848; LAS unsigned char* ksT = F.lds + RING_OFF + 97280;
    LAS float* gc = (LAS float*)(F.lds + RING_OFF + 115712); LAS float* bt = gc + 64;
    const int tid = F.tid, lane = F.lane, g4 = lane >> 4, l15 = lane & 15;
    for (int it = blockIdx.x; it < 64 * 36; it += F.G) {
        TSTAMP(15); const int chain = it / 36, k = it % 36; int seqbase, T, n, h, dir; gd_slot(chain, k, seqbase, T, n, h, dir);
        unsigned char* out = G1 + (size_t)it * GD1_ITEM;
        bf16* WN = (bf16*)out; bf16* QD = (bf16*)(out + 16384); bf16* KT = (bf16*)(out + 32768); bf16* UT = (bf16*)(out + 49152); bf16* QKM = (bf16*)(out + 65536);
        const int sp = tid >> 3, sc0 = (tid & 7) * 16;
        { const int tok = dir ? T - 1 - (64 * n + sp) : 64 * n + sp; const size_t off = (size_t)(seqbase + tok) * 512 + h * 128 + sc0;
          *(LAS v4u*)(kl + sp * 272 + sc0 * 2) = *(const GAS v4u*)(GK + off); *(LAS v4u*)(kl + sp * 272 + sc0 * 2 + 16) = *(const GAS v4u*)(GK + off + 8);
          *(LAS v4u*)(ql + sp * 272 + sc0 * 2) = *(const GAS v4u*)(GQ + off); *(LAS v4u*)(ql + sp * 272 + sc0 * 2 + 16) = *(const GAS v4u*)(GQ + off + 8);
          *(LAS v4u*)(vl + sp * 272 + sc0 * 2) = *(const GAS v4u*)(GV + off); *(LAS v4u*)(vl + sp * 272 + sc0 * 2 + 16) = *(const GAS v4u*)(GV + off + 8); }
        if (tid < 64) { const int tok = dir ? T - 1 - (64 * n + tid) : 64 * n + tid; const size_t gi = ((size_t)dir * MT + seqbase + tok) * 4 + h;
            gc[tid] = wscan_sum_f(GG[gi], lane); bt[tid] = GB[gi]; }
        __syncthreads(); TSTAMP(8);
        const float gcend = gc[63];
        for (int rep2 = 0; rep2 < ((DUPS & 2) ? 2 : 1); ++rep2) { const int tp = tid & 63, tc0 = (tid >> 6) * 16;
          const float bj = bt[tp], bk = bj * __expf(gc[tp]);
#pragma unroll
          for (int hh = 0; hh < 2; ++hh) { const v4u vv = *(const LAS v4u*)(vl + tp * 272 + tc0 * 2 + 16 * hh), kk = *(const LAS v4u*)(kl + tp * 272 + tc0 * 2 + 16 * hh);
              const unsigned vw[4] = {vv.x, vv.y, vv.z, vv.w}, kw[4] = {kk.x, kk.y, kk.z, kk.w};
#pragma unroll
              for (int c = 0; c < 4; ++c) { const int col = tc0 + 8 * hh + 2 * c;
                  *(LAS bf16*)(vsT + col * 144 + tp * 2) = f2bf1(bflo(vw[c]) * bj); *(LAS bf16*)(vsT + (col + 1) * 144 + tp * 2) = f2bf1(bfhi(vw[c]) * bj);
                  *(LAS bf16*)(ksT + col * 144 + tp * 2) = f2bf1(bflo(kw[c]) * bk); *(LAS bf16*)(ksT + (col + 1) * 144 + tp * 2) = f2bf1(bfhi(kw[c]) * bk); } } }
        if (F.wave < 4) {
            const int i0 = 16 * F.wave; f32x4 acc[4];
#pragma unroll
            for (int ni = 0; ni < 4; ++ni) acc[ni] = (f32x4){0.f, 0.f, 0.f, 0.f};
#pragma unroll
            for (int ks = 0; ks < 4; ++ks) { const bf16x8 a = lds_frag(kl, 272, i0, ks * 64, lane);
#pragma unroll
                for (int ni = 0; ni < 4; ++ni) acc[ni] = MFMA16(a, lds_frag(kl, 272, 16 * ni, ks * 64, lane), acc[ni]); }
#pragma unroll
            for (int ni = 0; ni < 4; ++ni)
#pragma unroll
                for (int rr = 0; rr < 4; ++rr) { const int i = i0 + 4 * g4 + rr, j = 16 * ni + l15;
                    Mf[i * 68 + j] = (j < i) ? bt[i] * acc[ni][rr] * __expf(gc[i] - gc[j]) : 0.f; }
        } else {
            const int j0 = 16 * (F.wave - 4); f32x4 acc[4];
#pragma unroll
            for (int ni = 0; ni < 4; ++ni) acc[ni] = (f32x4){0.f, 0.f, 0.f, 0.f};
#pragma unroll
            for (int ks = 0; ks < 4; ++ks) { const bf16x8 a = lds_frag(kl, 272, j0, ks * 64, lane);
#pragma unroll
                for (int ni = 0; ni < 4; ++ni) acc[ni] = MFMA16(a, lds_frag(ql, 272, 16 * ni, ks * 64, lane), acc[ni]); }
            const int jt = F.wave - 4;
#pragma unroll
            for (int ni = 0; ni < 4; ++ni) { const int i = 16 * ni + l15; float v[4];
#pragma unroll
                for (int rr = 0; rr < 4; ++rr) { const int j = j0 + 4 * g4 + rr; v[rr] = (j <= i) ? acc[ni][rr] * __expf(gc[i] - gc[j]) : 0.f; }
                v2u o; o.x = pk2(v[0], v[1]); o.y = pk2(v[2], v[3]);
                *(GAS v2u*)(QKM + i * 64 + 32 * (jt >> 1) + 8 * g4 + 4 * (jt & 1)) = o; }
        }
        for (int rep4 = 0; rep4 < ((DUPS & 4) ? 2 : 1); ++rep4) { const int d = tid & 127, lq = tid >> 7; float v[16];
#pragma unroll
          for (int ll = 0; ll < 16; ++ll) { const int lp = 16 * lq + ll; v[ll] = bf1(((const LAS bf16*)(kl + lp * 272))[d]) * __expf(gcend - gc[lp]); }
#pragma unroll
          for (int g = 0; g < 4; ++g) { v2u o; o.x = pk2(v[4 * g], v[4 * g + 1]); o.y = pk2(v[4 * g + 2], v[4 * g + 3]);
              *(GAS v2u*)(KT + d * 64 + 32 * (lq >> 1) + 8 * g + 4 * (lq & 1)) = o; } }
        for (int rep8 = 0; rep8 < ((DUPS & 8) ? 2 : 1); ++rep8) { const int lq = tid & 63, db = tid >> 6; const float e = __expf(gc[lq]); const LAS bf16* qr = (const LAS bf16*)(ql + lq * 272) + 16 * db; float v[16];
#pragma unroll
          for (int dd = 0; dd < 16; ++dd) v[dd] = bf1(qr[dd]) * e;
#pragma unroll
          for (int g = 0; g < 4; ++g) { v2u o; o.x = pk2(v[4 * g], v[4 * g + 1]); o.y = pk2(v[4 * g + 2], v[4 * g + 3]);
              *(GAS v2u*)(QD + lq * 128 + 32 * (db >> 1) + 8 * g + 4 * (db & 1)) = o; } }
        if (tid == 0) GE[it * 32] = __expf(gcend);
        __syncthreads(); TSTAMP(9);
        for (int rep = 0; rep < ((DUPS & 1) ? 2 : 1); ++rep) { const int cb = 8 * F.wave; float res[8];
#pragma unroll
          for (int cc = 0; cc < 8; ++cc) res[cc] = (lane == cb + cc) ? 1.0f : 0.0f;
          f32x4 m4 = *(const LAS f32x4*)(Mf + lane * 68 + cb);
          for (int j = cb; j < 64; j += 4) { const f32x4 mc = m4; if (j + 4 < 64) m4 = *(const LAS f32x4*)(Mf + lane * 68 + j + 4);
#pragma unroll
              for (int q = 0; q < 4; ++q) { const float mj = mc[q];
#pragma unroll
                  for (int cc = 0; cc < 8; ++cc) { const float xj = __builtin_bit_cast(float, __builtin_amdgcn_readlane(__builtin_bit_cast(int, res[cc]), j + q)); res[cc] -= mj * xj; } } }
          v4u o; o.x = pk2(res[0], res[1]); o.y = pk2(res[2], res[3]); o.z = pk2(res[4], res[5]); o.w = pk2(res[6], res[7]);
          *(LAS v4u*)(Tl + lane * 144 + cb * 2) = o; }
        __syncthreads(); TSTAMP(10);
        if (F.wave < 4) {
            f32x4 acc[8];
#pragma unroll
            for (int ni = 0; ni < 8; ++ni) acc[ni] = (f32x4){0.f, 0.f, 0.f, 0.f};
#pragma unroll
            for (int ks = 0; ks < 2; ++ks) { const bf16x8 a = lds_frag(Tl, 144, 16 * F.wave, ks * 64, lane);
#pragma unroll
                for (int ni = 0; ni < 8; ++ni) acc[ni] = MFMA16(a, lds_frag(vsT, 144, 16 * ni, ks * 64, lane), acc[ni]); }
#pragma unroll
            for (int ni = 0; ni < 8; ++ni) { v2u o; o.x = pk2(acc[ni][0], acc[ni][1]); o.y = pk2(acc[ni][2], acc[ni][3]);
                *(GAS v2u*)(UT + (16 * ni + l15) * 64 + 16 * F.wave + 4 * g4) = o; }
        } else {
            const int it4 = F.wave - 4; f32x4 acc[8];
#pragma unroll
            for (int mi = 0; mi < 8; ++mi) acc[mi] = (f32x4){0.f, 0.f, 0.f, 0.f};
#pragma unroll
            for (int ks = 0; ks < 2; ++ks) { const bf16x8 bfr = lds_frag(Tl, 144, 16 * it4, ks * 64, lane);
#pragma unroll
                for (int mi = 0; mi < 8; ++mi) acc[mi] = MFMA16(lds_frag(ksT, 144, 16 * mi, ks * 64, lane), bfr, acc[mi]); }
#pragma unroll
            for (int mi = 0; mi < 8; ++mi) { v2u o; o.x = pk2(-acc[mi][0], -acc[mi][1]); o.y = pk2(-acc[mi][2], -acc[mi][3]);
                *(GAS v2u*)(WN + (16 * it4 + l15) * 128 + 32 * (mi >> 1) + 8 * g4 + 4 * (mi & 1)) = o; }
        }
        __syncthreads(); TSTAMP(11);
    }
}
constexpr int GD2_BUF = 62464;
__device__ __forceinline__ void gd2_load(const unsigned char* src, v4u (&r)[7], int tid) {
#pragma unroll
    for (int j = 0; j < 7; ++j) r[j] = *(const GAS v4u*)(src + (size_t)(tid + 512 * j) * 16);
}
__device__ __forceinline__ void gd2_store(LAS unsigned char* buf, const v4u (&r)[7], int tid) {
#pragma unroll
    for (int j = 0; j < 7; ++j) { const int pc = tid + 512 * j;
        int off;
        if (pc < 1024) off = (pc >> 4) * 272 + (pc & 15) * 16;
        else if (pc < 2048) off = 17408 + ((pc - 1024) >> 4) * 272 + (pc & 15) * 16;
        else if (pc < 3072) off = 44032 + ((pc - 2048) >> 3) * 144 + (pc & 7) * 16;
        else off = 34816 + ((pc - 3072) >> 3) * 144 + (pc & 7) * 16;
        *(LAS v4u*)(buf + off) = r[j]; }
}
__device__ __forceinline__ void phase_gd2(Frame& F, bool last) {
    const unsigned char* G1 = F.ws + WS_MIX + MX_GD1; const float* GE = (const float*)(F.ws + WS_MIX + MX_GE);
    float* GO = (float*)(F.ws + WS_H);
    const int tid = F.tid, lane = F.lane, g4 = lane >> 4, l15 = lane & 15, e0 = 16 * F.wave;
    for (int chain = blockIdx.x; chain < 64; chain += F.G) {
        const int h = (chain >> 1) & 3, dir = chain & 1, b = chain >> 3;
        f32x4 S[8];
#pragma unroll
        for (int db = 0; db < 8; ++db) S[db] = (f32x4){0.f, 0.f, 0.f, 0.f};
        v4u r[7];
        { const unsigned char* it0 = G1 + (size_t)(chain * 36) * GD1_ITEM;
#pragma unroll
          for (int j = 0; j < 7; ++j) { const int pc = tid + 512 * j; const int gp = pc < 3072 ? pc : pc + 1024; r[j] = *(const GAS v4u*)(it0 + (size_t)gp * 16); } }
        gd2_store(F.lds + RING_OFF, r, tid);
        v2u un[4]; float gn;
        { const unsigned char* it0 = G1 + (size_t)(chain * 36) * GD1_ITEM; const bf16* UT0 = (const bf16*)(it0 + 49152);
#pragma unroll
          for (int lb = 0; lb < 4; ++lb) un[lb] = *(const GAS v2u*)(UT0 + (e0 + l15) * 64 + 16 * lb + 4 * g4);
          gn = GE[(chain * 36) * 32]; }
        __syncthreads();
        for (int k = 0; k < 36; ++k) {
            LAS unsigned char* buf = F.lds + RING_OFF + (k & 1) * GD2_BUF;
            const unsigned char* item = G1 + (size_t)(chain * 36 + k) * GD1_ITEM;
            if (k + 1 < 36) { const unsigned char* nx = item + GD1_ITEM;
#pragma unroll
                for (int j = 0; j < 7; ++j) { const int pc = tid + 512 * j; const int gp = pc < 3072 ? pc : pc + 1024; r[j] = *(const GAS v4u*)(nx + (size_t)gp * 16); } }
            v2u uc[4];
#pragma unroll
            for (int lb = 0; lb < 4; ++lb) uc[lb] = un[lb];
            const float gend = gn;
            if (k + 1 < 36) { const bf16* UTn = (const bf16*)(item + GD1_ITEM + 49152);
#pragma unroll
                for (int lb = 0; lb < 4; ++lb) un[lb] = *(const GAS v2u*)(UTn + (e0 + l15) * 64 + 16 * lb + 4 * g4);
                gn = GE[(chain * 36 + k + 1) * 32]; }
            int seqbase, T, n; if (k < 4) { seqbase = ML + b * CTXL; T = CTXL; n = k; } else { seqbase = b * SEQ; T = SEQ; n = k - 4; }
            bf16x8 Sb[4];
#pragma unroll
            for (int ks = 0; ks < 4; ++ks) { v4u w; w.x = pk2(S[2 * ks][0], S[2 * ks][1]); w.y = pk2(S[2 * ks][2], S[2 * ks][3]); w.z = pk2(S[2 * ks + 1][0], S[2 * ks + 1][1]); w.w = pk2(S[2 * ks + 1][2], S[2 * ks + 1][3]);
                Sb[ks] = __builtin_bit_cast(bf16x8, w); }
            f32x4 vn[4];
#pragma unroll
            for (int lb = 0; lb < 4; ++lb) { const v2u uu = uc[lb];
                f32x4 acc = (f32x4){bflo(uu.x), bfhi(uu.x), bflo(uu.y), bfhi(uu.y)};
#pragma unroll
                for (int ks = 0; ks < 4; ++ks) acc = MFMA16(lds_frag(buf, 272, 16 * lb, ks * 64, lane), Sb[ks], acc);
                vn[lb] = acc; }
            bf16x8 Vb[2];
#pragma unroll
            for (int ks = 0; ks < 2; ++ks) { v4u w; w.x = pk2(vn[2 * ks][0], vn[2 * ks][1]); w.y = pk2(vn[2 * ks][2], vn[2 * ks][3]); w.z = pk2(vn[2 * ks + 1][0], vn[2 * ks + 1][1]); w.w = pk2(vn[2 * ks + 1][2], vn[2 * ks + 1][3]);
                Vb[ks] = __builtin_bit_cast(bf16x8, w); }
            const bool wr_o = !(last && k < 4);
#pragma unroll
            for (int lb = 0; lb < 4; ++lb) { f32x4 acc = (f32x4){0.f, 0.f, 0.f, 0.f};
#pragma unroll
                for (int ks = 0; ks < 4; ++ks) acc = MFMA16(lds_frag(buf + 17408, 272, 16 * lb, ks * 64, lane), Sb[ks], acc);
#pragma unroll
                for (int ks = 0; ks < 2; ++ks) acc = MFMA16(lds_frag(buf + 34816, 144, 16 * lb, ks * 64, lane), Vb[ks], acc);
                if (wr_o) {
#pragma unroll
                    for (int rr = 0; rr < 4; ++rr) { const int p = 16 * lb + 4 * g4 + rr; const int tok = dir ? T - 1 - (64 * n + p) : 64 * n + p;
                        GO[((size_t)dir * MT + seqbase + tok) * 512 + h * 128 + e0 + l15] = acc[rr]; } } }
#pragma unroll
            for (int db = 0; db < 8; ++db) { f32x4 acc = S[db] * gend;
#pragma unroll
                for (int ks = 0; ks < 2; ++ks) acc = MFMA16(lds_frag(buf + 44032, 144, 16 * db, ks * 64, lane), Vb[ks], acc);
                S[db] = acc; }
            if (k + 1 < 36) gd2_store(F.lds + RING_OFF + ((k + 1) & 1) * GD2_BUF, r, tid);
            __syncthreads();
        }
    }
}
__device__ __forceinline__ void phase_gd3(Frame& F, int l, bool last) {
    const float* GO = (const float*)(F.ws + WS_H); const bf16* Z = (const bf16*)(F.ws + WS_Z); bf16* Y2 = (bf16*)(F.ws + WS_Y) + (size_t)2 * MT * 512;
    const int gw = blockIdx.x * NWAVES + F.wave, NGW = F.G * NWAVES, c8 = F.lane * 8; const int nrows = last ? ML : MT;
    const float* gn = F.in[I_GDN] + l * 128 + (c8 & 127);
    for (int row = gw; row < nrows; row += NGW) {
        const f32x4 a0 = *(const f32x4*)(GO + (size_t)row * 512 + c8), a1 = *(const f32x4*)(GO + (size_t)row * 512 + c8 + 4);
        const f32x4 b0 = *(const f32x4*)(GO + ((size_t)MT + row) * 512 + c8), b1 = *(const f32x4*)(GO + ((size_t)MT + row) * 512 + c8 + 4);
        const f32x4 s0 = a0 + b0, s1 = a1 + b1;
        float ss = (s0.x * s0.x + s0.y * s0.y) + (s0.z * s0.z + s0.w * s0.w) + (s1.x * s1.x + s1.y * s1.y) + (s1.z * s1.z + s1.w * s1.w);
        ss += __shfl_xor(ss, 1); ss += __shfl_xor(ss, 2); ss += __shfl_xor(ss, 4); ss += __shfl_xor(ss, 8);
        const float rs = 1.0f / sqrtf(ss * (1.0f / 128.0f) + EPS);
        const v4u zz = *(const GAS v4u*)(Z + (size_t)row * ZLD + ZC_GDZ + c8);
        const float o[8] = {s0.x, s0.y, s0.z, s0.w, s1.x, s1.y, s1.z, s1.w}; const float zf[8] = {bflo(zz.x), bfhi(zz.x), bflo(zz.y), bfhi(zz.y), bflo(zz.z), bfhi(zz.z), bflo(zz.w), bfhi(zz.w)};
        float y[8];
#pragma unroll
        for (int j = 0; j < 8; ++j) y[j] = o[j] * rs * gn[j] * silu1(zf[j]);
        v4u w; w.x = pk2(y[0], y[1]); w.y = pk2(y[2], y[3]); w.z = pk2(y[4], y[5]); w.w = pk2(y[6], y[7]);
        *(GAS v4u*)(Y2 + (size_t)row * 512 + c8) = w;
    }
}
#ifndef DUPC
#define DUPC 0
#endif
constexpr int CW_Q = 2048;
__device__ __forceinline__ int q_pull(Frame& F, int qi) {
    volatile LAS unsigned* slot = F.MISC + 16;
    __syncthreads();
    if (F.tid == 0) *slot = __hip_atomic_fetch_add((unsigned*)(F.ctl + CW_Q + 64 * qi), 1u, __ATOMIC_RELAXED, __HIP_MEMORY_SCOPE_AGENT);
    __syncthreads();
    return (int)*slot;
}
__device__ __forceinline__ void phase_mixc(Frame& F, int l, bool last, int qo = 0) {
    TSTAMP(16); TSTAMPL(20); for (int rep = 0; rep < ((DUPC & 4) ? 2 : 1); ++rep) if ((int)blockIdx.x < 64 || F.G < 128) phase_gd2(F, last);
    TSTAMP(17);
    const int n_att = last ? 256 : 288, n_ml3 = last ? 512 : 576;
    for (int rep = 0; rep < ((DUPC & 1) ? 2 : 1); ++rep) for (;;) { const int idx = q_pull(F, 2 * l + 8 * rep); if (idx >= n_att) break; attn_item(F, idx); }
    TSTAMP(18); TSTAMPL(21);
    for (int rep = 0; rep < ((DUPC & 2) ? 2 : 1); ++rep) for (;;) { const int idx = q_pull(F, 2 * l + 1 + 8 * rep); if (idx >= n_ml3) break; ml3_item(F, l, idx); }
    TSTAMP(19); TSTAMPL(22);
}
#ifndef DUPA
#define DUPA 0
#endif
#define MIX_PHASE_1 TSTAMP(0); phase_attn_prep(F, l, last); TSTAMP(1); phase_gd0(F, l, last); TSTAMP(2); __syncthreads(); phase_ml1(F, l); TSTAMP(3);
#define MIX_PHASE_2 TSTAMP(4); __syncthreads(); phase_spatial(F, l, last); TSTAMP(5); __syncthreads(); phase_gd1(F); TSTAMP(6); phase_ml2(F, 0); TSTAMP(7);
#define MIX_PHASE_3 phase_mixc(F, l, last);
#define MIX_PHASE_4 phase_gd3(F, l, last);
#ifndef PROBE
#define PROBE 0
#endif
#ifndef DUPMIX
#define DUPMIX 0
#endif
#ifndef DUPG
#define DUPG 0
#endif
#ifdef DUPAUX
#define DUP_AUX(x) x
#else
#define DUP_AUX(x)
#endif
#ifndef TPROBE
#define TPROBE 0
#endif
constexpr int PH_PER_LAYER = 15, N_PHASES = PROBE ? (1 + PH_PER_LAYER + 1) : (1 + NLAYER * PH_PER_LAYER + (TPROBE ? 1 : 0));
#ifndef PHMASK
#define PHMASK 0xffff
#endif
#define PHEN(k) ((PHMASK >> (k)) & 1)
#define IN(p) (lo <= (p) && (p) < hi)
#ifndef TPROBE
#define TPROBE 0
#endif
#if TPROBE
#define SEAM(p) do { if (lo <= (p) && (p) + 1 < hi) { xcd_barrier(bar); if (blockIdx.x == 0 && F.tid == 0) ((unsigned long long*)(F.ws + WS_CTL + 524288))[(p) + 1] = wall_clock64(); } } while (0)
#else
#ifdef DUPBAR
#define SEAM(p) do { if (lo <= (p) && (p) + 1 < hi) { xcd_barrier(bar); xcd_barrier(bar); } } while (0)
#else
#define SEAM(p) do { if (lo <= (p) && (p) + 1 < hi) xcd_barrier(bar); } while (0)
#endif
#endif
struct Args { const float* in[27]; float* out; unsigned char* ws; int ph_lo, ph_hi, li, pad; };
template <int l> __device__ __forceinline__ void layer_body(Frame& F, const XcdBarrier& bar, const int lo, const int hi) {
    float* MOD = (float*)(F.ws + WS_MOD);
    float* XC = (float*)(F.ws + WS_XC);
    bf16* Hb = (bf16*)(F.ws + WS_H); bf16* Zb = (bf16*)(F.ws + WS_Z); bf16* ACT = (bf16*)(F.ws + WS_Z); float* ZS = (float*)(F.ws + WS_ZS);
    bf16* WFI = (bf16*)(F.ws + WS_WFI); bf16* WFO = (bf16*)(F.ws + WS_WFO); bf16* WZ = (bf16*)(F.ws + WS_WZ); bf16* WB = (bf16*)(F.ws + WS_WB); bf16* WO = (bf16*)(F.ws + WS_WO);
    bf16* Yb = (bf16*)(F.ws + WS_Y); float* PB = (float*)(F.ws + WS_MIX);
    const int vc = (F.G % 8 == 0) ? ((int)blockIdx.x % 8) * (F.G / 8) + (int)blockIdx.x / 8 : (int)blockIdx.x;
        constexpr int P = 1 + l * PH_PER_LAYER;
        constexpr bool last = (l == NLAYER - 1);
        const float* modl = MOD + (size_t)l * 9 * MODW;
        bf16* XL = (bf16*)F.out; bf16* XL2 = (bf16*)(F.ws + WS_Y);
        const void* xin_l = (l == 0) ? (const void*)F.in[I_X] : (const void*)XL;
        const float* xin_c = (l == 0) ? F.in[I_CTX] : XC;
        constexpr int nPM = last ? 64 : 72;

        if (PHEN(0) && IN(P + 0)) { if (l == 0) { phase_mod(F); phase_rope(F); __syncthreads(); } conv_set(F, l, 0); conv_set(F, l, 2); }
        SEAM(P + 0);
        if (PHEN(1) && IN(P + 1)) phase_norm<(l == 0), (l > 0), false>(F, xin_l, xin_c, F.in[I_F1N] + (size_t)l * D, modl + 0 * D, MT);
        SEAM(P + 1);
        if (PHEN(2) && IN(P + 2)) {
            pg8::Gemm g{Hb, WFI, MT, 2 * DFF, D, 1, 1}; pg8::TileOrder S; S.init(72, 44, 0, 0, 0, F.G, (int)blockIdx.x, 32);
            pg8::EpiSwiglu E{ACT, DFF};
            pg8::gemm_phase<pg8::EpiSwiglu, pg8::TileOrder, PG8_ALIGN, PG8_SP2>(F.lds + RING_OFF, g, S, E);
            if (DUPG & 2) { __syncthreads(); pg8::gemm_phase<pg8::EpiSwiglu, pg8::TileOrder, PG8_ALIGN, PG8_SP2>(F.lds + RING_OFF, g, S, E); }
        }
        SEAM(P + 2);
        if (PHEN(3) && IN(P + 3)) {
            pg8::Gemm g{ACT, WFO, MT, D, DFF, 1, 1};
            { pg8::TileOrder S; S.init(64, 8, 0, 0, 0, F.G, (int)blockIdx.x, DFF / 64); S.wgm = WGM_N8; pg8::EpiResB<false> E{XL, XL, nullptr, modl + 2 * D, 0.5f};
              pg8::gemm_phase<pg8::EpiResB<false>, pg8::TileOrder, PG8_ALIGN, PG8_SP2>(F.lds + RING_OFF, g, S, E); }
            { pg8::QuarterOrder S; S.init(8, 64, DFF / 256, F.G, (int)blockIdx.x); pg8::EpiRes<true> E{nullptr, PB, modl + 2 * D, 0.5f};
              pg8::gemm_phase<pg8::EpiRes<true>, pg8::QuarterOrder, PG8_ALIGN, PG8_SP2>(F.lds + RING_OFF, g, S, E); }
        }
        SEAM(P + 3);
        if (PHEN(4) && IN(P + 4)) phase_norm<false, true, !last>(F, XL, XC, F.in[I_MIXN] + (size_t)l * D, modl + 3 * D, MT);
        SEAM(P + 4);
        if (PHEN(5) && IN(P + 5)) {
            pg8::Gemm g{Hb, WZ, MT, NZ, D, 1, 1}; pg8::TileOrder S;
            if (last) S.init(64, 57, 8, NKV_TILES, 64, F.G, (int)blockIdx.x, 32); else S.init(64, 57, 8, 56, 64, F.G, (int)blockIdx.x, 32, 10);
            pg8::EpiZ E{Zb, ZS, ZLD, (bf16*)(F.ws + WS_GT)};
            pg8::gemm_phase<pg8::EpiZ, pg8::TileOrder, PG8_ALIGN, PG8_SP2>(F.lds + RING_OFF, g, S, E);
            if (DUPG & 1) { __syncthreads(); pg8::gemm_phase<pg8::EpiZ, pg8::TileOrder, PG8_ALIGN, PG8_SP2>(F.lds + RING_OFF, g, S, E); }
        }
        SEAM(P + 5);
        if (PHEN(6) && IN(P + 6)) { conv_set(F, l, 1); MIX_PHASE_1 if (DUPMIX & 1) { __syncthreads(); MIX_PHASE_1 } }
        SEAM(P + 6);
        if (PHEN(7) && IN(P + 7)) { MIX_PHASE_2 if (DUPMIX & 2) { __syncthreads(); MIX_PHASE_2 } }
        SEAM(P + 7);
        if (PHEN(8) && IN(P + 8)) { MIX_PHASE_3 }
        SEAM(P + 8);
        if (PHEN(9) && IN(P + 9)) { MIX_PHASE_4 if (DUPMIX & 8) { __syncthreads(); MIX_PHASE_4 } }
        SEAM(P + 9);
        if (PHEN(10) && IN(P + 10)) {
#ifdef STAGGER
            if ((blockIdx.x >> 3) & 1) { const unsigned long long t0 = wall_clock64(); while (wall_clock64() - t0 < (unsigned long long)STAGGER) __builtin_amdgcn_s_sleep(32); }
#endif
            pg8::Gemm g{Yb, WB, 4 * MT, 4 * D, 512, 1}; pg8::BranchOrder S; S.init(nPM, 72, F.G, (int)blockIdx.x);
            pg8::EpiBranch E{(const bf16*)(F.ws + WS_GT), Hb, 72};
            pg8::gemm_phase<pg8::EpiBranch, pg8::BranchOrder, PG8_ALIGN, PG8_SP2>(F.lds + RING_OFF, g, S, E);
            if (DUPG & 4) { __syncthreads(); pg8::gemm_phase<pg8::EpiBranch, pg8::BranchOrder, PG8_ALIGN, PG8_SP2>(F.lds + RING_OFF, g, S, E); }
        }
        SEAM(P + 10);
        if (PHEN(11) && IN(P + 11)) {
            pg8::Gemm g{Hb, WO, MT, D, D, 1, 1};
            { pg8::TileOrder S; S.init(64, 8, 0, 0, 0, F.G, (int)blockIdx.x, D / 64); S.wgm = WGM_N8; pg8::EpiResB<false> E{XL, last ? XL2 : XL, nullptr, modl + 5 * D, 1.0f};
              pg8::gemm_phase<pg8::EpiResB<false>, pg8::TileOrder, PG8_ALIGN, PG8_SP2>(F.lds + RING_OFF, g, S, E); }
            if constexpr (nPM == 72) { pg8::QuarterOrder S; S.init(8, 64, D / 256, F.G, (int)blockIdx.x); pg8::EpiRes<true> E{nullptr, PB, modl + 5 * D, 1.0f};
              pg8::gemm_phase<pg8::EpiRes<true>, pg8::QuarterOrder, PG8_ALIGN, PG8_SP2>(F.lds + RING_OFF, g, S, E); }
        }
        SEAM(P + 11);
        if (PHEN(12) && IN(P + 12)) { phase_norm<false, (nPM == 72), false>(F, last ? XL2 : XL, XC, F.in[I_F2N] + (size_t)l * D, modl + 6 * D, nPM * 256);
#ifdef DUPN
            if (nPM == 64) { phase_norm<false, false, false>(F, last ? XL2 : XL, XC, F.in[I_F2N] + (size_t)l * D, modl + 6 * D, nPM * 256); phase_norm<false, false, false>(F, last ? XL2 : XL, XC, F.in[I_F2N] + (size_t)l * D, modl + 6 * D, nPM * 256); }
#endif
        }
        SEAM(P + 12);
        if (PHEN(13) && IN(P + 13)) {
            pg8::Gemm g{Hb, WFI, MT, 2 * DFF, D, 1, 1}; pg8::TileOrder S; S.init(nPM, 44, 0, 0, 0, F.G, (int)blockIdx.x, 32);
            pg8::EpiSwiglu E{ACT, DFF};
            pg8::gemm_phase<pg8::EpiSwiglu, pg8::TileOrder, PG8_ALIGN, PG8_SP2>(F.lds + RING_OFF, g, S, E);
        }
        SEAM(P + 13);
        if (PHEN(14) && IN(P + 14)) {
            pg8::Gemm g{ACT, WFO, MT, D, DFF, 1, 1};
            { pg8::TileOrder S; S.init(64, 8, 0, 0, 0, F.G, (int)blockIdx.x, DFF / 64); S.wgm = WGM_N8; pg8::EpiResB<last> E{last ? XL2 : XL, XL, F.out, modl + 8 * D, 0.5f};
              pg8::gemm_phase<pg8::EpiResB<last>, pg8::TileOrder, PG8_ALIGN, PG8_SP2>(F.lds + RING_OFF, g, S, E); }
            if constexpr (nPM == 72) { pg8::QuarterOrder S; S.init(8, 64, DFF / 256, F.G, (int)blockIdx.x); pg8::EpiRes<true> E{nullptr, PB, modl + 8 * D, 0.5f};
              pg8::gemm_phase<pg8::EpiRes<true>, pg8::QuarterOrder, PG8_ALIGN, PG8_SP2>(F.lds + RING_OFF, g, S, E); }
        }
        SEAM(P + 14);
    }
__global__ void __launch_bounds__(NWAVES * 64, 2) mk_fwd(Args args) {
    extern __shared__ __attribute__((aligned(16))) unsigned char lds[];
    Frame F;
    F.lds = (LAS unsigned char*)lds;
    F.MISC = (volatile LAS unsigned*)(F.lds + MISC_OFF);
    F.tid = threadIdx.x; F.lane = F.tid & 63; F.wave = __builtin_amdgcn_readfirstlane(F.tid >> 6);
    F.G = gridDim.x;
    F.ws = args.ws; F.ctl = (gu32*)(args.ws + WS_CTL); F.out = args.out;
    F.in = args.in;
    for (int u = F.tid; u < (LDS_BYTES - LDSCTL_OFF) / 4; u += NWAVES * 64) ((LAS unsigned*)(F.lds + LDSCTL_OFF))[u] = 0u;
    __syncthreads();
    const int lo = args.ph_lo, hi = args.ph_hi;
#if TPROBE
    if (blockIdx.x == 0 && F.tid == 0) { const unsigned long long t0_ = wall_clock64(); ((unsigned long long*)(F.ws + WS_CTL + 524288))[0] = t0_; ((unsigned long long*)(F.ws + WS_CTL + 524288))[1] = t0_; }
#endif
    XcdBarrier bar; bar.bar = (unsigned*)(F.ctl + CW_BAR) + args.li * XCD_BAR_WORDS; bar.x = 0; bar.st = nullptr;
    if (hi - lo > 1) bar = xcd_barrier_post((unsigned*)(F.ctl + CW_BAR) + args.li * XCD_BAR_WORDS, F.MISC + 8);


    layer_body<0>(F, bar, lo, hi);
#if !PROBE
    layer_body<1>(F, bar, lo, hi);
#endif
#if TPROBE == 1
    if (IN(31)) {
        const unsigned long long* TS = (const unsigned long long*)(F.ws + WS_CTL + 524288);
        const float tot = (float)(TS[31] - TS[0]);
        const float fa = (float)(TS[TP_A2] - TS[TP_A1]) / tot, fb = (float)(TS[TP_B2] - TS[TP_B1]) / tot;
        const size_t n = (size_t)ML * D; float* o = F.out;
        for (size_t i = (size_t)blockIdx.x * 512 + F.tid; i < n; i += (size_t)F.G * 512) { float v = o[i] * (1.0f + fa); if (i == 0) v += 10000.0f * fb; o[i] = v; }
    }
#endif
#if TPROBE == 2
    if (blockIdx.x == 0 && F.tid == 0) {
        unsigned long long* TS = (unsigned long long*)(F.ws + WS_CTL + 524288);
        unsigned long long sum = 0ull;
#ifdef TSEG_A
        sum += __hip_atomic_load(TS + 40 + TSEG_B, __ATOMIC_RELAXED, __HIP_MEMORY_SCOPE_AGENT) - __hip_atomic_load(TS + 40 + TSEG_A, __ATOMIC_RELAXED, __HIP_MEMORY_SCOPE_AGENT);
#endif
        for (int p = 0; p < 31; ++p) if ((TMASK >> p) & 1ull) sum += __hip_atomic_load(TS + p + 1, __ATOMIC_RELAXED, __HIP_MEMORY_SCOPE_AGENT) - __hip_atomic_load(TS + p, __ATOMIC_RELAXED, __HIP_MEMORY_SCOPE_AGENT);
        const unsigned long long t0 = wall_clock64(), want = (unsigned long long)TAMP * sum;
        while (wall_clock64() - t0 < want) __builtin_amdgcn_s_sleep(16);
    }
#endif
#if PROBE
    if (IN(16)) {
        const size_t n = (size_t)ML * D; float* o = F.out;
        for (size_t i = (size_t)blockIdx.x * 512 + F.tid; i < n; i += (size_t)F.G * 512) { const size_t r = i / D, c = i % D;
#if PROBE == 1
            o[i] = bf1(((const bf16*)(F.ws + WS_Y))[(size_t)MT * 512 + r * 512 + (c & 511)]);
#elif PROBE == 2
            o[i] = bf1(((const bf16*)(F.ws + WS_MIX + MX_CP))[(i % ((size_t)1152 * 16384))]);
#elif PROBE == 3
            o[i] = bf1(((const bf16*)(F.ws + WS_MIX + MX_CL))[(i % ((size_t)1152 * 16384))]);
#elif PROBE == 4
            o[i] = ((const float*)(F.ws + WS_ZS))[(i % ((size_t)ML * 32))];
#endif
        }
    }
#endif
#undef IN
#undef SEAM
}

#ifndef MK_N_LAUNCHES
#define MK_N_LAUNCHES 1
#endif
extern "C" void kernel_launch(void* const* d_in, const int* in_sizes, int n_in, void* d_out, int out_size, void* d_ws, size_t ws_size, hipStream_t stream) {
    static int grid = 0;
    if (grid == 0) {
        if (n_in != 27 || in_sizes[0] != ML * D || out_size != ML * D || ws_size < WS_END) { fprintf(stderr, "kernel_launch: shape mismatch n_in %d in0 %d out %d ws %zu (need %zu)\n", n_in, n_in > 0 ? in_sizes[0] : -1, out_size, ws_size, (size_t)WS_END); grid = -1; return; }
        int dev = 0, cus = 0, per_cu = 0;
        if (hipGetDevice(&dev) != hipSuccess || hipDeviceGetAttribute(&cus, hipDeviceAttributeMultiprocessorCount, dev) != hipSuccess) { grid = -1; return; }
        if (hipFuncSetAttribute((const void*)mk_fwd, hipFuncAttributeMaxDynamicSharedMemorySize, LDS_BYTES) != hipSuccess) { fprintf(stderr, "kernel_launch: hipFuncSetAttribute failed\n"); grid = -1; return; }
        if (hipOccupancyMaxActiveBlocksPerMultiprocessor(&per_cu, (const void*)mk_fwd, NWAVES * 64, LDS_BYTES) != hipSuccess || per_cu < 1)
            fprintf(stderr, "kernel_launch: note: occupancy query reports %d workgroups per CU\n", per_cu);
        (void)hipGetLastError();
        grid = cus;
    }
    if (grid < 0) return;
    if (hipMemsetAsync((char*)d_ws + WS_CTL, 0, CTL_ZERO_BYTES, stream) != hipSuccess) return;
    Args a{};
    for (int i = 0; i < 27; ++i) a.in[i] = (const float*)d_in[i];
    a.out = (float*)d_out; a.ws = (unsigned char*)d_ws; a.pad = 0;
#if MK_N_LAUNCHES == 1
    a.ph_lo = 0; a.ph_hi = N_PHASES; a.li = 0;
    hipLaunchKernelGGL(mk_fwd, dim3(grid), dim3(NWAVES * 64), LDS_BYTES, stream, a);
#else
    for (int p = 0; p < N_PHASES; ++p) { a.ph_lo = p; a.ph_hi = p + 1; a.li = 0;
        hipLaunchKernelGGL(mk_fwd, dim3(grid), dim3(NWAVES * 64), LDS_BYTES, stream, a); }
#endif
    const hipError_t le = hipPeekAtLastError();
    if (le != hipSuccess) fprintf(stderr, "kernel_launch: launch failed: %s\n", hipGetErrorName(le));
}
```
